# Optimizing an MI355X kernel written in HIP

```python
import math
import jax
import jax.numpy as jnp
from jax import lax
import numpy as np

D_MODEL = 1024
BATCH = 4
SEQ = 4096
DEPTH = 4

GRID_W = 64
CTX_LEN = 256
N_EVEN = (DEPTH + 1) // 2
N_ODD = DEPTH // 2
NORM_EPS = 1e-6
N_MOD = 6

RW_WIDTH = D_MODEL // 2
RW_HEAD = 64
RW_HEADS = RW_WIDTH // RW_HEAD
RW_DECAY_RANK = 32
RW_A_RANK = 32
RW_GATE_RANK = 96
RW_GN_EPS = 64e-5
RW_SPLITS = (RW_WIDTH, 2 * RW_WIDTH, 3 * RW_WIDTH, 3 * RW_WIDTH + 2 * RW_DECAY_RANK, 3 * RW_WIDTH + 2 * RW_DECAY_RANK + 2 * RW_A_RANK)
RW_COLS = 3 * RW_WIDTH + 2 * RW_DECAY_RANK + 2 * RW_A_RANK + RW_GATE_RANK

HY_WIDTH = D_MODEL - RW_WIDTH
HY_ORDER = 2
HY_EMB = 33
HY_BANDS = (HY_EMB - 1) // 2
HY_FILTER_HIDDEN = 64
HY_DECAY_TARGET = 1e-2
HY_FAST_DECAY = 0.3
HY_SLOW_DECAY = 1.5
HY_COLS = (HY_ORDER + 1) * HY_WIDTH
EVEN_COLS = RW_COLS + HY_COLS

DA_HEADS = 8
DA_HEAD = 64
DA_QCOLS = DA_HEADS * 2 * DA_HEAD
DA_COLS = 3 * DA_QCOLS
ROPE_BASE = 10000.0
Q_BLOCK = 128

N_EXPERTS = 16
EXPERT_HIDDEN = 1024
CAPACITY_FACTOR = 2

kernel_name = "hybrid_rwkv7_hyena_diffattn_ecmoe_dit"


def rms_norm(x, g, eps=NORM_EPS):
    x32 = x.astype(jnp.float32)
    y = x32 * lax.rsqrt(jnp.mean(x32 * x32, axis=-1, keepdims=True) + eps)
    return (y * g.astype(jnp.float32)).astype(x.dtype)


def modulate(x, g, shift, scale):
    return rms_norm(x, g) * (1 + scale[..., None, :]) + shift[..., None, :]


def rwkv_inputs(u, mu, w0, w2, a0, a2, g2, k_k, k_a):
    B, L, _ = u.shape
    u_prev = jnp.pad(u, ((0, 0), (1, 0), (0, 0)))[:, :-1]
    u_next = jnp.pad(u, ((0, 0), (0, 1), (0, 0)))[:, 1:]
    u = u + mu[0] * (u_prev - u) + mu[1] * (u_next - u)
    r, k, v, wl, al, gl = jnp.split(u, list(RW_SPLITS), axis=-1)
    wl = wl.reshape(B, L, 2, RW_DECAY_RANK)
    al = al.reshape(B, L, 2, RW_A_RANK)
    w = w0 + jnp.einsum('bldr,drc->bldc', jnp.tanh(wl), w2)
    decay = jnp.exp(-jnp.exp((-jax.nn.softplus(-w) - 0.5).astype(jnp.float32)))
    a = jax.nn.sigmoid(a0 + jnp.einsum('bldr,drc->bldc', al, a2))
    g = jax.nn.sigmoid(gl) @ g2
    kk = (k * k_k).reshape(B, L, RW_HEADS, RW_HEAD).astype(jnp.float32)
    kk = kk / jnp.maximum(jnp.sqrt(jnp.sum(kk * kk, axis=-1, keepdims=True)), 1e-12)
    k_dir = k[:, :, None] * (1 + (a - 1) * k_a)
    hd = lambda t: t.reshape(*t.shape[:-1], RW_HEADS, RW_HEAD)
    return hd(r), hd(decay), hd(k_dir), hd(v), kk, hd(a), g


def wkv7_scan(r, decay, k, v, kk, a, s0, reverse):
    def step(s, inp):
        r_t, w_t, k_t, v_t, kk_t, a_t = inp
        sa = jnp.einsum('bhij,bhj->bhi', s, kk_t)
        s = (s * w_t[:, :, None, :]
             - sa[..., None] * (kk_t * a_t)[:, :, None, :]
             + v_t[..., None] * k_t[:, :, None, :])
        return s, jnp.einsum('bhij,bhj->bhi', s, r_t)
    xs = tuple(jnp.moveaxis(t.astype(jnp.float32), 1, 0) for t in (r, decay, k, v, kk, a))
    s_fin, ys = lax.scan(step, s0, xs, reverse=reverse)
    return jnp.moveaxis(ys, 0, 1), s_fin


def rwkv_readout(y, r, k_dir, v, g, r_k, gn):
    B, L = y.shape[:2]
    mu = jnp.mean(y, axis=-1, keepdims=True)
    var = jnp.mean(jnp.square(y - mu), axis=-1, keepdims=True)
    yn = ((y - mu) * lax.rsqrt(var + RW_GN_EPS)).reshape(B, L, RW_WIDTH) * gn[0] + gn[1]
    bonus = jnp.sum(r[:, :, None] * k_dir * r_k, axis=(2, 4))
    out = yn + (bonus[..., None] * v).reshape(B, L, RW_WIDTH)
    return (out * g).astype(g.dtype)


def hyena_filters(L, w1, b1, w2, b2, w3, freq):
    f32 = jnp.float32
    t = jnp.linspace(0.0, 1.0, L, dtype=f32)[:, None]
    pos = jnp.arange(L, dtype=f32)[:, None]
    bands = jnp.linspace(1e-4, HY_BANDS - 1, HY_BANDS, dtype=f32)[None, :]
    ang = 2.0 * math.pi * pos * bands / L
    z = jnp.concatenate([t, jnp.cos(ang), -jnp.sin(ang)], axis=-1)
    hdn = jnp.sin(freq[0].astype(f32) * (z @ w1.astype(f32) + b1.astype(f32)))
    hdn = jnp.sin(freq[1].astype(f32) * (hdn @ w2.astype(f32) + b2.astype(f32)))
    h = (hdn @ w3.astype(f32)).reshape(L, HY_ORDER, 2, HY_WIDTH)
    deltas = jnp.linspace(math.log(HY_DECAY_TARGET) / HY_SLOW_DECAY,
                          math.log(HY_DECAY_TARGET) / HY_FAST_DECAY, HY_WIDTH, dtype=f32)
    h = h * jnp.exp(-t[:, :, None, None] * jnp.abs(deltas))
    fwd = h[:, :, 0]
    bwd = h[1:, :, 1][::-1]
    norm = jnp.sum(jnp.abs(fwd), axis=0) + jnp.sum(jnp.abs(bwd), axis=0) + 1e-6
    kc = jnp.concatenate([fwd, jnp.zeros((1, HY_ORDER, HY_WIDTH), f32), bwd], axis=0) / norm
    return jnp.fft.rfft(kc, axis=0)


def fft_long_conv(u, kf):
    L = u.shape[1]
    uf = jnp.fft.rfft(u.astype(jnp.float32), n=2 * L, axis=1)
    y = jnp.fft.irfft(uf * kf[None], n=2 * L, axis=1)[:, :L]
    return y.astype(u.dtype)


def hyena_mixer(u, conv_w, conv_b, f_w1, f_b1, f_w2, f_b2, f_w3, f_freq, hy_b):
    L = u.shape[1]
    up = jnp.pad(u, ((0, 0), (1, 1), (0, 0)))
    u = up[:, :-2] * conv_w[0] + up[:, 1:-1] * conv_w[1] + up[:, 2:] * conv_w[2] + conv_b
    v, x1, x2 = jnp.split(u, HY_ORDER + 1, axis=-1)
    kf = hyena_filters(L, f_w1, f_b1, f_w2, f_b2, f_w3, f_freq)
    z = x1 * (fft_long_conv(v, kf[:, 0]) + v * hy_b[0])
    return x2 * (fft_long_conv(z, kf[:, 1]) + z * hy_b[1])


def even_mixer(h_lat, h_ctx, w_in, w_out, mu, w0, w2, a0, a2, g2, k_k, k_a, r_k, gn,
               conv_w, conv_b, f_w1, f_b1, f_w2, f_b2, f_w3, f_freq, hy_b, need_ctx):
    p_lat = h_lat @ w_in
    p_ctx = h_ctx @ w_in
    lat = rwkv_inputs(p_lat[..., :RW_COLS], mu, w0, w2, a0, a2, g2, k_k, k_a)
    ctx = rwkv_inputs(p_ctx[..., :RW_COLS], mu, w0, w2, a0, a2, g2, k_k, k_a)
    s0 = jnp.zeros((h_lat.shape[0], RW_HEADS, RW_HEAD, RW_HEAD), jnp.float32)
    ys_lat, ys_ctx = [], []
    for d in range(2):
        rev = d == 1
        yc, sc = wkv7_scan(ctx[0], ctx[1][:, :, d], ctx[2][:, :, d], ctx[3], ctx[4], ctx[5][:, :, d], s0, rev)
        yl, _ = wkv7_scan(lat[0], lat[1][:, :, d], lat[2][:, :, d], lat[3], lat[4], lat[5][:, :, d], sc, rev)
        ys_lat.append(yl)
        ys_ctx.append(yc)
    rw_lat = rwkv_readout(ys_lat[0] + ys_lat[1], lat[0], lat[2], lat[3], lat[6], r_k, gn)
    hy_lat = hyena_mixer(p_lat[..., RW_COLS:], conv_w, conv_b, f_w1, f_b1, f_w2, f_b2, f_w3, f_freq, hy_b)
    o_lat = jnp.concatenate([rw_lat, hy_lat], axis=-1) @ w_out
    o_ctx = None
    if need_ctx:
        rw_ctx = rwkv_readout(ys_ctx[0] + ys_ctx[1], ctx[0], ctx[2], ctx[3], ctx[6], r_k, gn)
        hy_ctx = hyena_mixer(p_ctx[..., RW_COLS:], conv_w, conv_b, f_w1, f_b1, f_w2, f_b2, f_w3, f_freq, hy_b)
        o_ctx = jnp.concatenate([rw_ctx, hy_ctx], axis=-1) @ w_out
    return o_lat, o_ctx


def axial_rope(L):
    rows = L // GRID_W
    row = jnp.repeat(jnp.arange(rows, dtype=jnp.float32), GRID_W)
    col = jnp.tile(jnp.arange(GRID_W, dtype=jnp.float32), rows)
    n_freq = DA_HEAD // 4
    inv = ROPE_BASE ** (-jnp.arange(n_freq, dtype=jnp.float32) / n_freq)
    ang = jnp.stack([row[:, None] * inv, col[:, None] * inv], axis=1)
    return jnp.cos(ang), jnp.sin(ang)


def apply_rope(x, cos, sin):
    shp = x.shape
    xr = x.reshape(*shp[:-1], 2, 2, DA_HEAD // 4).astype(jnp.float32)
    x1, x2 = xr[..., 0, :], xr[..., 1, :]
    c = cos[None, :, None, None]
    s = sin[None, :, None, None]
    out = jnp.stack([x1 * c - x2 * s, x2 * c + x1 * s], axis=-2)
    return out.reshape(shp).astype(x.dtype)


def diff_attend(q, k, v, lam):
    s = jnp.einsum('bqhcd,bkhcd->bhcqk', q, k).astype(jnp.float32) * (DA_HEAD ** -0.5)
    p = jax.nn.softmax(s, axis=-1)
    w = p[:, :, 0] - lam * p[:, :, 1]
    return jnp.einsum('bhqk,bkhe->bqhe', w.astype(v.dtype), v)


def diff_attn_mixer(h_lat, h_ctx, w_qkv, w_out, lam_vecs, subln_g, lambda_init, need_ctx):
    B, L, _ = h_lat.shape
    Lc = h_ctx.shape[1]
    p = h_lat @ w_qkv
    q = p[..., :DA_QCOLS].reshape(B, L, DA_HEADS, 2, DA_HEAD)
    k = p[..., DA_QCOLS:2 * DA_QCOLS].reshape(B, L, DA_HEADS, 2, DA_HEAD)
    v = p[..., 2 * DA_QCOLS:].reshape(B, L, DA_HEADS, 2 * DA_HEAD)
    cos, sin = axial_rope(L)
    q = apply_rope(q, cos, sin)
    k = apply_rope(k, cos, sin)
    kv_c = h_ctx @ w_qkv[:, DA_QCOLS:]
    k_c = kv_c[..., :DA_QCOLS].reshape(B, Lc, DA_HEADS, 2, DA_HEAD)
    v_c = kv_c[..., DA_QCOLS:].reshape(B, Lc, DA_HEADS, 2 * DA_HEAD)
    lv = lam_vecs.astype(jnp.float32)
    lam = jnp.exp(jnp.sum(lv[0] * lv[1])) - jnp.exp(jnp.sum(lv[2] * lv[3])) + lambda_init
    keys = jnp.concatenate([k_c, k], axis=1)
    vals = jnp.concatenate([v_c, v], axis=1)
    nb = L // Q_BLOCK
    qb = jnp.moveaxis(q.reshape(B, nb, Q_BLOCK, DA_HEADS, 2, DA_HEAD), 1, 0)
    o = lax.map(lambda qq: diff_attend(qq, keys, vals, lam), qb)
    o = jnp.moveaxis(o, 0, 1).reshape(B, L, DA_HEADS, 2 * DA_HEAD)

    def finish(oo):
        oo = rms_norm(oo, subln_g, 1e-5) * (1 - lambda_init)
        return oo.reshape(*oo.shape[:2], DA_HEADS * 2 * DA_HEAD) @ w_out

    o_lat = finish(o)
    o_ctx = None
    if need_ctx:
        q_c = (h_ctx @ w_qkv[:, :DA_QCOLS]).reshape(B, Lc, DA_HEADS, 2, DA_HEAD)
        o_ctx = finish(diff_attend(q_c, k_c, v_c, lam))
    return o_lat, o_ctx


def expert_choice_ffn(h, router_w, w1, w3, w2):
    B, L, D = h.shape
    cap = CAPACITY_FACTOR * L // N_EXPERTS
    aff = jax.nn.softmax((h @ router_w).astype(jnp.float32), axis=-1)
    gate, idx = lax.top_k(jnp.swapaxes(aff, 1, 2), cap)
    xg = jax.vmap(lambda hb, ib: hb[ib])(h, idx)
    a = jnp.einsum('becd,edf->becf', xg, w1)
    b = jnp.einsum('becd,edf->becf', xg, w3)
    y = jnp.einsum('becf,efd->becd', jax.nn.silu(a) * b, w2) * gate[..., None].astype(h.dtype)
    return jax.vmap(lambda yb, ib: jax.ops.segment_sum(yb.reshape(-1, D), ib.reshape(-1), num_segments=L))(y, idx)


def setup_inputs(seed: int = 0) -> dict:
    key = jax.random.key(seed)
    keys = iter(jax.random.split(key, 40))
    f32 = jnp.float32

    def nrm(shape, scale):
        return jax.random.normal(next(keys), shape, f32) * scale

    def unif(shape, lo, hi):
        return jax.random.uniform(next(keys), shape, f32, lo, hi)

    D, E, F = D_MODEL, N_EXPERTS, EXPERT_HIDDEN
    return {
        "x": nrm((BATCH, SEQ, D), 1.0),
        "c": nrm((BATCH, D), 1.0),
        "ctx": nrm((BATCH, CTX_LEN, D), 1.0),
        "c_ctx": nrm((D,), 1.0),
        "ada_w": nrm((DEPTH, D, N_MOD * D), 0.5 * D ** -0.5),
        "ada_b": nrm((DEPTH, N_MOD * D), 0.02),
        "norm_g": 1.0 + nrm((DEPTH, 2, D), 0.02),
        "final_g": 1.0 + nrm((D,), 0.02),
        "ev_w_in": nrm((N_EVEN, D, EVEN_COLS), D ** -0.5),
        "ev_w_out": nrm((N_EVEN, RW_WIDTH + HY_WIDTH, D), (RW_WIDTH + HY_WIDTH) ** -0.5),
        "rw_mu": unif((N_EVEN, 2, RW_COLS), 0.0, 0.5),
        "rw_w0": unif((N_EVEN, 2, RW_WIDTH), -6.0, 0.0),
        "rw_w2": nrm((N_EVEN, 2, RW_DECAY_RANK, RW_WIDTH), 0.1 * RW_DECAY_RANK ** -0.5),
        "rw_a0": nrm((N_EVEN, 2, RW_WIDTH), 0.5),
        "rw_a2": nrm((N_EVEN, 2, RW_A_RANK, RW_WIDTH), 0.3 * RW_A_RANK ** -0.5),
        "rw_g2": nrm((N_EVEN, RW_GATE_RANK, RW_WIDTH), RW_GATE_RANK ** -0.5),
        "rw_kk": 0.85 + nrm((N_EVEN, RW_WIDTH), 0.05),
        "rw_ka": 1.0 + nrm((N_EVEN, RW_WIDTH), 0.05),
        "rw_rk": nrm((N_EVEN, RW_HEADS, RW_HEAD), 0.1),
        "rw_gn": nrm((N_EVEN, 2, RW_WIDTH), 0.02) + jnp.array([1.0, 0.0], f32)[:, None],
        "hy_conv_w": nrm((N_EVEN, 3, HY_COLS), 3 ** -0.5),
        "hy_conv_b": nrm((N_EVEN, HY_COLS), 0.02),
        "hy_f_w1": nrm((N_EVEN, HY_EMB, HY_FILTER_HIDDEN), HY_EMB ** -0.5),
        "hy_f_b1": nrm((N_EVEN, HY_FILTER_HIDDEN), 0.5),
        "hy_f_w2": nrm((N_EVEN, HY_FILTER_HIDDEN, HY_FILTER_HIDDEN), HY_FILTER_HIDDEN ** -0.5),
        "hy_f_b2": nrm((N_EVEN, HY_FILTER_HIDDEN), 0.5),
        "hy_f_w3": nrm((N_EVEN, HY_FILTER_HIDDEN, HY_ORDER * 2 * HY_WIDTH), HY_FILTER_HIDDEN ** -0.5),
        "hy_freq": 1.0 + nrm((N_EVEN, 2, HY_FILTER_HIDDEN), 0.1),
        "hy_bias": nrm((N_EVEN, HY_ORDER, HY_WIDTH), 0.5),
        "da_w_qkv": nrm((N_ODD, D, DA_COLS), D ** -0.5),
        "da_w_out": nrm((N_ODD, DA_QCOLS, D), DA_QCOLS ** -0.5),
        "da_lambda": nrm((N_ODD, 4, DA_HEAD), 0.1),
        "da_subln": 1.0 + nrm((N_ODD, 2 * DA_HEAD), 0.02),
        "moe_router": nrm((DEPTH, D, E), D ** -0.5),
        "moe_w1": nrm((DEPTH, E, D, F), D ** -0.5),
        "moe_w3": nrm((DEPTH, E, D, F), D ** -0.5),
        "moe_w2": nrm((DEPTH, E, F, D), F ** -0.5),
    }


def reference(x, c, ctx, c_ctx, ada_w, ada_b, norm_g, final_g, ev_w_in, ev_w_out,
              rw_mu, rw_w0, rw_w2, rw_a0, rw_a2, rw_g2, rw_kk, rw_ka, rw_rk, rw_gn,
              hy_conv_w, hy_conv_b, hy_f_w1, hy_f_b1, hy_f_w2, hy_f_b2, hy_f_w3, hy_freq, hy_bias,
              da_w_qkv, da_w_out, da_lambda, da_subln, moe_router, moe_w1, moe_w3, moe_w2):
    x_lat, x_ctx = x, ctx
    s_lat = jax.nn.silu(c)
    s_ctx = jax.nn.silu(c_ctx)
    for i in range(DEPTH):
        j = i // 2
        need_ctx = i < DEPTH - 1
        m_lat = jnp.split(s_lat @ ada_w[i] + ada_b[i], N_MOD, axis=-1)
        m_ctx = jnp.split(s_ctx @ ada_w[i] + ada_b[i], N_MOD, axis=-1)
        h_lat = modulate(x_lat, norm_g[i, 0], m_lat[0], m_lat[1])
        h_ctx = modulate(x_ctx, norm_g[i, 0], m_ctx[0], m_ctx[1])
        if i % 2 == 0:
            o_lat, o_ctx = even_mixer(h_lat, h_ctx, ev_w_in[j], ev_w_out[j], rw_mu[j], rw_w0[j], rw_w2[j],
                                      rw_a0[j], rw_a2[j], rw_g2[j], rw_kk[j], rw_ka[j], rw_rk[j], rw_gn[j],
                                      hy_conv_w[j], hy_conv_b[j], hy_f_w1[j], hy_f_b1[j], hy_f_w2[j],
                                      hy_f_b2[j], hy_f_w3[j], hy_freq[j], hy_bias[j], need_ctx)
        else:
            lambda_init = 0.8 - 0.6 * math.exp(-0.3 * i)
            o_lat, o_ctx = diff_attn_mixer(h_lat, h_ctx, da_w_qkv[j], da_w_out[j], da_lambda[j],
                                           da_subln[j], lambda_init, need_ctx)
        x_lat = x_lat + m_lat[2][:, None, :] * o_lat
        x_lat = x_lat + m_lat[5][:, None, :] * expert_choice_ffn(
            modulate(x_lat, norm_g[i, 1], m_lat[3], m_lat[4]), moe_router[i], moe_w1[i], moe_w3[i], moe_w2[i])
        if need_ctx:
            x_ctx = x_ctx + m_ctx[2] * o_ctx
            x_ctx = x_ctx + m_ctx[5] * expert_choice_ffn(
                modulate(x_ctx, norm_g[i, 1], m_ctx[3], m_ctx[4]), moe_router[i], moe_w1[i], moe_w3[i], moe_w2[i])
    return rms_norm(x_lat, final_g)
```

```cpp
#define MK_PER_PHASE 0
#include <hip/hip_runtime.h>
#include <cstdio>
#include <cstdint>
#include <cmath>

#ifndef MK_PER_PHASE
#define MK_PER_PHASE 0
#endif

#define GAS __attribute__((address_space(1)))
#define LAS __attribute__((address_space(3)))
typedef unsigned short bf16;
typedef unsigned v4u __attribute__((ext_vector_type(4)));
typedef unsigned v2u __attribute__((ext_vector_type(2)));
typedef float f32x4 __attribute__((ext_vector_type(4)));
typedef float f32x2 __attribute__((ext_vector_type(2)));
typedef short bf16x8 __attribute__((ext_vector_type(8)));

constexpr int DM = 1024, NB = 4, SEQ = 4096, CTXL = 256, DEPTH = 4;
constexpr int TLAT = NB * SEQ, TCTX = NB * CTXL, TT = TLAT + TCTX;
constexpr int RWC = 1760, HYC = 1536, EVC = RWC + HYC, EVCP = 3328;
constexpr int RWW = 512, NH = 8, HD = 64;
constexpr int QKVC = 3072;
constexpr int NE = 16, FF = 1024, EROWS = 2304;
constexpr int NMOD = 6;
constexpr int KSEQ = CTXL + SEQ;

enum { I_X = 0, I_C, I_CTX, I_CCTX, I_ADAW, I_ADAB, I_NORMG, I_FINALG, I_EVWIN, I_EVWOUT, I_MU, I_W0, I_W2, I_A0, I_A2, I_G2, I_KK, I_KA, I_RK, I_GN,
       I_CONVW, I_CONVB, I_FW1, I_FB1, I_FW2, I_FB2, I_FW3, I_FREQ, I_HYB, I_WQKV, I_DAWOUT, I_LAM, I_SUBLN, I_ROUTER, I_MW1, I_MW3, I_MW2, N_IN };

struct Args { const float* in[N_IN]; float* out; unsigned char* ws; int ph_lo, ph_hi; };
static_assert(__builtin_offsetof(Args, in) == 0, "Args::in must be first");

constexpr size_t MiB = 1u << 20;
constexpr size_t WS_CTL = 0, CTL_ZERO_BYTES = 64 * 1024;
constexpr size_t WS_MODP = 1 * MiB;
constexpr size_t WS_MODS = 5 * MiB;
constexpr size_t WS_TW = 6 * MiB;
constexpr size_t WS_FRAGB = 7 * MiB;
constexpr size_t WS_AFF = 8 * MiB;
constexpr size_t WS_SLOT = 10 * MiB;
constexpr size_t WS_IDX = 12 * MiB;
constexpr size_t WS_GATE = 12 * MiB + 512 * 1024;
constexpr size_t WS_WIN = 16 * MiB;
constexpr size_t WS_WOE = 30 * MiB;
constexpr size_t WS_WQKV = 34 * MiB;
constexpr size_t WS_WOD = 46 * MiB;
constexpr size_t WS_W13 = 50 * MiB;
constexpr size_t WS_W2 = 114 * MiB;
constexpr size_t WS_UTL = 50 * MiB;
constexpr size_t WS_X = 146 * MiB;
constexpr size_t WS_HA = 214 * MiB;
constexpr size_t WS_CAT = 248 * MiB;
constexpr size_t WS_KSPL = 282 * MiB;
constexpr size_t WS_KSPC = 346 * MiB;
constexpr size_t WS_BIG = 384 * MiB;
constexpr size_t WS_P = WS_BIG;
constexpr size_t WS_RW = WS_BIG + 221 * MiB;
constexpr size_t RW_STRIDE = 34 * MiB;
constexpr size_t WS_Y = WS_RW + 9 * RW_STRIDE;
constexpr size_t WS_KCL = WS_Y + 68 * MiB;
constexpr size_t WS_KCC = WS_KCL + 32 * MiB;
constexpr size_t WS_UTC = WS_KCC + 2 * MiB;
constexpr size_t WS_HYTL = WS_P;
constexpr size_t WS_HYTC = WS_P + 32 * MiB;
static_assert(WS_UTC + 6 * MiB <= 1024 * MiB, "ws map");
constexpr size_t WS_QB = WS_BIG + 204 * MiB;
constexpr size_t WS_KB = WS_QB + 34 * MiB;
constexpr size_t WS_VB = WS_KB + 34 * MiB;
constexpr size_t WS_OB = WS_VB + 34 * MiB;
static_assert(WS_OB + 136 * MiB <= 1024 * MiB, "ws map");
constexpr size_t WS_XG = WS_BIG;
constexpr size_t WS_HB = WS_BIG + 72 * MiB;
constexpr size_t WS_YB = WS_BIG + 144 * MiB;
constexpr size_t WS_END = 1024 * MiB;

constexpr int CW_BAR = 4096;

constexpr int RING_BYTES = 143360;
constexpr int LDSCTL_OFF = RING_BYTES;
constexpr int LDS_BYTES = 147456;
constexpr int NWAVES = 8, NTHR = 512;

__device__ __forceinline__ unsigned f2bf(float f) { unsigned u = __builtin_bit_cast(unsigned, f); return (u + 0x7fffu + ((u >> 16) & 1u)) >> 16; }
__device__ __forceinline__ unsigned pk2(float lo, float hi) { return f2bf(lo) | (f2bf(hi) << 16); }
__device__ __forceinline__ float bf2f(unsigned short h) { return __builtin_bit_cast(float, ((unsigned)h) << 16); }
template <int CTRL> __device__ __forceinline__ float dpp_f(float x) { return __builtin_bit_cast(float, __builtin_amdgcn_update_dpp(0, __builtin_bit_cast(int, x), CTRL, 0xF, 0xF, true)); }
template <int CTRL> __device__ __forceinline__ int dpp_i(int x) { return __builtin_amdgcn_update_dpp(0, x, CTRL, 0xF, 0xF, true); }
#define DPP_XOR1 0xB1
#define DPP_XOR2 0x4E
#define DPP_HMIRROR 0x141
#define DPP_MIRROR 0x140
__device__ __forceinline__ float xor1_f(float x) { return dpp_f<DPP_XOR1>(x); }
__device__ __forceinline__ float sum4_f(float x) { x += dpp_f<DPP_XOR1>(x); x += dpp_f<DPP_XOR2>(x); return x; }
__device__ __forceinline__ float sum8_f(float x) { x = sum4_f(x); x += dpp_f<DPP_HMIRROR>(x); return x; }
__device__ __forceinline__ float sum16_f(float x) { x = sum8_f(x); x += dpp_f<DPP_MIRROR>(x); return x; }
__device__ __forceinline__ float max16_f(float x) { x = fmaxf(x, dpp_f<DPP_XOR1>(x)); x = fmaxf(x, dpp_f<DPP_XOR2>(x)); x = fmaxf(x, dpp_f<DPP_HMIRROR>(x)); x = fmaxf(x, dpp_f<DPP_MIRROR>(x)); return x; }
__device__ __forceinline__ float wave_sum(float v) {
    v = sum16_f(v);
    v += __builtin_bit_cast(float, __builtin_amdgcn_ds_swizzle(__builtin_bit_cast(int, v), 0x401F));
    { auto rr = __builtin_amdgcn_permlane32_swap(__float_as_uint(v), __float_as_uint(v), false, false); const unsigned lo_ = rr[0], hi_ = rr[1];
      v = __uint_as_float(lo_) + __uint_as_float(hi_); }
    return v;
}
__device__ __forceinline__ int wave_sum_i(int v) {
    v += dpp_i<DPP_XOR1>(v); v += dpp_i<DPP_XOR2>(v); v += dpp_i<DPP_HMIRROR>(v); v += dpp_i<DPP_MIRROR>(v);
    v += __builtin_amdgcn_ds_swizzle(v, 0x401F);
    { auto rr = __builtin_amdgcn_permlane32_swap((unsigned)v, (unsigned)v, false, false); v = (int)rr[0] + (int)rr[1]; }
    return v;
}
__device__ __forceinline__ float sigmoidf_(float x) { return 1.0f / (1.0f + __expf(-x)); }
__device__ __forceinline__ float siluf_(float x) { return x / (1.0f + __expf(-x)); }
#define LDS_WAIT() asm volatile("s_waitcnt lgkmcnt(0)" ::: "memory")
#define VM_WAIT() asm volatile("s_waitcnt vmcnt(0)" ::: "memory")

namespace pg8 {
#define PG8_LAS __attribute__((address_space(3)))
typedef unsigned short bf16_t;
typedef short bf16x8 __attribute__((ext_vector_type(8)));
typedef float f32x4 __attribute__((ext_vector_type(4)));
typedef unsigned u32x4 __attribute__((ext_vector_type(4)));
constexpr int BM = 256, BK = 64, HALF = 128, HTB = HALF * BK * 2  , STAGE_BYTES = 8 * HTB, NXCD = 8, WGM = 8;

__host__ __device__ __forceinline__ int lds_byte(int r, int c) { const int st = (r >> 4) * 2 + (c >> 5), rr = r & 15, cc = c & 31, ob = rr * 64 + cc * 2; return st * 1024 + (ob ^ (((ob >> 9) & 1) << 5)); }
__host__ __device__ __forceinline__ void stage_rc(int b, int& R, int& C) { const int st = b / 1024, sb = b % 1024, swz = sb ^ (((sb >> 9) & 1) << 5); R = (st >> 1) * 16 + swz / 64; C = (st & 1) * 32 + (swz % 64) / 2; }
__host__ __device__ __forceinline__ int perm32(int rho) { const int n = rho >> 4, i = rho & 15; return 8 * (i >> 2) + 4 * n + (i & 3); }

struct Unit { int pm, pn; };
struct Gemm { const bf16_t* A; const bf16_t* Bt; int M, N, K; };

struct StaticOrder {
    int nM, nN, nwg, G, c;
    __host__ __device__ void init(int M, int N, int G_, int c_) { nM = M / BM; nN = N / BM; nwg = nM * nN; G = G_; c = c_; }
    __host__ __device__ bool next(int i, Unit& u) const {
        const long L = (long)i * G + c; if (L >= nwg) return false;
        int wgid = (int)L; { const int q = nwg / NXCD, r = nwg % NXCD, xcd = wgid % NXCD, off = wgid / NXCD; wgid = (xcd < r ? xcd * (q + 1) : r * (q + 1) + (xcd - r) * q) + off; }
        const int nig = WGM * nN, gid = wgid / nig, fm = gid * WGM, gsz = (nM - fm) < WGM ? (nM - fm) : WGM;
        u.pm = fm + ((wgid % nig) % gsz); u.pn = (wgid % nig) / gsz; return true;
    }
    __device__ __forceinline__ void a_ready(const Unit&) const {}
    __device__ __forceinline__ void done(const Unit&) const {}
};

__device__ __forceinline__ unsigned cvt_pk_bf16(float lo, float hi) { unsigned r; asm volatile("v_cvt_pk_bf16_f32 %0, %1, %2" : "=v"(r) : "v"(lo), "v"(hi)); return r; }
typedef float f32x2 __attribute__((ext_vector_type(2)));
typedef unsigned u32x2v __attribute__((ext_vector_type(2)));

struct EpiF32 {
    static constexpr bool PERM = false, AFTER_DRAIN = false;
    float* O; int ldc;
    __device__ __forceinline__ void operator()(const f32x4 (&acc)[2][2][4][2], const Unit& u, int wr, int wc, int fr, int fq) const {
        const int col0 = u.pn * BM + wc * 32 + 4 * fq;
#pragma unroll
        for (int ai = 0; ai < 2; ++ai)
#pragma unroll
            for (int m = 0; m < 4; ++m) { float* rowp = O + (size_t)(u.pm * BM + ai * HALF + wr * 64 + m * 16 + fr) * ldc + col0;
#pragma unroll
                for (int bj = 0; bj < 2; ++bj)
#pragma unroll
                    for (int n = 0; n < 2; ++n) *(f32x4*)(rowp + bj * HALF + n * 16) = acc[ai][bj][m][n]; }
    }
};
struct EpiResGate {
    static constexpr bool PERM = false, AFTER_DRAIN = false;
    float* X; const float* mods;
    __device__ __forceinline__ void operator()(const f32x4 (&acc)[2][2][4][2], const Unit& u, int wr, int wc, int fr, int fq) const {
        const int col0 = u.pn * BM + wc * 32 + 4 * fq;
#pragma unroll
        for (int ai = 0; ai < 2; ++ai)
#pragma unroll
            for (int m = 0; m < 4; ++m) { const int row = u.pm * BM + ai * HALF + wr * 64 + m * 16 + fr; const int s = row < 16384 ? (row >> 12) : 4;
                float* rowp = X + (size_t)row * 1024 + col0; const float* gp = mods + s * 6144 + 2048 + col0;
#pragma unroll
                for (int bj = 0; bj < 2; ++bj)
#pragma unroll
                    for (int n = 0; n < 2; ++n) { const f32x4 g = *(const f32x4*)(gp + bj * HALF + n * 16); f32x4 x = *(f32x4*)(rowp + bj * HALF + n * 16);
                        x = x + g * acc[ai][bj][m][n]; *(f32x4*)(rowp + bj * HALF + n * 16) = x; } }
    }
};
struct EpiSwiGLU {
    static constexpr bool PERM = false, AFTER_DRAIN = false;
    bf16_t* H;
    __device__ __forceinline__ void operator()(const f32x4 (&acc)[2][2][4][2], const Unit& u, int wr, int wc, int fr, int fq) const {
        const int nt = u.pn & 7; const int col0 = nt * 128 + wc * 32 + 4 * fq;
#pragma unroll
        for (int ai = 0; ai < 2; ++ai)
#pragma unroll
            for (int m = 0; m < 4; ++m) { bf16_t* rowp = H + (size_t)(u.pm * BM + ai * HALF + wr * 64 + m * 16 + fr) * 1024 + col0;
#pragma unroll
                for (int n = 0; n < 2; ++n) { const f32x4 a = acc[ai][0][m][n], b = acc[ai][1][m][n]; f32x4 h;
#pragma unroll
                    for (int j = 0; j < 4; ++j) h[j] = a[j] / (1.0f + __expf(-a[j])) * b[j];
                    u32x2v w; w.x = cvt_pk_bf16(h[0], h[1]); w.y = cvt_pk_bf16(h[2], h[3]); *(u32x2v*)(rowp + n * 16) = w; } }
    }
};
struct EpiGateBf16 {
    static constexpr bool PERM = false, AFTER_DRAIN = false;
    bf16_t* Y; const float* gate;
    __device__ __forceinline__ void operator()(const f32x4 (&acc)[2][2][4][2], const Unit& u, int wr, int wc, int fr, int fq) const {
        const int nt = u.pn & 3; const int col0 = nt * 256 + wc * 32 + 4 * fq;
#pragma unroll
        for (int ai = 0; ai < 2; ++ai)
#pragma unroll
            for (int m = 0; m < 4; ++m) { const int row = u.pm * BM + ai * HALF + wr * 64 + m * 16 + fr; const float g = gate[row]; bf16_t* rowp = Y + (size_t)row * 1024 + col0;
#pragma unroll
                for (int bj = 0; bj < 2; ++bj)
#pragma unroll
                    for (int n = 0; n < 2; ++n) { const f32x4 v = acc[ai][bj][m][n] * g; u32x2v w; w.x = cvt_pk_bf16(v[0], v[1]); w.y = cvt_pk_bf16(v[2], v[3]); *(u32x2v*)(rowp + bj * HALF + n * 16) = w; } }
    }
};
struct MoeOrder {
    int G, c, ntn;
    __device__ __forceinline__ bool next(int i, Unit& u) const {
        const int L = i * G + c; const int per_e = 9 * ntn; if (L >= 16 * per_e) return false;
        const int e = L / per_e, r = L % per_e; u.pm = e * 9 + (r % 9); u.pn = e * ntn + (r / 9); return true;
    }
    __device__ __forceinline__ void a_ready(const Unit&) const {}
    __device__ __forceinline__ void done(const Unit&) const {}
};
template <class Epi, class Sched, bool ALIGN_EPI = false, bool SP2 = false>
__device__ __forceinline__ void gemm_phase(PG8_LAS unsigned char* lds, const Gemm g, const Sched& S, const Epi& E) {
    int tid_ = threadIdx.x; asm volatile("" : "+v"(tid_));
    const int tid = tid_, wid = __builtin_amdgcn_readfirstlane(tid >> 6), lane = tid & 63, wr = wid >> 2, wc = wid & 3, fr = lane & 15, fq = lane >> 4;
    const int K = g.K, nt = K / BK;
    unsigned voffA[2], voffB[2];
#pragma unroll
    for (int i = 0; i < 2; ++i) { int R, C; stage_rc(tid * 16 + i * 8192, R, C); const int Rb = Epi::PERM ? ((R & ~31) + perm32(R & 31)) : R;
        voffA[i] = (unsigned)(R * K + C) * 2u; voffB[i] = (unsigned)(Rb * K + C) * 2u; }
    const size_t kstep = (size_t)(BK * 2);
    const size_t hstep = (size_t)HALF * K * 2;
    const size_t tstep = 2 * hstep;
    const unsigned ldsw = (unsigned)wid * 1024u;
    const int aoff = lds_byte(wr * 64 + fr, fq * 8), boff = lds_byte(wc * 32 + fr, fq * 8);
#define PG8_SA(b, h) (((b) * 2 + (h)) * HTB)
#define PG8_SB(b, h) ((4 + (b) * 2 + (h)) * HTB)
#define PG8_STAGE(bufoff, gbase, voff) do { _Pragma("unroll") for (int _i = 0; _i < 2; ++_i) \
        __builtin_amdgcn_global_load_lds((const unsigned*)((const char*)(gbase) + (voff)[_i]), (PG8_LAS unsigned*)(lds + (bufoff) + ldsw + _i * 8192), 16, 0, 0); } while (0)
#define PG8_LDA(dst, b, h) do { _Pragma("unroll") for (int m = 0; m < 4; ++m) _Pragma("unroll") for (int k = 0; k < 2; ++k) dst[m][k] = *(const PG8_LAS bf16x8*)(lds + PG8_SA(b, h) + aoff + m * 2048 + k * 1024); } while (0)
#define PG8_LDB(dst, b, h) do { _Pragma("unroll") for (int n = 0; n < 2; ++n) _Pragma("unroll") for (int k = 0; k < 2; ++k) dst[n][k] = *(const PG8_LAS bf16x8*)(lds + PG8_SB(b, h) + boff + n * 2048 + k * 1024); } while (0)
#define PG8_MMA(ai, bj, At, Bt) do { __builtin_amdgcn_s_setprio(1); _Pragma("unroll") for (int m = 0; m < 4; ++m) _Pragma("unroll") for (int n = 0; n < 2; ++n) _Pragma("unroll") for (int k = 0; k < 2; ++k) \
        acc[ai][bj][m][n] = __builtin_amdgcn_mfma_f32_16x16x32_bf16(Bt[n][k], At[m][k], acc[ai][bj][m][n], 0, 0, 0); __builtin_amdgcn_s_setprio(0); } while (0)
#define PG8_WAIT_V(n) asm volatile("s_waitcnt vmcnt(" #n ")" ::: "memory")
#define PG8_WAIT_L(n) asm volatile("s_waitcnt lgkmcnt(" #n ")" ::: "memory")
#define PG8_BAR __builtin_amdgcn_s_barrier()
#define PG8_SCHED __builtin_amdgcn_sched_barrier(0)
    Unit cur, nxt; int ui = 0;
    if (!S.next(0, cur)) return;
    f32x4 acc[2][2][4][2];
#pragma unroll
    for (int a = 0; a < 2; ++a)
#pragma unroll
        for (int b = 0; b < 2; ++b)
#pragma unroll
            for (int m = 0; m < 4; ++m)
#pragma unroll
                for (int n = 0; n < 2; ++n) acc[a][b][m][n] = (f32x4){0.f, 0.f, 0.f, 0.f};
    bf16x8 At[4][2], B0[2][2], B1[2][2];
    const char* cA = (const char*)g.A + (size_t)cur.pm * tstep; const char* cB = (const char*)g.Bt + (size_t)cur.pn * tstep;
    S.a_ready(cur);
    if constexpr (SP2) {
        PG8_STAGE(PG8_SB(0, 0), cB, voffB); PG8_STAGE(PG8_SB(0, 1), cB + hstep, voffB); PG8_STAGE(PG8_SA(0, 0), cA, voffA); PG8_STAGE(PG8_SA(0, 1), cA + hstep, voffA);
        if (wr == 1) PG8_BAR;
        PG8_WAIT_V(2); PG8_BAR;
        PG8_STAGE(PG8_SB(1, 0), cB + kstep, voffB); PG8_STAGE(PG8_SA(1, 0), cA + kstep, voffA); PG8_STAGE(PG8_SB(1, 1), cB + hstep + kstep, voffB);
        PG8_WAIT_V(6); PG8_BAR;
    } else {
        PG8_STAGE(PG8_SB(0, 0), cB, voffB); PG8_STAGE(PG8_SA(0, 0), cA, voffA); PG8_STAGE(PG8_SB(0, 1), cB + hstep, voffB); PG8_STAGE(PG8_SA(0, 1), cA + hstep, voffA);
        if (wr == 1) PG8_BAR;
        PG8_WAIT_V(4); PG8_BAR;
        PG8_STAGE(PG8_SB(1, 0), cB + kstep, voffB); PG8_STAGE(PG8_SA(1, 0), cA + kstep, voffA); PG8_STAGE(PG8_SB(1, 1), cB + hstep + kstep, voffB);
        PG8_WAIT_V(6); PG8_BAR;
    }
    for (;;) {
        const bool has_next = S.next(ui + 1, nxt);
        const char* nA = has_next ? (const char*)g.A + (size_t)nxt.pm * tstep : cA; const char* nB = has_next ? (const char*)g.Bt + (size_t)nxt.pn * tstep : cB;
        for (int t = 0; t < nt; t += 2) {
            const bool last = (t == nt - 2);
            const char* a1 = cA + (size_t)(t + 1) * kstep;
            const char* a2 = last ? nA : cA + (size_t)(t + 2) * kstep; const char* b2 = last ? nB : cB + (size_t)(t + 2) * kstep;
            const char* a3 = a2 + kstep; const char* b3 = b2 + kstep;
            if (last && has_next) S.a_ready(nxt);
            if constexpr (SP2) {
            PG8_LDB(B0, 0, 0); PG8_LDB(B1, 0, 1); PG8_SCHED; PG8_LDA(At, 0, 0); PG8_STAGE(PG8_SA(1, 1), a1 + hstep, voffA);
            PG8_WAIT_V(8); PG8_WAIT_L(0); PG8_BAR; PG8_MMA(0, 0, At, B0); PG8_MMA(0, 1, At, B1); PG8_BAR; PG8_SCHED;
            PG8_LDA(At, 0, 1); PG8_STAGE(PG8_SB(0, 0), b2, voffB); PG8_STAGE(PG8_SB(0, 1), b2 + hstep, voffB); PG8_STAGE(PG8_SA(0, 0), a2, voffA);
            PG8_WAIT_V(8); PG8_WAIT_L(0); PG8_BAR; PG8_MMA(1, 0, At, B0); PG8_MMA(1, 1, At, B1); PG8_BAR; PG8_SCHED;
            PG8_LDB(B0, 1, 0); PG8_LDB(B1, 1, 1); PG8_SCHED; PG8_LDA(At, 1, 0); PG8_STAGE(PG8_SA(0, 1), a2 + hstep, voffA);
            PG8_WAIT_V(8); PG8_WAIT_L(0); PG8_BAR; PG8_MMA(0, 0, At, B0); PG8_MMA(0, 1, At, B1); PG8_BAR; PG8_SCHED;
            PG8_LDA(At, 1, 1); PG8_STAGE(PG8_SB(1, 0), b3, voffB); PG8_STAGE(PG8_SB(1, 1), b3 + hstep, voffB); PG8_STAGE(PG8_SA(1, 0), a3, voffA);
            PG8_WAIT_V(8); PG8_WAIT_L(0); PG8_BAR; PG8_MMA(1, 0, At, B0); PG8_MMA(1, 1, At, B1); PG8_BAR; PG8_SCHED;
            } else {
            PG8_LDB(B0, 0, 0); PG8_SCHED; PG8_LDA(At, 0, 0); PG8_STAGE(PG8_SA(1, 1), a1 + hstep, voffA);
            PG8_WAIT_L(8); PG8_BAR; PG8_WAIT_L(0); PG8_MMA(0, 0, At, B0); PG8_BAR; PG8_SCHED;
            PG8_LDB(B1, 0, 1); PG8_STAGE(PG8_SB(0, 0), b2, voffB);
            PG8_BAR; PG8_WAIT_L(0); PG8_MMA(0, 1, At, B1); PG8_BAR;
            PG8_LDA(At, 0, 1); PG8_STAGE(PG8_SA(0, 0), a2, voffA);
            PG8_BAR; PG8_WAIT_L(0); PG8_MMA(1, 0, At, B0); PG8_BAR; PG8_SCHED;
            PG8_STAGE(PG8_SB(0, 1), b2 + hstep, voffB);
            PG8_WAIT_V(6); PG8_BAR; PG8_MMA(1, 1, At, B1); PG8_BAR;
            PG8_LDB(B0, 1, 0); PG8_SCHED; PG8_LDA(At, 1, 0); PG8_STAGE(PG8_SA(0, 1), a2 + hstep, voffA);
            PG8_WAIT_L(8); PG8_BAR; PG8_WAIT_L(0); PG8_MMA(0, 0, At, B0); PG8_BAR; PG8_SCHED;
            PG8_LDB(B1, 1, 1); PG8_STAGE(PG8_SB(1, 0), b3, voffB);
            PG8_BAR; PG8_WAIT_L(0); PG8_MMA(0, 1, At, B1); PG8_BAR;
            PG8_LDA(At, 1, 1); PG8_STAGE(PG8_SA(1, 0), a3, voffA);
            PG8_BAR; PG8_WAIT_L(0); PG8_MMA(1, 0, At, B0); PG8_BAR; PG8_SCHED;
            PG8_STAGE(PG8_SB(1, 1), b3 + hstep, voffB);
            PG8_WAIT_V(6); PG8_BAR; PG8_MMA(1, 1, At, B1); PG8_BAR;
            }
        }
        if constexpr (ALIGN_EPI) { if (wr == 0) PG8_BAR; }
        if constexpr (!Epi::AFTER_DRAIN) { E(acc, cur, wr, wc, fr, fq); S.done(cur); }
        if (!has_next) break;
#pragma unroll
        for (int a = 0; a < 2; ++a)
#pragma unroll
            for (int b = 0; b < 2; ++b)
#pragma unroll
                for (int m = 0; m < 4; ++m)
#pragma unroll
                    for (int n = 0; n < 2; ++n) acc[a][b][m][n] = (f32x4){0.f, 0.f, 0.f, 0.f};
        cur = nxt; cA = nA; cB = nB; ++ui;
        if constexpr (ALIGN_EPI) { if (wr == 1) PG8_BAR; }
    }
    PG8_WAIT_V(0);
    if constexpr (!ALIGN_EPI) { if (wr == 0) PG8_BAR; }
    PG8_BAR;
    if constexpr (Epi::AFTER_DRAIN) { E.fused(acc, cur, wr, wc, fr, fq, lds, wid, lane); S.done(cur); }
#undef PG8_SA
#undef PG8_SB
#undef PG8_STAGE
#undef PG8_LDA
#undef PG8_LDB
#undef PG8_MMA
#undef PG8_WAIT_V
#undef PG8_WAIT_L
#undef PG8_BAR
#undef PG8_SCHED
}
}
#define XB_TMO      128
#define XB_XCNT(j)  (256  + 64 * (j))
#define XB_XSUB(j)  (1280 + 64 * (j))
#define XB_XGEN(j)  (2304 + 64 * (j))
#define XB_TOP      3328
#define XB_TOPGEN   3392
#define XCD_BAR_WORDS 3456
#define XB_SPIN_CAP (1u << 18)

__device__ __forceinline__ unsigned xb_ld(unsigned* p)              { return __hip_atomic_load(p, __ATOMIC_RELAXED, __HIP_MEMORY_SCOPE_AGENT); }
__device__ __forceinline__ unsigned xb_add(unsigned* p, unsigned v) { return __hip_atomic_fetch_add(p, v, __ATOMIC_RELAXED, __HIP_MEMORY_SCOPE_AGENT); }
__device__ __forceinline__ unsigned xb_xcc_id() { return (unsigned)__builtin_amdgcn_s_getreg((3 << 11) | 20) & 0xFu; }
#define XB_SPIN(cond, bar) do { unsigned _sp = 0; while (cond) { __builtin_amdgcn_s_sleep(1); \
    if ((++_sp & 255u) == 0u) { if (xb_ld(&(bar)[XB_TMO])) break; if (_sp > XB_SPIN_CAP) { atomicAdd(&(bar)[XB_TMO], 1u); break; } } } } while (0)

struct XcdBarrier {
    unsigned* bar; unsigned x;
    volatile LAS unsigned* st;
};

__device__ __forceinline__ XcdBarrier xcd_barrier_post(unsigned* bar, volatile LAS unsigned* st) {
    XcdBarrier b; b.bar = bar; b.x = xb_xcc_id(); b.st = st;
    if (threadIdx.x == 0) (void)xb_add(&bar[XB_XCNT(b.x)], 1u);
    return b;
}
__device__ __forceinline__ void xcd_barrier_complete(unsigned* bar, unsigned x, unsigned& nloc, unsigned& nx) {
    const unsigned G = gridDim.x * gridDim.y * gridDim.z;
    unsigned sum, cnt, mine, sp = 0u;
    for (;;) {
        sum = 0u; cnt = 0u; mine = 0u;
#pragma unroll
        for (unsigned j = 0; j < 16; ++j) { const unsigned c = xb_ld(&bar[XB_XCNT(j)]); sum += c; cnt += (c > 0u) ? 1u : 0u; mine = (j == x) ? c : mine; }
        if (sum == G) break;
        __builtin_amdgcn_s_sleep(1);
        if ((++sp & 255u) == 0u) { if (xb_ld(&bar[XB_TMO])) break; if (sp > XB_SPIN_CAP) { atomicAdd(&bar[XB_TMO], 1u); break; } }
    }
    nloc = mine > 0u ? mine : 1u; nx = cnt > 0u ? cnt : 1u;
}

__device__ __forceinline__ void xcd_barrier(const XcdBarrier& b) {
    asm volatile("s_waitcnt vmcnt(0)" ::: "memory");
    __syncthreads();
    if (threadIdx.x == 0) {
        unsigned* bar = b.bar;
        __builtin_amdgcn_s_waitcnt(0);
        unsigned nloc = b.st[0], nx = b.st[1];
        if (nloc == 0u) { xcd_barrier_complete(bar, b.x, nloc, nx); b.st[0] = nloc; b.st[1] = nx; }
        const unsigned old = xb_add(&bar[XB_XSUB(b.x)], 1u);
        const unsigned gen = old / nloc;
        if (old + 1u == (gen + 1u) * nloc) {
            __builtin_amdgcn_fence(__ATOMIC_RELEASE, "agent");
            asm volatile("s_waitcnt vmcnt(0)" ::: "memory");
            const unsigned og = xb_add(&bar[XB_TOP], 1u);
            const unsigned tg = og / nx;
            if (og + 1u == (tg + 1u) * nx) xb_add(&bar[XB_TOPGEN], 1u);
            else XB_SPIN(xb_ld(&bar[XB_TOPGEN]) == tg, bar);
            __builtin_amdgcn_fence(__ATOMIC_ACQUIRE, "agent");
            xb_add(&bar[XB_XGEN(b.x)], 1u);
            asm volatile("s_waitcnt vmcnt(0)" ::: "memory");
        } else {
            XB_SPIN(xb_ld(&bar[XB_XGEN(b.x)]) == gen, bar);
            __builtin_amdgcn_fence(__ATOMIC_ACQUIRE, "agent");
            asm volatile("s_waitcnt vmcnt(0)" ::: "memory");
        }
    }
    __syncthreads();
}
struct Frame {
    LAS unsigned char* lds;
    unsigned char* ldsg;
    volatile LAS unsigned* MISC;
    int tid, lane, wave, vcu, G, gw, NGW;
    const float* const* in;
    unsigned char* ws;
    float* out;
};
#define WSP(T, off) ((T*)(F.ws + (off)))
#define LAUNDER(F) asm volatile("" : "+s"(F.ws), "+s"(F.in), "+s"(F.out), "+v"(F.tid), "+v"(F.lane), "+s"(F.wave), "+s"(F.gw), "+s"(F.vcu), "+s"(F.G), "+s"(F.NGW))

__device__ __forceinline__ int row_s(int row) { return row < TLAT ? (row >> 12) : 4; }

__device__ __forceinline__ void mod_row_store(const f32x4 (&v)[4], const float* g, const float* shift, const float* scale, bf16* orow, int lane, f32x4 (&h)[4]) {
    float s = 0.f;
#pragma unroll
    for (int j = 0; j < 4; ++j) s += (v[j].x * v[j].x + v[j].y * v[j].y) + (v[j].z * v[j].z + v[j].w * v[j].w);
    const float rstd = 1.0f / sqrtf(wave_sum(s) * (1.0f / 1024.0f) + 1e-6f);
#pragma unroll
    for (int j = 0; j < 4; ++j) {
        const f32x4 g4 = ((const f32x4*)g)[64 * j + lane], sh = ((const f32x4*)shift)[64 * j + lane], sc = ((const f32x4*)scale)[64 * j + lane];
        h[j] = (v[j] * rstd) * g4 * (sc + 1.0f) + sh;
        v2u o; o.x = pk2(h[j].x, h[j].y); o.y = pk2(h[j].z, h[j].w);
        ((v2u*)orow)[64 * j + lane] = o;
    }
}

template <class RowMap>
__device__ __forceinline__ void transpose_item(const float* W, int K, int N, bf16* WT, const RowMap& rowmap, LAS float* scr, int item, int lane) {
    const int nblk = N / 32, kb = item / nblk, nb = item % nblk, k0 = 64 * kb, n0 = 32 * nb;
#pragma unroll 8
    for (int i = 0; i < 32; ++i) { const int kk = 2 * i + (lane >> 5); scr[kk * 33 + (lane & 31)] = W[(size_t)(k0 + kk) * N + n0 + (lane & 31)]; }
    LDS_WAIT(); asm volatile("" ::: "memory");
    const int c = lane & 7;
#pragma unroll
    for (int j = 0; j < 4; ++j) { const int n = (lane >> 3) + 8 * j; const LAS float* s = scr + (8 * c) * 33 + n;
        v4u o; o.x = pk2(s[0 * 33], s[1 * 33]); o.y = pk2(s[2 * 33], s[3 * 33]); o.z = pk2(s[4 * 33], s[5 * 33]); o.w = pk2(s[6 * 33], s[7 * 33]);
        *(v4u*)(WT + (size_t)rowmap(n0 + n) * K + k0 + 8 * c) = o; }
    LDS_WAIT(); asm volatile("" ::: "memory");
}
struct RowId { int off; __device__ __forceinline__ int operator()(int n) const { return off + n; } };
struct RowW13 { int e, w3; __device__ __forceinline__ int operator()(int n) const { return e * 2048 + (n >> 7) * 256 + w3 * 128 + (n & 127); } };

__device__ __forceinline__ void ph_prologue(Frame& F0) { Frame F = F0; LAUNDER(F);
    LAS float* scr = (LAS float*)(F.lds + F.wave * 8448);
    LAS float* sv = (LAS float*)(F.lds + 69632);
    for (int i = F.tid; i < 5 * 1024; i += NTHR) { const float x = i < 4096 ? F.in[I_C][i] : F.in[I_CCTX][i - 4096]; sv[i] = siluf_(x); }
    __syncthreads();
    constexpr int I_IN = 16 * (EVC / 32), I_O = 16 * 32, I_Q = 16 * (QKVC / 32);
    constexpr int PER_J = I_IN + I_O + I_Q + I_O, NT_ITEMS = 2 * PER_J;
    for (int it = F.gw; it < NT_ITEMS; it += F.NGW) {
        const int j = it / PER_J; int r = it % PER_J;
        if (r < I_IN) { transpose_item(F.in[I_EVWIN] + (size_t)j * DM * EVC, DM, EVC, WSP(bf16, WS_WIN) + (size_t)j * EVCP * DM, RowId{0}, scr, r, F.lane); continue; } r -= I_IN;
        if (r < I_O) { transpose_item(F.in[I_EVWOUT] + (size_t)j * DM * DM, DM, DM, WSP(bf16, WS_WOE) + (size_t)j * DM * DM, RowId{0}, scr, r, F.lane); continue; } r -= I_O;
        if (r < I_Q) { transpose_item(F.in[I_WQKV] + (size_t)j * DM * QKVC, DM, QKVC, WSP(bf16, WS_WQKV) + (size_t)j * QKVC * DM, RowId{0}, scr, r, F.lane); continue; } r -= I_Q;
        transpose_item(F.in[I_DAWOUT] + (size_t)j * DM * DM, DM, DM, WSP(bf16, WS_WOD) + (size_t)j * DM * DM, RowId{0}, scr, r, F.lane);
    }
    for (int i = F.gw * 64 + F.lane; i < 2 * 32 * DM / 8; i += F.NGW * 64) { const int j = i / (32 * DM / 8), r = i % (32 * DM / 8);
        *(v4u*)(WSP(bf16, WS_WIN) + (size_t)j * EVCP * DM + (size_t)EVC * DM + r * 8) = (v4u){0u, 0u, 0u, 0u}; }
    for (int it = F.gw; it < 4 * 24 * 8; it += F.NGW) {
        const int kc = it & 7, cg = (it >> 3) % 24, i = it / (8 * 24); const int col = cg * 256 + F.lane * 4;
        const float* wp = F.in[I_ADAW] + (size_t)i * DM * 6144 + (size_t)(kc * 128) * 6144 + col;
        f32x4 acc[5];
#pragma unroll
        for (int s = 0; s < 5; ++s) acc[s] = (f32x4){0.f, 0.f, 0.f, 0.f};
#pragma unroll 8
        for (int k = 0; k < 128; ++k) { const f32x4 w = *(const f32x4*)(wp + (size_t)k * 6144);
#pragma unroll
            for (int s = 0; s < 5; ++s) acc[s] = acc[s] + w * sv[s * 1024 + kc * 128 + k]; }
#pragma unroll
        for (int s = 0; s < 5; ++s) *(f32x4*)(WSP(float, WS_MODP) + ((size_t)(kc * 4 + i) * 5 + s) * 6144 + col) = acc[s];
    }
    for (int k = F.gw * 64 + F.lane; k < 8192; k += F.NGW * 64) { float s, c; sincospif((float)k * (1.0f / 4096.0f), &s, &c); WSP(f32x2, WS_TW)[k] = (f32x2){c, -s}; }
    for (int idx = F.gw * 64 + F.lane; idx < 2 * 224 * 64; idx += F.NGW * 64) {
        const int l = idx & 63, f = (idx >> 6) % 224, j = idx / (224 * 64); const int kb = 8 * (l >> 4), n = l & 15;
        const float* src; int col;
        if (f < 64) { const int d = f >> 5, nt = f & 31; src = F.in[I_W2] + ((size_t)(j * 2 + d) * 32 + kb) * RWW; col = nt * 16 + n; }
        else if (f < 128) { const int d = (f - 64) >> 5, nt = (f - 64) & 31; src = F.in[I_A2] + ((size_t)(j * 2 + d) * 32 + kb) * RWW; col = nt * 16 + n; }
        else { const int nt = (f - 128) / 3, ks = (f - 128) % 3; src = F.in[I_G2] + ((size_t)j * 96 + ks * 32 + kb) * RWW; col = nt * 16 + n; }
        v4u o; o.x = pk2(src[0 * RWW + col], src[1 * RWW + col]); o.y = pk2(src[2 * RWW + col], src[3 * RWW + col]); o.z = pk2(src[4 * RWW + col], src[5 * RWW + col]); o.w = pk2(src[6 * RWW + col], src[7 * RWW + col]);
        WSP(v4u, WS_FRAGB)[idx] = o;
    }
}
__device__ __forceinline__ void ph_modred(Frame& F0) { Frame F = F0; LAUNDER(F);
    for (int idx = F.gw * 64 + F.lane; idx < 4 * 5 * 6144; idx += F.NGW * 64) {
        const int col = idx % 6144, i = idx / (5 * 6144); float a = F.in[I_ADAB][i * 6144 + col];
#pragma unroll
        for (int kc = 0; kc < 8; ++kc) a += WSP(float, WS_MODP)[(size_t)kc * 4 * 5 * 6144 + idx];
        WSP(float, WS_MODS)[idx] = a;
    }
}
__device__ __forceinline__ void ph_mod0(Frame& F0) { Frame F = F0; LAUNDER(F);
    const float* mods = WSP(float, WS_MODS);
    for (int row = F.gw; row < TT; row += F.NGW) {
        const float* src = row < TLAT ? F.in[I_X] + (size_t)row * DM : F.in[I_CTX] + (size_t)(row - TLAT) * DM;
        f32x4 v[4], h[4];
#pragma unroll
        for (int j = 0; j < 4; ++j) { v[j] = ((const f32x4*)src)[64 * j + F.lane]; ((f32x4*)(WSP(float, WS_X) + (size_t)row * DM))[64 * j + F.lane] = v[j]; }
        const int s = row_s(row);
        mod_row_store(v, F.in[I_NORMG], mods + s * 6144, mods + s * 6144 + 1024, WSP(bf16, WS_HA) + (size_t)row * DM, F.lane, h);
    }
}
__device__ __forceinline__ float seq_pos(int row, int& L) { if (row < TLAT) { L = SEQ; return (float)(row & (SEQ - 1)); } L = CTXL; return (float)((row - TLAT) & (CTXL - 1)); }
__device__ __forceinline__ int seq_l(int row, int& L) { if (row < TLAT) { L = SEQ; return row & (SEQ - 1); } L = CTXL; return (row - TLAT) & (CTXL - 1); }

__device__ __forceinline__ f32x4 shift4(const float* P, size_t off, bool hp, bool hn, f32x4 m0, f32x4 m1) {
    const f32x4 u = *(const f32x4*)(P + off);
    const f32x4 up = hp ? *(const f32x4*)(P + off - EVCP) : (f32x4){0.f, 0.f, 0.f, 0.f};
    const f32x4 un = hn ? *(const f32x4*)(P + off + EVCP) : (f32x4){0.f, 0.f, 0.f, 0.f};
    return u + m0 * (up - u) + m1 * (un - u);
}

__device__ __forceinline__ void ph_evprep(Frame& F0, int j) { Frame F = F0; LAUNDER(F);
    const float* P = WSP(float, WS_P);
    const float* mu = F.in[I_MU] + (size_t)j * 2 * RWC;
    float* RW[9];
#pragma unroll
    for (int a = 0; a < 9; ++a) RW[a] = (float*)(F.ws + WS_RW + (size_t)a * RW_STRIDE);
#ifndef NO_EV_A
    for (int tile = F.gw; tile < TT / 32; tile += F.NGW) {
        const int base = tile * 32;
        LAS unsigned char* sA = F.lds + F.wave * 14848;
#pragma unroll 2
        for (int idx = F.lane; idx < 32 * 56; idx += 64) {
            const int t = idx / 56, cg = idx - t * 56, col = 1536 + 4 * cg; const int row = base + t; int L; const int l = seq_l(row, L);
            const f32x4 m0 = *(const f32x4*)(mu + col), m1 = *(const f32x4*)(mu + RWC + col);
            f32x4 s = shift4(P, (size_t)row * EVCP + col, l > 0, l < L - 1, m0, m1);
            if (cg < 16) { s.x = tanhf(s.x); s.y = tanhf(s.y); s.z = tanhf(s.z); s.w = tanhf(s.w); }
            else if (cg >= 32) { s.x = sigmoidf_(s.x); s.y = sigmoidf_(s.y); s.z = sigmoidf_(s.z); s.w = sigmoidf_(s.w); }
            v2u w; w.x = pk2(s.x, s.y); w.y = pk2(s.z, s.w);
            *(LAS v2u*)(sA + t * 464 + cg * 8) = w;
        }
        LDS_WAIT(); asm volatile("" ::: "memory");
        bf16x8 af[2][7];
#pragma unroll
        for (int st = 0; st < 2; ++st)
#pragma unroll
            for (int f7 = 0; f7 < 7; ++f7) af[st][f7] = *(const LAS bf16x8*)(sA + (st * 16 + (F.lane & 15)) * 464 + (f7 * 32 + 8 * (F.lane >> 4)) * 2);
        LDS_WAIT(); asm volatile("" ::: "memory");
        const v4u* FB = WSP(v4u, WS_FRAGB) + (size_t)j * 224 * 64;
        const int ocol = F.lane & 15, orow = (F.lane >> 4) * 4;
#ifndef NO_A2
#pragma unroll
        for (int d = 0; d < 2; ++d) {
#pragma unroll 2
            for (int nt = 0; nt < 32; ++nt) {
                const bf16x8 bw = __builtin_bit_cast(bf16x8, FB[(d * 32 + nt) * 64 + F.lane]);
                const bf16x8 ba = __builtin_bit_cast(bf16x8, FB[(64 + d * 32 + nt) * 64 + F.lane]);
                const int col = nt * 16 + ocol;
                const float w0 = F.in[I_W0][(size_t)(j * 2 + d) * RWW + col], a0 = F.in[I_A0][(size_t)(j * 2 + d) * RWW + col];
#pragma unroll
                for (int st = 0; st < 2; ++st) {
                    f32x4 cw = __builtin_amdgcn_mfma_f32_16x16x32_bf16(af[st][d], bw, (f32x4){0.f, 0.f, 0.f, 0.f}, 0, 0, 0);
                    f32x4 ca = __builtin_amdgcn_mfma_f32_16x16x32_bf16(af[st][2 + d], ba, (f32x4){0.f, 0.f, 0.f, 0.f}, 0, 0, 0);
#pragma unroll
                    for (int r = 0; r < 4; ++r) { const size_t o = (size_t)(base + st * 16 + orow + r) * RWW + col;
                        RW[5 + d][o] = __expf(-0.6065306597126334f * sigmoidf_(w0 + cw[r]));
                        RW[7 + d][o] = sigmoidf_(a0 + ca[r]); }
                }
            }
        }
#endif
#ifndef NO_A3
#pragma unroll 2
        for (int nt = 0; nt < 32; ++nt) {
            const bf16x8 b0 = __builtin_bit_cast(bf16x8, FB[(128 + nt * 3 + 0) * 64 + F.lane]);
            const bf16x8 b1 = __builtin_bit_cast(bf16x8, FB[(128 + nt * 3 + 1) * 64 + F.lane]);
            const bf16x8 b2 = __builtin_bit_cast(bf16x8, FB[(128 + nt * 3 + 2) * 64 + F.lane]);
            const int col = nt * 16 + ocol;
#pragma unroll
            for (int st = 0; st < 2; ++st) {
                f32x4 cg = __builtin_amdgcn_mfma_f32_16x16x32_bf16(af[st][4], b0, (f32x4){0.f, 0.f, 0.f, 0.f}, 0, 0, 0);
                cg = __builtin_amdgcn_mfma_f32_16x16x32_bf16(af[st][5], b1, cg, 0, 0, 0);
                cg = __builtin_amdgcn_mfma_f32_16x16x32_bf16(af[st][6], b2, cg, 0, 0, 0);
#pragma unroll
                for (int r = 0; r < 4; ++r) RW[4][(size_t)(base + st * 16 + orow + r) * RWW + col] = cg[r];
            }
        }
#endif
#ifndef NO_A4
#pragma unroll 1
        for (int t = 0; t < 32; ++t) {
            const int row = base + t; int L; const int l = seq_l(row, L); const bool hp = l > 0, hn = l < L - 1;
#pragma unroll
            for (int q = 0; q < 2; ++q) {
                const int c = 4 * F.lane + 256 * q;
#pragma unroll
                for (int a = 0; a < 3; ++a) {
                    const int col = a * 512 + c;
                    const f32x4 m0 = *(const f32x4*)(mu + col), m1 = *(const f32x4*)(mu + RWC + col);
                    const f32x4 s = shift4(P, (size_t)row * EVCP + col, hp, hn, m0, m1);
                    *(f32x4*)(RW[a] + (size_t)row * RWW + c) = s;
                    if (a == 1) {
                        const f32x4 kx = s * *(const f32x4*)(F.in[I_KK] + (size_t)j * RWW + c);
                        float ss = (kx.x * kx.x + kx.y * kx.y) + (kx.z * kx.z + kx.w * kx.w);
                        ss = sum16_f(ss);
                        const float inv = 1.0f / fmaxf(sqrtf(ss), 1e-12f);
                        *(f32x4*)(RW[3] + (size_t)row * RWW + c) = kx * inv;
                    }
                }
            }
        }
#endif
    }
#endif
#ifndef NO_EV_B
    {
        LAS float* scr = (LAS float*)(F.lds + F.wave * 16640);
        const float* cw = F.in[I_CONVW] + (size_t)j * 3 * HYC; const float* cb = F.in[I_CONVB] + (size_t)j * HYC;
        for (int it = F.gw; it < (TT / 64) * (HYC / 64); it += F.NGW) {
            const int rt = it / (HYC / 64), ct = it % (HYC / 64); const int r0 = rt * 64, c = ct * 64 + F.lane;
            const float w0 = cw[c], w1 = cw[HYC + c], w2 = cw[2 * HYC + c], bb = cb[c];
            int L; const int l0 = seq_l(r0, L);
            for (int rr = 0; rr < 64; ++rr) {
                const int row = r0 + rr, l = l0 + rr; const size_t o = (size_t)row * EVCP + RWC + c;
                const float u = P[o], up = l > 0 ? P[o - EVCP] : 0.f, un = l < L - 1 ? P[o + EVCP] : 0.f;
                scr[F.lane * 65 + rr] = up * w0 + u * w1 + un * w2 + bb;
            }
            LDS_WAIT(); asm volatile("" ::: "memory");
            float* dst; if (r0 < TLAT) dst = WSP(float, WS_UTL) + ((size_t)(r0 >> 12) * HYC + ct * 64) * SEQ + l0; else dst = WSP(float, WS_UTC) + ((size_t)((r0 - TLAT) >> 8) * HYC + ct * 64) * CTXL + l0;
            for (int cc = 0; cc < 64; ++cc) dst[(size_t)cc * L + F.lane] = scr[cc * 65 + F.lane];
            LDS_WAIT(); asm volatile("" ::: "memory");
        }
    }
#endif
    __syncthreads();
#ifndef NO_EV_C
    {
        LAS float* H1 = (LAS float*)F.lds; LAS float* H2 = (LAS float*)(F.lds + 16384);
        LAS float* W1s = (LAS float*)(F.lds + 32768); LAS float* B1s = (LAS float*)(F.lds + 41216); LAS float* B2s = (LAS float*)(F.lds + 41472); LAS float* FRs = (LAS float*)(F.lds + 41728);
        LAS float* W2s = (LAS float*)(F.lds + 42240); LAS float* W3s = (LAS float*)(F.lds + 58624);
        for (int i = F.tid; i < 33 * 64; i += NTHR) W1s[i] = F.in[I_FW1][(size_t)j * 33 * 64 + i];
        for (int i = F.tid; i < 64 * 64; i += NTHR) W2s[i] = F.in[I_FW2][(size_t)j * 64 * 64 + i];
        if (F.tid < 64) { B1s[F.tid] = F.in[I_FB1][j * 64 + F.tid]; B2s[F.tid] = F.in[I_FB2][j * 64 + F.tid]; }
        if (F.tid < 128) FRs[F.tid] = F.in[I_FREQ][j * 128 + F.tid];
        const float* w3 = F.in[I_FW3] + (size_t)j * 64 * 2048;
        const int p = F.tid & 63, cg = F.wave;
        for (int it = F.vcu; it < 1088; it += F.G) {
            const bool lat = it < 1024; const int L = lat ? SEQ : CTXL; const int r = lat ? it : it - 1024; const int pt = r >> 4, ct = r & 15; const int m = pt * 64 + p;
            __syncthreads();
            for (int i = F.tid; i < 64 * 32; i += NTHR) { const int k = i >> 5, c4 = i & 31; *(LAS f32x4*)(W3s + k * 128 + c4 * 4) = *(const f32x4*)(w3 + (size_t)k * 2048 + ct * 128 + c4 * 4); }
            float z[33];
            z[0] = (float)m / (float)(L - 1);
#pragma unroll
            for (int i = 0; i < 16; ++i) { const float band = 1e-4f + (float)i * ((15.0f - 1e-4f) / 15.0f); float s, c; sincospif(2.0f * (float)m * band / (float)L, &s, &c); z[1 + i] = c; z[17 + i] = -s; }
            __syncthreads();
#pragma unroll 1
            for (int q = 0; q < 8; ++q) { const int n = cg * 8 + q; float a = B1s[n];
#pragma unroll
                for (int i = 0; i < 33; ++i) a += z[i] * W1s[i * 64 + n];
                H1[n * 64 + p] = sinf(FRs[n] * a); }
            __syncthreads();
#pragma unroll 1
            for (int q = 0; q < 8; ++q) { const int n = cg * 8 + q; float a = B2s[n];
#pragma unroll 8
                for (int k = 0; k < 64; ++k) a += H1[k * 64 + p] * W2s[k * 64 + n];
                H2[n * 64 + p] = sinf(FRs[64 + n] * a); }
            __syncthreads();
            f32x4 acc[4];
#pragma unroll
            for (int q = 0; q < 4; ++q) acc[q] = (f32x4){0.f, 0.f, 0.f, 0.f};
#pragma unroll 2
            for (int k = 0; k < 64; ++k) { const float hv = H2[k * 64 + p]; const LAS f32x4* wr = (const LAS f32x4*)(W3s + k * 128 + cg * 16);
#pragma unroll
                for (int q = 0; q < 4; ++q) acc[q] = acc[q] + wr[q] * hv; }
            const float t = z[0];
            float* KC = lat ? WSP(float, WS_KCL) : WSP(float, WS_KCC); const int N2 = 2 * L;
            const int colb = ct * 128 + cg * 16;
#pragma unroll
            for (int q = 0; q < 16; ++q) { const int col = colb + q; const int o = col >> 10, dirn = (col >> 9) & 1, c = col & 511;
                const float d0 = -3.0701134573253945f, d1 = -15.350567286626973f; const float del = fabsf(d0 + (d1 - d0) * ((float)c / 511.0f));
                const float val = acc[q >> 2][q & 3] * __expf(-t * del); float* kr = KC + (size_t)(o * 512 + c) * N2;
                if (dirn == 0) kr[m] = val; else { if (m > 0) kr[N2 - m] = val; else kr[L] = 0.f; } }
        }
        __syncthreads();
    }
#endif
}

__device__ __forceinline__ float row16_sum(float x) { return sum16_f(x); }

__device__ __forceinline__ int scan_row(int b, int d, int n) {
    if (n < CTXL) return TLAT + b * CTXL + (d ? CTXL - 1 - n : n);
    const int t = n - CTXL; return b * SEQ + (d ? SEQ - 1 - t : t);
}
__device__ __forceinline__ void ph_scan(Frame& F0, int j) { Frame F = F0; LAUNDER(F);
    constexpr int CH = 32, NCH = KSEQ / CH, VECB = CH * 5 * 64 * 4, BUFB = VECB + CH * 16 * 4, YOFF = 2 * BUFB;
    const float* Rr = (const float*)(F.ws + WS_RW + 0 * RW_STRIDE); const float* Kk = (const float*)(F.ws + WS_RW + 1 * RW_STRIDE); const float* Vv = (const float*)(F.ws + WS_RW + 2 * RW_STRIDE);
    const float* KKn = (const float*)(F.ws + WS_RW + 3 * RW_STRIDE);
    const float* ka = F.in[I_KA] + (size_t)j * RWW;
    for (int it = F.vcu; it < 256; it += F.G) {
        const int s = it >> 2, g = it & 3, b = s >> 4, h = (s >> 1) & 7, d = s & 1;
        const float* Wd = (const float*)(F.ws + WS_RW + (size_t)(5 + d) * RW_STRIDE); const float* Ad = (const float*)(F.ws + WS_RW + (size_t)(7 + d) * RW_STRIDE);
        float* Yd = WSP(float, WS_Y) + (size_t)d * TT * RWW;
        const bool loader = F.wave >= 4; const int lt = F.tid - 256;
        float lr[8], lkk[8], lk[8], lw[8], la[8], lv[2];
#define SC_LOAD(c) do { _Pragma("unroll") for (int q = 0; q < 8; ++q) { const int pp = lt + 256 * q, st = pp >> 6, col = h * 64 + (pp & 63); const size_t o = (size_t)scan_row(b, d, (c) * CH + st) * RWW + col; \
            lr[q] = Rr[o]; lkk[q] = KKn[o]; lk[q] = Kk[o]; lw[q] = Wd[o]; la[q] = Ad[o]; } \
        _Pragma("unroll") for (int q = 0; q < 2; ++q) { const int pp = lt + 256 * q, st = pp >> 4, i = pp & 15; lv[q] = Vv[(size_t)scan_row(b, d, (c) * CH + st) * RWW + h * 64 + g * 16 + i]; } } while (0)
#define SC_STORE(buf) do { LAS float* vb = (LAS float*)(F.lds + (buf) * BUFB); \
        _Pragma("unroll") for (int q = 0; q < 8; ++q) { const int pp = lt + 256 * q, st = pp >> 6, cc = pp & 63; const float kav = ka[h * 64 + cc]; LAS float* e = vb + st * 320 + cc; \
            e[0] = lkk[q]; e[64] = lw[q]; e[128] = lkk[q] * la[q]; e[192] = lk[q] * (1.0f + (la[q] - 1.0f) * kav); e[256] = lr[q]; } \
        _Pragma("unroll") for (int q = 0; q < 2; ++q) { const int pp = lt + 256 * q; ((LAS float*)(F.lds + (buf) * BUFB + VECB))[pp] = lv[q]; } } while (0)
        if (loader) { SC_LOAD(0); SC_STORE(0); }
        __syncthreads();
        f32x4 S = (f32x4){0.f, 0.f, 0.f, 0.f};
        const int rl = (F.wave & 3) * 4 + (F.lane >> 4), cq = F.lane & 15;
        for (int c = 0; c < NCH; ++c) {
            if (loader) {
                if (c + 1 < NCH) SC_LOAD(c + 1);
                if (c > 0) {
                    const LAS float* yb = (const LAS float*)(F.lds + YOFF + ((c - 1) & 1) * 2048);
#pragma unroll
                    for (int q = 0; q < 2; ++q) { const int pp = lt + 256 * q, st = pp >> 4, i = pp & 15; Yd[(size_t)scan_row(b, d, (c - 1) * CH + st) * RWW + h * 64 + g * 16 + i] = yb[pp]; }
                }
                if (c + 1 < NCH) SC_STORE((c + 1) & 1);
            } else {
                const LAS unsigned char* vb = F.lds + (c & 1) * BUFB; LAS float* yb = (LAS float*)(F.lds + YOFF + (c & 1) * 2048);
#pragma unroll 4
                for (int st = 0; st < CH; ++st) {
                    const LAS unsigned char* e = vb + st * 1280 + cq * 16;
                    const f32x4 kk4 = *(const LAS f32x4*)(e), w4 = *(const LAS f32x4*)(e + 256), b4 = *(const LAS f32x4*)(e + 512), kd4 = *(const LAS f32x4*)(e + 768), r4 = *(const LAS f32x4*)(e + 1024);
                    const float v = *(const LAS float*)(vb + VECB + (st * 16 + rl) * 4);
                    float sa = (S.x * kk4.x + S.y * kk4.y) + (S.z * kk4.z + S.w * kk4.w);
                    const f32x4 T = S * w4 + kd4 * v;
                    sa = row16_sum(sa);
                    S = T - b4 * sa;
                    float y = (S.x * r4.x + S.y * r4.y) + (S.z * r4.z + S.w * r4.w);
                    y = row16_sum(y);
                    if (cq == 0) yb[st * 16 + rl] = y;
                }
            }
            __syncthreads();
        }
        if (loader) {
            const LAS float* yb = (const LAS float*)(F.lds + YOFF + ((NCH - 1) & 1) * 2048);
#pragma unroll
            for (int q = 0; q < 2; ++q) { const int pp = lt + 256 * q, st = pp >> 4, i = pp & 15; Yd[(size_t)scan_row(b, d, (NCH - 1) * CH + st) * RWW + h * 64 + g * 16 + i] = yb[pp]; }
        }
        __syncthreads();
#undef SC_LOAD
#undef SC_STORE
    }
}
__device__ __forceinline__ f32x2 cmul(f32x2 a, f32x2 b) { return (f32x2){a.x * b.x - a.y * b.y, a.x * b.y + a.y * b.x}; }
__device__ __forceinline__ f32x2 cmulc(f32x2 a, f32x2 b) { return (f32x2){a.x * b.x + a.y * b.y, a.y * b.x - a.x * b.y}; }
template <int LOGN> __device__ __forceinline__ void fft_dif(LAS f32x2* Z, const LAS f32x2* TWL, int tid) {
    constexpr int N = 1 << LOGN;
#pragma unroll 1
    for (int lh = LOGN - 1; lh >= 0; --lh) {
        const int half = 1 << lh;
        for (int bf = tid; bf < N / 2; bf += NTHR) {
            const int jx = bf & (half - 1), i = ((bf - jx) << 1) + jx;
            const f32x2 a = Z[i], b = Z[i + half]; Z[i] = a + b; Z[i + half] = cmul(a - b, TWL[jx << (LOGN - 1 - lh)]);
        }
        __syncthreads();
    }
}
template <int LOGN> __device__ __forceinline__ void fft_dit_inv(LAS f32x2* Z, const LAS f32x2* TWL, int tid) {
    constexpr int N = 1 << LOGN;
#pragma unroll 1
    for (int lh = 0; lh < LOGN; ++lh) {
        const int half = 1 << lh;
        for (int bf = tid; bf < N / 2; bf += NTHR) {
            const int jx = bf & (half - 1), i = ((bf - jx) << 1) + jx;
            const f32x2 a = Z[i], b = cmulc(Z[i + half], TWL[jx << (LOGN - 1 - lh)]); Z[i] = a + b; Z[i + half] = a - b;
        }
        __syncthreads();
    }
}
template <int LOGN> __device__ __forceinline__ int brev_n(int x) { return (int)(__brev((unsigned)x) >> (32 - LOGN)); }
template <int LOGN> __device__ __forceinline__ void load_tw(Frame& F, LAS f32x2* TWL) {
    constexpr int N = 1 << LOGN; const f32x2* TW = WSP(f32x2, WS_TW);
    for (int k = F.tid; k < N / 2; k += NTHR) TWL[k] = TW[k << (13 - LOGN)];
}
__device__ __forceinline__ float block_sum(Frame& F, float v, LAS float* red) {
    v = wave_sum(v); __syncthreads(); if (F.lane == 0) red[F.wave] = v; __syncthreads();
    float t = 0.f;
#pragma unroll
    for (int w = 0; w < NWAVES; ++w) t += red[w];
    return t;
}

template <int LOGN> __device__ __forceinline__ void fftk_item(Frame& F, const float* KC, f32x4* KSP, int o, int pr) {
    constexpr int N = 1 << LOGN;
    LAS f32x2* Z = (LAS f32x2*)F.lds; LAS f32x2* TWL = (LAS f32x2*)(F.lds + 65536); LAS float* red = (LAS float*)(F.lds + 65536 + 32768);
    const float* ka = KC + (size_t)(o * 512 + 2 * pr) * N; const float* kb = ka + N;
    float sa = 0.f, sb = 0.f;
    for (int i = F.tid; i < N; i += NTHR) { const float a = ka[i], b = kb[i]; sa += fabsf(a); sb += fabsf(b); Z[i] = (f32x2){a, b}; }
    const float na = block_sum(F, sa, red) + 1e-6f; const float nb = block_sum(F, sb, red + 8) + 1e-6f;
    __syncthreads();
    fft_dif<LOGN>(Z, TWL, F.tid);
    const float ia = 0.5f / (na * (float)N), ib = 0.5f / (nb * (float)N);
    f32x4* dst = KSP + (size_t)(o * 256 + pr) * N;
    for (int p = F.tid; p < N; p += NTHR) {
        const int k = brev_n<LOGN>(p), p2 = brev_n<LOGN>((N - k) & (N - 1));
        const f32x2 z1 = Z[p], z2 = Z[p2];
        const f32x2 Ka = (f32x2){(z1.x + z2.x) * ia, (z1.y - z2.y) * ia}, Kb = (f32x2){(z1.y + z2.y) * ib, -(z1.x - z2.x) * ib};
        dst[p] = (f32x4){0.5f * (Ka.x + Kb.x), 0.5f * (Ka.y + Kb.y), 0.5f * (Ka.x - Kb.x), 0.5f * (Ka.y - Kb.y)};
    }
    __syncthreads();
}
__device__ __forceinline__ void ph_fftk(Frame& F0) { Frame F = F0; LAUNDER(F);
    LAS f32x2* TWL = (LAS f32x2*)(F.lds + 65536);
    load_tw<13>(F, TWL); __syncthreads();
    for (int it = F.vcu; it < 512; it += F.G) fftk_item<13>(F, WSP(float, WS_KCL), WSP(f32x4, WS_KSPL), it >> 8, it & 255);
    __syncthreads(); load_tw<9>(F, TWL); __syncthreads();
    for (int it = F.vcu; it < 512; it += F.G) fftk_item<9>(F, WSP(float, WS_KCC), WSP(f32x4, WS_KSPC), it >> 8, it & 255);
    __syncthreads();
}

template <int LOGN> __device__ __forceinline__ void spec_mul(LAS f32x2* Z, const f32x4* KS, int tid) {
    constexpr int N = 1 << LOGN;
    for (int p = tid; p < N; p += NTHR) {
        const int k = brev_n<LOGN>(p), p2 = brev_n<LOGN>((N - k) & (N - 1));
        if (p > p2) continue;
        const f32x2 z1 = Z[p], z2 = Z[p2];
        const f32x4 k1 = KS[p];
        const f32x2 y1 = cmul(z1, (f32x2){k1.x, k1.y}) + cmul((f32x2){z2.x, -z2.y}, (f32x2){k1.z, k1.w});
        if (p2 != p) { const f32x4 k2 = KS[p2]; const f32x2 y2 = cmul(z2, (f32x2){k2.x, k2.y}) + cmul((f32x2){z1.x, -z1.y}, (f32x2){k2.z, k2.w}); Z[p2] = y2; }
        Z[p] = y1;
    }
    __syncthreads();
}
template <int LOGN> __device__ __forceinline__ void hyena_item(Frame& F, const float* UT, const f32x4* KSP, float* HYT, const float* hyb, int pr) {
    constexpr int N = 1 << LOGN, L = N / 2, PT = (L + NTHR - 1) / NTHR;
    LAS f32x2* Z = (LAS f32x2*)F.lds; LAS f32x2* TWL = (LAS f32x2*)(F.lds + 65536);
    const int c0 = 2 * pr; const float b0a = hyb[c0], b0b = hyb[c0 + 1], b1a = hyb[512 + c0], b1b = hyb[512 + c0 + 1];
    const float* va = UT + (size_t)c0 * L; const float* vb = va + L;
    f32x2 keep[PT];
#pragma unroll
    for (int q = 0; q < PT; ++q) { const int l = F.tid + NTHR * q; if (l < L) { keep[q] = (f32x2){va[l], vb[l]}; Z[l] = keep[q]; Z[l + L] = (f32x2){0.f, 0.f}; } }
    __syncthreads();
    fft_dif<LOGN>(Z, TWL, F.tid);
    spec_mul<LOGN>(Z, KSP + (size_t)pr * N, F.tid);
    fft_dit_inv<LOGN>(Z, TWL, F.tid);
    const float* xa = UT + (size_t)(512 + c0) * L; const float* xb = xa + L;
#pragma unroll
    for (int q = 0; q < PT; ++q) { const int l = F.tid + NTHR * q; if (l < L) { const f32x2 y = Z[l]; keep[q] = (f32x2){xa[l] * (y.x + keep[q].x * b0a), xb[l] * (y.y + keep[q].y * b0b)}; } }
    __syncthreads();
#pragma unroll
    for (int q = 0; q < PT; ++q) { const int l = F.tid + NTHR * q; if (l < L) { Z[l] = keep[q]; Z[l + L] = (f32x2){0.f, 0.f}; } }
    __syncthreads();
    fft_dif<LOGN>(Z, TWL, F.tid);
    spec_mul<LOGN>(Z, KSP + (size_t)(256 + pr) * N, F.tid);
    fft_dit_inv<LOGN>(Z, TWL, F.tid);
    const float* x2a = UT + (size_t)(1024 + c0) * L; const float* x2b = x2a + L;
    float* oa = HYT + (size_t)c0 * L; float* ob = oa + L;
#pragma unroll
    for (int q = 0; q < PT; ++q) { const int l = F.tid + NTHR * q; if (l < L) { const f32x2 y = Z[l]; oa[l] = x2a[l] * (y.x + keep[q].x * b1a); ob[l] = x2b[l] * (y.y + keep[q].y * b1b); } }
    __syncthreads();
}
__device__ __forceinline__ void ph_hyena(Frame& F0, int j) { Frame F = F0; LAUNDER(F);
    LAS f32x2* TWL = (LAS f32x2*)(F.lds + 65536);
    const float* hyb = F.in[I_HYB] + (size_t)j * 1024;
    load_tw<13>(F, TWL); __syncthreads();
    for (int it = F.vcu; it < 1024; it += F.G) { const int b = it >> 8, pr = it & 255;
        hyena_item<13>(F, WSP(float, WS_UTL) + (size_t)b * HYC * SEQ, WSP(f32x4, WS_KSPL), WSP(float, WS_HYTL) + (size_t)b * 512 * SEQ, hyb, pr); }
    __syncthreads(); load_tw<9>(F, TWL); __syncthreads();
    for (int it = F.vcu; it < 1024; it += F.G) { const int b = it >> 8, pr = it & 255;
        hyena_item<9>(F, WSP(float, WS_UTC) + (size_t)b * HYC * CTXL, WSP(f32x4, WS_KSPC), WSP(float, WS_HYTC) + (size_t)b * 512 * CTXL, hyb, pr); }
    __syncthreads();
}

__device__ __forceinline__ void ph_readout(Frame& F0, int j) { Frame F = F0; LAUNDER(F);
    const float* Rr = (const float*)(F.ws + WS_RW + 0 * RW_STRIDE); const float* Kk = (const float*)(F.ws + WS_RW + 1 * RW_STRIDE); const float* Vv = (const float*)(F.ws + WS_RW + 2 * RW_STRIDE);
    const float* Gg = (const float*)(F.ws + WS_RW + 4 * RW_STRIDE); const float* A0 = (const float*)(F.ws + WS_RW + 7 * RW_STRIDE); const float* A1 = (const float*)(F.ws + WS_RW + 8 * RW_STRIDE);
    const float* Y0 = WSP(float, WS_Y); const float* Y1 = Y0 + (size_t)TT * RWW;
    const float* gn = F.in[I_GN] + (size_t)j * 2 * RWW; const float* ka = F.in[I_KA] + (size_t)j * RWW; const float* rk = F.in[I_RK] + (size_t)j * RWW;
    bf16* CAT = WSP(bf16, WS_CAT);
    for (int row = F.gw; row < TT; row += F.NGW) {
#pragma unroll
        for (int q = 0; q < 2; ++q) {
            const int c = 4 * F.lane + 256 * q; const size_t o = (size_t)row * RWW + c;
            const f32x4 y = *(const f32x4*)(Y0 + o) + *(const f32x4*)(Y1 + o);
            float s = (y.x + y.y) + (y.z + y.w);
            s = sum16_f(s);
            const float mu = s * (1.0f / 64.0f); const f32x4 dy = y - mu;
            float v2 = (dy.x * dy.x + dy.y * dy.y) + (dy.z * dy.z + dy.w * dy.w);
            v2 = sum16_f(v2);
            const float rstd = 1.0f / sqrtf(v2 * (1.0f / 64.0f) + 64e-5f);
            const f32x4 yn = dy * rstd * *(const f32x4*)(gn + c) + *(const f32x4*)(gn + RWW + c);
            const f32x4 r = *(const f32x4*)(Rr + o), k = *(const f32x4*)(Kk + o), v = *(const f32x4*)(Vv + o), g = *(const f32x4*)(Gg + o);
            const f32x4 a0 = *(const f32x4*)(A0 + o), a1 = *(const f32x4*)(A1 + o), kav = *(const f32x4*)(ka + c), rkv = *(const f32x4*)(rk + c);
            const f32x4 kd = k * ((a0 - 1.0f) * kav + 1.0f) + k * ((a1 - 1.0f) * kav + 1.0f);
            const f32x4 bt = r * kd * rkv;
            float bs = (bt.x + bt.y) + (bt.z + bt.w);
            bs = sum16_f(bs);
            f32x4 ov = (yn + v * bs) * g;
#ifdef ABL_RW
            ov = ov * 0.0f;
#endif
            v2u w; w.x = pk2(ov.x, ov.y); w.y = pk2(ov.z, ov.w);
            *(v2u*)(CAT + (size_t)row * DM + c) = w;
        }
    }
    LAS float* scr = (LAS float*)(F.lds + F.wave * 16640);
    for (int it = F.gw; it < (TT / 64) * 8; it += F.NGW) {
        const int rt = it >> 3, ct = it & 7; const int r0 = rt * 64; int L; const int l0 = seq_l(r0, L);
        const float* src; if (r0 < TLAT) src = WSP(float, WS_HYTL) + ((size_t)(r0 >> 12) * 512 + ct * 64) * SEQ + l0; else src = WSP(float, WS_HYTC) + ((size_t)((r0 - TLAT) >> 8) * 512 + ct * 64) * CTXL + l0;
        for (int cc = 0; cc < 64; ++cc) scr[cc * 65 + F.lane] = src[(size_t)cc * L + F.lane];
        LDS_WAIT(); asm volatile("" ::: "memory");
        const int c2 = 2 * (F.lane & 31);
        for (int i2 = 0; i2 < 32; ++i2) { const int rr = 2 * i2 + (F.lane >> 5);
            unsigned pkv = pk2(scr[c2 * 65 + rr], scr[(c2 + 1) * 65 + rr]);
#ifdef ABL_HY
            pkv = 0u;
#endif
            *(unsigned*)(CAT + (size_t)(r0 + rr) * DM + 512 + ct * 64 + c2) = pkv; }
        LDS_WAIT(); asm volatile("" ::: "memory");
    }
}
__device__ __forceinline__ void ph_mod2(Frame& F0, int i) { Frame F = F0; LAUNDER(F);
    LAS float* RL = (LAS float*)F.lds;
    const float* router = F.in[I_ROUTER] + (size_t)i * DM * NE;
    for (int idx = F.tid; idx < DM * NE; idx += NTHR) { const int c = idx >> 4, e = idx & 15; RL[e * 1024 + c] = router[idx]; }
    __syncthreads();
    const float* mods = WSP(float, WS_MODS) + (size_t)i * 5 * 6144; const float* g = F.in[I_NORMG] + (size_t)(i * 2 + 1) * DM;
    for (int row = F.gw; row < TT; row += F.NGW) {
        f32x4 v[4], h[4];
#pragma unroll
        for (int jj = 0; jj < 4; ++jj) v[jj] = ((const f32x4*)(WSP(float, WS_X) + (size_t)row * DM))[64 * jj + F.lane];
        const int s = row_s(row);
        mod_row_store(v, g, mods + s * 6144 + 3 * 1024, mods + s * 6144 + 4 * 1024, WSP(bf16, WS_HA) + (size_t)row * DM, F.lane, h);
        float mylg = -1e30f;
#pragma unroll 2
        for (int e = 0; e < 16; ++e) { float a = 0.f;
#pragma unroll
            for (int jj = 0; jj < 4; ++jj) { const f32x4 r4 = ((const LAS f32x4*)(RL + e * 1024))[64 * jj + F.lane]; a += (h[jj].x * r4.x + h[jj].y * r4.y) + (h[jj].z * r4.z + h[jj].w * r4.w); }
            a = wave_sum(a); if (F.lane == e) mylg = a; }
        const float mx = max16_f(mylg);
        const float ex = expf(mylg - mx); const float den = sum16_f(ex);
        const float mine = ex / den;
        if (F.lane < 16) WSP(float, WS_AFF)[(size_t)row * 16 + F.lane] = mine;
    }
}

__device__ __forceinline__ int block_excl_scan(Frame& F, int v, LAS int* sc, int& total) {
    LAS int* cnt = sc + 16;
    __syncthreads();
    cnt[F.tid] = v;
    const int ws = wave_sum_i(v);
    if (F.lane == 0) sc[F.wave] = ws;
    __syncthreads();
    int base = 0, tot = 0;
#pragma unroll
    for (int w = 0; w < NWAVES; ++w) { const int t = sc[w]; if (w < F.wave) base += t; tot += t; }
    int pre = 0;
    for (int k = 0; k < F.lane; ++k) pre += cnt[F.wave * 64 + k];
    total = tot; return base + pre;
}
__device__ __forceinline__ int block_sum_i(Frame& F, int v, LAS int* sc) {
    v = wave_sum_i(v);
    __syncthreads(); if (F.lane == 0) sc[F.wave] = v; __syncthreads();
    int t = 0;
#pragma unroll
    for (int w = 0; w < NWAVES; ++w) t += sc[w];
    return t;
}
__device__ __forceinline__ void topk_item(Frame& F, int set, int e) {
    LAS int* sc = (LAS int*)(F.lds + 69632);
    const bool lat = set < 4; const int L = lat ? SEQ : CTXL, cap = lat ? 512 : 32; const int rbase = lat ? set * SEQ : TLAT + (set - 4) * CTXL;
    const int sbase = e * EROWS + (lat ? set * 512 : 2048 + (set - 4) * 32);
    const float* aff = WSP(float, WS_AFF);
    unsigned key[8];
#pragma unroll
    for (int q = 0; q < 8; ++q) { const int l = F.tid * 8 + q; key[q] = l < L ? __builtin_bit_cast(unsigned, aff[(size_t)(rbase + l) * 16 + e]) : 0u; }
    unsigned thr = 0u;
    for (int bit = 30; bit >= 0; --bit) {
        const unsigned cand = thr | (1u << bit); int cnt = 0;
#pragma unroll
        for (int q = 0; q < 8; ++q) cnt += (key[q] >= cand) ? 1 : 0;
        if (block_sum_i(F, cnt, sc) >= cap) thr = cand;
    }
    int ngt = 0, neq = 0;
#pragma unroll
    for (int q = 0; q < 8; ++q) { ngt += key[q] > thr ? 1 : 0; neq += (key[q] == thr && (F.tid * 8 + q) < L) ? 1 : 0; }
    int tot_gt, tot_eq; const int bgt = block_excl_scan(F, ngt, sc, tot_gt); const int beq = block_excl_scan(F, neq, sc, tot_eq);
    const int need_eq = cap - tot_gt; int rg = bgt, re = beq;
    int* slotmap = WSP(int, WS_SLOT); int* idxo = WSP(int, WS_IDX); float* gate = WSP(float, WS_GATE);
#pragma unroll
    for (int q = 0; q < 8; ++q) { const int l = F.tid * 8 + q; if (l < L) {
        int slot = -1;
        if (key[q] > thr) { slot = rg; ++rg; } else if (key[q] == thr) { if (re < need_eq) slot = tot_gt + re; ++re; }
        slotmap[(size_t)e * TT + rbase + l] = slot;
        if (slot >= 0) { idxo[sbase + slot] = rbase + l; gate[sbase + slot] = __builtin_bit_cast(float, key[q]); } } }
    if (set == 0) for (int p = F.tid; p < EROWS - 2176; p += NTHR) { idxo[e * EROWS + 2176 + p] = 0; gate[e * EROWS + 2176 + p] = 0.f; }
    __syncthreads();
}
__device__ __forceinline__ void ph_topk(Frame& F0, int i) { Frame F = F0; LAUNDER(F);
    for (int it = F.vcu; it < 128; it += F.G) topk_item(F, it >> 4, it & 15);
    LAS float* scr = (LAS float*)(F.lds + F.wave * 8448);
    const float* w1 = F.in[I_MW1] + (size_t)i * NE * DM * FF; const float* w3 = F.in[I_MW3] + (size_t)i * NE * DM * FF; const float* w2 = F.in[I_MW2] + (size_t)i * NE * FF * DM;
    for (int it = F.gw; it < 3 * NE * 512; it += F.NGW) {
        const int which = it / (NE * 512), r = it % (NE * 512), e = r >> 9, item = r & 511;
        if (which == 0) transpose_item(w1 + (size_t)e * DM * FF, DM, FF, WSP(bf16, WS_W13), RowW13{e, 0}, scr, item, F.lane);
        else if (which == 1) transpose_item(w3 + (size_t)e * DM * FF, DM, FF, WSP(bf16, WS_W13), RowW13{e, 1}, scr, item, F.lane);
        else transpose_item(w2 + (size_t)e * FF * DM, FF, DM, WSP(bf16, WS_W2), RowId{e * 1024}, scr, item, F.lane);
    }
}
__device__ __forceinline__ void ph_gather(Frame& F0) { Frame F = F0; LAUNDER(F);
    const int* idx = WSP(int, WS_IDX); const bf16* HA = WSP(bf16, WS_HA); bf16* XG = WSP(bf16, WS_XG);
    for (int r = F.gw; r < NE * EROWS; r += F.NGW) {
        const int src = idx[r]; const v4u* s = (const v4u*)(HA + (size_t)src * DM); v4u* d = (v4u*)(XG + (size_t)r * DM);
        d[F.lane] = s[F.lane]; d[64 + F.lane] = s[64 + F.lane];
    }
}
__device__ __forceinline__ void ph_combine(Frame& F0, int i) { Frame F = F0; LAUNDER(F);
    const int* slotmap = WSP(int, WS_SLOT); const bf16* YB = WSP(bf16, WS_YB);
    const float* mods = WSP(float, WS_MODS) + (size_t)i * 5 * 6144;
    for (int row = F.gw; row < TT; row += F.NGW) {
        f32x4 acc[4];
#pragma unroll
        for (int jj = 0; jj < 4; ++jj) acc[jj] = (f32x4){0.f, 0.f, 0.f, 0.f};
        for (int e = 0; e < NE; ++e) {
            const int sl = slotmap[(size_t)e * TT + row];
            if (sl >= 0) { const v2u* yr = (const v2u*)(YB + (size_t)(e * EROWS + (row < TLAT ? (row >> 12) * 512 : 2048 + ((row - TLAT) >> 8) * 32) + sl) * DM);
#pragma unroll
                for (int jj = 0; jj < 4; ++jj) { const v2u w = yr[64 * jj + F.lane];
                    acc[jj].x += __builtin_bit_cast(float, w.x << 16); acc[jj].y += __builtin_bit_cast(float, w.x & 0xffff0000u);
                    acc[jj].z += __builtin_bit_cast(float, w.y << 16); acc[jj].w += __builtin_bit_cast(float, w.y & 0xffff0000u); } }
        }
#ifdef ABL_MOE
#pragma unroll
        for (int jj = 0; jj < 4; ++jj) acc[jj] = acc[jj] * 0.0f;
#endif
        const int s = row_s(row); f32x4 v[4], h[4];
        float* xr = WSP(float, WS_X) + (size_t)row * DM;
#pragma unroll
        for (int jj = 0; jj < 4; ++jj) { const f32x4 gm = ((const f32x4*)(mods + s * 6144 + 5 * 1024))[64 * jj + F.lane]; v[jj] = ((const f32x4*)xr)[64 * jj + F.lane] + gm * acc[jj]; ((f32x4*)xr)[64 * jj + F.lane] = v[jj]; }
        if (i + 1 < DEPTH) {
            const float* m2 = WSP(float, WS_MODS) + (size_t)(i + 1) * 5 * 6144;
            mod_row_store(v, F.in[I_NORMG] + (size_t)((i + 1) * 2) * DM, m2 + s * 6144, m2 + s * 6144 + 1024, WSP(bf16, WS_HA) + (size_t)row * DM, F.lane, h);
        } else if (row < TLAT) {
            float ss = 0.f;
#pragma unroll
            for (int jj = 0; jj < 4; ++jj) ss += (v[jj].x * v[jj].x + v[jj].y * v[jj].y) + (v[jj].z * v[jj].z + v[jj].w * v[jj].w);
            const float rstd = 1.0f / sqrtf(wave_sum(ss) * (1.0f / 1024.0f) + 1e-6f);
#pragma unroll
            for (int jj = 0; jj < 4; ++jj) ((f32x4*)(F.out + (size_t)row * DM))[64 * jj + F.lane] = v[jj] * rstd * ((const f32x4*)F.in[I_FINALG])[64 * jj + F.lane];
        }
    }
}
__device__ __forceinline__ void ph_rope(Frame& F0) { Frame F = F0; LAUNDER(F);
    const float* P = WSP(float, WS_P); bf16* QB = WSP(bf16, WS_QB); bf16* KB = WSP(bf16, WS_KB); bf16* VB = WSP(bf16, WS_VB);
    const int axis = (F.lane >> 1) & 1, half = F.lane & 1;
    float inv[16];
#pragma unroll
    for (int f = 0; f < 16; ++f) inv[f] = exp2f(-(float)f * (13.287712379549449f / 16.0f));
    for (int row = F.gw; row < TT; row += F.NGW) {
        const bool lat = row < TLAT; const int b = lat ? (row >> 12) : ((row - TLAT) >> 8); const int l = lat ? (row & (SEQ - 1)) : ((row - TLAT) & (CTXL - 1));
        const size_t krow = (size_t)b * KSEQ + (lat ? CTXL + l : l);
        float cs[16], sn[16];
        if (lat) { const float pos = (float)(axis ? (l & 63) : (l >> 6));
#pragma unroll
            for (int f = 0; f < 16; ++f) sincosf(pos * inv[f], &sn[f], &cs[f]); }
#pragma unroll
        for (int part = 0; part < 3; ++part) {
            float x[16];
            const float* src = P + (size_t)row * QKVC + part * 1024 + 16 * F.lane;
#pragma unroll
            for (int q = 0; q < 4; ++q) { const f32x4 t = *(const f32x4*)(src + 4 * q); x[4 * q] = t.x; x[4 * q + 1] = t.y; x[4 * q + 2] = t.z; x[4 * q + 3] = t.w; }
            if (part < 2 && lat) {
#pragma unroll
                for (int f = 0; f < 16; ++f) { const float o = xor1_f(x[f]);
                    x[f] = half ? (x[f] * cs[f] + o * sn[f]) : (x[f] * cs[f] - o * sn[f]); }
            }
            v4u w0, w1; w0.x = pk2(x[0], x[1]); w0.y = pk2(x[2], x[3]); w0.z = pk2(x[4], x[5]); w0.w = pk2(x[6], x[7]); w1.x = pk2(x[8], x[9]); w1.y = pk2(x[10], x[11]); w1.z = pk2(x[12], x[13]); w1.w = pk2(x[14], x[15]);
            bf16* dst = part == 0 ? QB + (size_t)row * DM : (part == 1 ? KB + krow * DM : VB + krow * DM);
            *(v4u*)(dst + 16 * F.lane) = w0; *(v4u*)(dst + 16 * F.lane + 8) = w1;
        }
    }
}

namespace att {
using s16x4 = __attribute__((ext_vector_type(4))) short;
using f32x16 = __attribute__((ext_vector_type(16))) float;
using u32x4 = __attribute__((ext_vector_type(4))) unsigned;
constexpr int DQ = 64, DV = 128, NW = 8, QBLK = 32, KVBLK = 64, LD = 1024;
constexpr float SCALE = 0.125f, THR = 8.f;
#ifndef ATT_SDEPTH
#define ATT_SDEPTH 1
#endif
constexpr int SDEPTH = ATT_SDEPTH;
constexpr size_t SHM_V = KVBLK * DV * 2, SHM_K = KVBLK * DQ * 2, SHM_ATTN = 2 * SHM_V + 2 * SHM_K + NW * 64 * 4;
#define KSWZ(row, colB) ((row) * 128 + ((colB) ^ (((row) & 7) << 4)))
#define SBAR() __builtin_amdgcn_sched_barrier(0)
__device__ __forceinline__ int crow(int r, int hi) { return (r & 3) + 8 * (r >> 2) + 4 * hi; }
__device__ __forceinline__ unsigned cvtpk(float lo, float hi) { unsigned r; asm volatile("v_cvt_pk_bf16_f32 %0, %1, %2" : "=v"(r) : "v"(lo), "v"(hi)); return r; }
__device__ __forceinline__ void partialSM(f32x16& p0, f32x16& p1, float& m_reg, float& mn, float& alpha) {
  constexpr float C = SCALE * 1.4426950408889634f;
  float pmax = p0[0]; for (int r = 1; r < 16; ++r) pmax = fmaxf(pmax, p0[r]); for (int r = 0; r < 16; ++r) pmax = fmaxf(pmax, p1[r]);
  { auto rr = __builtin_amdgcn_permlane32_swap(__float_as_uint(pmax), __float_as_uint(pmax), false, false);
    pmax = fmaxf(__uint_as_float(rr[0]), __uint_as_float(rr[1])); }
  if (__builtin_expect(__all(pmax - m_reg <= THR / SCALE), 1)) { mn = m_reg; alpha = 1.f; }
  else { mn = fmaxf(m_reg, pmax); alpha = __builtin_amdgcn_exp2f((m_reg - mn) * C); m_reg = mn; }
  float mnC = -mn * C;
  for (int r = 0; r < 16; ++r) p0[r] = fmaf(p0[r], C, mnC); for (int r = 0; r < 16; ++r) p1[r] = fmaf(p1[r], C, mnC);
  for (int r = 0; r < 16; ++r) p0[r] = __builtin_amdgcn_exp2f(p0[r]);
}
__device__ __forceinline__ void finishSM(f32x16& p0, f32x16& p1, float alpha, float& l_reg, bf16x8& pa0, bf16x8& pa1, bf16x8& pa2, bf16x8& pa3) {
  for (int r = 0; r < 16; ++r) p1[r] = __builtin_amdgcn_exp2f(p1[r]);
  float ps = 0; for (int r = 0; r < 16; ++r) ps += p0[r]; for (int r = 0; r < 16; ++r) ps += p1[r];
  { auto rr = __builtin_amdgcn_permlane32_swap(__float_as_uint(ps), __float_as_uint(ps), false, false);
    ps = __uint_as_float(rr[0]) + __uint_as_float(rr[1]); }
  l_reg = l_reg * alpha + ps;
#define PK4(P, BASE, OUT) do { unsigned a0 = cvtpk(P[BASE + 0], P[BASE + 1]), a1 = cvtpk(P[BASE + 2], P[BASE + 3]);   \
    unsigned b0 = cvtpk(P[BASE + 4], P[BASE + 5]), b1 = cvtpk(P[BASE + 6], P[BASE + 7]);                              \
    auto r0 = __builtin_amdgcn_permlane32_swap(a0, b0, false, false); auto r1 = __builtin_amdgcn_permlane32_swap(a1, b1, false, false); \
    u32x4 w = {r0[0], r1[0], r0[1], r1[1]}; OUT = *reinterpret_cast<bf16x8*>(&w); } while (0)
  PK4(p0, 0, pa0); PK4(p0, 8, pa1); PK4(p1, 0, pa2); PK4(p1, 8, pa3);
#undef PK4
}
__device__ __forceinline__ void qkt(f32x16& p0, f32x16& p1, const bf16* Ks, const bf16x8* qr, int r32, int hi) {
  p0 = f32x16{}; p1 = f32x16{};
#pragma unroll
  for (int d0 = 0; d0 < 4; ++d0) { int cb = (d0 * 16 + hi * 8) * 2;
    bf16x8 b0 = *reinterpret_cast<const bf16x8*>((const char*)Ks + KSWZ(r32, cb));
    bf16x8 b1 = *reinterpret_cast<const bf16x8*>((const char*)Ks + KSWZ(32 + r32, cb));
    p0 = __builtin_amdgcn_mfma_f32_32x32x16_bf16(b0, qr[d0], p0, 0, 0, 0);
    p1 = __builtin_amdgcn_mfma_f32_32x32x16_bf16(b1, qr[d0], p1, 0, 0, 0); }
}
__device__ __forceinline__ int v_st(int k, int c) { const int kk = (k & ~0xC) | ((k & 4) << 1) | ((k & 8) >> 1); return ((kk >> 3) * 4 + (c >> 5)) * 512 + ((kk & 7) * 32 + (c & 31)) * 2; }
__device__ __forceinline__ int v_rd_base(int lane) { return ((lane & 3) << 3) | (((lane >> 2) & 3) << 6) | (((lane >> 4) & 1) << 5) | (((lane >> 5) & 1) << 8); }
constexpr int v_rd_off(int d0, int ks, int half) { return d0 * 512 + ks * 4096 + half * 2048; }
template <int OFF> __device__ __forceinline__ s16x4 tr_read(int vb) {
  s16x4 r; asm volatile("ds_read_b64_tr_b16 %0, %1 offset:%2" : "=&v"(r) : "v"(vb), "i"(OFF) : "memory"); return r;
}
template <int D0> __device__ __forceinline__ void pv_one(f32x16& od, int vb, bf16x8 pa0, bf16x8 pa1, bf16x8 pa2, bf16x8 pa3) {
  const s16x4 l0 = tr_read<v_rd_off(D0, 0, 0)>(vb), h0 = tr_read<v_rd_off(D0, 0, 1)>(vb), l1 = tr_read<v_rd_off(D0, 1, 0)>(vb), h1 = tr_read<v_rd_off(D0, 1, 1)>(vb);
  const s16x4 l2 = tr_read<v_rd_off(D0, 2, 0)>(vb), h2 = tr_read<v_rd_off(D0, 2, 1)>(vb), l3 = tr_read<v_rd_off(D0, 3, 0)>(vb), h3 = tr_read<v_rd_off(D0, 3, 1)>(vb);
  asm volatile("s_waitcnt lgkmcnt(0)" ::: "memory"); SBAR();
#define PK(L, H) (bf16x8){L[0], L[1], L[2], L[3], H[0], H[1], H[2], H[3]}
  od = __builtin_amdgcn_mfma_f32_32x32x16_bf16(pa0, PK(l0, h0), od, 0, 0, 0);
  od = __builtin_amdgcn_mfma_f32_32x32x16_bf16(pa1, PK(l1, h1), od, 0, 0, 0);
  od = __builtin_amdgcn_mfma_f32_32x32x16_bf16(pa2, PK(l2, h2), od, 0, 0, 0);
  od = __builtin_amdgcn_mfma_f32_32x32x16_bf16(pa3, PK(l3, h3), od, 0, 0, 0);
#undef PK
}
__device__ __forceinline__ void pv_d0(f32x16* o, int vb, bf16x8 pa0, bf16x8 pa1, bf16x8 pa2, bf16x8 pa3) {
  pv_one<0>(o[0], vb, pa0, pa1, pa2, pa3); pv_one<1>(o[1], vb, pa0, pa1, pa2, pa3); pv_one<2>(o[2], vb, pa0, pa1, pa2, pa3); pv_one<3>(o[3], vb, pa0, pa1, pa2, pa3);
}
__device__ __forceinline__ void attn_body(const bf16* __restrict__ Qb, const bf16* __restrict__ Kh, const bf16* __restrict__ Vh, float* __restrict__ Ob, int ldo, int seq, char* lds) {
  int tid_ = threadIdx.x; asm volatile("" : "+v"(tid_));
  const int tid = tid_, wid = tid >> 6, lane = tid & 63, r32 = lane & 31, hi = lane >> 5;
  bf16* V_lds = (bf16*)lds; bf16* K_lds = (bf16*)(lds + 2 * SHM_V);
  float* ws = (float*)(lds + 2 * SHM_V + 2 * SHM_K) + wid * 64; float* li_l = ws; float* al_l = ws + 32;
  float m_reg = -1e30f, l_reg = 0; f32x16 o[4] = {}; bf16x8 qr[4];
  const bf16* Qw = Qb + (long)(wid * QBLK + r32) * LD + hi * 8;
#pragma unroll
  for (int d0 = 0; d0 < 4; ++d0) qr[d0] = *reinterpret_cast<const bf16x8*>(Qw + d0 * 16);
  const int sr = tid >> 4, sc = (tid & 15) * 8, vst0 = v_st(sr, sc), vst1 = v_st(32 + sr, sc);
  const int kr = tid >> 3, kc = (tid & 7) * 8;
  const int vb0 = (int)(uintptr_t)V_lds + v_rd_base(lane);
  struct { bf16x8 vs0, vs1, ks0; } sr_[SDEPTH];
#define SLOAD(i, k0) do { sr_[i].vs0 = *reinterpret_cast<const bf16x8*>(&Vh[(long)((k0) + sr) * LD + sc]); sr_[i].vs1 = *reinterpret_cast<const bf16x8*>(&Vh[(long)((k0) + 32 + sr) * LD + sc]); \
    sr_[i].ks0 = *reinterpret_cast<const bf16x8*>(&Kh[(long)((k0) + kr) * LD + kc]); } while (0)
#define SWRITE(b, i) do { *(bf16x8*)((char*)V_lds + (b) * SHM_V + vst0) = sr_[i].vs0;          \
    *(bf16x8*)((char*)V_lds + (b) * SHM_V + vst1) = sr_[i].vs1;               \
    *(bf16x8*)((char*)K_lds + (b) * SHM_K + KSWZ(kr, kc * 2)) = sr_[i].ks0; } while (0)
#define SWAIT() do { if constexpr (SDEPTH == 2) asm volatile("s_waitcnt vmcnt(3)" ::: "memory"); else asm volatile("s_waitcnt vmcnt(0)" ::: "memory"); } while (0)
#define RESC(a) do { if (__any((a) < 1.f)) { if (hi == 0) al_l[r32] = (a); asm volatile("s_waitcnt lgkmcnt(0)" ::: "memory"); \
    for (int d = 0; d < 4; ++d) for (int r = 0; r < 16; ++r) o[d][r] *= al_l[crow(r, hi)]; } } while (0)
  f32x16 pA0, pA1, pB0, pB1; float mnA, mnB, alA, alB; bf16x8 pa0, pa1, pa2, pa3; const int NT = seq / KVBLK;
  constexpr int SE = 0, SO = SDEPTH - 1;
  SLOAD(SE, 0); asm volatile("s_waitcnt vmcnt(0)" ::: "memory"); SWRITE(0, SE); __syncthreads();
  qkt(pA0, pA1, K_lds, qr, r32, hi); partialSM(pA0, pA1, m_reg, mnA, alA);
  SLOAD(SO, KVBLK); if constexpr (SDEPTH == 2) { if (2 < NT) SLOAD(SE, 2 * KVBLK); }
  SWAIT(); SWRITE(1, SO); __syncthreads();
  for (int j = 1; j + 1 < NT; j += 2) {
    SBAR(); qkt(pB0, pB1, (bf16*)((char*)K_lds + SHM_K), qr, r32, hi);
    finishSM(pA0, pA1, alA, l_reg, pa0, pa1, pa2, pa3); SBAR();
    SLOAD(SO, (j + SDEPTH) * KVBLK); SBAR();
    pv_d0(o, vb0, pa0, pa1, pa2, pa3); partialSM(pB0, pB1, m_reg, mnB, alB);
    __syncthreads(); SWAIT(); SWRITE(0, SE);
    RESC(alB); __syncthreads();
    SBAR(); qkt(pA0, pA1, K_lds, qr, r32, hi);
    finishSM(pB0, pB1, alB, l_reg, pa0, pa1, pa2, pa3); SBAR();
    if (SDEPTH == 1 || j + 3 < NT) SLOAD(SE, (j + 1 + SDEPTH) * KVBLK); SBAR();
    pv_d0(o, vb0 + (int)SHM_V, pa0, pa1, pa2, pa3); partialSM(pA0, pA1, m_reg, mnA, alA);
    __syncthreads(); SWAIT(); SWRITE(1, SO);
    RESC(alA); __syncthreads();
  }
  SBAR(); qkt(pB0, pB1, (bf16*)((char*)K_lds + SHM_K), qr, r32, hi);
  finishSM(pA0, pA1, alA, l_reg, pa0, pa1, pa2, pa3); SBAR();
  pv_d0(o, vb0, pa0, pa1, pa2, pa3); partialSM(pB0, pB1, m_reg, mnB, alB);
  __syncthreads(); RESC(alB);
  finishSM(pB0, pB1, alB, l_reg, pa0, pa1, pa2, pa3); SBAR();
  pv_d0(o, vb0 + (int)SHM_V, pa0, pa1, pa2, pa3);
  if (hi == 0) li_l[r32] = l_reg; asm volatile("s_waitcnt lgkmcnt(0)" ::: "memory");
  float rli[16];
#pragma unroll
  for (int r = 0; r < 16; ++r) rli[r] = __builtin_amdgcn_rcpf(li_l[crow(r, hi)]);
  float* Ow = Ob + (long)(wid * QBLK) * ldo;
#pragma unroll
  for (int r = 0; r < 16; ++r) { int orow = crow(r, hi);
    for (int d0 = 0; d0 < 4; ++d0) Ow[(long)orow * ldo + d0 * 32 + r32] = o[d0][r] * rli[r]; }
  __syncthreads();
#undef SLOAD
#undef SWRITE
#undef SWAIT
#undef RESC
}
#undef KSWZ
#undef SBAR
}

__device__ __forceinline__ void ph_attn(Frame& F0, bool need_ctx) { Frame F = F0; LAUNDER(F);
    const bf16* QB = WSP(bf16, WS_QB); const bf16* KB = WSP(bf16, WS_KB); const bf16* VB = WSP(bf16, WS_VB); float* OB = WSP(float, WS_OB);
    const int nun = 1024 + (need_ctx ? 64 : 0);
    for (int u = F.vcu; u < nun; u += F.G) {
        if (u < 1024) { const int qb = u & 15, hc = (u >> 4) & 15, b = u >> 8; const size_t qrow = (size_t)b * SEQ + qb * 256;
            att::attn_body(QB + qrow * DM + hc * 64, KB + (size_t)b * KSEQ * DM + hc * 64, VB + (size_t)b * KSEQ * DM + (hc >> 1) * 128, OB + qrow * 2048 + hc * 128, 2048, KSEQ, (char*)F.ldsg);
        } else { const int hc = (u - 1024) & 15, b = (u - 1024) >> 4; const size_t qrow = (size_t)TLAT + b * CTXL;
            att::attn_body(QB + qrow * DM + hc * 64, KB + (size_t)b * KSEQ * DM + hc * 64, VB + (size_t)b * KSEQ * DM + (hc >> 1) * 128, OB + qrow * 2048 + hc * 128, 2048, CTXL, (char*)F.ldsg);
        }
    }
}
__device__ __forceinline__ void ph_attnfin(Frame& F0, int i, bool need_ctx) { Frame F = F0; LAUNDER(F);
    const int j = i >> 1; const float* lv = F.in[I_LAM] + (size_t)j * 256; const float* sg = F.in[I_SUBLN] + (size_t)j * 128;
    const float linit = (i == 1) ? 0.35550906759096934f : 0.5560582041556406f;
    const float d1 = wave_sum(lv[F.lane] * lv[64 + F.lane]), d2 = wave_sum(lv[128 + F.lane] * lv[192 + F.lane]);
    const float lam = expf(d1) - expf(d2) + linit;
    const float* OB = WSP(float, WS_OB); bf16* CAT = WSP(bf16, WS_CAT);
    const int nrows = need_ctx ? TT : TLAT;
    for (int row = F.gw; row < nrows; row += F.NGW) {
        const int h = F.lane >> 3, e0 = 16 * (F.lane & 7);
        const float* o0 = OB + (size_t)row * 2048 + (2 * h) * 128 + e0; const float* o1 = o0 + 128;
        float x[16]; float ss = 0.f;
#pragma unroll
        for (int q = 0; q < 4; ++q) { const f32x4 a = *(const f32x4*)(o0 + 4 * q), bb = *(const f32x4*)(o1 + 4 * q); const f32x4 d = a - bb * lam;
            x[4 * q] = d.x; x[4 * q + 1] = d.y; x[4 * q + 2] = d.z; x[4 * q + 3] = d.w; ss += (d.x * d.x + d.y * d.y) + (d.z * d.z + d.w * d.w); }
        ss = sum8_f(ss);
        const float sc = (1.0f - linit) / sqrtf(ss * (1.0f / 128.0f) + 1e-5f);
#pragma unroll
        for (int q = 0; q < 16; ++q) x[q] = x[q] * sc * sg[e0 + q];
#ifdef ABL_ATT
#pragma unroll
        for (int q = 0; q < 16; ++q) x[q] = 0.f;
#endif
        v4u w0, w1; w0.x = pk2(x[0], x[1]); w0.y = pk2(x[2], x[3]); w0.z = pk2(x[4], x[5]); w0.w = pk2(x[6], x[7]); w1.x = pk2(x[8], x[9]); w1.y = pk2(x[10], x[11]); w1.z = pk2(x[12], x[13]); w1.w = pk2(x[14], x[15]);
        bf16* dst = CAT + (size_t)row * DM + h * 128 + e0;
        *(v4u*)dst = w0; *(v4u*)(dst + 8) = w1;
    }
}
#ifdef DBG_MOE
__device__ __forceinline__ void ph_debug_moe(Frame& F0, int i) { Frame F = F0; LAUNDER(F);
    LAS float* xs = (LAS float*)F.lds; LAS float* hs = xs + 1024; LAS float* red = hs + 1024;
    unsigned* dbg = (unsigned*)(F.ws + WS_CTL) + 100;
    for (int s = F.vcu; s < 64; s += F.G) {
        const int e = s & 15, slot = (s * 37) % 2176; const int r = e * EROWS + slot;
        const int tok = WSP(int, WS_IDX)[r]; const float gate = WSP(float, WS_GATE)[r];
        const bf16* hrow = WSP(bf16, WS_HA) + (size_t)tok * DM;
        __syncthreads();
        for (int k = F.tid; k < 1024; k += NTHR) xs[k] = bf2f(hrow[k]);
        __syncthreads();
        const float* w1 = F.in[I_MW1] + ((size_t)i * NE + e) * DM * FF; const float* w3 = F.in[I_MW3] + ((size_t)i * NE + e) * DM * FF; const float* w2 = F.in[I_MW2] + ((size_t)i * NE + e) * FF * DM;
        for (int f = F.tid; f < 1024; f += NTHR) { float a = 0.f, b = 0.f; for (int k = 0; k < 1024; ++k) { a += xs[k] * w1[(size_t)k * FF + f]; b += xs[k] * w3[(size_t)k * FF + f]; }
            hs[f] = a / (1.0f + __expf(-a)) * b; }
        __syncthreads();
        float num = 0.f, den = 0.f;
        for (int d = F.tid; d < 1024; d += NTHR) { float y = 0.f; for (int f = 0; f < 1024; ++f) y += hs[f] * w2[(size_t)f * DM + d]; y *= gate;
            const float yk = bf2f(WSP(bf16, WS_YB)[(size_t)r * DM + d]); num += (y - yk) * (y - yk); den += y * y; }
        num = block_sum(F, num, red); den = block_sum(F, den, red + 8);
        const float rel = sqrtf(num / fmaxf(den, 1e-30f));
        if (F.tid == 0) atomicMax(dbg, __builtin_bit_cast(unsigned, rel));
        if (s < 64) {
            const int set = s >> 4; const int rbase = set * SEQ; int cnt = 0; float mn_sel = 1e30f, mx_uns = -1e30f;
            for (int l = F.tid; l < SEQ; l += NTHR) { const int sl = WSP(int, WS_SLOT)[(size_t)e * TT + rbase + l]; const float a = WSP(float, WS_AFF)[(size_t)(rbase + l) * 16 + e];
                if (sl >= 0) { ++cnt; mn_sel = fminf(mn_sel, a); if (sl >= 512 || WSP(int, WS_IDX)[e * EROWS + set * 512 + sl] != rbase + l) atomicAdd(dbg + 1, 1u); } else mx_uns = fmaxf(mx_uns, a); }
            const float tc = block_sum(F, (float)cnt, red);
            float a1 = -mn_sel, a2 = mx_uns;
#pragma unroll
            for (int o = 1; o < 64; o <<= 1) { a1 = fmaxf(a1, __shfl_xor(a1, o)); a2 = fmaxf(a2, __shfl_xor(a2, o)); }
            __syncthreads(); if (F.lane == 0) { red[F.wave] = a1; red[8 + F.wave] = a2; } __syncthreads();
            float m1 = red[0], m2 = red[8];
            for (int w = 1; w < 8; ++w) { m1 = fmaxf(m1, red[w]); m2 = fmaxf(m2, red[8 + w]); }
            if (F.tid == 0) { if ((int)tc != 512) atomicAdd(dbg + 2, 1u); if (-m1 < m2) atomicAdd(dbg + 3, 1u); atomicAdd(dbg + 4, (unsigned)(int)tc); }
        }
    }
}
#endif
__device__ __forceinline__ void ph_debug_out(Frame& F0) { Frame F = F0; LAUNDER(F);
    const unsigned* dbg = (const unsigned*)(F.ws + WS_CTL) + 100;
    const float e1 = __builtin_bit_cast(float, dbg[0]); const unsigned v2 = dbg[1];
#ifdef DBG_SEL2
    const float d1 = 1.0f + (float)dbg[2] + 100.0f * (float)dbg[3];
#elif defined(DBG_SEL3)
    const float d1 = (float)dbg[4] / 64.0f / 16.0f;
#else
    const float d1 = 1.0f + 10.0f * fminf(e1, 3.0f);
#endif
    float d2 = 10.0f + (float)v2 * 0.1f; d2 = fminf(d2, 900.f);
    for (size_t idx = (size_t)F.gw * 64 + F.lane; idx < (size_t)TLAT * DM; idx += (size_t)F.NGW * 64) F.out[idx] = idx == 0 ? d2 : d1;
}
constexpr int PH_PER_LAYER = 13, N_PHASES = 3 + DEPTH * PH_PER_LAYER;
#ifndef PH_MASK
#define PH_MASK 0xFFFFFFFFu
#endif
#define PK_ON(k) ((PH_MASK >> (k)) & 1u)

__device__ __forceinline__ bool phase_is_nop(int ph) {
    if (ph < 3) return false; const int i = (ph - 3) / PH_PER_LAYER, p = (ph - 3) % PH_PER_LAYER; return (i & 1) && (p == 4 || p == 5);
}

__global__ void __launch_bounds__(NTHR, 2) mega_fwd(Args args) {
    extern __shared__ __attribute__((aligned(16))) unsigned char lds[];
    Frame F;
    F.lds = (LAS unsigned char*)lds; F.ldsg = lds;
    F.MISC = (volatile LAS unsigned*)(F.lds + LDSCTL_OFF + 320);
    F.tid = threadIdx.x; F.lane = F.tid & 63; F.wave = __builtin_amdgcn_readfirstlane(F.tid >> 6);
    F.G = gridDim.x; { const int bx = blockIdx.x; F.vcu = (F.G % 8 == 0) ? (bx % 8) * (F.G / 8) + bx / 8 : bx; }
    F.gw = F.vcu * NWAVES + F.wave; F.NGW = F.G * NWAVES;
    F.in = (const float* const*)__builtin_amdgcn_kernarg_segment_ptr();
    F.ws = args.ws; F.out = args.out;
    for (int u = F.tid; u < (LDS_BYTES - LDSCTL_OFF) / 4; u += NTHR) ((LAS unsigned*)(F.lds + LDSCTL_OFF))[u] = 0u;
    __syncthreads();
    XcdBarrier bar; bar.bar = (unsigned*)(F.ws + WS_CTL) + CW_BAR; bar.x = 0; bar.st = nullptr;
    const int lo = args.ph_lo, hi = args.ph_hi;
    if (hi - lo > 1) bar = xcd_barrier_post((unsigned*)(F.ws + WS_CTL) + CW_BAR, F.MISC + 8);

    Frame F0 = F;
    for (int ph = lo; ph < hi; ++ph) {
        if (phase_is_nop(ph)) continue;
        Frame F = F0; LAUNDER(F);
#ifdef DBG_MOE
        if (ph == 1000) { ph_debug_moe(F, 0); VM_WAIT(); continue; }
        if (ph == 1001) { ph_debug_out(F); VM_WAIT(); continue; }
#endif
        if (ph == 0) { if (PK_ON(0)) ph_prologue(F); }
        else if (ph == 1) { if (PK_ON(1)) ph_modred(F); }
        else if (ph == 2) { if (PK_ON(2)) ph_mod0(F); }
        else {
            const int i = (ph - 3) / PH_PER_LAYER, p = (ph - 3) % PH_PER_LAYER, j = i >> 1; const bool even = !(i & 1), need_ctx = i < DEPTH - 1;
            if (p == 0) {
                if (even) { if (PK_ON(3)) { pg8::Gemm g{WSP(bf16, WS_HA), WSP(bf16, WS_WIN) + (size_t)j * EVCP * DM, TT, EVCP, DM}; pg8::StaticOrder S; S.init(TT, EVCP, F.G, (int)blockIdx.x);
                    pg8::EpiF32 E{WSP(float, WS_P), EVCP}; pg8::gemm_phase<pg8::EpiF32, pg8::StaticOrder, true, true>(F.lds, g, S, E); } }
                else if (PK_ON(4)) { pg8::Gemm g{WSP(bf16, WS_HA), WSP(bf16, WS_WQKV) + (size_t)j * QKVC * DM, TT, QKVC, DM}; pg8::StaticOrder S; S.init(TT, QKVC, F.G, (int)blockIdx.x);
                    pg8::EpiF32 E{WSP(float, WS_P), QKVC}; pg8::gemm_phase<pg8::EpiF32, pg8::StaticOrder, true, true>(F.lds, g, S, E); }
            } else if (p == 1) { if (even) { if (PK_ON(5)) ph_evprep(F, j); } else { if (PK_ON(6)) ph_rope(F); } }
            else if (p == 2) { if (even) { if (PK_ON(7)) ph_scan(F, j); } else { if (PK_ON(8)) ph_attn(F, need_ctx); } }
            else if (p == 3) { if (even) { if (PK_ON(9)) ph_fftk(F); } else { if (PK_ON(10)) ph_attnfin(F, i, need_ctx); } }
            else if (p == 4) { if (PK_ON(11)) ph_hyena(F, j); }
            else if (p == 5) { if (PK_ON(12)) ph_readout(F, j); }
            else if (p == 6) { if (PK_ON(13)) {
                pg8::Gemm g{WSP(bf16, WS_CAT), (even ? WSP(bf16, WS_WOE) : WSP(bf16, WS_WOD)) + (size_t)j * DM * DM, TT, DM, DM}; pg8::StaticOrder S; S.init(TT, DM, F.G, (int)blockIdx.x);
                pg8::EpiResGate E{WSP(float, WS_X), WSP(float, WS_MODS) + (size_t)i * 5 * 6144}; pg8::gemm_phase<pg8::EpiResGate, pg8::StaticOrder, true, true>(F.lds, g, S, E); }
            } else if (p == 7) { if (PK_ON(14)) ph_mod2(F, i); }
            else if (p == 8) { if (PK_ON(15)) ph_topk(F, i); }
            else if (p == 9) { if (PK_ON(16)) ph_gather(F); }
            else if (p == 10) { if (PK_ON(17)) {
                pg8::Gemm g{WSP(bf16, WS_XG), WSP(bf16, WS_W13), NE * EROWS, NE * 2048, DM}; pg8::MoeOrder S{F.G, (int)blockIdx.x, 8};
                pg8::EpiSwiGLU E{WSP(bf16, WS_HB)}; pg8::gemm_phase<pg8::EpiSwiGLU, pg8::MoeOrder, true, true>(F.lds, g, S, E); }
            } else if (p == 11) { if (PK_ON(18)) {
                pg8::Gemm g{WSP(bf16, WS_HB), WSP(bf16, WS_W2), NE * EROWS, NE * 1024, FF}; pg8::MoeOrder S{F.G, (int)blockIdx.x, 4};
                pg8::EpiGateBf16 E{WSP(bf16, WS_YB), WSP(float, WS_GATE)}; pg8::gemm_phase<pg8::EpiGateBf16, pg8::MoeOrder, true, true>(F.lds, g, S, E); }
            } else { if (PK_ON(19)) ph_combine(F, i); }
        }
        if (ph + 1 < hi) xcd_barrier(bar); else { VM_WAIT(); }
    }
}

extern "C" void kernel_launch(void* const* d_in, const int* in_sizes, int n_in, void* d_out, int out_size, void* d_ws, size_t ws_size, hipStream_t stream) {
    static int grid = 0;
    if (grid == 0) {
        if (n_in != N_IN || out_size != TLAT * DM || ws_size < WS_END) { fprintf(stderr, "kernel_launch: unexpected shapes: n_in %d out %d ws %zu (need %zu)\n", n_in, out_size, ws_size, (size_t)WS_END); grid = -1; return; }
        int dev = 0, cus = 0, per_cu = 0;
        if (hipGetDevice(&dev) != hipSuccess || hipDeviceGetAttribute(&cus, hipDeviceAttributeMultiprocessorCount, dev) != hipSuccess) { grid = -1; return; }
        if (hipFuncSetAttribute((const void*)mega_fwd, hipFuncAttributeMaxDynamicSharedMemorySize, LDS_BYTES) != hipSuccess) { fprintf(stderr, "kernel_launch: hipFuncSetAttribute failed\n"); grid = -1; return; }
        if (hipOccupancyMaxActiveBlocksPerMultiprocessor(&per_cu, (const void*)mega_fwd, NTHR, LDS_BYTES) != hipSuccess || per_cu < 1) fprintf(stderr, "kernel_launch: occupancy query reports %d\n", per_cu);
        (void)hipGetLastError();
        grid = cus;
    }
    if (grid < 0) return;
    if (hipMemsetAsync((char*)d_ws + WS_CTL, 0, CTL_ZERO_BYTES, stream) != hipSuccess) { fprintf(stderr, "kernel_launch: memset failed\n"); return; }
    Args a{};
    for (int i = 0; i < N_IN; ++i) a.in[i] = (const float*)d_in[i];
    a.out = (float*)d_out; a.ws = (unsigned char*)d_ws;
#if MK_PER_PHASE
    for (int ph = 0; ph < N_PHASES; ++ph) {
#ifdef DBG_MOE
        if (ph == 3 + 12) { a.ph_lo = 1000; a.ph_hi = 1001; hipLaunchKernelGGL(mega_fwd, dim3(grid), dim3(NTHR), LDS_BYTES, stream, a); a.ph_lo = 1001; a.ph_hi = 1002; hipLaunchKernelGGL(mega_fwd, dim3(grid), dim3(NTHR), LDS_BYTES, stream, a); break; }
#endif
        if ((ph >= 3) && (((ph - 3) / PH_PER_LAYER) & 1) && (((ph - 3) % PH_PER_LAYER) == 4 || ((ph - 3) % PH_PER_LAYER) == 5)) continue;
        a.ph_lo = ph; a.ph_hi = ph + 1;
        hipLaunchKernelGGL(mega_fwd, dim3(grid), dim3(NTHR), LDS_BYTES, stream, a);
    }
#else
    a.ph_lo = 0; a.ph_hi = N_PHASES;
    hipLaunchKernelGGL(mega_fwd, dim3(grid), dim3(NTHR), LDS_BYTES, stream, a);
#endif
    const hipError_t le = hipPeekAtLastError();
    if (le != hipSuccess) fprintf(stderr, "kernel_launch: launch failed: %s\n", hipGetErrorName(le));
}
```

```cpp
#define MK_PER_PHASE 0
#include <hip/hip_runtime.h>
#include <cstdio>
#include <cstdint>
#include <cmath>

#ifndef MK_PER_PHASE
#define MK_PER_PHASE 0
#endif

#define GAS __attribute__((address_space(1)))
#define LAS __attribute__((address_space(3)))
typedef unsigned short bf16;
typedef unsigned v4u __attribute__((ext_vector_type(4)));
typedef unsigned v2u __attribute__((ext_vector_type(2)));
typedef float f32x4 __attribute__((ext_vector_type(4)));
typedef float f32x2 __attribute__((ext_vector_type(2)));
typedef short bf16x8 __attribute__((ext_vector_type(8)));

constexpr int DM = 1024, NB = 4, SEQ = 4096, CTXL = 256, DEPTH = 4;
constexpr int TLAT = NB * SEQ, TCTX = NB * CTXL, TT = TLAT + TCTX;
constexpr int RWC = 1760, HYC = 1536, EVC = RWC + HYC, EVCP = 3328;
constexpr int RWW = 512, NH = 8, HD = 64;
constexpr int QKVC = 3072;
constexpr int NE = 16, FF = 1024, EROWS = 2304;
constexpr int NMOD = 6;
constexpr int KSEQ = CTXL + SEQ;

enum { I_X = 0, I_C, I_CTX, I_CCTX, I_ADAW, I_ADAB, I_NORMG, I_FINALG, I_EVWIN, I_EVWOUT, I_MU, I_W0, I_W2, I_A0, I_A2, I_G2, I_KK, I_KA, I_RK, I_GN,
       I_CONVW, I_CONVB, I_FW1, I_FB1, I_FW2, I_FB2, I_FW3, I_FREQ, I_HYB, I_WQKV, I_DAWOUT, I_LAM, I_SUBLN, I_ROUTER, I_MW1, I_MW3, I_MW2, N_IN };

struct Args { const float* in[N_IN]; float* out; unsigned char* ws; int ph_lo, ph_hi; };
static_assert(__builtin_offsetof(Args, in) == 0, "Args::in must be first");

constexpr size_t MiB = 1u << 20;
constexpr size_t WS_CTL = 0, CTL_ZERO_BYTES = 64 * 1024;
constexpr size_t WS_MODP = 1 * MiB;
constexpr size_t WS_MODS = 5 * MiB;
constexpr size_t WS_TW = 6 * MiB;
constexpr size_t WS_FRAGB = 7 * MiB;
constexpr size_t WS_AFF = 8 * MiB;
constexpr size_t WS_SLOT = 10 * MiB;
constexpr size_t WS_IDX = 12 * MiB;
constexpr size_t WS_GATE = 12 * MiB + 512 * 1024;
constexpr size_t WS_WIN = 16 * MiB;
constexpr size_t WS_WOE = 30 * MiB;
constexpr size_t WS_WQKV = 34 * MiB;
constexpr size_t WS_WOD = 46 * MiB;
constexpr size_t WS_W13 = 50 * MiB;
constexpr size_t WS_W2 = 114 * MiB;
constexpr size_t WS_UTL = 50 * MiB;
constexpr size_t WS_X = 146 * MiB;
constexpr size_t WS_HA = 214 * MiB;
constexpr size_t WS_CAT = 248 * MiB;
constexpr size_t WS_KSPL = 282 * MiB;
constexpr size_t WS_KSPC = 346 * MiB;
constexpr size_t WS_BIG = 384 * MiB;
constexpr size_t WS_P = WS_BIG;
constexpr size_t REC_BYTES = 20 * 1024;
constexpr size_t WS_REC = WS_BIG;
constexpr size_t WS_RW = WS_BIG + 340 * MiB;
constexpr size_t RW_STRIDE = 34 * MiB;
constexpr size_t WS_AOP = WS_BIG + 476 * MiB;
constexpr size_t WS_G = WS_BIG + 484 * MiB;
constexpr size_t WS_KCL = WS_BIG + 518 * MiB;
constexpr size_t WS_KCC = WS_BIG + 550 * MiB;
constexpr size_t WS_UTC = WS_BIG + 552 * MiB;
constexpr size_t WS_BON = WS_BIG + 558 * MiB;
constexpr size_t WS_Y = WS_BIG + 559 * MiB;
constexpr size_t WS_HYTL = WS_RW + 1 * RW_STRIDE;
constexpr size_t WS_HYTC = WS_RW + 3 * RW_STRIDE;
static_assert(WS_Y + 68 * MiB <= 1024 * MiB && 64 * 272 * REC_BYTES <= 340 * MiB, "ws map");
constexpr size_t WS_QB = WS_BIG + 204 * MiB;
constexpr size_t WS_KB = WS_QB + 34 * MiB;
constexpr size_t WS_VB = WS_KB + 34 * MiB;
constexpr size_t WS_OB = WS_VB + 34 * MiB;
static_assert(WS_OB + 136 * MiB <= 1024 * MiB, "ws map");
constexpr size_t WS_XG = WS_BIG;
constexpr size_t WS_HB = WS_BIG + 72 * MiB;
constexpr size_t WS_YB = WS_BIG + 144 * MiB;
constexpr size_t WS_END = 1024 * MiB;

constexpr int CW_BAR = 4096;

constexpr int RING_BYTES = 143360;
constexpr int LDSCTL_OFF = RING_BYTES;
constexpr int LDS_BYTES = 147456;
constexpr int NWAVES = 8, NTHR = 512;

__device__ __forceinline__ unsigned f2bf(float f) { unsigned u = __builtin_bit_cast(unsigned, f); return (u + 0x7fffu + ((u >> 16) & 1u)) >> 16; }
__device__ __forceinline__ unsigned pk2(float lo, float hi) { return f2bf(lo) | (f2bf(hi) << 16); }
__device__ __forceinline__ float bf2f(unsigned short h) { return __builtin_bit_cast(float, ((unsigned)h) << 16); }
template <int CTRL> __device__ __forceinline__ float dpp_f(float x) { return __builtin_bit_cast(float, __builtin_amdgcn_update_dpp(0, __builtin_bit_cast(int, x), CTRL, 0xF, 0xF, true)); }
template <int CTRL> __device__ __forceinline__ int dpp_i(int x) { return __builtin_amdgcn_update_dpp(0, x, CTRL, 0xF, 0xF, true); }
#define DPP_XOR1 0xB1
#define DPP_XOR2 0x4E
#define DPP_HMIRROR 0x141
#define DPP_MIRROR 0x140
__device__ __forceinline__ float xor1_f(float x) { return dpp_f<DPP_XOR1>(x); }
__device__ __forceinline__ float sum4_f(float x) { x += dpp_f<DPP_XOR1>(x); x += dpp_f<DPP_XOR2>(x); return x; }
__device__ __forceinline__ float sum8_f(float x) { x = sum4_f(x); x += dpp_f<DPP_HMIRROR>(x); return x; }
__device__ __forceinline__ float sum16_f(float x) { x = sum8_f(x); x += dpp_f<DPP_MIRROR>(x); return x; }
__device__ __forceinline__ float max16_f(float x) { x = fmaxf(x, dpp_f<DPP_XOR1>(x)); x = fmaxf(x, dpp_f<DPP_XOR2>(x)); x = fmaxf(x, dpp_f<DPP_HMIRROR>(x)); x = fmaxf(x, dpp_f<DPP_MIRROR>(x)); return x; }
__device__ __forceinline__ float wave_sum(float v) {
    v = sum16_f(v);
    v += __builtin_bit_cast(float, __builtin_amdgcn_ds_swizzle(__builtin_bit_cast(int, v), 0x401F));
    { auto rr = __builtin_amdgcn_permlane32_swap(__float_as_uint(v), __float_as_uint(v), false, false); const unsigned lo_ = rr[0], hi_ = rr[1];
      v = __uint_as_float(lo_) + __uint_as_float(hi_); }
    return v;
}
__device__ __forceinline__ int wave_sum_i(int v) {
    v += dpp_i<DPP_XOR1>(v); v += dpp_i<DPP_XOR2>(v); v += dpp_i<DPP_HMIRROR>(v); v += dpp_i<DPP_MIRROR>(v);
    v += __builtin_amdgcn_ds_swizzle(v, 0x401F);
    { auto rr = __builtin_amdgcn_permlane32_swap((unsigned)v, (unsigned)v, false, false); v = (int)rr[0] + (int)rr[1]; }
    return v;
}
__device__ __forceinline__ float sigmoidf_(float x) { return 1.0f / (1.0f + __expf(-x)); }
__device__ __forceinline__ float siluf_(float x) { return x / (1.0f + __expf(-x)); }
#define LDS_WAIT() asm volatile("s_waitcnt lgkmcnt(0)" ::: "memory")
#define VM_WAIT() asm volatile("s_waitcnt vmcnt(0)" ::: "memory")

namespace pg8 {
#define PG8_LAS __attribute__((address_space(3)))
typedef unsigned short bf16_t;
typedef short bf16x8 __attribute__((ext_vector_type(8)));
typedef float f32x4 __attribute__((ext_vector_type(4)));
typedef unsigned u32x4 __attribute__((ext_vector_type(4)));
constexpr int BM = 256, BK = 64, HALF = 128, HTB = HALF * BK * 2  , STAGE_BYTES = 8 * HTB, NXCD = 8, WGM = 8;

__host__ __device__ __forceinline__ int lds_byte(int r, int c) { const int st = (r >> 4) * 2 + (c >> 5), rr = r & 15, cc = c & 31, ob = rr * 64 + cc * 2; return st * 1024 + (ob ^ (((ob >> 9) & 1) << 5)); }
__host__ __device__ __forceinline__ void stage_rc(int b, int& R, int& C) { const int st = b / 1024, sb = b % 1024, swz = sb ^ (((sb >> 9) & 1) << 5); R = (st >> 1) * 16 + swz / 64; C = (st & 1) * 32 + (swz % 64) / 2; }
__host__ __device__ __forceinline__ int perm32(int rho) { const int n = rho >> 4, i = rho & 15; return 8 * (i >> 2) + 4 * n + (i & 3); }

struct Unit { int pm, pn; };
struct Gemm { const bf16_t* A; const bf16_t* Bt; int M, N, K; };

struct StaticOrder {
    int nM, nN, nwg, G, c;
    __host__ __device__ void init(int M, int N, int G_, int c_) { nM = M / BM; nN = N / BM; nwg = nM * nN; G = G_; c = c_; }
    __host__ __device__ bool next(int i, Unit& u) const {
        const long L = (long)i * G + c; if (L >= nwg) return false;
        int wgid = (int)L; { const int q = nwg / NXCD, r = nwg % NXCD, xcd = wgid % NXCD, off = wgid / NXCD; wgid = (xcd < r ? xcd * (q + 1) : r * (q + 1) + (xcd - r) * q) + off; }
        const int nig = WGM * nN, gid = wgid / nig, fm = gid * WGM, gsz = (nM - fm) < WGM ? (nM - fm) : WGM;
        u.pm = fm + ((wgid % nig) % gsz); u.pn = (wgid % nig) / gsz; return true;
    }
    __device__ __forceinline__ void a_ready(const Unit&) const {}
    __device__ __forceinline__ void done(const Unit&) const {}
};

__device__ __forceinline__ unsigned cvt_pk_bf16(float lo, float hi) { unsigned r; asm volatile("v_cvt_pk_bf16_f32 %0, %1, %2" : "=v"(r) : "v"(lo), "v"(hi)); return r; }
typedef float f32x2 __attribute__((ext_vector_type(2)));
typedef unsigned u32x2v __attribute__((ext_vector_type(2)));

struct EpiF32 {
    static constexpr bool PERM = false, AFTER_DRAIN = false;
    float* O; int ldc;
    __device__ __forceinline__ void operator()(const f32x4 (&acc)[2][2][4][2], const Unit& u, int wr, int wc, int fr, int fq) const {
        const int col0 = u.pn * BM + wc * 32 + 4 * fq;
#pragma unroll
        for (int ai = 0; ai < 2; ++ai)
#pragma unroll
            for (int m = 0; m < 4; ++m) { float* rowp = O + (size_t)(u.pm * BM + ai * HALF + wr * 64 + m * 16 + fr) * ldc + col0;
#pragma unroll
                for (int bj = 0; bj < 2; ++bj)
#pragma unroll
                    for (int n = 0; n < 2; ++n) *(f32x4*)(rowp + bj * HALF + n * 16) = acc[ai][bj][m][n]; }
    }
};
struct EpiResGate {
    static constexpr bool PERM = false, AFTER_DRAIN = false;
    float* X; const float* mods;
    __device__ __forceinline__ void operator()(const f32x4 (&acc)[2][2][4][2], const Unit& u, int wr, int wc, int fr, int fq) const {
        const int col0 = u.pn * BM + wc * 32 + 4 * fq;
#pragma unroll
        for (int ai = 0; ai < 2; ++ai)
#pragma unroll
            for (int m = 0; m < 4; ++m) { const int row = u.pm * BM + ai * HALF + wr * 64 + m * 16 + fr; const int s = row < 16384 ? (row >> 12) : 4;
                float* rowp = X + (size_t)row * 1024 + col0; const float* gp = mods + s * 6144 + 2048 + col0;
#pragma unroll
                for (int bj = 0; bj < 2; ++bj)
#pragma unroll
                    for (int n = 0; n < 2; ++n) { const f32x4 g = *(const f32x4*)(gp + bj * HALF + n * 16); f32x4 x = *(f32x4*)(rowp + bj * HALF + n * 16);
                        x = x + g * acc[ai][bj][m][n]; *(f32x4*)(rowp + bj * HALF + n * 16) = x; } }
    }
};
struct EpiSwiGLU {
    static constexpr bool PERM = false, AFTER_DRAIN = false;
    bf16_t* H;
    __device__ __forceinline__ void operator()(const f32x4 (&acc)[2][2][4][2], const Unit& u, int wr, int wc, int fr, int fq) const {
        const int nt = u.pn & 7; const int col0 = nt * 128 + wc * 32 + 4 * fq;
#pragma unroll
        for (int ai = 0; ai < 2; ++ai)
#pragma unroll
            for (int m = 0; m < 4; ++m) { bf16_t* rowp = H + (size_t)(u.pm * BM + ai * HALF + wr * 64 + m * 16 + fr) * 1024 + col0;
#pragma unroll
                for (int n = 0; n < 2; ++n) { const f32x4 a = acc[ai][0][m][n], b = acc[ai][1][m][n]; f32x4 h;
#pragma unroll
                    for (int j = 0; j < 4; ++j) h[j] = a[j] / (1.0f + __expf(-a[j])) * b[j];
                    u32x2v w; w.x = cvt_pk_bf16(h[0], h[1]); w.y = cvt_pk_bf16(h[2], h[3]); *(u32x2v*)(rowp + n * 16) = w; } }
    }
};
struct EpiGateBf16 {
    static constexpr bool PERM = false, AFTER_DRAIN = false;
    bf16_t* Y; const float* gate;
    __device__ __forceinline__ void operator()(const f32x4 (&acc)[2][2][4][2], const Unit& u, int wr, int wc, int fr, int fq) const {
        const int nt = u.pn & 3; const int col0 = nt * 256 + wc * 32 + 4 * fq;
#pragma unroll
        for (int ai = 0; ai < 2; ++ai)
#pragma unroll
            for (int m = 0; m < 4; ++m) { const int row = u.pm * BM + ai * HALF + wr * 64 + m * 16 + fr; const float g = gate[row]; bf16_t* rowp = Y + (size_t)row * 1024 + col0;
#pragma unroll
                for (int bj = 0; bj < 2; ++bj)
#pragma unroll
                    for (int n = 0; n < 2; ++n) { const f32x4 v = acc[ai][bj][m][n] * g; u32x2v w; w.x = cvt_pk_bf16(v[0], v[1]); w.y = cvt_pk_bf16(v[2], v[3]); *(u32x2v*)(rowp + bj * HALF + n * 16) = w; } }
    }
};
struct EpiQKV {
    static constexpr bool PERM = false, AFTER_DRAIN = false;
    bf16_t* Q; bf16_t* Kb; bf16_t* Vb;
    __device__ __forceinline__ void operator()(const f32x4 (&acc)[2][2][4][2], const Unit& u, int wr, int wc, int fr, int fq) const {
        const int part = u.pn >> 2; const int col0 = (u.pn & 3) * BM + wc * 32 + 4 * fq; const bool lat = u.pm < 64;
        float invf[4];
#pragma unroll
        for (int j = 0; j < 4; ++j) invf[j] = exp2f(-(float)(4 * fq + j) * (13.287712379549449f / 16.0f)) * 0.15915494309189535f;
#pragma unroll
        for (int ai = 0; ai < 2; ++ai)
#pragma unroll
            for (int m = 0; m < 4; ++m) {
                const int row = u.pm * BM + ai * HALF + wr * 64 + m * 16 + fr;
                const int b = lat ? (row >> 12) : ((row - 16384) >> 8); const int l = lat ? (row & 4095) : ((row - 16384) & 255);
                float cs[4], sn[4];
                if (part < 2 && lat) { const float pos = (float)((wc & 1) ? (l & 63) : (l >> 6));
#pragma unroll
                    for (int j = 0; j < 4; ++j) { const float rev = pos * invf[j]; const float fr_ = rev - floorf(rev); cs[j] = __builtin_amdgcn_cosf(fr_); sn[j] = __builtin_amdgcn_sinf(fr_); } }
                bf16_t* rowp = (part == 0 ? Q + (size_t)row * 1024 : (part == 1 ? Kb : Vb) + ((size_t)b * 4352 + (lat ? 256 + l : l)) * 1024) + col0;
#pragma unroll
                for (int bj = 0; bj < 2; ++bj) {
                    f32x4 x1 = acc[ai][bj][m][0], x2 = acc[ai][bj][m][1];
                    if (part < 2 && lat) {
#pragma unroll
                        for (int j = 0; j < 4; ++j) { const float a = x1[j], bb = x2[j]; x1[j] = a * cs[j] - bb * sn[j]; x2[j] = bb * cs[j] + a * sn[j]; } }
                    u32x2v w; w.x = cvt_pk_bf16(x1[0], x1[1]); w.y = cvt_pk_bf16(x1[2], x1[3]); *(u32x2v*)(rowp + bj * HALF) = w;
                    w.x = cvt_pk_bf16(x2[0], x2[1]); w.y = cvt_pk_bf16(x2[2], x2[3]); *(u32x2v*)(rowp + bj * HALF + 16) = w;
                }
            }
    }
};
struct MoeOrder {
    int G, c, ntn, nmt;
    __device__ __forceinline__ bool next(int i, Unit& u) const {
        const int L = i * G + c; const int per_e = nmt * ntn; if (L >= 16 * per_e) return false;
        const int e = L / per_e, r = L % per_e; u.pm = e * 9 + (r % nmt); u.pn = e * ntn + (r / nmt); return true;
    }
    __device__ __forceinline__ void a_ready(const Unit&) const {}
    __device__ __forceinline__ void done(const Unit&) const {}
};
template <class Epi, class Sched, bool ALIGN_EPI = false, bool SP2 = false>
__device__ __forceinline__ void gemm_phase(PG8_LAS unsigned char* lds, const Gemm g, const Sched& S, const Epi& E) {
    int tid_ = threadIdx.x; asm volatile("" : "+v"(tid_));
    const int tid = tid_, wid = __builtin_amdgcn_readfirstlane(tid >> 6), lane = tid & 63, wr = wid >> 2, wc = wid & 3, fr = lane & 15, fq = lane >> 4;
    const int K = g.K, nt = K / BK;
    unsigned voffA[2], voffB[2];
#pragma unroll
    for (int i = 0; i < 2; ++i) { int R, C; stage_rc(tid * 16 + i * 8192, R, C); const int Rb = Epi::PERM ? ((R & ~31) + perm32(R & 31)) : R;
        voffA[i] = (unsigned)(R * K + C) * 2u; voffB[i] = (unsigned)(Rb * K + C) * 2u; }
    const size_t kstep = (size_t)(BK * 2);
    const size_t hstep = (size_t)HALF * K * 2;
    const size_t tstep = 2 * hstep;
    const unsigned ldsw = (unsigned)wid * 1024u;
    const int aoff = lds_byte(wr * 64 + fr, fq * 8), boff = lds_byte(wc * 32 + fr, fq * 8);
#define PG8_SA(b, h) (((b) * 2 + (h)) * HTB)
#define PG8_SB(b, h) ((4 + (b) * 2 + (h)) * HTB)
#define PG8_STAGE(bufoff, gbase, voff) do { _Pragma("unroll") for (int _i = 0; _i < 2; ++_i) \
        __builtin_amdgcn_global_load_lds((const unsigned*)((const char*)(gbase) + (voff)[_i]), (PG8_LAS unsigned*)(lds + (bufoff) + ldsw + _i * 8192), 16, 0, 0); } while (0)
#define PG8_LDA(dst, b, h) do { _Pragma("unroll") for (int m = 0; m < 4; ++m) _Pragma("unroll") for (int k = 0; k < 2; ++k) dst[m][k] = *(const PG8_LAS bf16x8*)(lds + PG8_SA(b, h) + aoff + m * 2048 + k * 1024); } while (0)
#define PG8_LDB(dst, b, h) do { _Pragma("unroll") for (int n = 0; n < 2; ++n) _Pragma("unroll") for (int k = 0; k < 2; ++k) dst[n][k] = *(const PG8_LAS bf16x8*)(lds + PG8_SB(b, h) + boff + n * 2048 + k * 1024); } while (0)
#define PG8_MMA(ai, bj, At, Bt) do { __builtin_amdgcn_s_setprio(1); _Pragma("unroll") for (int m = 0; m < 4; ++m) _Pragma("unroll") for (int n = 0; n < 2; ++n) _Pragma("unroll") for (int k = 0; k < 2; ++k) \
        acc[ai][bj][m][n] = __builtin_amdgcn_mfma_f32_16x16x32_bf16(Bt[n][k], At[m][k], acc[ai][bj][m][n], 0, 0, 0); __builtin_amdgcn_s_setprio(0); } while (0)
#define PG8_WAIT_V(n) asm volatile("s_waitcnt vmcnt(" #n ")" ::: "memory")
#define PG8_WAIT_L(n) asm volatile("s_waitcnt lgkmcnt(" #n ")" ::: "memory")
#define PG8_BAR __builtin_amdgcn_s_barrier()
#define PG8_SCHED __builtin_amdgcn_sched_barrier(0)
    Unit cur, nxt; int ui = 0;
    if (!S.next(0, cur)) return;
    f32x4 acc[2][2][4][2];
#pragma unroll
    for (int a = 0; a < 2; ++a)
#pragma unroll
        for (int b = 0; b < 2; ++b)
#pragma unroll
            for (int m = 0; m < 4; ++m)
#pragma unroll
                for (int n = 0; n < 2; ++n) acc[a][b][m][n] = (f32x4){0.f, 0.f, 0.f, 0.f};
    bf16x8 At[4][2], B0[2][2], B1[2][2];
    const char* cA = (const char*)g.A + (size_t)cur.pm * tstep; const char* cB = (const char*)g.Bt + (size_t)cur.pn * tstep;
    S.a_ready(cur);
    if constexpr (SP2) {
        PG8_STAGE(PG8_SB(0, 0), cB, voffB); PG8_STAGE(PG8_SB(0, 1), cB + hstep, voffB); PG8_STAGE(PG8_SA(0, 0), cA, voffA); PG8_STAGE(PG8_SA(0, 1), cA + hstep, voffA);
        if (wr == 1) PG8_BAR;
        PG8_WAIT_V(2); PG8_BAR;
        PG8_STAGE(PG8_SB(1, 0), cB + kstep, voffB); PG8_STAGE(PG8_SA(1, 0), cA + kstep, voffA); PG8_STAGE(PG8_SB(1, 1), cB + hstep + kstep, voffB);
        PG8_WAIT_V(6); PG8_BAR;
    } else {
        PG8_STAGE(PG8_SB(0, 0), cB, voffB); PG8_STAGE(PG8_SA(0, 0), cA, voffA); PG8_STAGE(PG8_SB(0, 1), cB + hstep, voffB); PG8_STAGE(PG8_SA(0, 1), cA + hstep, voffA);
        if (wr == 1) PG8_BAR;
        PG8_WAIT_V(4); PG8_BAR;
        PG8_STAGE(PG8_SB(1, 0), cB + kstep, voffB); PG8_STAGE(PG8_SA(1, 0), cA + kstep, voffA); PG8_STAGE(PG8_SB(1, 1), cB + hstep + kstep, voffB);
        PG8_WAIT_V(6); PG8_BAR;
    }
    for (;;) {
        const bool has_next = S.next(ui + 1, nxt);
        const char* nA = has_next ? (const char*)g.A + (size_t)nxt.pm * tstep : cA; const char* nB = has_next ? (const char*)g.Bt + (size_t)nxt.pn * tstep : cB;
        for (int t = 0; t < nt; t += 2) {
            const bool last = (t == nt - 2);
            const char* a1 = cA + (size_t)(t + 1) * kstep;
            const char* a2 = last ? nA : cA + (size_t)(t + 2) * kstep; const char* b2 = last ? nB : cB + (size_t)(t + 2) * kstep;
            const char* a3 = a2 + kstep; const char* b3 = b2 + kstep;
            if (last && has_next) S.a_ready(nxt);
            if constexpr (SP2) {
            PG8_LDB(B0, 0, 0); PG8_LDB(B1, 0, 1); PG8_SCHED; PG8_LDA(At, 0, 0); PG8_STAGE(PG8_SA(1, 1), a1 + hstep, voffA);
            PG8_WAIT_V(8); PG8_WAIT_L(0); PG8_BAR; PG8_MMA(0, 0, At, B0); PG8_MMA(0, 1, At, B1); PG8_BAR; PG8_SCHED;
            PG8_LDA(At, 0, 1); PG8_STAGE(PG8_SB(0, 0), b2, voffB); PG8_STAGE(PG8_SB(0, 1), b2 + hstep, voffB); PG8_STAGE(PG8_SA(0, 0), a2, voffA);
            PG8_WAIT_V(8); PG8_WAIT_L(0); PG8_BAR; PG8_MMA(1, 0, At, B0); PG8_MMA(1, 1, At, B1); PG8_BAR; PG8_SCHED;
            PG8_LDB(B0, 1, 0); PG8_LDB(B1, 1, 1); PG8_SCHED; PG8_LDA(At, 1, 0); PG8_STAGE(PG8_SA(0, 1), a2 + hstep, voffA);
            PG8_WAIT_V(8); PG8_WAIT_L(0); PG8_BAR; PG8_MMA(0, 0, At, B0); PG8_MMA(0, 1, At, B1); PG8_BAR; PG8_SCHED;
            PG8_LDA(At, 1, 1); PG8_STAGE(PG8_SB(1, 0), b3, voffB); PG8_STAGE(PG8_SB(1, 1), b3 + hstep, voffB); PG8_STAGE(PG8_SA(1, 0), a3, voffA);
            PG8_WAIT_V(8); PG8_WAIT_L(0); PG8_BAR; PG8_MMA(1, 0, At, B0); PG8_MMA(1, 1, At, B1); PG8_BAR; PG8_SCHED;
            } else {
            PG8_LDB(B0, 0, 0); PG8_SCHED; PG8_LDA(At, 0, 0); PG8_STAGE(PG8_SA(1, 1), a1 + hstep, voffA);
            PG8_WAIT_L(8); PG8_BAR; PG8_WAIT_L(0); PG8_MMA(0, 0, At, B0); PG8_BAR; PG8_SCHED;
            PG8_LDB(B1, 0, 1); PG8_STAGE(PG8_SB(0, 0), b2, voffB);
            PG8_BAR; PG8_WAIT_L(0); PG8_MMA(0, 1, At, B1); PG8_BAR;
            PG8_LDA(At, 0, 1); PG8_STAGE(PG8_SA(0, 0), a2, voffA);
            PG8_BAR; PG8_WAIT_L(0); PG8_MMA(1, 0, At, B0); PG8_BAR; PG8_SCHED;
            PG8_STAGE(PG8_SB(0, 1), b2 + hstep, voffB);
            PG8_WAIT_V(6); PG8_BAR; PG8_MMA(1, 1, At, B1); PG8_BAR;
            PG8_LDB(B0, 1, 0); PG8_SCHED; PG8_LDA(At, 1, 0); PG8_STAGE(PG8_SA(0, 1), a2 + hstep, voffA);
            PG8_WAIT_L(8); PG8_BAR; PG8_WAIT_L(0); PG8_MMA(0, 0, At, B0); PG8_BAR; PG8_SCHED;
            PG8_LDB(B1, 1, 1); PG8_STAGE(PG8_SB(1, 0), b3, voffB);
            PG8_BAR; PG8_WAIT_L(0); PG8_MMA(0, 1, At, B1); PG8_BAR;
            PG8_LDA(At, 1, 1); PG8_STAGE(PG8_SA(1, 0), a3, voffA);
            PG8_BAR; PG8_WAIT_L(0); PG8_MMA(1, 0, At, B0); PG8_BAR; PG8_SCHED;
            PG8_STAGE(PG8_SB(1, 1), b3 + hstep, voffB);
            PG8_WAIT_V(6); PG8_BAR; PG8_MMA(1, 1, At, B1); PG8_BAR;
            }
        }
        if constexpr (ALIGN_EPI) { if (wr == 0) PG8_BAR; }
        if constexpr (!Epi::AFTER_DRAIN) { E(acc, cur, wr, wc, fr, fq); S.done(cur); }
        if (!has_next) break;
#pragma unroll
        for (int a = 0; a < 2; ++a)
#pragma unroll
            for (int b = 0; b < 2; ++b)
#pragma unroll
                for (int m = 0; m < 4; ++m)
#pragma unroll
                    for (int n = 0; n < 2; ++n) acc[a][b][m][n] = (f32x4){0.f, 0.f, 0.f, 0.f};
        cur = nxt; cA = nA; cB = nB; ++ui;
        if constexpr (ALIGN_EPI) { if (wr == 1) PG8_BAR; }
    }
    PG8_WAIT_V(0);
    if constexpr (!ALIGN_EPI) { if (wr == 0) PG8_BAR; }
    PG8_BAR;
    if constexpr (Epi::AFTER_DRAIN) { E.fused(acc, cur, wr, wc, fr, fq, lds, wid, lane); S.done(cur); }
#undef PG8_SA
#undef PG8_SB
#undef PG8_STAGE
#undef PG8_LDA
#undef PG8_LDB
#undef PG8_MMA
#undef PG8_WAIT_V
#undef PG8_WAIT_L
#undef PG8_BAR
#undef PG8_SCHED
}
}
#define XB_TMO      128
#define XB_XCNT(j)  (256  + 64 * (j))
#define XB_XSUB(j)  (1280 + 64 * (j))
#define XB_XGEN(j)  (2304 + 64 * (j))
#define XB_TOP      3328
#define XB_TOPGEN   3392
#define XCD_BAR_WORDS 3456
#define XB_SPIN_CAP (1u << 18)

__device__ __forceinline__ unsigned xb_ld(unsigned* p)              { return __hip_atomic_load(p, __ATOMIC_RELAXED, __HIP_MEMORY_SCOPE_AGENT); }
__device__ __forceinline__ unsigned xb_add(unsigned* p, unsigned v) { return __hip_atomic_fetch_add(p, v, __ATOMIC_RELAXED, __HIP_MEMORY_SCOPE_AGENT); }
__device__ __forceinline__ unsigned xb_xcc_id() { return (unsigned)__builtin_amdgcn_s_getreg((3 << 11) | 20) & 0xFu; }
#define XB_SPIN(cond, bar) do { unsigned _sp = 0; while (cond) { __builtin_amdgcn_s_sleep(1); \
    if ((++_sp & 255u) == 0u) { if (xb_ld(&(bar)[XB_TMO])) break; if (_sp > XB_SPIN_CAP) { atomicAdd(&(bar)[XB_TMO], 1u); break; } } } } while (0)

struct XcdBarrier {
    unsigned* bar; unsigned x;
    volatile LAS unsigned* st;
};

__device__ __forceinline__ XcdBarrier xcd_barrier_post(unsigned* bar, volatile LAS unsigned* st) {
    XcdBarrier b; b.bar = bar; b.x = xb_xcc_id(); b.st = st;
    if (threadIdx.x == 0) (void)xb_add(&bar[XB_XCNT(b.x)], 1u);
    return b;
}
__device__ __forceinline__ void xcd_barrier_complete(unsigned* bar, unsigned x, unsigned& nloc, unsigned& nx) {
    const unsigned G = gridDim.x * gridDim.y * gridDim.z;
    unsigned sum, cnt, mine, sp = 0u;
    for (;;) {
        sum = 0u; cnt = 0u; mine = 0u;
#pragma unroll
        for (unsigned j = 0; j < 16; ++j) { const unsigned c = xb_ld(&bar[XB_XCNT(j)]); sum += c; cnt += (c > 0u) ? 1u : 0u; mine = (j == x) ? c : mine; }
        if (sum == G) break;
        __builtin_amdgcn_s_sleep(1);
        if ((++sp & 255u) == 0u) { if (xb_ld(&bar[XB_TMO])) break; if (sp > XB_SPIN_CAP) { atomicAdd(&bar[XB_TMO], 1u); break; } }
    }
    nloc = mine > 0u ? mine : 1u; nx = cnt > 0u ? cnt : 1u;
}

__device__ __forceinline__ void xcd_barrier(const XcdBarrier& b) {
    asm volatile("s_waitcnt vmcnt(0)" ::: "memory");
    __syncthreads();
    if (threadIdx.x == 0) {
        unsigned* bar = b.bar;
        __builtin_amdgcn_s_waitcnt(0);
        unsigned nloc = b.st[0], nx = b.st[1];
        if (nloc == 0u) { xcd_barrier_complete(bar, b.x, nloc, nx); b.st[0] = nloc; b.st[1] = nx; }
        const unsigned old = xb_add(&bar[XB_XSUB(b.x)], 1u);
        const unsigned gen = old / nloc;
        if (old + 1u == (gen + 1u) * nloc) {
            __builtin_amdgcn_fence(__ATOMIC_RELEASE, "agent");
            asm volatile("s_waitcnt vmcnt(0)" ::: "memory");
            const unsigned og = xb_add(&bar[XB_TOP], 1u);
            const unsigned tg = og / nx;
            if (og + 1u == (tg + 1u) * nx) xb_add(&bar[XB_TOPGEN], 1u);
            else XB_SPIN(xb_ld(&bar[XB_TOPGEN]) == tg, bar);
            __builtin_amdgcn_fence(__ATOMIC_ACQUIRE, "agent");
            xb_add(&bar[XB_XGEN(b.x)], 1u);
            asm volatile("s_waitcnt vmcnt(0)" ::: "memory");
        } else {
            XB_SPIN(xb_ld(&bar[XB_XGEN(b.x)]) == gen, bar);
            __builtin_amdgcn_fence(__ATOMIC_ACQUIRE, "agent");
            asm volatile("s_waitcnt vmcnt(0)" ::: "memory");
        }
    }
    __syncthreads();
}
struct Frame {
    LAS unsigned char* lds;
    unsigned char* ldsg;
    volatile LAS unsigned* MISC;
    int tid, lane, wave, vcu, G, gw, NGW;
    const float* const* in;
    unsigned char* ws;
    float* out;
    unsigned long long tprobe;
};
#ifndef PROBE_SUB
#define PROBE_SUB 0
#endif
#define TP_BEGIN() unsigned long long tp0_ = PROBE_SUB ? __builtin_amdgcn_s_memrealtime() : 0ull
#define TP_END(id) do { if (PROBE_SUB == (id)) { const unsigned long long t1_ = __builtin_amdgcn_s_memrealtime(); F0.tprobe += t1_ - tp0_; } if (PROBE_SUB) tp0_ = __builtin_amdgcn_s_memrealtime(); } while (0)
#define WSP(T, off) ((T*)(F.ws + (off)))
#define LAUNDER(F) asm volatile("" : "+s"(F.ws), "+s"(F.in), "+s"(F.out), "+v"(F.tid), "+v"(F.lane), "+s"(F.wave), "+s"(F.gw), "+s"(F.vcu), "+s"(F.G), "+s"(F.NGW))

__device__ __forceinline__ int row_s(int row) { return row < TLAT ? (row >> 12) : 4; }

__device__ __forceinline__ void mod_row_store(const f32x4 (&v)[4], const float* g, const float* shift, const float* scale, bf16* orow, int lane, f32x4 (&h)[4]) {
    float s = 0.f;
#pragma unroll
    for (int j = 0; j < 4; ++j) s += (v[j].x * v[j].x + v[j].y * v[j].y) + (v[j].z * v[j].z + v[j].w * v[j].w);
    const float rstd = 1.0f / sqrtf(wave_sum(s) * (1.0f / 1024.0f) + 1e-6f);
#pragma unroll
    for (int j = 0; j < 4; ++j) {
        const f32x4 g4 = ((const f32x4*)g)[64 * j + lane], sh = ((const f32x4*)shift)[64 * j + lane], sc = ((const f32x4*)scale)[64 * j + lane];
        h[j] = (v[j] * rstd) * g4 * (sc + 1.0f) + sh;
        v2u o; o.x = pk2(h[j].x, h[j].y); o.y = pk2(h[j].z, h[j].w);
        ((v2u*)orow)[64 * j + lane] = o;
    }
}

template <class RowMap>
__device__ __forceinline__ void transpose_item(const float* W, int K, int N, bf16* WT, const RowMap& rowmap, LAS float* scr, int item, int lane) {
    const int nblk = (N + 63) / 64, kb = item / nblk, nb = item % nblk, k0 = 64 * kb, n0 = 64 * nb;
    const int r = lane >> 4, c4 = (lane & 15) * 4;
    f32x4 t_[16];
#pragma unroll
    for (int i = 0; i < 16; ++i) t_[i] = (n0 + c4 < N) ? *(const f32x4*)(W + (size_t)(k0 + 4 * i + r) * N + n0 + c4) : (f32x4){0.f, 0.f, 0.f, 0.f};
#pragma unroll
    for (int i = 0; i < 16; ++i) { LAS float* d = scr + (4 * i + r) * 65 + c4; d[0] = t_[i].x; d[1] = t_[i].y; d[2] = t_[i].z; d[3] = t_[i].w; }
    LDS_WAIT(); asm volatile("" ::: "memory");
    const int c = lane & 7;
#pragma unroll
    for (int j = 0; j < 8; ++j) { const int n = (lane >> 3) + 8 * j; const LAS float* s = scr + (8 * c) * 65 + n;
        v4u o; o.x = pk2(s[0 * 65], s[1 * 65]); o.y = pk2(s[2 * 65], s[3 * 65]); o.z = pk2(s[4 * 65], s[5 * 65]); o.w = pk2(s[6 * 65], s[7 * 65]);
        *(v4u*)(WT + (size_t)rowmap(n0 + n) * K + k0 + 8 * c) = o; }
    LDS_WAIT(); asm volatile("" ::: "memory");
}
struct RowId { int off; __device__ __forceinline__ int operator()(int n) const { return off + n; } };
struct RowW13 { int e, w3; __device__ __forceinline__ int operator()(int n) const { return e * 2048 + (n >> 7) * 256 + w3 * 128 + (n & 127); } };

__device__ __forceinline__ void ph_prologue(Frame& F0) { Frame F = F0; LAUNDER(F);
    LAS float* scr = (LAS float*)(F.lds + F.wave * 16640);
    LAS float* sv = (LAS float*)F.lds;
    constexpr int I_IN = 16 * ((EVC + 63) / 64), I_O = 16 * 16, I_Q = 16 * (QKVC / 64);
    constexpr int PER_J = I_IN + I_O + I_Q + I_O, NT_ITEMS = 2 * PER_J;
    for (int it = F.gw; it < NT_ITEMS; it += F.NGW) {
        const int j = it / PER_J; int r = it % PER_J;
        if (r < I_IN) { transpose_item(F.in[I_EVWIN] + (size_t)j * DM * EVC, DM, EVC, WSP(bf16, WS_WIN) + (size_t)j * EVCP * DM, RowId{0}, scr, r, F.lane); continue; } r -= I_IN;
        if (r < I_O) { transpose_item(F.in[I_EVWOUT] + (size_t)j * DM * DM, DM, DM, WSP(bf16, WS_WOE) + (size_t)j * DM * DM, RowId{0}, scr, r, F.lane); continue; } r -= I_O;
        if (r < I_Q) { transpose_item(F.in[I_WQKV] + (size_t)j * DM * QKVC, DM, QKVC, WSP(bf16, WS_WQKV) + (size_t)j * QKVC * DM, RowId{0}, scr, r, F.lane); continue; } r -= I_Q;
        transpose_item(F.in[I_DAWOUT] + (size_t)j * DM * DM, DM, DM, WSP(bf16, WS_WOD) + (size_t)j * DM * DM, RowId{0}, scr, r, F.lane);
    }
    __syncthreads();
    for (int i = F.tid; i < 5 * 1024; i += NTHR) { const float x = i < 4096 ? F.in[I_C][i] : F.in[I_CCTX][i - 4096]; sv[i] = siluf_(x); }
    __syncthreads();
    for (int it = F.gw; it < 4 * 24 * 8; it += F.NGW) {
        const int kc = it & 7, cg = (it >> 3) % 24, i = it / (8 * 24); const int col = cg * 256 + F.lane * 4;
        const float* wp = F.in[I_ADAW] + (size_t)i * DM * 6144 + (size_t)(kc * 128) * 6144 + col;
        f32x4 acc[5];
#pragma unroll
        for (int s = 0; s < 5; ++s) acc[s] = (f32x4){0.f, 0.f, 0.f, 0.f};
#pragma unroll 8
        for (int k = 0; k < 128; ++k) { const f32x4 w = *(const f32x4*)(wp + (size_t)k * 6144);
#pragma unroll
            for (int s = 0; s < 5; ++s) acc[s] = acc[s] + w * sv[s * 1024 + kc * 128 + k]; }
#pragma unroll
        for (int s = 0; s < 5; ++s) *(f32x4*)(WSP(float, WS_MODP) + ((size_t)(kc * 4 + i) * 5 + s) * 6144 + col) = acc[s];
    }
    for (int k = F.gw * 64 + F.lane; k < 8192; k += F.NGW * 64) { float s, c; sincospif((float)k * (1.0f / 4096.0f), &s, &c); WSP(f32x2, WS_TW)[k] = (f32x2){c, -s}; }
    for (int idx = F.gw * 64 + F.lane; idx < 2 * 224 * 64; idx += F.NGW * 64) {
        const int l = idx & 63, f = (idx >> 6) % 224, j = idx / (224 * 64); const int kb = 8 * (l >> 4), n = l & 15;
        const float* src; int col;
        if (f < 64) { const int d = f >> 5, nt = f & 31; src = F.in[I_W2] + ((size_t)(j * 2 + d) * 32 + kb) * RWW; col = nt * 16 + n; }
        else if (f < 128) { const int d = (f - 64) >> 5, nt = (f - 64) & 31; src = F.in[I_A2] + ((size_t)(j * 2 + d) * 32 + kb) * RWW; col = nt * 16 + n; }
        else { const int nt = (f - 128) / 3, ks = (f - 128) % 3; src = F.in[I_G2] + ((size_t)j * 96 + ks * 32 + kb) * RWW; col = nt * 16 + n; }
        v4u o; o.x = pk2(src[0 * RWW + col], src[1 * RWW + col]); o.y = pk2(src[2 * RWW + col], src[3 * RWW + col]); o.z = pk2(src[4 * RWW + col], src[5 * RWW + col]); o.w = pk2(src[6 * RWW + col], src[7 * RWW + col]);
        WSP(v4u, WS_FRAGB)[idx] = o;
    }
}
__device__ __forceinline__ void ph_modred(Frame& F0) { Frame F = F0; LAUNDER(F);
    for (int idx = F.gw * 64 + F.lane; idx < 4 * 5 * 6144; idx += F.NGW * 64) {
        const int col = idx % 6144, i = idx / (5 * 6144); float a = F.in[I_ADAB][i * 6144 + col];
#pragma unroll
        for (int kc = 0; kc < 8; ++kc) a += WSP(float, WS_MODP)[(size_t)kc * 4 * 5 * 6144 + idx];
        WSP(float, WS_MODS)[idx] = a;
    }
}
__device__ __forceinline__ void ph_mod0(Frame& F0) { Frame F = F0; LAUNDER(F);
    const float* mods = WSP(float, WS_MODS);
    for (int row = F.gw; row < TT; row += F.NGW) {
        const float* src = row < TLAT ? F.in[I_X] + (size_t)row * DM : F.in[I_CTX] + (size_t)(row - TLAT) * DM;
        f32x4 v[4], h[4];
#pragma unroll
        for (int j = 0; j < 4; ++j) { v[j] = ((const f32x4*)src)[64 * j + F.lane]; ((f32x4*)(WSP(float, WS_X) + (size_t)row * DM))[64 * j + F.lane] = v[j]; }
        const int s = row_s(row);
        mod_row_store(v, F.in[I_NORMG], mods + s * 6144, mods + s * 6144 + 1024, WSP(bf16, WS_HA) + (size_t)row * DM, F.lane, h);
    }
}
__device__ __forceinline__ float seq_pos(int row, int& L) { if (row < TLAT) { L = SEQ; return (float)(row & (SEQ - 1)); } L = CTXL; return (float)((row - TLAT) & (CTXL - 1)); }
__device__ __forceinline__ int seq_l(int row, int& L) { if (row < TLAT) { L = SEQ; return row & (SEQ - 1); } L = CTXL; return (row - TLAT) & (CTXL - 1); }

__device__ __forceinline__ f32x4 shift4(const float* P, size_t off, bool hp, bool hn, f32x4 m0, f32x4 m1) {
    const f32x4 u = *(const f32x4*)(P + off);
    const f32x4 up = hp ? *(const f32x4*)(P + off - EVCP) : (f32x4){0.f, 0.f, 0.f, 0.f};
    const f32x4 un = hn ? *(const f32x4*)(P + off + EVCP) : (f32x4){0.f, 0.f, 0.f, 0.f};
    return u + m0 * (up - u) + m1 * (un - u);
}

__device__ __forceinline__ void ph_evprep(Frame& F0, int j) { Frame F = F0; LAUNDER(F);
    const float* P = WSP(float, WS_P);
    const float* mu = F.in[I_MU] + (size_t)j * 2 * RWC;
    TP_BEGIN();
    {
        float* Rr = (float*)(F.ws + WS_RW); float* Kk = (float*)(F.ws + WS_RW + RW_STRIDE); float* Vv = (float*)(F.ws + WS_RW + 2 * RW_STRIDE); float* KKn = (float*)(F.ws + WS_RW + 3 * RW_STRIDE);
        bf16* AOP = WSP(bf16, WS_AOP); const float* kkw = F.in[I_KK] + (size_t)j * RWW;
        for (int row = F.gw; row < TT; row += F.NGW) {
            int L; const int l = seq_l(row, L); const bool hp = l > 0, hn = l < L - 1;
#pragma unroll
            for (int q = 0; q < 7; ++q) {
                const int g = F.lane + 64 * q;
                if (q < 6 || g < 440) {
                    const int col = 4 * g;
                    const f32x4 m0 = *(const f32x4*)(mu + col), m1 = *(const f32x4*)(mu + RWC + col);
                    f32x4 sv = shift4(P, (size_t)row * EVCP + col, hp, hn, m0, m1);
                    if (q < 2) *(f32x4*)(Rr + (size_t)row * RWW + col) = sv;
                    else if (q < 4) { const int c = col - 512; *(f32x4*)(Kk + (size_t)row * RWW + c) = sv;
                        const f32x4 kx = sv * *(const f32x4*)(kkw + c);
                        const float ss = sum16_f((kx.x * kx.x + kx.y * kx.y) + (kx.z * kx.z + kx.w * kx.w));
                        *(f32x4*)(KKn + (size_t)row * RWW + c) = kx * (1.0f / fmaxf(sqrtf(ss), 1e-12f)); }
                    else if (q < 6) *(f32x4*)(Vv + (size_t)row * RWW + (col - 1024)) = sv;
                    else { const int c = col - 1536;
                        if (c < 64) { sv.x = tanhf(sv.x); sv.y = tanhf(sv.y); sv.z = tanhf(sv.z); sv.w = tanhf(sv.w); }
                        else if (c >= 128) { sv.x = sigmoidf_(sv.x); sv.y = sigmoidf_(sv.y); sv.z = sigmoidf_(sv.z); sv.w = sigmoidf_(sv.w); }
                        v2u w; w.x = pk2(sv.x, sv.y); w.y = pk2(sv.z, sv.w); *(v2u*)(AOP + (size_t)row * 224 + c) = w; }
                }
            }
        }
    }
    __syncthreads(); TP_END(1);
#ifndef NO_EV_B
    {
        LAS float* scr = (LAS float*)(F.lds + F.wave * 16640);
        const float* cw = F.in[I_CONVW] + (size_t)j * 3 * HYC; const float* cb = F.in[I_CONVB] + (size_t)j * HYC;
        for (int it = F.gw; it < (TT / 64) * (HYC / 64); it += F.NGW) {
            const int rt = it / (HYC / 64), ct = it % (HYC / 64); const int r0 = rt * 64, c = ct * 64 + F.lane;
            const float w0 = cw[c], w1 = cw[HYC + c], w2 = cw[2 * HYC + c], bb = cb[c];
            int L; const int l0 = seq_l(r0, L);
            {
                const size_t o0 = (size_t)r0 * EVCP + RWC + c;
                float up = l0 > 0 ? P[o0 - EVCP] : 0.f, u = P[o0];
#pragma unroll 1
                for (int r8 = 0; r8 < 64; r8 += 8) {
                    float nx[8];
#pragma unroll
                    for (int k = 0; k < 8; ++k) { const int l = l0 + r8 + k; nx[k] = l < L - 1 ? P[o0 + (size_t)(r8 + k + 1) * EVCP] : 0.f; }
#pragma unroll
                    for (int k = 0; k < 8; ++k) { scr[F.lane * 65 + r8 + k] = up * w0 + u * w1 + nx[k] * w2 + bb; up = u; u = nx[k]; }
                }
            }
            LDS_WAIT(); asm volatile("" ::: "memory");
            float* dst; if (r0 < TLAT) dst = WSP(float, WS_UTL) + ((size_t)(r0 >> 12) * HYC + ct * 64) * SEQ + l0; else dst = WSP(float, WS_UTC) + ((size_t)((r0 - TLAT) >> 8) * HYC + ct * 64) * CTXL + l0;
            for (int cc = 0; cc < 64; ++cc) dst[(size_t)cc * L + F.lane] = scr[cc * 65 + F.lane];
            LDS_WAIT(); asm volatile("" ::: "memory");
        }
    }
#endif
    __syncthreads(); TP_END(2);
#ifndef NO_EV_C
    {
        LAS float* H1 = (LAS float*)F.lds; LAS float* H2 = (LAS float*)(F.lds + 16384);
        LAS float* W1s = (LAS float*)(F.lds + 32768); LAS float* B1s = (LAS float*)(F.lds + 41216); LAS float* B2s = (LAS float*)(F.lds + 41472); LAS float* FRs = (LAS float*)(F.lds + 41728);
        LAS float* W2s = (LAS float*)(F.lds + 42240); LAS float* W3s = (LAS float*)(F.lds + 58624);
        for (int i = F.tid; i < 33 * 64; i += NTHR) W1s[i] = F.in[I_FW1][(size_t)j * 33 * 64 + i];
        for (int i = F.tid; i < 64 * 64; i += NTHR) W2s[i] = F.in[I_FW2][(size_t)j * 64 * 64 + i];
        if (F.tid < 64) { B1s[F.tid] = F.in[I_FB1][j * 64 + F.tid]; B2s[F.tid] = F.in[I_FB2][j * 64 + F.tid]; }
        if (F.tid < 128) FRs[F.tid] = F.in[I_FREQ][j * 128 + F.tid];
        const float* w3 = F.in[I_FW3] + (size_t)j * 64 * 2048;
        const int p = F.tid & 63, cg = F.wave;
        for (int it = F.vcu; it < 272; it += F.G) {
            const bool lat = it < 256; const int L = lat ? SEQ : CTXL; const int r = lat ? it : it - 256; const int pt = r >> 2, cq4 = r & 3; const int m = pt * 64 + p;
            float z[33];
            z[0] = (float)m / (float)(L - 1);
#pragma unroll
            for (int i = 0; i < 16; ++i) { const float band = 1e-4f + (float)i * ((15.0f - 1e-4f) / 15.0f); const float rev = (float)m * band / (float)L; const float fr_ = rev - floorf(rev);
                z[1 + i] = __builtin_amdgcn_cosf(fr_); z[17 + i] = -__builtin_amdgcn_sinf(fr_); }
            __syncthreads();
#pragma unroll 1
            for (int q = 0; q < 8; ++q) { const int n = cg * 8 + q; float a = B1s[n];
#pragma unroll
                for (int i = 0; i < 33; ++i) a += z[i] * W1s[i * 64 + n];
                H1[n * 64 + p] = __sinf(FRs[n] * a); }
            __syncthreads();
#pragma unroll 1
            for (int q = 0; q < 8; ++q) { const int n = cg * 8 + q; float a = B2s[n];
#pragma unroll 8
                for (int k = 0; k < 64; ++k) a += H1[k * 64 + p] * W2s[k * 64 + n];
                H2[n * 64 + p] = __sinf(FRs[64 + n] * a); }
            const float t = z[0];
            float* KC = lat ? WSP(float, WS_KCL) : WSP(float, WS_KCC); const int N2 = 2 * L;
#pragma unroll 1
            for (int c4 = 0; c4 < 4; ++c4) {
                const int ct = cq4 * 4 + c4;
                __syncthreads();
                for (int i = F.tid; i < 64 * 32; i += NTHR) { const int k = i >> 5, cc = i & 31; *(LAS f32x4*)(W3s + k * 128 + cc * 4) = *(const f32x4*)(w3 + (size_t)k * 2048 + ct * 128 + cc * 4); }
                __syncthreads();
                f32x4 acc[4];
#pragma unroll
                for (int q = 0; q < 4; ++q) acc[q] = (f32x4){0.f, 0.f, 0.f, 0.f};
#pragma unroll 2
                for (int k = 0; k < 64; ++k) { const float hv = H2[k * 64 + p]; const LAS f32x4* wr = (const LAS f32x4*)(W3s + k * 128 + cg * 16);
#pragma unroll
                    for (int q = 0; q < 4; ++q) acc[q] = acc[q] + wr[q] * hv; }
                const int colb = ct * 128 + cg * 16;
#pragma unroll
                for (int q = 0; q < 16; ++q) { const int col = colb + q; const int o = col >> 10, dirn = (col >> 9) & 1, c = col & 511;
                    const float d0 = -3.0701134573253945f, d1 = -15.350567286626973f; const float del = fabsf(d0 + (d1 - d0) * ((float)c / 511.0f));
                    const float val = acc[q >> 2][q & 3] * __expf(-t * del); float* kr = KC + (size_t)(o * 512 + c) * N2;
                    if (dirn == 0) kr[m] = val; else { if (m > 0) kr[N2 - m] = val; else kr[L] = 0.f; } }
            }
        }
        __syncthreads();
    }
#endif
    TP_END(3);
}

#define ZI(i) ((i) + ((i) >> 5))
__device__ __forceinline__ f32x2 cmul(f32x2 a, f32x2 b) { return (f32x2){a.x * b.x - a.y * b.y, a.x * b.y + a.y * b.x}; }
__device__ __forceinline__ f32x2 cmulc(f32x2 a, f32x2 b) { return (f32x2){a.x * b.x + a.y * b.y, a.y * b.x - a.x * b.y}; }
template <int LOGN, int NF> __device__ __forceinline__ void fft_r2_dif(LAS f32x2* Z, const LAS f32x2* TWL, int lt, int lh) {
    constexpr int N = 1 << LOGN, TPG = NTHR / NF; const int half = 1 << lh;
    for (int bf = lt; bf < N / 2; bf += TPG) { const int jx = bf & (half - 1), i = ((bf - jx) << 1) + jx;
        const f32x2 a = Z[ZI(i)], b = Z[ZI(i + half)]; Z[ZI(i)] = a + b; Z[ZI(i + half)] = cmul(a - b, TWL[half + jx]); }
    __syncthreads();
}
template <int LOGN, int NF> __device__ __forceinline__ void fft_r8_dif(LAS f32x2* Z, const LAS f32x2* TWL, int lt, int lh) {
    constexpr int N = 1 << LOGN, TPG = NTHR / NF, NG = N / 8, PT = (NG + TPG - 1) / TPG; const int h = 1 << lh, qd = h >> 2, lq = lh - 2;
    f32x2 x[PT][8]; int i0[PT], j0[PT];
#pragma unroll
    for (int t = 0; t < PT; ++t) { const int g = lt + TPG * t; j0[t] = g & (qd - 1); i0[t] = ((g >> lq) << (lq + 3)) + j0[t];
        if (g < NG) {
#pragma unroll
            for (int m = 0; m < 8; ++m) x[t][m] = Z[ZI(i0[t] + m * qd)]; } }
#pragma unroll
    for (int t = 0; t < PT; ++t) { const int g = lt + TPG * t; if (g < NG) {
#pragma unroll
        for (int m = 0; m < 4; ++m) { const f32x2 a = x[t][m], b = x[t][m + 4]; x[t][m] = a + b; x[t][m + 4] = cmul(a - b, TWL[h + j0[t] + m * qd]); }
#pragma unroll
        for (int mm = 0; mm < 4; ++mm) { const int m = (mm & 1) + 4 * (mm >> 1); const f32x2 a = x[t][m], b = x[t][m + 2]; x[t][m] = a + b; x[t][m + 2] = cmul(a - b, TWL[(h >> 1) + j0[t] + (m & 1) * qd]); }
        const f32x2 wc = TWL[qd + j0[t]];
#pragma unroll
        for (int m = 0; m < 8; m += 2) { const f32x2 a = x[t][m], b = x[t][m + 1]; x[t][m] = a + b; x[t][m + 1] = cmul(a - b, wc); }
#pragma unroll
        for (int m = 0; m < 8; ++m) Z[ZI(i0[t] + m * qd)] = x[t][m]; } }
    __syncthreads();
}
template <int LOGN, int NF> __device__ __forceinline__ void fft_dif(LAS f32x2* Z, const LAS f32x2* TWL, int lt) {
    int lh = LOGN - 1;
    if (LOGN % 3 == 1) { fft_r2_dif<LOGN, NF>(Z, TWL, lt, lh); lh -= 1; }
#pragma unroll 1
    for (; lh >= 2; lh -= 3) fft_r8_dif<LOGN, NF>(Z, TWL, lt, lh);
}
template <int LOGN, int NF> __device__ __forceinline__ void fft_r8_dit(LAS f32x2* Z, const LAS f32x2* TWL, int lt, int lq) {
    constexpr int N = 1 << LOGN, TPG = NTHR / NF, NG = N / 8, PT = (NG + TPG - 1) / TPG; const int qd = 1 << lq;
    f32x2 x[PT][8]; int i0[PT], j0[PT];
#pragma unroll
    for (int t = 0; t < PT; ++t) { const int g = lt + TPG * t; j0[t] = g & (qd - 1); i0[t] = ((g >> lq) << (lq + 3)) + j0[t];
        if (g < NG) {
#pragma unroll
            for (int m = 0; m < 8; ++m) x[t][m] = Z[ZI(i0[t] + m * qd)]; } }
#pragma unroll
    for (int t = 0; t < PT; ++t) { const int g = lt + TPG * t; if (g < NG) {
        const f32x2 wc = TWL[qd + j0[t]];
#pragma unroll
        for (int m = 0; m < 8; m += 2) { const f32x2 a = x[t][m], b = cmulc(x[t][m + 1], wc); x[t][m] = a + b; x[t][m + 1] = a - b; }
#pragma unroll
        for (int mm = 0; mm < 4; ++mm) { const int m = (mm & 1) + 4 * (mm >> 1); const f32x2 a = x[t][m], b = cmulc(x[t][m + 2], TWL[2 * qd + j0[t] + (m & 1) * qd]); x[t][m] = a + b; x[t][m + 2] = a - b; }
#pragma unroll
        for (int m = 0; m < 4; ++m) { const f32x2 a = x[t][m], b = cmulc(x[t][m + 4], TWL[4 * qd + j0[t] + m * qd]); x[t][m] = a + b; x[t][m + 4] = a - b; }
#pragma unroll
        for (int m = 0; m < 8; ++m) Z[ZI(i0[t] + m * qd)] = x[t][m]; } }
    __syncthreads();
}
template <int LOGN, int NF> __device__ __forceinline__ void fft_dit_inv(LAS f32x2* Z, const LAS f32x2* TWL, int lt) {
    constexpr int N = 1 << LOGN, TPG = NTHR / NF; constexpr int NTRI = LOGN / 3;
#pragma unroll 1
    for (int k = 0; k < NTRI; ++k) fft_r8_dit<LOGN, NF>(Z, TWL, lt, 3 * k);
    if (LOGN % 3 == 1) { const int half = N / 2;
        for (int bf = lt; bf < N / 2; bf += TPG) { const f32x2 a = Z[ZI(bf)], b = cmulc(Z[ZI(bf + half)], TWL[half + bf]); Z[ZI(bf)] = a + b; Z[ZI(bf + half)] = a - b; }
        __syncthreads(); }
}
template <int LOGN> __device__ __forceinline__ int brev_n(int x) { return (int)(__brev((unsigned)x) >> (32 - LOGN)); }
template <int LOGN> __device__ __forceinline__ void load_tw(Frame& F, LAS f32x2* TWL) {
    constexpr int N = 1 << LOGN; const f32x2* TW = WSP(f32x2, WS_TW);
    for (int k = F.tid; k < N; k += NTHR) { if (k == 0) { TWL[0] = (f32x2){1.f, 0.f}; continue; }
        const int lh = 31 - __builtin_clz((unsigned)k), jx = k - (1 << lh);
        TWL[k] = TW[(size_t)jx << (12 - lh)]; }
}
__device__ __forceinline__ float block_sum(Frame& F, float v, LAS float* red) {
    v = wave_sum(v); __syncthreads(); if (F.lane == 0) red[F.wave] = v; __syncthreads();
    float t = 0.f;
#pragma unroll
    for (int w = 0; w < NWAVES; ++w) t += red[w];
    return t;
}
template <int LOGN, int NF> struct FftGeo { static constexpr int N = 1 << LOGN, TPG = NTHR / NF, ZS = N + N / 32; };

template <int LOGN, int NF> __device__ __forceinline__ void fftk_item(Frame& F, const float* KC, f32x4* KSP, int item) {
    constexpr int N = 1 << LOGN, TPG = NTHR / NF, ZS = FftGeo<LOGN, NF>::ZS;
    const int fi = F.tid / TPG, lt = F.tid % TPG; const int p8 = item * NF + fi, o = p8 >> 8, pr = p8 & 255;
    LAS f32x2* Z = (LAS f32x2*)F.lds + fi * ZS; LAS f32x2* TWL = (LAS f32x2*)(F.lds + 67584); LAS float* red = (LAS float*)(F.lds + 133120);
    const float* ka = KC + (size_t)(o * 512 + 2 * pr) * N; const float* kb = ka + N;
    float sa = 0.f, sb = 0.f;
    for (int i = lt; i < N; i += TPG) { const float a = ka[i], b = kb[i]; sa += fabsf(a); sb += fabsf(b); Z[ZI(i)] = (f32x2){a, b}; }
    float na, nb;
    if (NF == 1) { na = block_sum(F, sa, red) + 1e-6f; nb = block_sum(F, sb, red + 8) + 1e-6f; } else { static_assert(NF == 1 || NTHR / NF == 64, "one wave per transform"); na = wave_sum(sa) + 1e-6f; nb = wave_sum(sb) + 1e-6f; }
    __syncthreads();
    fft_dif<LOGN, NF>(Z, TWL, lt);
    const float ia = 0.5f / (na * (float)N), ib = 0.5f / (nb * (float)N);
    f32x4* dst = KSP + (size_t)(o * 256 + pr) * N;
    for (int p = lt; p < N; p += TPG) {
        const int k = brev_n<LOGN>(p), p2 = brev_n<LOGN>((N - k) & (N - 1));
        const f32x2 z1 = Z[ZI(p)], z2 = Z[ZI(p2)];
        const f32x2 Ka = (f32x2){(z1.x + z2.x) * ia, (z1.y - z2.y) * ia}, Kb = (f32x2){(z1.y + z2.y) * ib, -(z1.x - z2.x) * ib};
        dst[p] = (f32x4){0.5f * (Ka.x + Kb.x), 0.5f * (Ka.y + Kb.y), 0.5f * (Ka.x - Kb.x), 0.5f * (Ka.y - Kb.y)};
    }
    __syncthreads();
}

template <int LOGN, int NF> __device__ __forceinline__ void spec_mul(LAS f32x2* Z, const f32x4* KS, int lt) {
    constexpr int N = 1 << LOGN, TPG = NTHR / NF, PT = (N + TPG - 1) / TPG;
    f32x4 kv[PT]; f32x2 yv[PT];
#pragma unroll
    for (int t = 0; t < PT; ++t) { const int p = lt + TPG * t; if (p < N) kv[t] = KS[p]; }
#pragma unroll
    for (int t = 0; t < PT; ++t) { const int p = lt + TPG * t; if (p < N) {
        const int k = brev_n<LOGN>(p), p2 = brev_n<LOGN>((N - k) & (N - 1));
        const f32x2 z1 = Z[ZI(p)], z2 = Z[ZI(p2)];
        yv[t] = cmul(z1, (f32x2){kv[t].x, kv[t].y}) + cmul((f32x2){z2.x, -z2.y}, (f32x2){kv[t].z, kv[t].w}); } }
    __syncthreads();
#pragma unroll
    for (int t = 0; t < PT; ++t) { const int p = lt + TPG * t; if (p < N) Z[ZI(p)] = yv[t]; }
    __syncthreads();
}
template <int LOGN, int NF> __device__ __forceinline__ void hyena_item(Frame& F, const float* UTall, const f32x4* KSP, float* HYTall, const float* hyb, int item) {
    constexpr int N = 1 << LOGN, L = N / 2, TPG = NTHR / NF, PT = (L + TPG - 1) / TPG, ZS = FftGeo<LOGN, NF>::ZS;
    const int fi = F.tid / TPG, lt = F.tid % TPG; const int p8 = item * NF + fi, b = p8 >> 8, pr = p8 & 255;
    const float* UT = UTall + (size_t)b * HYC * L; float* HYT = HYTall + (size_t)b * 512 * L;
    LAS f32x2* Z = (LAS f32x2*)F.lds + fi * ZS; LAS f32x2* TWL = (LAS f32x2*)(F.lds + 67584);
    const int c0 = 2 * pr; const float b0a = hyb[c0], b0b = hyb[c0 + 1], b1a = hyb[512 + c0], b1b = hyb[512 + c0 + 1];
    const float* va = UT + (size_t)c0 * L; const float* vb = va + L;
    f32x2 keep[PT];
#pragma unroll
    for (int q = 0; q < PT; ++q) { const int l = lt + TPG * q; if (l < L) { keep[q] = (f32x2){va[l], vb[l]}; Z[ZI(l)] = keep[q]; Z[ZI(l + L)] = (f32x2){0.f, 0.f}; } }
    __syncthreads();
    fft_dif<LOGN, NF>(Z, TWL, lt);
    spec_mul<LOGN, NF>(Z, KSP + (size_t)pr * N, lt);
    fft_dit_inv<LOGN, NF>(Z, TWL, lt);
    const float* xa = UT + (size_t)(512 + c0) * L; const float* xb = xa + L;
#pragma unroll
    for (int q = 0; q < PT; ++q) { const int l = lt + TPG * q; if (l < L) { const f32x2 y = Z[ZI(l)]; keep[q] = (f32x2){xa[l] * (y.x + keep[q].x * b0a), xb[l] * (y.y + keep[q].y * b0b)}; } }
    __syncthreads();
#pragma unroll
    for (int q = 0; q < PT; ++q) { const int l = lt + TPG * q; if (l < L) { Z[ZI(l)] = keep[q]; Z[ZI(l + L)] = (f32x2){0.f, 0.f}; } }
    __syncthreads();
    fft_dif<LOGN, NF>(Z, TWL, lt);
    spec_mul<LOGN, NF>(Z, KSP + (size_t)(256 + pr) * N, lt);
    fft_dit_inv<LOGN, NF>(Z, TWL, lt);
    const float* x2a = UT + (size_t)(1024 + c0) * L; const float* x2b = x2a + L;
    float* oa = HYT + (size_t)c0 * L; float* ob = oa + L;
#pragma unroll
    for (int q = 0; q < PT; ++q) { const int l = lt + TPG * q; if (l < L) { const f32x2 y = Z[ZI(l)]; oa[l] = x2a[l] * (y.x + keep[q].x * b1a); ob[l] = x2b[l] * (y.y + keep[q].y * b1b); } }
    __syncthreads();
}
__device__ __forceinline__ void ph_hyena(Frame& F0, int j) { Frame F = F0; LAUNDER(F);
    LAS f32x2* TWL = (LAS f32x2*)(F.lds + 67584);
    const float* hyb = F.in[I_HYB] + (size_t)j * 1024;
    load_tw<13>(F, TWL); __syncthreads();
    for (int it = F.vcu; it < 1024; it += F.G) hyena_item<13, 1>(F, WSP(float, WS_UTL), WSP(f32x4, WS_KSPL), WSP(float, WS_HYTL), hyb, it);
    __syncthreads(); load_tw<9>(F, TWL); __syncthreads();
    for (int it = F.vcu; it < 128; it += F.G) hyena_item<9, 8>(F, WSP(float, WS_UTC), WSP(f32x4, WS_KSPC), WSP(float, WS_HYTC), hyb, it);
    __syncthreads();
}

__device__ __forceinline__ void ph_readout(Frame& F0, int j) { Frame F = F0; LAUNDER(F);
    const float* Vv = (const float*)(F.ws + WS_RW + 2 * RW_STRIDE); const float* Gg = WSP(float, WS_G); const float* BON = WSP(float, WS_BON);
    const float* Y0 = WSP(float, WS_Y); const float* Y1 = Y0 + (size_t)TT * RWW;
    const float* gn = F.in[I_GN] + (size_t)j * 2 * RWW;
    bf16* CAT = WSP(bf16, WS_CAT);
    for (int row = F.gw; row < TT; row += F.NGW) {
#pragma unroll
        for (int q = 0; q < 2; ++q) {
            const int c = 4 * F.lane + 256 * q; const size_t o = (size_t)row * RWW + c;
            const f32x4 y = *(const f32x4*)(Y0 + o) + *(const f32x4*)(Y1 + o);
            float s = (y.x + y.y) + (y.z + y.w);
            s = sum16_f(s);
            const float mu = s * (1.0f / 64.0f); const f32x4 dy = y - mu;
            float v2 = (dy.x * dy.x + dy.y * dy.y) + (dy.z * dy.z + dy.w * dy.w);
            v2 = sum16_f(v2);
            const float rstd = 1.0f / sqrtf(v2 * (1.0f / 64.0f) + 64e-5f);
            const f32x4 yn = dy * rstd * *(const f32x4*)(gn + c) + *(const f32x4*)(gn + RWW + c);
            const f32x4 v = *(const f32x4*)(Vv + o), g = *(const f32x4*)(Gg + o);
            const float bs = BON[(size_t)row * 8 + (c >> 6)];
            f32x4 ov = (yn + v * bs) * g;
#ifdef ABL_RW
            ov = ov * 0.0f;
#endif
            v2u w; w.x = pk2(ov.x, ov.y); w.y = pk2(ov.z, ov.w);
            *(v2u*)(CAT + (size_t)row * DM + c) = w;
        }
    }
    LAS float* scr = (LAS float*)(F.lds + F.wave * 16640);
    for (int it = F.gw; it < (TT / 64) * 8; it += F.NGW) {
        const int rt = it >> 3, ct = it & 7; const int r0 = rt * 64; int L; const int l0 = seq_l(r0, L);
        const float* src; if (r0 < TLAT) src = WSP(float, WS_HYTL) + ((size_t)(r0 >> 12) * 512 + ct * 64) * SEQ + l0; else src = WSP(float, WS_HYTC) + ((size_t)((r0 - TLAT) >> 8) * 512 + ct * 64) * CTXL + l0;
        for (int cc = 0; cc < 64; ++cc) scr[cc * 65 + F.lane] = src[(size_t)cc * L + F.lane];
        LDS_WAIT(); asm volatile("" ::: "memory");
        const int c2 = 2 * (F.lane & 31);
        for (int i2 = 0; i2 < 32; ++i2) { const int rr = 2 * i2 + (F.lane >> 5);
            unsigned pkv = pk2(scr[c2 * 65 + rr], scr[(c2 + 1) * 65 + rr]);
#ifdef ABL_HY
            pkv = 0u;
#endif
            *(unsigned*)(CAT + (size_t)(r0 + rr) * DM + 512 + ct * 64 + c2) = pkv; }
        LDS_WAIT(); asm volatile("" ::: "memory");
    }
}

__device__ __forceinline__ int chunk_base_row(int b, int d, int n) {
    if (n < 16) return TLAT + b * CTXL + 16 * (d ? 15 - n : n);
    const int m = n - 16; return b * SEQ + 16 * (d ? 255 - m : m);
}

__device__ __forceinline__ void ph_chunkprep(Frame& F0, int j) { Frame F = F0; LAUNDER(F);
    const float* Rr = (const float*)(F.ws + WS_RW); const float* Kk = (const float*)(F.ws + WS_RW + RW_STRIDE); const float* Vv = (const float*)(F.ws + WS_RW + 2 * RW_STRIDE); const float* KKn = (const float*)(F.ws + WS_RW + 3 * RW_STRIDE);
    const bf16* AOP = WSP(bf16, WS_AOP); float* Gg = WSP(float, WS_G); float* BON = WSP(float, WS_BON);
    LAS unsigned char* wl = F.lds + F.wave * 14336;
    LAS float* ST = (LAS float*)wl; LAS bf16* OPB = (LAS bf16*)(wl + 4096); LAS float* TM = (LAS float*)(wl + 12288); LAS float* M2s = (LAS float*)(wl + 13312);
    LAS v4u* FBL = (LAS v4u*)(F.lds + 8 * 14336);
    const int h = F.vcu & 7;
    {
        const v4u* FB = WSP(v4u, WS_FRAGB) + (size_t)j * 224 * 64;
        for (int i = F.tid; i < 28 * 64; i += NTHR) { const int f = i >> 6, l = i & 63; int src;
            if (f < 8) src = (f >> 2) * 32 + 4 * h + (f & 3); else if (f < 16) src = 64 + ((f - 8) >> 2) * 32 + 4 * h + (f & 3); else src = 128 + (4 * h + (f - 16) / 3) * 3 + (f - 16) % 3;
            FBL[i] = FB[src * 64 + l]; }
    }
    __syncthreads();
    const int lane = F.lane, n15 = lane & 15, q = lane >> 4;
    LAS float* BIAS = (LAS float*)(F.lds + LDSCTL_OFF + 1024);
    if (F.tid < 256) { const int which = F.tid >> 7, d = (F.tid >> 6) & 1, c = F.tid & 63; BIAS[F.tid] = (which ? F.in[I_A0] : F.in[I_W0])[(size_t)(j * 2 + d) * RWW + h * 64 + c]; }
    __syncthreads();
    const int col = h * 64 + lane;
    const float kav = F.in[I_KA][(size_t)j * RWW + col], rkv = F.in[I_RK][(size_t)j * RWW + col];
    for (int c16 = (F.vcu >> 3) * 8 + F.wave; c16 < TT / 16; c16 += (F.G >> 3) * 8) {
        const int base = c16 * 16;
        const bool lat = base < TLAT; const int b = lat ? (base >> 12) : ((base - TLAT) >> 8); const int cidx = lat ? ((base & (SEQ - 1)) >> 4) : (((base - TLAT) & (CTXL - 1)) >> 4);
        bf16x8 af[7];
#pragma unroll
        for (int f7 = 4; f7 < 7; ++f7) af[f7] = *(const bf16x8*)(AOP + (size_t)(base + n15) * 224 + f7 * 32 + 8 * q);
        float kkv[16], kxv[16], rxv[16];
#pragma unroll
        for (int s = 0; s < 16; ++s) { const size_t o = (size_t)(base + s) * RWW + col; kkv[s] = KKn[o]; kxv[s] = Kk[o]; rxv[s] = Rr[o]; }
#pragma unroll
        for (int nt = 0; nt < 4; ++nt) {
            f32x4 cg = __builtin_amdgcn_mfma_f32_16x16x32_bf16(af[4], __builtin_bit_cast(bf16x8, FBL[(16 + nt * 3 + 0) * 64 + lane]), (f32x4){0.f, 0.f, 0.f, 0.f}, 0, 0, 0);
            cg = __builtin_amdgcn_mfma_f32_16x16x32_bf16(af[5], __builtin_bit_cast(bf16x8, FBL[(16 + nt * 3 + 1) * 64 + lane]), cg, 0, 0, 0);
            cg = __builtin_amdgcn_mfma_f32_16x16x32_bf16(af[6], __builtin_bit_cast(bf16x8, FBL[(16 + nt * 3 + 2) * 64 + lane]), cg, 0, 0, 0);
#pragma unroll
            for (int r = 0; r < 4; ++r) Gg[(size_t)(base + 4 * q + r) * RWW + h * 64 + nt * 16 + n15] = cg[r];
        }
        float bon_mine = 0.f;
#pragma unroll 1
        for (int d = 0; d < 2; ++d) {
            float wv[16], av[16];
            const bf16x8 afw = *(const bf16x8*)(AOP + (size_t)(base + n15) * 224 + d * 32 + 8 * q), afa = *(const bf16x8*)(AOP + (size_t)(base + n15) * 224 + 64 + d * 32 + 8 * q);
#pragma unroll
            for (int which = 0; which < 2; ++which) {
#pragma unroll
                for (int nt = 0; nt < 4; ++nt) {
                    const bf16x8 aop = which ? afa : afw;
                    const f32x4 c4 = __builtin_amdgcn_mfma_f32_16x16x32_bf16(aop, __builtin_bit_cast(bf16x8, FBL[(8 * which + 4 * d + nt) * 64 + lane]), (f32x4){0.f, 0.f, 0.f, 0.f}, 0, 0, 0);
                    const float bias = BIAS[(which * 2 + d) * 64 + nt * 16 + n15];
#pragma unroll
                    for (int r = 0; r < 4; ++r) { const int tok = 4 * q + r, st = d ? 15 - tok : tok; const float x = bias + c4[r];
                        ST[st * 64 + nt * 16 + n15] = which ? sigmoidf_(x) : __expf(-0.6065306597126334f * sigmoidf_(x)); }
                }
                LDS_WAIT(); asm volatile("" ::: "memory");
#pragma unroll
                for (int s = 0; s < 16; ++s) { if (which) av[s] = ST[s * 64 + lane]; else wv[s] = ST[s * 64 + lane]; }
                LDS_WAIT(); asm volatile("" ::: "memory");
            }
            float kt[16];
            float p = 1.0f;
#pragma unroll
            for (int s = 0; s < 16; ++s) {
                const float kk = d ? kkv[15 - s] : kkv[s], kx = d ? kxv[15 - s] : kxv[s], rx = d ? rxv[15 - s] : rxv[s];
                const float kd = kx * (1.0f + (av[s] - 1.0f) * kav);
                { const float bt_ = wave_sum(rx * kd * rkv); if (lane == (d ? 15 - s : s)) bon_mine += bt_; }
                kt[s] = kk * p; p *= wv[s]; const float ip = 1.0f / p;
                OPB[0 * 1024 + s * 64 + lane] = (bf16)f2bf(kt[s]);
                OPB[1 * 1024 + s * 64 + lane] = (bf16)f2bf(rx * p);
                OPB[2 * 1024 + s * 64 + lane] = (bf16)f2bf(kd * ip);
                OPB[3 * 1024 + s * 64 + lane] = (bf16)f2bf(kk * av[s] * ip);
            }
            const float pc = p;
            LDS_WAIT(); asm volatile("" ::: "memory");
            {
                bf16x8 fk[2], fr[2], fb[2], fkk[2];
#pragma unroll
                for (int ks = 0; ks < 2; ++ks) { const int off = n15 * 64 + ks * 32 + 8 * q;
                    fk[ks] = *(const LAS bf16x8*)(OPB + 0 * 1024 + off); fr[ks] = *(const LAS bf16x8*)(OPB + 1 * 1024 + off);
                    fkk[ks] = *(const LAS bf16x8*)(OPB + 2 * 1024 + off); fb[ks] = *(const LAS bf16x8*)(OPB + 3 * 1024 + off); }
                f32x4 mA = (f32x4){0.f, 0.f, 0.f, 0.f}, mB = mA, mE = mA, mG = mA;
#pragma unroll
                for (int ks = 0; ks < 2; ++ks) {
                    mA = __builtin_amdgcn_mfma_f32_16x16x32_bf16(fk[ks], fb[ks], mA, 0, 0, 0);
                    mB = __builtin_amdgcn_mfma_f32_16x16x32_bf16(fk[ks], fkk[ks], mB, 0, 0, 0);
                    mE = __builtin_amdgcn_mfma_f32_16x16x32_bf16(fr[ks], fkk[ks], mE, 0, 0, 0);
                    mG = __builtin_amdgcn_mfma_f32_16x16x32_bf16(fr[ks], fb[ks], mG, 0, 0, 0);
                }
#pragma unroll
                for (int r = 0; r < 4; ++r) { const int sr = 4 * q + r;
                    ST[0 * 256 + sr * 16 + n15] = n15 < sr ? mA[r] : 0.f; ST[1 * 256 + sr * 16 + n15] = n15 < sr ? mB[r] : 0.f;
                    ST[2 * 256 + sr * 16 + n15] = n15 <= sr ? mE[r] : 0.f; ST[3 * 256 + sr * 16 + n15] = n15 <= sr ? mG[r] : 0.f; }
            }
            LDS_WAIT(); asm volatile("" ::: "memory");
            float vfa[2][8], vfb[2][8];
#pragma unroll
            for (int ig = 0; ig < 2; ++ig)
#pragma unroll
                for (int jj = 0; jj < 8; ++jj) { const int sg = (8 * q + jj) & 15; vfa[ig][jj] = Vv[(size_t)(base + (d ? 15 - sg : sg)) * RWW + h * 64 + ig * 16 + n15]; }
            {
                float tc[16];
#pragma unroll
                for (int s = 0; s < 16; ++s) { float acc = (s == n15) ? 1.0f : 0.0f;
#pragma unroll
                    for (int sg = 0; sg < s; ++sg) acc -= ST[0 * 256 + s * 16 + sg] * tc[sg];
                    tc[s] = acc; }
                if (q == 0) {
#pragma unroll
                    for (int s = 0; s < 16; ++s) TM[s * 16 + n15] = tc[s]; }
            }
            LDS_WAIT(); asm volatile("" ::: "memory");
            {
                float m1[16];
#pragma unroll
                for (int s = 0; s < 16; ++s) { float acc = 0.f;
#pragma unroll
                    for (int sg = 0; sg <= s; ++sg) acc += TM[s * 16 + sg] * kt[sg];
                    m1[s] = acc; }
#pragma unroll
                for (int s = 0; s < 16; ++s) OPB[0 * 1024 + s * 64 + lane] = (bf16)f2bf(m1[s]);
#pragma unroll
                for (int r = 0; r < 4; ++r) { const int sr = 4 * q + r; float acc = 0.f;
#pragma unroll
                    for (int sg = 0; sg < 16; ++sg) acc += TM[sr * 16 + sg] * ST[1 * 256 + sg * 16 + n15];
                    M2s[sr * 16 + n15] = acc; }
            }
            LDS_WAIT(); asm volatile("" ::: "memory");
#pragma unroll
            for (int ig = 0; ig < 2; ++ig)
#pragma unroll
                for (int jj = 0; jj < 8; ++jj) { const int sg = (8 * q + jj) & 15; vfb[ig][jj] = Vv[(size_t)(base + (d ? 15 - sg : sg)) * RWW + h * 64 + (2 + ig) * 16 + n15]; }
            {
                const int scan = b * 16 + h * 2 + d; const int npos = lat ? 16 + (d ? 255 - cidx : cidx) : (d ? 15 - cidx : cidx);
                unsigned char* rec = F.ws + WS_REC + ((size_t)scan * 272 + npos) * REC_BYTES;
                v4u* fo = (v4u*)rec + lane;
                unsigned short e8[8];
#define PACK_STORE(fi) do { v4u o_; o_.x = e8[0] | ((unsigned)e8[1] << 16); o_.y = e8[2] | ((unsigned)e8[3] << 16); o_.z = e8[4] | ((unsigned)e8[5] << 16); o_.w = e8[6] | ((unsigned)e8[7] << 16); fo[(fi) * 64] = o_; } while (0)
#pragma unroll
                for (int ks = 0; ks < 2; ++ks) {
#pragma unroll
                    for (int jj = 0; jj < 8; ++jj) e8[jj] = OPB[0 * 1024 + n15 * 64 + 32 * ks + 16 * (jj >> 2) + 4 * q + (jj & 3)];
                    PACK_STORE(ks);
#pragma unroll
                    for (int jj = 0; jj < 8; ++jj) e8[jj] = OPB[1 * 1024 + n15 * 64 + 32 * ks + 16 * (jj >> 2) + 4 * q + (jj & 3)];
                    PACK_STORE(2 + ks);
                }
#pragma unroll
                for (int jj = 0; jj < 8; ++jj) e8[jj] = q < 2 ? (unsigned short)f2bf(M2s[n15 * 16 + 8 * q + jj]) : (unsigned short)0;
                PACK_STORE(4);
#pragma unroll
                for (int jj = 0; jj < 8; ++jj) e8[jj] = q < 2 ? (unsigned short)f2bf(ST[2 * 256 + n15 * 16 + 8 * q + jj]) : (unsigned short)0;
                PACK_STORE(5);
#pragma unroll
                for (int jj = 0; jj < 8; ++jj) e8[jj] = jj < 4 ? (unsigned short)f2bf(-ST[3 * 256 + n15 * 16 + 4 * q + jj]) : (unsigned short)0;
                PACK_STORE(6);
#pragma unroll
                for (int tl = 0; tl < 4; ++tl) {
#pragma unroll
                    for (int jj = 0; jj < 8; ++jj) e8[jj] = q < 2 ? (unsigned short)OPB[2 * 1024 + (8 * q + jj) * 64 + 16 * tl + n15] : (unsigned short)0;
                    PACK_STORE(7 + tl);
#pragma unroll
                    for (int jj = 0; jj < 8; ++jj) e8[jj] = jj < 4 ? (unsigned short)(OPB[3 * 1024 + (4 * q + jj) * 64 + 16 * tl + n15] ^ 0x8000u) : (unsigned short)0;
                    PACK_STORE(11 + tl);
                }
#pragma unroll
                for (int ig = 0; ig < 4; ++ig) {
#pragma unroll
                    for (int jj = 0; jj < 8; ++jj) e8[jj] = q < 2 ? (unsigned short)f2bf(ig < 2 ? vfa[ig & 1][jj] : vfb[ig & 1][jj]) : (unsigned short)0;
                    PACK_STORE(15 + ig);
                }
#undef PACK_STORE
                ((float*)(rec + 19 * 1024))[lane] = pc;
            }
            LDS_WAIT(); asm volatile("" ::: "memory");
        }
        if (lane < 16) BON[(size_t)(base + lane) * 8 + h] = bon_mine;
    }
}

__device__ __forceinline__ void scan_unit(Frame& F, int scan) {
    constexpr int R = 7, D = 6, NCH = 272;
    const int b = scan >> 4, h = (scan >> 1) & 7, d = scan & 1;
    const int lane = F.lane, n15 = lane & 15, q = lane >> 4;
    const unsigned char* rec0 = F.ws + WS_REC + (size_t)scan * NCH * REC_BYTES;
    const bool loader = F.wave >= 4; const int lw = F.wave & 3, ig = F.wave & 3;
    float* Yd = WSP(float, WS_Y) + (size_t)d * TT * RWW;
    f32x4 S[4];
#pragma unroll
    for (int t = 0; t < 4; ++t) S[t] = (f32x4){0.f, 0.f, 0.f, 0.f};
#define ISSUE(n_) do { const unsigned char* g_ = rec0 + (size_t)(n_) * REC_BYTES + lw * 1024 + lane * 16; LAS unsigned char* l_ = F.lds + ((n_) % R) * (int)REC_BYTES + lw * 1024; \
        _Pragma("unroll") for (int p_ = 0; p_ < 5; ++p_) __builtin_amdgcn_global_load_lds((const unsigned*)(g_ + p_ * 4096), (LAS unsigned*)(l_ + p_ * 4096), 16, 0, 0); } while (0)
#define BF8(x) __builtin_bit_cast(bf16x8, x)
    if (loader) {
#pragma unroll 1
        for (int n = 0; n < D; ++n) ISSUE(n);
        asm volatile("s_waitcnt vmcnt(25)" ::: "memory");
    }
    __builtin_amdgcn_s_barrier();
#pragma unroll 1
    for (int n = 0; n < NCH; ++n) {
        if (loader) {
            if (n + D < NCH) { ISSUE(n + D); asm volatile("s_waitcnt vmcnt(25)" ::: "memory"); }
            else asm volatile("s_waitcnt vmcnt(0)" ::: "memory");
        } else {
            const LAS unsigned char* sl = F.lds + (n % R) * (int)REC_BYTES; const LAS v4u* fp = (const LAS v4u*)sl + lane;
            v4u sb0, sb1; sb0.x = pk2(S[0][0], S[0][1]); sb0.y = pk2(S[0][2], S[0][3]); sb0.z = pk2(S[1][0], S[1][1]); sb0.w = pk2(S[1][2], S[1][3]);
            sb1.x = pk2(S[2][0], S[2][1]); sb1.y = pk2(S[2][2], S[2][3]); sb1.z = pk2(S[3][0], S[3][1]); sb1.w = pk2(S[3][2], S[3][3]);
            const f32x4 z4 = (f32x4){0.f, 0.f, 0.f, 0.f};
            const v4u fv = fp[(15 + ig) * 64];
            f32x4 U = __builtin_amdgcn_mfma_f32_16x16x32_bf16(BF8(fp[0]), BF8(sb0), z4, 0, 0, 0);
            f32x4 Y = __builtin_amdgcn_mfma_f32_16x16x32_bf16(BF8(fp[128]), BF8(sb0), z4, 0, 0, 0);
            U = __builtin_amdgcn_mfma_f32_16x16x32_bf16(BF8(fp[64]), BF8(sb1), U, 0, 0, 0);
            Y = __builtin_amdgcn_mfma_f32_16x16x32_bf16(BF8(fp[192]), BF8(sb1), Y, 0, 0, 0);
            U = __builtin_amdgcn_mfma_f32_16x16x32_bf16(BF8(fp[256]), BF8(fv), U, 0, 0, 0);
            Y = __builtin_amdgcn_mfma_f32_16x16x32_bf16(BF8(fp[320]), BF8(fv), Y, 0, 0, 0);
#pragma unroll
            for (int t = 0; t < 4; ++t) S[t] = __builtin_amdgcn_mfma_f32_16x16x32_bf16(BF8(fp[(7 + t) * 64]), BF8(fv), S[t], 0, 0, 0);
            v4u ub; ub.x = pk2(U[0], U[1]); ub.y = pk2(U[2], U[3]); ub.z = 0u; ub.w = 0u;
            Y = __builtin_amdgcn_mfma_f32_16x16x32_bf16(BF8(fp[384]), BF8(ub), Y, 0, 0, 0);
#pragma unroll
            for (int t = 0; t < 4; ++t) { S[t] = __builtin_amdgcn_mfma_f32_16x16x32_bf16(BF8(fp[(11 + t) * 64]), BF8(ub), S[t], 0, 0, 0);
                S[t] = S[t] * *(const LAS f32x4*)(sl + 19 * 1024 + (16 * t + 4 * q) * 4); }
            const int base = chunk_base_row(b, d, n);
#pragma unroll
            for (int r = 0; r < 4; ++r) { const int st = 4 * q + r; Yd[(size_t)(base + (d ? 15 - st : st)) * RWW + h * 64 + ig * 16 + n15] = Y[r]; }
            asm volatile("s_waitcnt lgkmcnt(0)" ::: "memory");
        }
        __builtin_amdgcn_s_barrier();
    }
#undef ISSUE
#undef BF8
    asm volatile("s_waitcnt vmcnt(0)" ::: "memory");
    __syncthreads();
}

__device__ __forceinline__ void ph_scan_fftk(Frame& F0) { Frame F = F0; LAUNDER(F);
    const int nscan_wg = F.G >= 128 ? 64 : 0;
    TP_BEGIN();
    if (nscan_wg && F.vcu < 64) { scan_unit(F, F.vcu); __syncthreads(); TP_END(6); }
    else {
        if (!nscan_wg) { for (int sc = F.vcu; sc < 64; sc += F.G) scan_unit(F, sc); __syncthreads(); }
        LAS f32x2* TWL = (LAS f32x2*)(F.lds + 67584);
        const int id = nscan_wg ? F.vcu - 64 : F.vcu, nw = nscan_wg ? F.G - 64 : F.G;
        load_tw<13>(F, TWL); __syncthreads();
        for (int it = id; it < 512; it += nw) fftk_item<13, 1>(F, WSP(float, WS_KCL), WSP(f32x4, WS_KSPL), it);
        __syncthreads(); load_tw<9>(F, TWL); __syncthreads();
        for (int it = id; it < 64; it += nw) fftk_item<9, 8>(F, WSP(float, WS_KCC), WSP(f32x4, WS_KSPC), it);
        __syncthreads();
    }
}
__device__ __forceinline__ void ph_mod2(Frame& F0, int i) { Frame F = F0; LAUNDER(F);
    LAS float* RL = (LAS float*)F.lds;
    const float* router = F.in[I_ROUTER] + (size_t)i * DM * NE;
    for (int idx = F.tid; idx < DM * NE; idx += NTHR) { const int c = idx >> 4, e = idx & 15; RL[e * 1024 + c] = router[idx]; }
    __syncthreads();
    const float* mods = WSP(float, WS_MODS) + (size_t)i * 5 * 6144; const float* g = F.in[I_NORMG] + (size_t)(i * 2 + 1) * DM;
    const int nrows = i + 1 < DEPTH ? TT : TLAT;
    f32x4 vn[4];
    if (F.gw < nrows) {
#pragma unroll
        for (int jj = 0; jj < 4; ++jj) vn[jj] = ((const f32x4*)(WSP(float, WS_X) + (size_t)F.gw * DM))[64 * jj + F.lane]; }
    for (int row = F.gw; row < nrows; row += F.NGW) {
        f32x4 v[4], h[4];
#pragma unroll
        for (int jj = 0; jj < 4; ++jj) v[jj] = vn[jj];
        if (row + F.NGW < nrows) {
#pragma unroll
            for (int jj = 0; jj < 4; ++jj) vn[jj] = ((const f32x4*)(WSP(float, WS_X) + (size_t)(row + F.NGW) * DM))[64 * jj + F.lane]; }
        const int s = row_s(row);
        mod_row_store(v, g, mods + s * 6144 + 3 * 1024, mods + s * 6144 + 4 * 1024, WSP(bf16, WS_HA) + (size_t)row * DM, F.lane, h);
        float mylg = -1e30f;
#pragma unroll 2
        for (int e = 0; e < 16; ++e) { float a = 0.f;
#pragma unroll
            for (int jj = 0; jj < 4; ++jj) { const f32x4 r4 = ((const LAS f32x4*)(RL + e * 1024))[64 * jj + F.lane]; a += (h[jj].x * r4.x + h[jj].y * r4.y) + (h[jj].z * r4.z + h[jj].w * r4.w); }
            a = wave_sum(a); if (F.lane == e) mylg = a; }
        const float mx = max16_f(mylg);
        const float ex = expf(mylg - mx); const float den = sum16_f(ex);
        const float mine = ex / den;
        if (F.lane < 16) WSP(float, WS_AFF)[(size_t)row * 16 + F.lane] = mine;
    }
}

__device__ __forceinline__ int block_excl_scan(Frame& F, int v, LAS int* sc, int& total) {
    LAS int* cnt = sc + 16;
    __syncthreads();
    cnt[F.tid] = v;
    const int ws = wave_sum_i(v);
    if (F.lane == 0) sc[F.wave] = ws;
    __syncthreads();
    int base = 0, tot = 0;
#pragma unroll
    for (int w = 0; w < NWAVES; ++w) { const int t = sc[w]; if (w < F.wave) base += t; tot += t; }
    int pre = 0;
    for (int k = 0; k < F.lane; ++k) pre += cnt[F.wave * 64 + k];
    total = tot; return base + pre;
}
__device__ __forceinline__ int block_sum_i(Frame& F, int v, LAS int* sc) {
    v = wave_sum_i(v);
    __syncthreads(); if (F.lane == 0) sc[F.wave] = v; __syncthreads();
    int t = 0;
#pragma unroll
    for (int w = 0; w < NWAVES; ++w) t += sc[w];
    return t;
}
__device__ __forceinline__ void topk_item(Frame& F, int set, int e) {
    LAS int* sc = (LAS int*)(F.lds + 133120);
    const bool lat = set < 4; const int L = lat ? SEQ : CTXL, cap = lat ? 512 : 32; const int rbase = lat ? set * SEQ : TLAT + (set - 4) * CTXL;
    const int sbase = e * EROWS + (lat ? set * 512 : 2048 + (set - 4) * 32);
    const float* aff = WSP(float, WS_AFF);
    unsigned key[8];
#pragma unroll
    for (int q = 0; q < 8; ++q) { const int l = F.tid * 8 + q; key[q] = l < L ? __builtin_bit_cast(unsigned, aff[(size_t)(rbase + l) * 16 + e]) : 0u; }
    unsigned thr = 0u;
    for (int bit = 30; bit >= 0; --bit) {
        const unsigned cand = thr | (1u << bit); int cnt = 0;
#pragma unroll
        for (int q = 0; q < 8; ++q) cnt += (key[q] >= cand) ? 1 : 0;
        if (block_sum_i(F, cnt, sc) >= cap) thr = cand;
    }
    int ngt = 0, neq = 0;
#pragma unroll
    for (int q = 0; q < 8; ++q) { ngt += key[q] > thr ? 1 : 0; neq += (key[q] == thr && (F.tid * 8 + q) < L) ? 1 : 0; }
    int tot_gt, tot_eq; const int bgt = block_excl_scan(F, ngt, sc, tot_gt); const int beq = block_excl_scan(F, neq, sc, tot_eq);
    const int need_eq = cap - tot_gt; int rg = bgt, re = beq;
    int* slotmap = WSP(int, WS_SLOT); int* idxo = WSP(int, WS_IDX); float* gate = WSP(float, WS_GATE);
#pragma unroll
    for (int q = 0; q < 8; ++q) { const int l = F.tid * 8 + q; if (l < L) {
        int slot = -1;
        if (key[q] > thr) { slot = rg; ++rg; } else if (key[q] == thr) { if (re < need_eq) slot = tot_gt + re; ++re; }
        slotmap[(size_t)(rbase + l) * 16 + e] = slot;
        if (slot >= 0) { idxo[sbase + slot] = rbase + l; gate[sbase + slot] = __builtin_bit_cast(float, key[q]); } } }
    if (set == 0) for (int p = F.tid; p < EROWS - 2176; p += NTHR) { idxo[e * EROWS + 2176 + p] = 0; gate[e * EROWS + 2176 + p] = 0.f; }
    __syncthreads();
}
__device__ __forceinline__ void ph_topk(Frame& F0, int i) { Frame F = F0; LAUNDER(F);
    TP_BEGIN();
    for (int it = F.vcu; it < (i + 1 < DEPTH ? 128 : 64); it += F.G) topk_item(F, it >> 4, it & 15);
    TP_END(4);
    LAS float* scr = (LAS float*)(F.lds + F.wave * 16640);
    const float* w1 = F.in[I_MW1] + (size_t)i * NE * DM * FF; const float* w3 = F.in[I_MW3] + (size_t)i * NE * DM * FF; const float* w2 = F.in[I_MW2] + (size_t)i * NE * FF * DM;
    for (int it = F.gw; it < 3 * NE * 256; it += F.NGW) {
        const int which = it / (NE * 256), r = it % (NE * 256), e = r >> 8, item = r & 255;
        if (which == 0) transpose_item(w1 + (size_t)e * DM * FF, DM, FF, WSP(bf16, WS_W13), RowW13{e, 0}, scr, item, F.lane);
        else if (which == 1) transpose_item(w3 + (size_t)e * DM * FF, DM, FF, WSP(bf16, WS_W13), RowW13{e, 1}, scr, item, F.lane);
        else transpose_item(w2 + (size_t)e * FF * DM, FF, DM, WSP(bf16, WS_W2), RowId{e * 1024}, scr, item, F.lane);
    }
    TP_END(5);
}
__device__ __forceinline__ void ph_gather(Frame& F0, bool need_ctx) { Frame F = F0; LAUNDER(F);
    const int* idx = WSP(int, WS_IDX); const bf16* HA = WSP(bf16, WS_HA); bf16* XG = WSP(bf16, WS_XG);
    for (int r = F.gw; r < NE * EROWS; r += F.NGW) {
        if (!need_ctx && (r % EROWS) >= 2048) continue;
        const int src = idx[r]; const v4u* s = (const v4u*)(HA + (size_t)src * DM); v4u* d = (v4u*)(XG + (size_t)r * DM);
        d[F.lane] = s[F.lane]; d[64 + F.lane] = s[64 + F.lane];
    }
}
__device__ __forceinline__ void ph_combine(Frame& F0, int i) { Frame F = F0; LAUNDER(F);
    const int* slotmap = WSP(int, WS_SLOT); const bf16* YB = WSP(bf16, WS_YB);
    const float* mods = WSP(float, WS_MODS) + (size_t)i * 5 * 6144;
    const int nrows_c = i + 1 < DEPTH ? TT : TLAT;
    int slotn = -1; f32x4 xn[4];
    if (F.gw < nrows_c) { slotn = F.lane < 16 ? slotmap[(size_t)F.gw * 16 + F.lane] : -1;
#pragma unroll
        for (int jj = 0; jj < 4; ++jj) xn[jj] = ((const f32x4*)(WSP(float, WS_X) + (size_t)F.gw * DM))[64 * jj + F.lane]; }
    for (int row = F.gw; row < nrows_c; row += F.NGW) {
        f32x4 acc[4], xc[4];
#pragma unroll
        for (int jj = 0; jj < 4; ++jj) { acc[jj] = (f32x4){0.f, 0.f, 0.f, 0.f}; xc[jj] = xn[jj]; }
        const int myslot = slotn;
        if (row + F.NGW < nrows_c) { slotn = F.lane < 16 ? slotmap[(size_t)(row + F.NGW) * 16 + F.lane] : -1;
#pragma unroll
            for (int jj = 0; jj < 4; ++jj) xn[jj] = ((const f32x4*)(WSP(float, WS_X) + (size_t)(row + F.NGW) * DM))[64 * jj + F.lane]; }
        unsigned long long sel = __ballot(myslot >= 0);
        const int sbase = row < TLAT ? (row >> 12) * 512 : 2048 + ((row - TLAT) >> 8) * 32;
        while (sel) {
            const int e = __builtin_ctzll(sel); sel &= sel - 1;
            const int sl = __builtin_amdgcn_readlane(myslot, e);
            const v2u* yr = (const v2u*)(YB + (size_t)(e * EROWS + sbase + sl) * DM);
#pragma unroll
            for (int jj = 0; jj < 4; ++jj) { const v2u w = yr[64 * jj + F.lane];
                acc[jj].x += __builtin_bit_cast(float, w.x << 16); acc[jj].y += __builtin_bit_cast(float, w.x & 0xffff0000u);
                acc[jj].z += __builtin_bit_cast(float, w.y << 16); acc[jj].w += __builtin_bit_cast(float, w.y & 0xffff0000u); }
        }
#ifdef ABL_MOE
#pragma unroll
        for (int jj = 0; jj < 4; ++jj) acc[jj] = acc[jj] * 0.0f;
#endif
        const int s = row_s(row); f32x4 v[4], h[4];
        float* xr = WSP(float, WS_X) + (size_t)row * DM;
#pragma unroll
        for (int jj = 0; jj < 4; ++jj) { const f32x4 gm = ((const f32x4*)(mods + s * 6144 + 5 * 1024))[64 * jj + F.lane]; v[jj] = xc[jj] + gm * acc[jj]; ((f32x4*)xr)[64 * jj + F.lane] = v[jj]; }
        if (i + 1 < DEPTH) {
            const float* m2 = WSP(float, WS_MODS) + (size_t)(i + 1) * 5 * 6144;
            mod_row_store(v, F.in[I_NORMG] + (size_t)((i + 1) * 2) * DM, m2 + s * 6144, m2 + s * 6144 + 1024, WSP(bf16, WS_HA) + (size_t)row * DM, F.lane, h);
        } else if (row < TLAT) {
            float ss = 0.f;
#pragma unroll
            for (int jj = 0; jj < 4; ++jj) ss += (v[jj].x * v[jj].x + v[jj].y * v[jj].y) + (v[jj].z * v[jj].z + v[jj].w * v[jj].w);
            const float rstd = 1.0f / sqrtf(wave_sum(ss) * (1.0f / 1024.0f) + 1e-6f);
#pragma unroll
            for (int jj = 0; jj < 4; ++jj) ((f32x4*)(F.out + (size_t)row * DM))[64 * jj + F.lane] = v[jj] * rstd * ((const f32x4*)F.in[I_FINALG])[64 * jj + F.lane];
        }
    }
}
__device__ __forceinline__ void ph_rope(Frame& F0) { Frame F = F0; LAUNDER(F);
    const float* P = WSP(float, WS_P); bf16* QB = WSP(bf16, WS_QB); bf16* KB = WSP(bf16, WS_KB); bf16* VB = WSP(bf16, WS_VB);
    const int axis = (F.lane >> 1) & 1, half = F.lane & 1;
    float inv[16];
#pragma unroll
    for (int f = 0; f < 16; ++f) inv[f] = exp2f(-(float)f * (13.287712379549449f / 16.0f));
    for (int row = F.gw; row < TT; row += F.NGW) {
        const bool lat = row < TLAT; const int b = lat ? (row >> 12) : ((row - TLAT) >> 8); const int l = lat ? (row & (SEQ - 1)) : ((row - TLAT) & (CTXL - 1));
        const size_t krow = (size_t)b * KSEQ + (lat ? CTXL + l : l);
        float cs[16], sn[16];
        if (lat) { const float pos = (float)(axis ? (l & 63) : (l >> 6));
#pragma unroll
            for (int f = 0; f < 16; ++f) sincosf(pos * inv[f], &sn[f], &cs[f]); }
#pragma unroll
        for (int part = 0; part < 3; ++part) {
            float x[16];
            const float* src = P + (size_t)row * QKVC + part * 1024 + 16 * F.lane;
#pragma unroll
            for (int q = 0; q < 4; ++q) { const f32x4 t = *(const f32x4*)(src + 4 * q); x[4 * q] = t.x; x[4 * q + 1] = t.y; x[4 * q + 2] = t.z; x[4 * q + 3] = t.w; }
            if (part < 2 && lat) {
#pragma unroll
                for (int f = 0; f < 16; ++f) { const float o = xor1_f(x[f]);
                    x[f] = half ? (x[f] * cs[f] + o * sn[f]) : (x[f] * cs[f] - o * sn[f]); }
            }
            v4u w0, w1; w0.x = pk2(x[0], x[1]); w0.y = pk2(x[2], x[3]); w0.z = pk2(x[4], x[5]); w0.w = pk2(x[6], x[7]); w1.x = pk2(x[8], x[9]); w1.y = pk2(x[10], x[11]); w1.z = pk2(x[12], x[13]); w1.w = pk2(x[14], x[15]);
            bf16* dst = part == 0 ? QB + (size_t)row * DM : (part == 1 ? KB + krow * DM : VB + krow * DM);
            *(v4u*)(dst + 16 * F.lane) = w0; *(v4u*)(dst + 16 * F.lane + 8) = w1;
        }
    }
}

namespace att {
using s16x4 = __attribute__((ext_vector_type(4))) short;
using f32x16 = __attribute__((ext_vector_type(16))) float;
using u32x4 = __attribute__((ext_vector_type(4))) unsigned;
constexpr int DQ = 64, DV = 128, NW = 8, QBLK = 32, KVBLK = 64, LD = 1024;
constexpr float SCALE = 0.125f, THR = 8.f;
#ifndef ATT_SDEPTH
#define ATT_SDEPTH 1
#endif
constexpr int SDEPTH = ATT_SDEPTH;
constexpr size_t SHM_V = KVBLK * DV * 2, SHM_K = KVBLK * DQ * 2, SHM_ATTN = 2 * SHM_V + 2 * SHM_K + NW * 64 * 4;
#define KSWZ(row, colB) ((row) * 128 + ((colB) ^ (((row) & 7) << 4)))
#define SBAR() __builtin_amdgcn_sched_barrier(0)
__device__ __forceinline__ int crow(int r, int hi) { return (r & 3) + 8 * (r >> 2) + 4 * hi; }
__device__ __forceinline__ unsigned cvtpk(float lo, float hi) { unsigned r; asm volatile("v_cvt_pk_bf16_f32 %0, %1, %2" : "=v"(r) : "v"(lo), "v"(hi)); return r; }
__device__ __forceinline__ void partialSM(f32x16& p0, f32x16& p1, float& m_reg, float& mn, float& alpha) {
  constexpr float C = SCALE * 1.4426950408889634f;
  float pmax = p0[0]; for (int r = 1; r < 16; ++r) pmax = fmaxf(pmax, p0[r]); for (int r = 0; r < 16; ++r) pmax = fmaxf(pmax, p1[r]);
  { auto rr = __builtin_amdgcn_permlane32_swap(__float_as_uint(pmax), __float_as_uint(pmax), false, false);
    pmax = fmaxf(__uint_as_float(rr[0]), __uint_as_float(rr[1])); }
  if (__builtin_expect(__all(pmax - m_reg <= THR / SCALE), 1)) { mn = m_reg; alpha = 1.f; }
  else { mn = fmaxf(m_reg, pmax); alpha = __builtin_amdgcn_exp2f((m_reg - mn) * C); m_reg = mn; }
  float mnC = -mn * C;
  for (int r = 0; r < 16; ++r) p0[r] = fmaf(p0[r], C, mnC); for (int r = 0; r < 16; ++r) p1[r] = fmaf(p1[r], C, mnC);
  for (int r = 0; r < 16; ++r) p0[r] = __builtin_amdgcn_exp2f(p0[r]);
}
__device__ __forceinline__ void finishSM(f32x16& p0, f32x16& p1, float alpha, float& l_reg, bf16x8& pa0, bf16x8& pa1, bf16x8& pa2, bf16x8& pa3) {
  for (int r = 0; r < 16; ++r) p1[r] = __builtin_amdgcn_exp2f(p1[r]);
  float ps = 0; for (int r = 0; r < 16; ++r) ps += p0[r]; for (int r = 0; r < 16; ++r) ps += p1[r];
  { auto rr = __builtin_amdgcn_permlane32_swap(__float_as_uint(ps), __float_as_uint(ps), false, false);
    ps = __uint_as_float(rr[0]) + __uint_as_float(rr[1]); }
  l_reg = l_reg * alpha + ps;
#define PK4(P, BASE, OUT) do { unsigned a0 = cvtpk(P[BASE + 0], P[BASE + 1]), a1 = cvtpk(P[BASE + 2], P[BASE + 3]);   \
    unsigned b0 = cvtpk(P[BASE + 4], P[BASE + 5]), b1 = cvtpk(P[BASE + 6], P[BASE + 7]);                              \
    auto r0 = __builtin_amdgcn_permlane32_swap(a0, b0, false, false); auto r1 = __builtin_amdgcn_permlane32_swap(a1, b1, false, false); \
    u32x4 w = {r0[0], r1[0], r0[1], r1[1]}; OUT = *reinterpret_cast<bf16x8*>(&w); } while (0)
  PK4(p0, 0, pa0); PK4(p0, 8, pa1); PK4(p1, 0, pa2); PK4(p1, 8, pa3);
#undef PK4
}
__device__ __forceinline__ void qkt(f32x16& p0, f32x16& p1, const bf16* Ks, const bf16x8* qr, int r32, int hi) {
  p0 = f32x16{}; p1 = f32x16{};
#pragma unroll
  for (int d0 = 0; d0 < 4; ++d0) { int cb = (d0 * 16 + hi * 8) * 2;
    bf16x8 b0 = *reinterpret_cast<const bf16x8*>((const char*)Ks + KSWZ(r32, cb));
    bf16x8 b1 = *reinterpret_cast<const bf16x8*>((const char*)Ks + KSWZ(32 + r32, cb));
    p0 = __builtin_amdgcn_mfma_f32_32x32x16_bf16(b0, qr[d0], p0, 0, 0, 0);
    p1 = __builtin_amdgcn_mfma_f32_32x32x16_bf16(b1, qr[d0], p1, 0, 0, 0); }
}
__device__ __forceinline__ int v_st(int k, int c) { const int kk = (k & ~0xC) | ((k & 4) << 1) | ((k & 8) >> 1); return ((kk >> 3) * 4 + (c >> 5)) * 512 + ((kk & 7) * 32 + (c & 31)) * 2; }
__device__ __forceinline__ int v_rd_base(int lane) { return ((lane & 3) << 3) | (((lane >> 2) & 3) << 6) | (((lane >> 4) & 1) << 5) | (((lane >> 5) & 1) << 8); }
constexpr int v_rd_off(int d0, int ks, int half) { return d0 * 512 + ks * 4096 + half * 2048; }
template <int OFF> __device__ __forceinline__ s16x4 tr_read(int vb) {
  s16x4 r; asm volatile("ds_read_b64_tr_b16 %0, %1 offset:%2" : "=&v"(r) : "v"(vb), "i"(OFF) : "memory"); return r;
}
template <int D0> __device__ __forceinline__ void pv_one(f32x16& od, int vb, bf16x8 pa0, bf16x8 pa1, bf16x8 pa2, bf16x8 pa3) {
  const s16x4 l0 = tr_read<v_rd_off(D0, 0, 0)>(vb), h0 = tr_read<v_rd_off(D0, 0, 1)>(vb), l1 = tr_read<v_rd_off(D0, 1, 0)>(vb), h1 = tr_read<v_rd_off(D0, 1, 1)>(vb);
  const s16x4 l2 = tr_read<v_rd_off(D0, 2, 0)>(vb), h2 = tr_read<v_rd_off(D0, 2, 1)>(vb), l3 = tr_read<v_rd_off(D0, 3, 0)>(vb), h3 = tr_read<v_rd_off(D0, 3, 1)>(vb);
  asm volatile("s_waitcnt lgkmcnt(0)" ::: "memory"); SBAR();
#define PK(L, H) (bf16x8){L[0], L[1], L[2], L[3], H[0], H[1], H[2], H[3]}
  od = __builtin_amdgcn_mfma_f32_32x32x16_bf16(pa0, PK(l0, h0), od, 0, 0, 0);
  od = __builtin_amdgcn_mfma_f32_32x32x16_bf16(pa1, PK(l1, h1), od, 0, 0, 0);
  od = __builtin_amdgcn_mfma_f32_32x32x16_bf16(pa2, PK(l2, h2), od, 0, 0, 0);
  od = __builtin_amdgcn_mfma_f32_32x32x16_bf16(pa3, PK(l3, h3), od, 0, 0, 0);
#undef PK
}
__device__ __forceinline__ void pv_d0(f32x16* o, int vb, bf16x8 pa0, bf16x8 pa1, bf16x8 pa2, bf16x8 pa3) {
  pv_one<0>(o[0], vb, pa0, pa1, pa2, pa3); pv_one<1>(o[1], vb, pa0, pa1, pa2, pa3); pv_one<2>(o[2], vb, pa0, pa1, pa2, pa3); pv_one<3>(o[3], vb, pa0, pa1, pa2, pa3);
}
__device__ __forceinline__ void attn_body(const bf16* __restrict__ Qb, const bf16* __restrict__ Kh, const bf16* __restrict__ Vh, float* __restrict__ Ob, int ldo, int seq, char* lds) {
  int tid_ = threadIdx.x; asm volatile("" : "+v"(tid_));
  const int tid = tid_, wid = tid >> 6, lane = tid & 63, r32 = lane & 31, hi = lane >> 5;
  bf16* V_lds = (bf16*)lds; bf16* K_lds = (bf16*)(lds + 2 * SHM_V);
  float* ws = (float*)(lds + 2 * SHM_V + 2 * SHM_K) + wid * 64; float* li_l = ws; float* al_l = ws + 32;
  float m_reg = -1e30f, l_reg = 0; f32x16 o[4] = {}; bf16x8 qr[4];
  const bf16* Qw = Qb + (long)(wid * QBLK + r32) * LD + hi * 8;
#pragma unroll
  for (int d0 = 0; d0 < 4; ++d0) qr[d0] = *reinterpret_cast<const bf16x8*>(Qw + d0 * 16);
  const int sr = tid >> 4, sc = (tid & 15) * 8, vst0 = v_st(sr, sc), vst1 = v_st(32 + sr, sc);
  const int kr = tid >> 3, kc = (tid & 7) * 8;
  const int vb0 = (int)(uintptr_t)V_lds + v_rd_base(lane);
  struct { bf16x8 vs0, vs1, ks0; } sr_[SDEPTH];
#define SLOAD(i, k0) do { sr_[i].vs0 = *reinterpret_cast<const bf16x8*>(&Vh[(long)((k0) + sr) * LD + sc]); sr_[i].vs1 = *reinterpret_cast<const bf16x8*>(&Vh[(long)((k0) + 32 + sr) * LD + sc]); \
    sr_[i].ks0 = *reinterpret_cast<const bf16x8*>(&Kh[(long)((k0) + kr) * LD + kc]); } while (0)
#define SWRITE(b, i) do { *(bf16x8*)((char*)V_lds + (b) * SHM_V + vst0) = sr_[i].vs0;          \
    *(bf16x8*)((char*)V_lds + (b) * SHM_V + vst1) = sr_[i].vs1;               \
    *(bf16x8*)((char*)K_lds + (b) * SHM_K + KSWZ(kr, kc * 2)) = sr_[i].ks0; } while (0)
#define SWAIT() do { if constexpr (SDEPTH == 2) asm volatile("s_waitcnt vmcnt(3)" ::: "memory"); else asm volatile("s_waitcnt vmcnt(0)" ::: "memory"); } while (0)
#define RESC(a) do { if (__any((a) < 1.f)) { if (hi == 0) al_l[r32] = (a); asm volatile("s_waitcnt lgkmcnt(0)" ::: "memory"); \
    for (int d = 0; d < 4; ++d) for (int r = 0; r < 16; ++r) o[d][r] *= al_l[crow(r, hi)]; } } while (0)
  f32x16 pA0, pA1, pB0, pB1; float mnA, mnB, alA, alB; bf16x8 pa0, pa1, pa2, pa3; const int NT = seq / KVBLK;
  constexpr int SE = 0, SO = SDEPTH - 1;
  SLOAD(SE, 0); asm volatile("s_waitcnt vmcnt(0)" ::: "memory"); SWRITE(0, SE); __syncthreads();
  qkt(pA0, pA1, K_lds, qr, r32, hi); partialSM(pA0, pA1, m_reg, mnA, alA);
  SLOAD(SO, KVBLK); if constexpr (SDEPTH == 2) { if (2 < NT) SLOAD(SE, 2 * KVBLK); }
  SWAIT(); SWRITE(1, SO); __syncthreads();
  for (int j = 1; j + 1 < NT; j += 2) {
    SBAR(); qkt(pB0, pB1, (bf16*)((char*)K_lds + SHM_K), qr, r32, hi);
    finishSM(pA0, pA1, alA, l_reg, pa0, pa1, pa2, pa3); SBAR();
    SLOAD(SO, (j + SDEPTH) * KVBLK); SBAR();
    pv_d0(o, vb0, pa0, pa1, pa2, pa3); partialSM(pB0, pB1, m_reg, mnB, alB);
    __syncthreads(); SWAIT(); SWRITE(0, SE);
    RESC(alB); __syncthreads();
    SBAR(); qkt(pA0, pA1, K_lds, qr, r32, hi);
    finishSM(pB0, pB1, alB, l_reg, pa0, pa1, pa2, pa3); SBAR();
    if (SDEPTH == 1 || j + 3 < NT) SLOAD(SE, (j + 1 + SDEPTH) * KVBLK); SBAR();
    pv_d0(o, vb0 + (int)SHM_V, pa0, pa1, pa2, pa3); partialSM(pA0, pA1, m_reg, mnA, alA);
    __syncthreads(); SWAIT(); SWRITE(1, SO);
    RESC(alA); __syncthreads();
  }
  SBAR(); qkt(pB0, pB1, (bf16*)((char*)K_lds + SHM_K), qr, r32, hi);
  finishSM(pA0, pA1, alA, l_reg, pa0, pa1, pa2, pa3); SBAR();
  pv_d0(o, vb0, pa0, pa1, pa2, pa3); partialSM(pB0, pB1, m_reg, mnB, alB);
  __syncthreads(); RESC(alB);
  finishSM(pB0, pB1, alB, l_reg, pa0, pa1, pa2, pa3); SBAR();
  pv_d0(o, vb0 + (int)SHM_V, pa0, pa1, pa2, pa3);
  if (hi == 0) li_l[r32] = l_reg; asm volatile("s_waitcnt lgkmcnt(0)" ::: "memory");
  float rli[16];
#pragma unroll
  for (int r = 0; r < 16; ++r) rli[r] = __builtin_amdgcn_rcpf(li_l[crow(r, hi)]);
  float* Ow = Ob + (long)(wid * QBLK) * ldo;
#pragma unroll
  for (int r = 0; r < 16; ++r) { int orow = crow(r, hi);
    for (int d0 = 0; d0 < 4; ++d0) Ow[(long)orow * ldo + d0 * 32 + r32] = o[d0][r] * rli[r]; }
  __syncthreads();
#undef SLOAD
#undef SWRITE
#undef SWAIT
#undef RESC
}
#undef KSWZ
#undef SBAR
}

__device__ __forceinline__ void ph_attn(Frame& F0, bool need_ctx) { Frame F = F0; LAUNDER(F);
    const bf16* QB = WSP(bf16, WS_QB); const bf16* KB = WSP(bf16, WS_KB); const bf16* VB = WSP(bf16, WS_VB); float* OB = WSP(float, WS_OB);
    const int nun = 1024 + (need_ctx ? 64 : 0);
    for (int u = F.vcu; u < nun; u += F.G) {
        if (u < 1024) { const int qb = u & 15, hc = (u >> 4) & 15, b = u >> 8; const size_t qrow = (size_t)b * SEQ + qb * 256;
            att::attn_body(QB + qrow * DM + hc * 64, KB + (size_t)b * KSEQ * DM + hc * 64, VB + (size_t)b * KSEQ * DM + (hc >> 1) * 128, OB + qrow * 2048 + hc * 128, 2048, KSEQ, (char*)F.ldsg);
        } else { const int hc = (u - 1024) & 15, b = (u - 1024) >> 4; const size_t qrow = (size_t)TLAT + b * CTXL;
            att::attn_body(QB + qrow * DM + hc * 64, KB + (size_t)b * KSEQ * DM + hc * 64, VB + (size_t)b * KSEQ * DM + (hc >> 1) * 128, OB + qrow * 2048 + hc * 128, 2048, CTXL, (char*)F.ldsg);
        }
    }
}
__device__ __forceinline__ void ph_attnfin(Frame& F0, int i, bool need_ctx) { Frame F = F0; LAUNDER(F);
    const int j = i >> 1; const float* lv = F.in[I_LAM] + (size_t)j * 256; const float* sg = F.in[I_SUBLN] + (size_t)j * 128;
    const float linit = (i == 1) ? 0.35550906759096934f : 0.5560582041556406f;
    const float d1 = wave_sum(lv[F.lane] * lv[64 + F.lane]), d2 = wave_sum(lv[128 + F.lane] * lv[192 + F.lane]);
    const float lam = expf(d1) - expf(d2) + linit;
    const float* OB = WSP(float, WS_OB); bf16* CAT = WSP(bf16, WS_CAT);
    const int nrows = need_ctx ? TT : TLAT;
    for (int row = F.gw; row < nrows; row += F.NGW) {
        const int h = F.lane >> 3, e0 = 16 * (F.lane & 7);
        const float* o0 = OB + (size_t)row * 2048 + (2 * h) * 128 + e0; const float* o1 = o0 + 128;
        float x[16]; float ss = 0.f;
#pragma unroll
        for (int q = 0; q < 4; ++q) { const f32x4 a = *(const f32x4*)(o0 + 4 * q), bb = *(const f32x4*)(o1 + 4 * q); const f32x4 d = a - bb * lam;
            x[4 * q] = d.x; x[4 * q + 1] = d.y; x[4 * q + 2] = d.z; x[4 * q + 3] = d.w; ss += (d.x * d.x + d.y * d.y) + (d.z * d.z + d.w * d.w); }
        ss = sum8_f(ss);
        const float sc = (1.0f - linit) / sqrtf(ss * (1.0f / 128.0f) + 1e-5f);
#pragma unroll
        for (int q = 0; q < 16; ++q) x[q] = x[q] * sc * sg[e0 + q];
#ifdef ABL_ATT
#pragma unroll
        for (int q = 0; q < 16; ++q) x[q] = 0.f;
#endif
        v4u w0, w1; w0.x = pk2(x[0], x[1]); w0.y = pk2(x[2], x[3]); w0.z = pk2(x[4], x[5]); w0.w = pk2(x[6], x[7]); w1.x = pk2(x[8], x[9]); w1.y = pk2(x[10], x[11]); w1.z = pk2(x[12], x[13]); w1.w = pk2(x[14], x[15]);
        bf16* dst = CAT + (size_t)row * DM + h * 128 + e0;
        *(v4u*)dst = w0; *(v4u*)(dst + 8) = w1;
    }
}
#ifdef DBG_MOE
__device__ __forceinline__ void ph_debug_moe(Frame& F0, int i) { Frame F = F0; LAUNDER(F);
    LAS float* xs = (LAS float*)F.lds; LAS float* hs = xs + 1024; LAS float* red = hs + 1024;
    unsigned* dbg = (unsigned*)(F.ws + WS_CTL) + 100;
    for (int s = F.vcu; s < 64; s += F.G) {
        const int e = s & 15, slot = (s * 37) % 2176; const int r = e * EROWS + slot;
        const int tok = WSP(int, WS_IDX)[r]; const float gate = WSP(float, WS_GATE)[r];
        const bf16* hrow = WSP(bf16, WS_HA) + (size_t)tok * DM;
        __syncthreads();
        for (int k = F.tid; k < 1024; k += NTHR) xs[k] = bf2f(hrow[k]);
        __syncthreads();
        const float* w1 = F.in[I_MW1] + ((size_t)i * NE + e) * DM * FF; const float* w3 = F.in[I_MW3] + ((size_t)i * NE + e) * DM * FF; const float* w2 = F.in[I_MW2] + ((size_t)i * NE + e) * FF * DM;
        for (int f = F.tid; f < 1024; f += NTHR) { float a = 0.f, b = 0.f; for (int k = 0; k < 1024; ++k) { a += xs[k] * w1[(size_t)k * FF + f]; b += xs[k] * w3[(size_t)k * FF + f]; }
            hs[f] = a / (1.0f + __expf(-a)) * b; }
        __syncthreads();
        float num = 0.f, den = 0.f;
        for (int d = F.tid; d < 1024; d += NTHR) { float y = 0.f; for (int f = 0; f < 1024; ++f) y += hs[f] * w2[(size_t)f * DM + d]; y *= gate;
            const float yk = bf2f(WSP(bf16, WS_YB)[(size_t)r * DM + d]); num += (y - yk) * (y - yk); den += y * y; }
        num = block_sum(F, num, red); den = block_sum(F, den, red + 8);
        const float rel = sqrtf(num / fmaxf(den, 1e-30f));
        if (F.tid == 0) atomicMax(dbg, __builtin_bit_cast(unsigned, rel));
        if (s < 64) {
            const int set = s >> 4; const int rbase = set * SEQ; int cnt = 0; float mn_sel = 1e30f, mx_uns = -1e30f;
            for (int l = F.tid; l < SEQ; l += NTHR) { const int sl = WSP(int, WS_SLOT)[(size_t)(rbase + l) * 16 + e]; const float a = WSP(float, WS_AFF)[(size_t)(rbase + l) * 16 + e];
                if (sl >= 0) { ++cnt; mn_sel = fminf(mn_sel, a); if (sl >= 512 || WSP(int, WS_IDX)[e * EROWS + set * 512 + sl] != rbase + l) atomicAdd(dbg + 1, 1u); } else mx_uns = fmaxf(mx_uns, a); }
            const float tc = block_sum(F, (float)cnt, red);
            float a1 = -mn_sel, a2 = mx_uns;
#pragma unroll
            for (int o = 1; o < 64; o <<= 1) { a1 = fmaxf(a1, __shfl_xor(a1, o)); a2 = fmaxf(a2, __shfl_xor(a2, o)); }
            __syncthreads(); if (F.lane == 0) { red[F.wave] = a1; red[8 + F.wave] = a2; } __syncthreads();
            float m1 = red[0], m2 = red[8];
            for (int w = 1; w < 8; ++w) { m1 = fmaxf(m1, red[w]); m2 = fmaxf(m2, red[8 + w]); }
            if (F.tid == 0) { if ((int)tc != 512) atomicAdd(dbg + 2, 1u); if (-m1 < m2) atomicAdd(dbg + 3, 1u); atomicAdd(dbg + 4, (unsigned)(int)tc); }
        }
    }
}
#endif
__device__ __forceinline__ void ph_debug_out(Frame& F0) { Frame F = F0; LAUNDER(F);
    const unsigned* dbg = (const unsigned*)(F.ws + WS_CTL) + 100;
    const float e1 = __builtin_bit_cast(float, dbg[0]); const unsigned v2 = dbg[1];
#ifdef DBG_SEL2
    const float d1 = 1.0f + (float)dbg[2] + 100.0f * (float)dbg[3];
#elif defined(DBG_SEL3)
    const float d1 = (float)dbg[4] / 64.0f / 16.0f;
#else
    const float d1 = 1.0f + 10.0f * fminf(e1, 3.0f);
#endif
    float d2 = 10.0f + (float)v2 * 0.1f; d2 = fminf(d2, 900.f);
    for (size_t idx = (size_t)F.gw * 64 + F.lane; idx < (size_t)TLAT * DM; idx += (size_t)F.NGW * 64) F.out[idx] = idx == 0 ? d2 : d1;
}
constexpr int PH_PER_LAYER = 13, N_PHASES = 3 + DEPTH * PH_PER_LAYER;
#ifndef PH_MASK
#define PH_MASK 0xFFFFFFFFu
#endif
#define PK_ON(k) ((PH_MASK >> (k)) & 1u)

__device__ __forceinline__ bool phase_is_nop(int ph) {
    if (ph < 3) return false; const int i = (ph - 3) / PH_PER_LAYER, p = (ph - 3) % PH_PER_LAYER; return (i & 1) && (p == 1 || p == 4 || p == 5);
}

__device__ __forceinline__ int phase_kind(int ph) {
    if (ph < 3) return ph;
    const int i = (ph - 3) / PH_PER_LAYER, p = (ph - 3) % PH_PER_LAYER; const bool even = !(i & 1);
    switch (p) { case 0: return even ? 3 : 4; case 1: return even ? 5 : 6; case 2: return even ? 7 : 8; case 3: return even ? 9 : 10; case 4: return 11; case 5: return 12; case 6: return 13;
                 case 7: return 14; case 8: return 15; case 9: return 16; case 10: return 17; case 11: return 18; default: return 19; }
}
#ifndef PROBE_MASK
#define PROBE_MASK 0u
#endif
#ifndef PROBE_DIV
#define PROBE_DIV 100.0f
#endif
__global__ void __launch_bounds__(NTHR, 2) mega_fwd(Args args) {
    extern __shared__ __attribute__((aligned(16))) unsigned char lds[];
    Frame F;
    F.lds = (LAS unsigned char*)lds; F.ldsg = lds;
    F.MISC = (volatile LAS unsigned*)(F.lds + LDSCTL_OFF + 320);
    F.tid = threadIdx.x; F.lane = F.tid & 63; F.wave = __builtin_amdgcn_readfirstlane(F.tid >> 6);
    F.G = gridDim.x; { const int bx = blockIdx.x; F.vcu = (F.G % 8 == 0) ? (bx % 8) * (F.G / 8) + bx / 8 : bx; }
    F.gw = F.vcu * NWAVES + F.wave; F.NGW = F.G * NWAVES;
    F.tprobe = 0ull;
    F.in = (const float* const*)__builtin_amdgcn_kernarg_segment_ptr();
    F.ws = args.ws; F.out = args.out;
    for (int u = F.tid; u < (LDS_BYTES - LDSCTL_OFF) / 4; u += NTHR) ((LAS unsigned*)(F.lds + LDSCTL_OFF))[u] = 0u;
    __syncthreads();
    XcdBarrier bar; bar.bar = (unsigned*)(F.ws + WS_CTL) + CW_BAR; bar.x = 0; bar.st = nullptr;
    const int lo = args.ph_lo, hi = args.ph_hi;
    if (hi - lo > 1) bar = xcd_barrier_post((unsigned*)(F.ws + WS_CTL) + CW_BAR, F.MISC + 8);

    Frame F0 = F;
    unsigned long long t_prev = 0ull, t_acc = 0ull;
    if (PROBE_MASK) t_prev = __builtin_amdgcn_s_memrealtime();
    for (int ph = lo; ph < hi; ++ph) {
        if (phase_is_nop(ph)) continue;
        Frame F = F0; LAUNDER(F);
#ifdef DBG_MOE
        if (ph == 1000) { ph_debug_moe(F, 0); VM_WAIT(); continue; }
        if (ph == 1001) { ph_debug_out(F); VM_WAIT(); continue; }
#endif
        if (ph == 0) { if (PK_ON(0)) ph_prologue(F); }
        else if (ph == 1) { if (PK_ON(1)) ph_modred(F); }
        else if (ph == 2) { if (PK_ON(2)) ph_mod0(F); }
        else {
            const int i = (ph - 3) / PH_PER_LAYER, p = (ph - 3) % PH_PER_LAYER, j = i >> 1; const bool even = !(i & 1), need_ctx = i < DEPTH - 1;
            if (p == 0) {
                if (even) { if (PK_ON(3)) { pg8::Gemm g{WSP(bf16, WS_HA), WSP(bf16, WS_WIN) + (size_t)j * EVCP * DM, TT, EVCP, DM}; pg8::StaticOrder S; S.init(TT, EVCP, F.G, (int)blockIdx.x);
                    pg8::EpiF32 E{WSP(float, WS_P), EVCP}; pg8::gemm_phase<pg8::EpiF32, pg8::StaticOrder, true, true>(F.lds, g, S, E); } }
                else if (PK_ON(4)) { pg8::Gemm g{WSP(bf16, WS_HA), WSP(bf16, WS_WQKV) + (size_t)j * QKVC * DM, TT, QKVC, DM}; pg8::StaticOrder S; S.init(TT, QKVC, F.G, (int)blockIdx.x);
                    pg8::EpiQKV E{WSP(bf16, WS_QB), WSP(bf16, WS_KB), WSP(bf16, WS_VB)}; pg8::gemm_phase<pg8::EpiQKV, pg8::StaticOrder, true, true>(F.lds, g, S, E); }
            } else if (p == 1) { if (even) { if (PK_ON(5)) ph_evprep(F, j); } else {   } }
            else if (p == 2) { if (even) { if (PK_ON(7)) ph_chunkprep(F, j); } else { if (PK_ON(8)) ph_attn(F, need_ctx); } }
            else if (p == 3) { if (even) { if (PK_ON(9)) ph_scan_fftk(F); } else { if (PK_ON(10)) ph_attnfin(F, i, need_ctx); } }
            else if (p == 4) { if (PK_ON(11)) ph_hyena(F, j); }
            else if (p == 5) { if (PK_ON(12)) ph_readout(F, j); }
            else if (p == 6) { if (PK_ON(13)) {
                pg8::Gemm g{WSP(bf16, WS_CAT), (even ? WSP(bf16, WS_WOE) : WSP(bf16, WS_WOD)) + (size_t)j * DM * DM, need_ctx ? TT : TLAT, DM, DM}; pg8::StaticOrder S; S.init(need_ctx ? TT : TLAT, DM, F.G, (int)blockIdx.x);
                pg8::EpiResGate E{WSP(float, WS_X), WSP(float, WS_MODS) + (size_t)i * 5 * 6144}; pg8::gemm_phase<pg8::EpiResGate, pg8::StaticOrder, true, true>(F.lds, g, S, E); }
            } else if (p == 7) { if (PK_ON(14)) ph_mod2(F, i); }
            else if (p == 8) { if (PK_ON(15)) ph_topk(F, i); }
            else if (p == 9) { if (PK_ON(16)) ph_gather(F, need_ctx); }
            else if (p == 10) { if (PK_ON(17)) {
                pg8::Gemm g{WSP(bf16, WS_XG), WSP(bf16, WS_W13), NE * EROWS, NE * 2048, DM}; pg8::MoeOrder S{F.G, (int)blockIdx.x, 8, need_ctx ? 9 : 8};
                pg8::EpiSwiGLU E{WSP(bf16, WS_HB)}; pg8::gemm_phase<pg8::EpiSwiGLU, pg8::MoeOrder, true, true>(F.lds, g, S, E); }
            } else if (p == 11) { if (PK_ON(18)) {
                pg8::Gemm g{WSP(bf16, WS_HB), WSP(bf16, WS_W2), NE * EROWS, NE * 1024, FF}; pg8::MoeOrder S{F.G, (int)blockIdx.x, 4, need_ctx ? 9 : 8};
                pg8::EpiGateBf16 E{WSP(bf16, WS_YB), WSP(float, WS_GATE)}; pg8::gemm_phase<pg8::EpiGateBf16, pg8::MoeOrder, true, true>(F.lds, g, S, E); }
            } else { if (PK_ON(19)) ph_combine(F, i); }
        }
        if (PROBE_SUB) F0.tprobe = F.tprobe;
        if (ph + 1 < hi) xcd_barrier(bar); else { VM_WAIT(); }
        if (PROBE_MASK) { const unsigned long long t_now = __builtin_amdgcn_s_memrealtime(); if ((PROBE_MASK >> phase_kind(ph)) & 1u) t_acc += t_now - t_prev; t_prev = t_now; }
    }
    if (PROBE_MASK) { if (blockIdx.x == 0 && threadIdx.x == 0 && hi == N_PHASES) { const float us = (float)(PROBE_SUB ? F0.tprobe : t_acc) * 0.01f; F0.out[0] += 2.0f + us / PROBE_DIV; } }
}

extern "C" void kernel_launch(void* const* d_in, const int* in_sizes, int n_in, void* d_out, int out_size, void* d_ws, size_t ws_size, hipStream_t stream) {
    static int grid = 0;
    if (grid == 0) {
        if (n_in != N_IN || out_size != TLAT * DM || ws_size < WS_END) { fprintf(stderr, "kernel_launch: unexpected shapes: n_in %d out %d ws %zu (need %zu)\n", n_in, out_size, ws_size, (size_t)WS_END); grid = -1; return; }
        int dev = 0, cus = 0, per_cu = 0;
        if (hipGetDevice(&dev) != hipSuccess || hipDeviceGetAttribute(&cus, hipDeviceAttributeMultiprocessorCount, dev) != hipSuccess) { grid = -1; return; }
        if (hipFuncSetAttribute((const void*)mega_fwd, hipFuncAttributeMaxDynamicSharedMemorySize, LDS_BYTES) != hipSuccess) { fprintf(stderr, "kernel_launch: hipFuncSetAttribute failed\n"); grid = -1; return; }
        if (hipOccupancyMaxActiveBlocksPerMultiprocessor(&per_cu, (const void*)mega_fwd, NTHR, LDS_BYTES) != hipSuccess || per_cu < 1) fprintf(stderr, "kernel_launch: occupancy query reports %d\n", per_cu);
        (void)hipGetLastError();
        grid = cus;
    }
    if (grid < 0) return;
    if (hipMemsetAsync((char*)d_ws + WS_CTL, 0, CTL_ZERO_BYTES, stream) != hipSuccess) { fprintf(stderr, "kernel_launch: memset failed\n"); return; }
    Args a{};
    for (int i = 0; i < N_IN; ++i) a.in[i] = (const float*)d_in[i];
    a.out = (float*)d_out; a.ws = (unsigned char*)d_ws;
#if MK_PER_PHASE
    for (int ph = 0; ph < N_PHASES; ++ph) {
#ifdef DBG_MOE
        if (ph == 3 + 12) { a.ph_lo = 1000; a.ph_hi = 1001; hipLaunchKernelGGL(mega_fwd, dim3(grid), dim3(NTHR), LDS_BYTES, stream, a); a.ph_lo = 1001; a.ph_hi = 1002; hipLaunchKernelGGL(mega_fwd, dim3(grid), dim3(NTHR), LDS_BYTES, stream, a); break; }
#endif
        if ((ph >= 3) && (((ph - 3) / PH_PER_LAYER) & 1) && (((ph - 3) % PH_PER_LAYER) == 4 || ((ph - 3) % PH_PER_LAYER) == 5)) continue;
        a.ph_lo = ph; a.ph_hi = ph + 1;
        hipLaunchKernelGGL(mega_fwd, dim3(grid), dim3(NTHR), LDS_BYTES, stream, a);
    }
#else
    a.ph_lo = 0; a.ph_hi = N_PHASES;
    hipLaunchKernelGGL(mega_fwd, dim3(grid), dim3(NTHR), LDS_BYTES, stream, a);
#endif
    const hipError_t le = hipPeekAtLastError();
    if (le != hipSuccess) fprintf(stderr, "kernel_launch: launch failed: %s\n", hipGetErrorName(le));
}
```

```cpp
#define MK_PER_PHASE 0
#include <hip/hip_runtime.h>
#include <cstdio>
#include <cstdint>
#include <cmath>

#ifndef MK_PER_PHASE
#define MK_PER_PHASE 0
#endif

#define GAS __attribute__((address_space(1)))
#define LAS __attribute__((address_space(3)))
typedef unsigned short bf16;
typedef unsigned v4u __attribute__((ext_vector_type(4)));
typedef unsigned v2u __attribute__((ext_vector_type(2)));
typedef float f32x4 __attribute__((ext_vector_type(4)));
typedef float f32x2 __attribute__((ext_vector_type(2)));
typedef short bf16x8 __attribute__((ext_vector_type(8)));

constexpr int DM = 1024, NB = 4, SEQ = 4096, CTXL = 256, DEPTH = 4;
constexpr int TLAT = NB * SEQ, TCTX = NB * CTXL, TT = TLAT + TCTX;
constexpr int RWC = 1760, HYC = 1536, EVC = RWC + HYC, EVCP = 3328;
constexpr int RWW = 512, NH = 8, HD = 64;
constexpr int QKVC = 3072;
constexpr int NE = 16, FF = 1024, EROWS = 2304;
constexpr int NMOD = 6;
constexpr int KSEQ = CTXL + SEQ;

enum { I_X = 0, I_C, I_CTX, I_CCTX, I_ADAW, I_ADAB, I_NORMG, I_FINALG, I_EVWIN, I_EVWOUT, I_MU, I_W0, I_W2, I_A0, I_A2, I_G2, I_KK, I_KA, I_RK, I_GN,
       I_CONVW, I_CONVB, I_FW1, I_FB1, I_FW2, I_FB2, I_FW3, I_FREQ, I_HYB, I_WQKV, I_DAWOUT, I_LAM, I_SUBLN, I_ROUTER, I_MW1, I_MW3, I_MW2, N_IN };

struct Args { const float* in[N_IN]; float* out; unsigned char* ws; int ph_lo, ph_hi; };
static_assert(__builtin_offsetof(Args, in) == 0, "Args::in must be first");

constexpr size_t MiB = 1u << 20;
constexpr size_t WS_CTL = 0, CTL_ZERO_BYTES = 64 * 1024;
constexpr size_t WS_MODP = 1 * MiB;
constexpr size_t WS_MODS = 5 * MiB;
constexpr size_t WS_TW = 6 * MiB;
constexpr size_t WS_FRAGB = 7 * MiB;
constexpr size_t WS_AFF = 8 * MiB;
constexpr size_t WS_SLOT = 10 * MiB;
constexpr size_t WS_IDX = 12 * MiB;
constexpr size_t WS_GATE = 12 * MiB + 512 * 1024;
constexpr size_t WS_WIN = 16 * MiB;
constexpr size_t WS_WOE = 30 * MiB;
constexpr size_t WS_WQKV = 34 * MiB;
constexpr size_t WS_WOD = 46 * MiB;
constexpr size_t WS_W13 = 50 * MiB;
constexpr size_t WS_W2 = 114 * MiB;
constexpr size_t WS_UTL = 50 * MiB;
constexpr size_t WS_X = 146 * MiB;
constexpr size_t WS_HA = 214 * MiB;
constexpr size_t WS_CAT = 248 * MiB;
constexpr size_t WS_KSPL = 282 * MiB;
constexpr size_t WS_KSPC = 346 * MiB;
constexpr size_t WS_BIG = 384 * MiB;
constexpr size_t WS_P = WS_BIG;
constexpr size_t REC_BYTES = 20 * 1024;
constexpr size_t WS_REC = WS_BIG;
constexpr size_t WS_RW = WS_BIG + 340 * MiB;
constexpr size_t RW_STRIDE = 34 * MiB;
constexpr size_t WS_AOP = WS_BIG + 476 * MiB;
constexpr size_t WS_G = WS_BIG + 484 * MiB;
constexpr size_t WS_KCL = WS_BIG + 518 * MiB;
constexpr size_t WS_KCC = WS_BIG + 550 * MiB;
constexpr size_t WS_UTC = WS_BIG + 552 * MiB;
constexpr size_t WS_BON = WS_BIG + 558 * MiB;
constexpr size_t WS_Y = WS_BIG + 559 * MiB;
constexpr size_t WS_HYTL = WS_RW + 1 * RW_STRIDE;
constexpr size_t WS_HYTC = WS_RW + 3 * RW_STRIDE;
static_assert(WS_Y + 68 * MiB <= 1024 * MiB && 64 * 272 * REC_BYTES <= 340 * MiB, "ws map");
constexpr size_t WS_QB = WS_BIG + 204 * MiB;
constexpr size_t WS_KB = WS_QB + 34 * MiB;
constexpr size_t WS_VB = WS_KB + 34 * MiB;
constexpr size_t WS_OB = WS_VB + 34 * MiB;
static_assert(WS_OB + 136 * MiB <= 1024 * MiB, "ws map");
constexpr size_t WS_XG = WS_BIG;
constexpr size_t WS_HB = WS_BIG + 72 * MiB;
constexpr size_t WS_YB = WS_BIG + 144 * MiB;
constexpr size_t WS_END = 1024 * MiB;

constexpr int CW_BAR = 4096;

constexpr int RING_BYTES = 143360;
constexpr int LDSCTL_OFF = RING_BYTES;
constexpr int LDS_BYTES = 147456;
constexpr int NWAVES = 8, NTHR = 512;

__device__ __forceinline__ unsigned f2bf(float f) { unsigned u = __builtin_bit_cast(unsigned, f); return (u + 0x7fffu + ((u >> 16) & 1u)) >> 16; }
__device__ __forceinline__ unsigned pk2(float lo, float hi) { return f2bf(lo) | (f2bf(hi) << 16); }
__device__ __forceinline__ float bf2f(unsigned short h) { return __builtin_bit_cast(float, ((unsigned)h) << 16); }
template <int CTRL> __device__ __forceinline__ float dpp_f(float x) { return __builtin_bit_cast(float, __builtin_amdgcn_update_dpp(0, __builtin_bit_cast(int, x), CTRL, 0xF, 0xF, true)); }
template <int CTRL> __device__ __forceinline__ int dpp_i(int x) { return __builtin_amdgcn_update_dpp(0, x, CTRL, 0xF, 0xF, true); }
#define DPP_XOR1 0xB1
#define DPP_XOR2 0x4E
#define DPP_HMIRROR 0x141
#define DPP_MIRROR 0x140
__device__ __forceinline__ float xor1_f(float x) { return dpp_f<DPP_XOR1>(x); }
__device__ __forceinline__ float sum4_f(float x) { x += dpp_f<DPP_XOR1>(x); x += dpp_f<DPP_XOR2>(x); return x; }
__device__ __forceinline__ float sum8_f(float x) { x = sum4_f(x); x += dpp_f<DPP_HMIRROR>(x); return x; }
__device__ __forceinline__ float sum16_f(float x) { x = sum8_f(x); x += dpp_f<DPP_MIRROR>(x); return x; }
__device__ __forceinline__ float max16_f(float x) { x = fmaxf(x, dpp_f<DPP_XOR1>(x)); x = fmaxf(x, dpp_f<DPP_XOR2>(x)); x = fmaxf(x, dpp_f<DPP_HMIRROR>(x)); x = fmaxf(x, dpp_f<DPP_MIRROR>(x)); return x; }
__device__ __forceinline__ float wave_sum(float v) {
    v = sum16_f(v);
    v += __builtin_bit_cast(float, __builtin_amdgcn_ds_swizzle(__builtin_bit_cast(int, v), 0x401F));
    { auto rr = __builtin_amdgcn_permlane32_swap(__float_as_uint(v), __float_as_uint(v), false, false); const unsigned lo_ = rr[0], hi_ = rr[1];
      v = __uint_as_float(lo_) + __uint_as_float(hi_); }
    return v;
}
__device__ __forceinline__ int wave_sum_i(int v) {
    v += dpp_i<DPP_XOR1>(v); v += dpp_i<DPP_XOR2>(v); v += dpp_i<DPP_HMIRROR>(v); v += dpp_i<DPP_MIRROR>(v);
    v += __builtin_amdgcn_ds_swizzle(v, 0x401F);
    { auto rr = __builtin_amdgcn_permlane32_swap((unsigned)v, (unsigned)v, false, false); v = (int)rr[0] + (int)rr[1]; }
    return v;
}
__device__ __forceinline__ float sigmoidf_(float x) { return 1.0f / (1.0f + __expf(-x)); }
__device__ __forceinline__ float siluf_(float x) { return x / (1.0f + __expf(-x)); }
#define LDS_WAIT() asm volatile("s_waitcnt lgkmcnt(0)" ::: "memory")
#define VM_WAIT() asm volatile("s_waitcnt vmcnt(0)" ::: "memory")

namespace pg8 {
#define PG8_LAS __attribute__((address_space(3)))
typedef unsigned short bf16_t;
typedef short bf16x8 __attribute__((ext_vector_type(8)));
typedef float f32x4 __attribute__((ext_vector_type(4)));
typedef unsigned u32x4 __attribute__((ext_vector_type(4)));
constexpr int BM = 256, BK = 64, HALF = 128, HTB = HALF * BK * 2  , STAGE_BYTES = 8 * HTB, NXCD = 8, WGM = 8;

__host__ __device__ __forceinline__ int lds_byte(int r, int c) { const int st = (r >> 4) * 2 + (c >> 5), rr = r & 15, cc = c & 31, ob = rr * 64 + cc * 2; return st * 1024 + (ob ^ (((ob >> 9) & 1) << 5)); }
__host__ __device__ __forceinline__ void stage_rc(int b, int& R, int& C) { const int st = b / 1024, sb = b % 1024, swz = sb ^ (((sb >> 9) & 1) << 5); R = (st >> 1) * 16 + swz / 64; C = (st & 1) * 32 + (swz % 64) / 2; }
__host__ __device__ __forceinline__ int perm32(int rho) { const int n = rho >> 4, i = rho & 15; return 8 * (i >> 2) + 4 * n + (i & 3); }

struct Unit { int pm, pn; };
struct Gemm { const bf16_t* A; const bf16_t* Bt; int M, N, K; const int* gidx; };

struct StaticOrder {
    int nM, nN, nwg, G, c;
    __host__ __device__ void init(int M, int N, int G_, int c_) { nM = M / BM; nN = N / BM; nwg = nM * nN; G = G_; c = c_; }
    __host__ __device__ bool next(int i, Unit& u) const {
        const long L = (long)i * G + c; if (L >= nwg) return false;
        int wgid = (int)L; { const int q = nwg / NXCD, r = nwg % NXCD, xcd = wgid % NXCD, off = wgid / NXCD; wgid = (xcd < r ? xcd * (q + 1) : r * (q + 1) + (xcd - r) * q) + off; }
        const int nig = WGM * nN, gid = wgid / nig, fm = gid * WGM, gsz = (nM - fm) < WGM ? (nM - fm) : WGM;
        u.pm = fm + ((wgid % nig) % gsz); u.pn = (wgid % nig) / gsz; return true;
    }
    __device__ __forceinline__ void a_ready(const Unit&) const {}
    __device__ __forceinline__ void done(const Unit&) const {}
};

__device__ __forceinline__ unsigned cvt_pk_bf16(float lo, float hi) { unsigned r; asm volatile("v_cvt_pk_bf16_f32 %0, %1, %2" : "=v"(r) : "v"(lo), "v"(hi)); return r; }
typedef float f32x2 __attribute__((ext_vector_type(2)));
typedef unsigned u32x2v __attribute__((ext_vector_type(2)));

struct EpiF32 {
    static constexpr bool PERM = false, AFTER_DRAIN = false;
    float* O; int ldc;
    __device__ __forceinline__ void operator()(const f32x4 (&acc)[2][2][4][2], const Unit& u, int wr, int wc, int fr, int fq) const {
        const int col0 = u.pn * BM + wc * 32 + 4 * fq;
#pragma unroll
        for (int ai = 0; ai < 2; ++ai)
#pragma unroll
            for (int m = 0; m < 4; ++m) { float* rowp = O + (size_t)(u.pm * BM + ai * HALF + wr * 64 + m * 16 + fr) * ldc + col0;
#pragma unroll
                for (int bj = 0; bj < 2; ++bj)
#pragma unroll
                    for (int n = 0; n < 2; ++n) *(f32x4*)(rowp + bj * HALF + n * 16) = acc[ai][bj][m][n]; }
    }
};
struct EpiResGate {
    static constexpr bool PERM = false, AFTER_DRAIN = false;
    float* X; const float* mods;
    __device__ __forceinline__ void operator()(const f32x4 (&acc)[2][2][4][2], const Unit& u, int wr, int wc, int fr, int fq) const {
        const int col0 = u.pn * BM + wc * 32 + 4 * fq;
#pragma unroll
        for (int ai = 0; ai < 2; ++ai)
#pragma unroll
            for (int m = 0; m < 4; ++m) { const int row = u.pm * BM + ai * HALF + wr * 64 + m * 16 + fr; const int s = row < 16384 ? (row >> 12) : 4;
                float* rowp = X + (size_t)row * 1024 + col0; const float* gp = mods + s * 6144 + 2048 + col0;
#pragma unroll
                for (int bj = 0; bj < 2; ++bj)
#pragma unroll
                    for (int n = 0; n < 2; ++n) { const f32x4 g = *(const f32x4*)(gp + bj * HALF + n * 16); f32x4 x = *(f32x4*)(rowp + bj * HALF + n * 16);
                        x = x + g * acc[ai][bj][m][n]; *(f32x4*)(rowp + bj * HALF + n * 16) = x; } }
    }
};
struct EpiSwiGLU {
    static constexpr bool PERM = false, AFTER_DRAIN = false;
    bf16_t* H;
    __device__ __forceinline__ void operator()(const f32x4 (&acc)[2][2][4][2], const Unit& u, int wr, int wc, int fr, int fq) const {
        const int nt = u.pn & 7; const int col0 = nt * 128 + wc * 32 + 4 * fq;
#pragma unroll
        for (int ai = 0; ai < 2; ++ai)
#pragma unroll
            for (int m = 0; m < 4; ++m) { bf16_t* rowp = H + (size_t)(u.pm * BM + ai * HALF + wr * 64 + m * 16 + fr) * 1024 + col0;
#pragma unroll
                for (int n = 0; n < 2; ++n) { const f32x4 a = acc[ai][0][m][n], b = acc[ai][1][m][n]; f32x4 h;
#pragma unroll
                    for (int j = 0; j < 4; ++j) h[j] = a[j] / (1.0f + __expf(-a[j])) * b[j];
                    u32x2v w; w.x = cvt_pk_bf16(h[0], h[1]); w.y = cvt_pk_bf16(h[2], h[3]); *(u32x2v*)(rowp + n * 16) = w; } }
    }
};
struct EpiGateBf16 {
    static constexpr bool PERM = false, AFTER_DRAIN = false;
    bf16_t* Y; const float* gate;
    __device__ __forceinline__ void operator()(const f32x4 (&acc)[2][2][4][2], const Unit& u, int wr, int wc, int fr, int fq) const {
        const int nt = u.pn & 3; const int col0 = nt * 256 + wc * 32 + 4 * fq;
#pragma unroll
        for (int ai = 0; ai < 2; ++ai)
#pragma unroll
            for (int m = 0; m < 4; ++m) { const int row = u.pm * BM + ai * HALF + wr * 64 + m * 16 + fr; const float g = gate[row]; bf16_t* rowp = Y + (size_t)row * 1024 + col0;
#pragma unroll
                for (int bj = 0; bj < 2; ++bj)
#pragma unroll
                    for (int n = 0; n < 2; ++n) { const f32x4 v = acc[ai][bj][m][n] * g; u32x2v w; w.x = cvt_pk_bf16(v[0], v[1]); w.y = cvt_pk_bf16(v[2], v[3]); *(u32x2v*)(rowp + bj * HALF + n * 16) = w; } }
    }
};
struct EpiQKV {
    static constexpr bool PERM = false, AFTER_DRAIN = false;
    bf16_t* Q; bf16_t* Kb; bf16_t* Vb;
    __device__ __forceinline__ void operator()(const f32x4 (&acc)[2][2][4][2], const Unit& u, int wr, int wc, int fr, int fq) const {
        const int part = u.pn >> 2; const int col0 = (u.pn & 3) * BM + wc * 32 + 4 * fq; const bool lat = u.pm < 64;
        float invf[4];
#pragma unroll
        for (int j = 0; j < 4; ++j) invf[j] = exp2f(-(float)(4 * fq + j) * (13.287712379549449f / 16.0f)) * 0.15915494309189535f;
#pragma unroll
        for (int ai = 0; ai < 2; ++ai)
#pragma unroll
            for (int m = 0; m < 4; ++m) {
                const int row = u.pm * BM + ai * HALF + wr * 64 + m * 16 + fr;
                const int b = lat ? (row >> 12) : ((row - 16384) >> 8); const int l = lat ? (row & 4095) : ((row - 16384) & 255);
                float cs[4], sn[4];
                if (part < 2 && lat) { const float pos = (float)((wc & 1) ? (l & 63) : (l >> 6));
#pragma unroll
                    for (int j = 0; j < 4; ++j) { const float rev = pos * invf[j]; const float fr_ = rev - floorf(rev); cs[j] = __builtin_amdgcn_cosf(fr_); sn[j] = __builtin_amdgcn_sinf(fr_); } }
                bf16_t* rowp = (part == 0 ? Q + (size_t)row * 1024 : (part == 1 ? Kb : Vb) + ((size_t)b * 4352 + (lat ? 256 + l : l)) * 1024) + col0;
#pragma unroll
                for (int bj = 0; bj < 2; ++bj) {
                    f32x4 x1 = acc[ai][bj][m][0], x2 = acc[ai][bj][m][1];
                    if (part < 2 && lat) {
#pragma unroll
                        for (int j = 0; j < 4; ++j) { const float a = x1[j], bb = x2[j]; x1[j] = a * cs[j] - bb * sn[j]; x2[j] = bb * cs[j] + a * sn[j]; } }
                    u32x2v w; w.x = cvt_pk_bf16(x1[0], x1[1]); w.y = cvt_pk_bf16(x1[2], x1[3]); *(u32x2v*)(rowp + bj * HALF) = w;
                    w.x = cvt_pk_bf16(x2[0], x2[1]); w.y = cvt_pk_bf16(x2[2], x2[3]); *(u32x2v*)(rowp + bj * HALF + 16) = w;
                }
            }
    }
};
struct MoeOrder {
    int G, c, ntn, nmt;
    __device__ __forceinline__ bool next(int i, Unit& u) const {
        const int L = i * G + c; const int per_e = nmt * ntn; if (L >= 16 * per_e) return false;
        const int e = L / per_e, r = L % per_e; u.pm = e * 9 + (r % nmt); u.pn = e * ntn + (r / nmt); return true;
    }
    __device__ __forceinline__ void a_ready(const Unit&) const {}
    __device__ __forceinline__ void done(const Unit&) const {}
};
template <class Epi, class Sched, bool ALIGN_EPI = false, bool SP2 = false, bool GATHER = false>
__device__ __forceinline__ void gemm_phase(PG8_LAS unsigned char* lds, const Gemm g, const Sched& S, const Epi& E) {
    int tid_ = threadIdx.x; asm volatile("" : "+v"(tid_));
    const int tid = tid_, wid = __builtin_amdgcn_readfirstlane(tid >> 6), lane = tid & 63, wr = wid >> 2, wc = wid & 3, fr = lane & 15, fq = lane >> 4;
    const int K = g.K, nt = K / BK;
    unsigned voffA[2], voffB[2];
#pragma unroll
    for (int i = 0; i < 2; ++i) { int R, C; stage_rc(tid * 16 + i * 8192, R, C); const int Rb = Epi::PERM ? ((R & ~31) + perm32(R & 31)) : R;
        voffA[i] = (unsigned)(R * K + C) * 2u; voffB[i] = (unsigned)(Rb * K + C) * 2u; }
    unsigned vA0[2] = {0u, 0u}, vA1[2] = {0u, 0u}, nvA0[2] = {0u, 0u}, nvA1[2] = {0u, 0u};
#define PG8_GOFF(dst0, dst1, unit) do { _Pragma("unroll") for (int i_ = 0; i_ < 2; ++i_) { int R_, C_; stage_rc(tid * 16 + i_ * 8192, R_, C_); \
        dst0[i_] = (unsigned)g.gidx[(unit).pm * BM + R_] * (unsigned)(K * 2) + (unsigned)(C_ * 2); dst1[i_] = (unsigned)g.gidx[(unit).pm * BM + HALF + R_] * (unsigned)(K * 2) + (unsigned)(C_ * 2); } } while (0)
    const size_t kstep = (size_t)(BK * 2);
    const size_t hstep = (size_t)HALF * K * 2;
    const size_t tstep = 2 * hstep;
    const unsigned ldsw = (unsigned)wid * 1024u;
    const int aoff = lds_byte(wr * 64 + fr, fq * 8), boff = lds_byte(wc * 32 + fr, fq * 8);
#define PG8_SA(b, h) (((b) * 2 + (h)) * HTB)
#define PG8_SB(b, h) ((4 + (b) * 2 + (h)) * HTB)
#define PG8_STAGE(bufoff, gbase, voff) do { _Pragma("unroll") for (int _i = 0; _i < 2; ++_i) \
        __builtin_amdgcn_global_load_lds((const unsigned*)((const char*)(gbase) + (voff)[_i]), (PG8_LAS unsigned*)(lds + (bufoff) + ldsw + _i * 8192), 16, 0, 0); } while (0)
#define PG8_STAGE_AC(bufoff, kptr, half) do { if constexpr (GATHER) { if (half) PG8_STAGE(bufoff, kptr, vA1); else PG8_STAGE(bufoff, kptr, vA0); } else PG8_STAGE(bufoff, (kptr) + (half) * hstep, voffA); } while (0)
#define PG8_STAGE_AX(bufoff, kptr, half) do { if constexpr (GATHER) { unsigned s_[2]; _Pragma("unroll") for (int i_ = 0; i_ < 2; ++i_) s_[i_] = last ? ((half) ? nvA1[i_] : nvA0[i_]) : ((half) ? vA1[i_] : vA0[i_]); PG8_STAGE(bufoff, kptr, s_); } \
        else PG8_STAGE(bufoff, (kptr) + (half) * hstep, voffA); } while (0)
#define PG8_LDA(dst, b, h) do { _Pragma("unroll") for (int m = 0; m < 4; ++m) _Pragma("unroll") for (int k = 0; k < 2; ++k) dst[m][k] = *(const PG8_LAS bf16x8*)(lds + PG8_SA(b, h) + aoff + m * 2048 + k * 1024); } while (0)
#define PG8_LDB(dst, b, h) do { _Pragma("unroll") for (int n = 0; n < 2; ++n) _Pragma("unroll") for (int k = 0; k < 2; ++k) dst[n][k] = *(const PG8_LAS bf16x8*)(lds + PG8_SB(b, h) + boff + n * 2048 + k * 1024); } while (0)
#define PG8_MMA(ai, bj, At, Bt) do { __builtin_amdgcn_s_setprio(1); _Pragma("unroll") for (int m = 0; m < 4; ++m) _Pragma("unroll") for (int n = 0; n < 2; ++n) _Pragma("unroll") for (int k = 0; k < 2; ++k) \
        acc[ai][bj][m][n] = __builtin_amdgcn_mfma_f32_16x16x32_bf16(Bt[n][k], At[m][k], acc[ai][bj][m][n], 0, 0, 0); __builtin_amdgcn_s_setprio(0); } while (0)
#define PG8_WAIT_V(n) asm volatile("s_waitcnt vmcnt(" #n ")" ::: "memory")
#define PG8_WAIT_L(n) asm volatile("s_waitcnt lgkmcnt(" #n ")" ::: "memory")
#define PG8_BAR __builtin_amdgcn_s_barrier()
#define PG8_SCHED __builtin_amdgcn_sched_barrier(0)
    Unit cur, nxt; int ui = 0;
    if (!S.next(0, cur)) return;
    f32x4 acc[2][2][4][2];
#pragma unroll
    for (int a = 0; a < 2; ++a)
#pragma unroll
        for (int b = 0; b < 2; ++b)
#pragma unroll
            for (int m = 0; m < 4; ++m)
#pragma unroll
                for (int n = 0; n < 2; ++n) acc[a][b][m][n] = (f32x4){0.f, 0.f, 0.f, 0.f};
    bf16x8 At[4][2], B0[2][2], B1[2][2];
    const char* cA = (const char*)g.A + (GATHER ? (size_t)0 : (size_t)cur.pm * tstep); const char* cB = (const char*)g.Bt + (size_t)cur.pn * tstep;
    if constexpr (GATHER) PG8_GOFF(vA0, vA1, cur);
    S.a_ready(cur);
    if constexpr (SP2) {
        PG8_STAGE(PG8_SB(0, 0), cB, voffB); PG8_STAGE(PG8_SB(0, 1), cB + hstep, voffB); PG8_STAGE_AC(PG8_SA(0, 0), cA, 0); PG8_STAGE_AC(PG8_SA(0, 1), cA, 1);
        if (wr == 1) PG8_BAR;
        PG8_WAIT_V(2); PG8_BAR;
        PG8_STAGE(PG8_SB(1, 0), cB + kstep, voffB); PG8_STAGE_AC(PG8_SA(1, 0), cA + kstep, 0); PG8_STAGE(PG8_SB(1, 1), cB + hstep + kstep, voffB);
        PG8_WAIT_V(6); PG8_BAR;
    } else {
        PG8_STAGE(PG8_SB(0, 0), cB, voffB); PG8_STAGE_AC(PG8_SA(0, 0), cA, 0); PG8_STAGE(PG8_SB(0, 1), cB + hstep, voffB); PG8_STAGE_AC(PG8_SA(0, 1), cA, 1);
        if (wr == 1) PG8_BAR;
        PG8_WAIT_V(4); PG8_BAR;
        PG8_STAGE(PG8_SB(1, 0), cB + kstep, voffB); PG8_STAGE_AC(PG8_SA(1, 0), cA + kstep, 0); PG8_STAGE(PG8_SB(1, 1), cB + hstep + kstep, voffB);
        PG8_WAIT_V(6); PG8_BAR;
    }
    for (;;) {
        const bool has_next = S.next(ui + 1, nxt);
        if constexpr (GATHER) { if (has_next) PG8_GOFF(nvA0, nvA1, nxt); else { nvA0[0] = vA0[0]; nvA0[1] = vA0[1]; nvA1[0] = vA1[0]; nvA1[1] = vA1[1]; } }
        const char* nA = (has_next && !GATHER) ? (const char*)g.A + (size_t)nxt.pm * tstep : cA; const char* nB = has_next ? (const char*)g.Bt + (size_t)nxt.pn * tstep : cB;
        for (int t = 0; t < nt; t += 2) {
            const bool last = (t == nt - 2);
            const char* a1 = cA + (size_t)(t + 1) * kstep;
            const char* a2 = last ? nA : cA + (size_t)(t + 2) * kstep; const char* b2 = last ? nB : cB + (size_t)(t + 2) * kstep;
            const char* a3 = a2 + kstep; const char* b3 = b2 + kstep;
            if (last && has_next) S.a_ready(nxt);
            if constexpr (SP2) {
            PG8_LDB(B0, 0, 0); PG8_LDB(B1, 0, 1); PG8_SCHED; PG8_LDA(At, 0, 0); PG8_STAGE_AC(PG8_SA(1, 1), a1, 1);
            PG8_WAIT_V(8); PG8_WAIT_L(0); PG8_BAR; PG8_MMA(0, 0, At, B0); PG8_MMA(0, 1, At, B1); PG8_BAR; PG8_SCHED;
            PG8_LDA(At, 0, 1); PG8_STAGE(PG8_SB(0, 0), b2, voffB); PG8_STAGE(PG8_SB(0, 1), b2 + hstep, voffB); PG8_STAGE_AX(PG8_SA(0, 0), a2, 0);
            PG8_WAIT_V(8); PG8_WAIT_L(0); PG8_BAR; PG8_MMA(1, 0, At, B0); PG8_MMA(1, 1, At, B1); PG8_BAR; PG8_SCHED;
            PG8_LDB(B0, 1, 0); PG8_LDB(B1, 1, 1); PG8_SCHED; PG8_LDA(At, 1, 0); PG8_STAGE_AX(PG8_SA(0, 1), a2, 1);
            PG8_WAIT_V(8); PG8_WAIT_L(0); PG8_BAR; PG8_MMA(0, 0, At, B0); PG8_MMA(0, 1, At, B1); PG8_BAR; PG8_SCHED;
            PG8_LDA(At, 1, 1); PG8_STAGE(PG8_SB(1, 0), b3, voffB); PG8_STAGE(PG8_SB(1, 1), b3 + hstep, voffB); PG8_STAGE_AX(PG8_SA(1, 0), a3, 0);
            PG8_WAIT_V(8); PG8_WAIT_L(0); PG8_BAR; PG8_MMA(1, 0, At, B0); PG8_MMA(1, 1, At, B1); PG8_BAR; PG8_SCHED;
            } else {
            PG8_LDB(B0, 0, 0); PG8_SCHED; PG8_LDA(At, 0, 0); PG8_STAGE_AC(PG8_SA(1, 1), a1, 1);
            PG8_WAIT_L(8); PG8_BAR; PG8_WAIT_L(0); PG8_MMA(0, 0, At, B0); PG8_BAR; PG8_SCHED;
            PG8_LDB(B1, 0, 1); PG8_STAGE(PG8_SB(0, 0), b2, voffB);
            PG8_BAR; PG8_WAIT_L(0); PG8_MMA(0, 1, At, B1); PG8_BAR;
            PG8_LDA(At, 0, 1); PG8_STAGE_AX(PG8_SA(0, 0), a2, 0);
            PG8_BAR; PG8_WAIT_L(0); PG8_MMA(1, 0, At, B0); PG8_BAR; PG8_SCHED;
            PG8_STAGE(PG8_SB(0, 1), b2 + hstep, voffB);
            PG8_WAIT_V(6); PG8_BAR; PG8_MMA(1, 1, At, B1); PG8_BAR;
            PG8_LDB(B0, 1, 0); PG8_SCHED; PG8_LDA(At, 1, 0); PG8_STAGE_AX(PG8_SA(0, 1), a2, 1);
            PG8_WAIT_L(8); PG8_BAR; PG8_WAIT_L(0); PG8_MMA(0, 0, At, B0); PG8_BAR; PG8_SCHED;
            PG8_LDB(B1, 1, 1); PG8_STAGE(PG8_SB(1, 0), b3, voffB);
            PG8_BAR; PG8_WAIT_L(0); PG8_MMA(0, 1, At, B1); PG8_BAR;
            PG8_LDA(At, 1, 1); PG8_STAGE_AX(PG8_SA(1, 0), a3, 0);
            PG8_BAR; PG8_WAIT_L(0); PG8_MMA(1, 0, At, B0); PG8_BAR; PG8_SCHED;
            PG8_STAGE(PG8_SB(1, 1), b3 + hstep, voffB);
            PG8_WAIT_V(6); PG8_BAR; PG8_MMA(1, 1, At, B1); PG8_BAR;
            }
        }
        if constexpr (ALIGN_EPI) { if (wr == 0) PG8_BAR; }
        if constexpr (!Epi::AFTER_DRAIN) { E(acc, cur, wr, wc, fr, fq); S.done(cur); }
        if (!has_next) break;
#pragma unroll
        for (int a = 0; a < 2; ++a)
#pragma unroll
            for (int b = 0; b < 2; ++b)
#pragma unroll
                for (int m = 0; m < 4; ++m)
#pragma unroll
                    for (int n = 0; n < 2; ++n) acc[a][b][m][n] = (f32x4){0.f, 0.f, 0.f, 0.f};
        cur = nxt; cA = nA; cB = nB; ++ui;
        if constexpr (GATHER) { vA0[0] = nvA0[0]; vA0[1] = nvA0[1]; vA1[0] = nvA1[0]; vA1[1] = nvA1[1]; }
        if constexpr (ALIGN_EPI) { if (wr == 1) PG8_BAR; }
    }
    PG8_WAIT_V(0);
    if constexpr (!ALIGN_EPI) { if (wr == 0) PG8_BAR; }
    PG8_BAR;
    if constexpr (Epi::AFTER_DRAIN) { E.fused(acc, cur, wr, wc, fr, fq, lds, wid, lane); S.done(cur); }
#undef PG8_SA
#undef PG8_SB
#undef PG8_STAGE
#undef PG8_LDA
#undef PG8_STAGE_AC
#undef PG8_STAGE_AX
#undef PG8_GOFF
#undef PG8_LDB
#undef PG8_MMA
#undef PG8_WAIT_V
#undef PG8_WAIT_L
#undef PG8_BAR
#undef PG8_SCHED
}
}
#define XB_TMO      128
#define XB_XCNT(j)  (256  + 64 * (j))
#define XB_XSUB(j)  (1280 + 64 * (j))
#define XB_XGEN(j)  (2304 + 64 * (j))
#define XB_TOP      3328
#define XB_TOPGEN   3392
#define XCD_BAR_WORDS 3456
#define XB_SPIN_CAP (1u << 18)

__device__ __forceinline__ unsigned xb_ld(unsigned* p)              { return __hip_atomic_load(p, __ATOMIC_RELAXED, __HIP_MEMORY_SCOPE_AGENT); }
__device__ __forceinline__ unsigned xb_add(unsigned* p, unsigned v) { return __hip_atomic_fetch_add(p, v, __ATOMIC_RELAXED, __HIP_MEMORY_SCOPE_AGENT); }
__device__ __forceinline__ unsigned xb_xcc_id() { return (unsigned)__builtin_amdgcn_s_getreg((3 << 11) | 20) & 0xFu; }
#define XB_SPIN(cond, bar) do { unsigned _sp = 0; while (cond) { __builtin_amdgcn_s_sleep(1); \
    if ((++_sp & 255u) == 0u) { if (xb_ld(&(bar)[XB_TMO])) break; if (_sp > XB_SPIN_CAP) { atomicAdd(&(bar)[XB_TMO], 1u); break; } } } } while (0)

struct XcdBarrier {
    unsigned* bar; unsigned x;
    volatile LAS unsigned* st;
};

__device__ __forceinline__ XcdBarrier xcd_barrier_post(unsigned* bar, volatile LAS unsigned* st) {
    XcdBarrier b; b.bar = bar; b.x = xb_xcc_id(); b.st = st;
    if (threadIdx.x == 0) (void)xb_add(&bar[XB_XCNT(b.x)], 1u);
    return b;
}
__device__ __forceinline__ void xcd_barrier_complete(unsigned* bar, unsigned x, unsigned& nloc, unsigned& nx) {
    const unsigned G = gridDim.x * gridDim.y * gridDim.z;
    unsigned sum, cnt, mine, sp = 0u;
    for (;;) {
        sum = 0u; cnt = 0u; mine = 0u;
#pragma unroll
        for (unsigned j = 0; j < 16; ++j) { const unsigned c = xb_ld(&bar[XB_XCNT(j)]); sum += c; cnt += (c > 0u) ? 1u : 0u; mine = (j == x) ? c : mine; }
        if (sum == G) break;
        __builtin_amdgcn_s_sleep(1);
        if ((++sp & 255u) == 0u) { if (xb_ld(&bar[XB_TMO])) break; if (sp > XB_SPIN_CAP) { atomicAdd(&bar[XB_TMO], 1u); break; } }
    }
    nloc = mine > 0u ? mine : 1u; nx = cnt > 0u ? cnt : 1u;
}

__device__ __forceinline__ void xcd_barrier(const XcdBarrier& b) {
    asm volatile("s_waitcnt vmcnt(0)" ::: "memory");
    __syncthreads();
    if (threadIdx.x == 0) {
        unsigned* bar = b.bar;
        __builtin_amdgcn_s_waitcnt(0);
        unsigned nloc = b.st[0], nx = b.st[1];
        if (nloc == 0u) { xcd_barrier_complete(bar, b.x, nloc, nx); b.st[0] = nloc; b.st[1] = nx; }
        const unsigned old = xb_add(&bar[XB_XSUB(b.x)], 1u);
        const unsigned gen = old / nloc;
        if (old + 1u == (gen + 1u) * nloc) {
            __builtin_amdgcn_fence(__ATOMIC_RELEASE, "agent");
            asm volatile("s_waitcnt vmcnt(0)" ::: "memory");
            const unsigned og = xb_add(&bar[XB_TOP], 1u);
            const unsigned tg = og / nx;
            if (og + 1u == (tg + 1u) * nx) xb_add(&bar[XB_TOPGEN], 1u);
            else XB_SPIN(xb_ld(&bar[XB_TOPGEN]) == tg, bar);
            __builtin_amdgcn_fence(__ATOMIC_ACQUIRE, "agent");
            xb_add(&bar[XB_XGEN(b.x)], 1u);
            asm volatile("s_waitcnt vmcnt(0)" ::: "memory");
        } else {
            XB_SPIN(xb_ld(&bar[XB_XGEN(b.x)]) == gen, bar);
            __builtin_amdgcn_fence(__ATOMIC_ACQUIRE, "agent");
            asm volatile("s_waitcnt vmcnt(0)" ::: "memory");
        }
    }
    __syncthreads();
}
struct Frame {
    LAS unsigned char* lds;
    unsigned char* ldsg;
    volatile LAS unsigned* MISC;
    int tid, lane, wave, vcu, G, gw, NGW;
    const GAS float* const __attribute__((address_space(4)))* in;
    GAS unsigned char* ws;
    GAS float* out;
    unsigned long long tprobe;
};
#ifndef PROBE_SUB
#define PROBE_SUB 0
#endif
#define TP_BEGIN() unsigned long long tp0_ = PROBE_SUB ? __builtin_amdgcn_s_memrealtime() : 0ull
#define TP_END(id) do { if (PROBE_SUB == (id)) { const unsigned long long t1_ = __builtin_amdgcn_s_memrealtime(); F0.tprobe += t1_ - tp0_; } if (PROBE_SUB) tp0_ = __builtin_amdgcn_s_memrealtime(); } while (0)
#define WSP(T, off) ((T*)(F.ws + (off)))
#define INP(k) ((const float*)F.in[k])
#define LAUNDER(F) asm volatile("" : "+s"(F.ws), "+s"(F.in), "+s"(F.out), "+v"(F.tid), "+v"(F.lane), "+s"(F.wave), "+s"(F.gw), "+s"(F.vcu), "+s"(F.G), "+s"(F.NGW))

__device__ __forceinline__ int row_s(int row) { return row < TLAT ? (row >> 12) : 4; }

__device__ __forceinline__ void mod_row_store(const f32x4 (&v)[4], const float* g, const float* shift, const float* scale, bf16* orow, int lane, f32x4 (&h)[4]) {
    float s = 0.f;
#pragma unroll
    for (int j = 0; j < 4; ++j) s += (v[j].x * v[j].x + v[j].y * v[j].y) + (v[j].z * v[j].z + v[j].w * v[j].w);
    const float rstd = 1.0f / sqrtf(wave_sum(s) * (1.0f / 1024.0f) + 1e-6f);
#pragma unroll
    for (int j = 0; j < 4; ++j) {
        const f32x4 g4 = ((const f32x4*)g)[64 * j + lane], sh = ((const f32x4*)shift)[64 * j + lane], sc = ((const f32x4*)scale)[64 * j + lane];
        h[j] = (v[j] * rstd) * g4 * (sc + 1.0f) + sh;
        v2u o; o.x = pk2(h[j].x, h[j].y); o.y = pk2(h[j].z, h[j].w);
        ((v2u*)orow)[64 * j + lane] = o;
    }
}

template <class RowMap>
__device__ __forceinline__ void transpose_item(const float* W, int K, int N, bf16* WT, const RowMap& rowmap, LAS float* scr, int item, int lane) {
    const int nblk = (N + 63) / 64, kb = item / nblk, nb = item % nblk, k0 = 64 * kb, n0 = 64 * nb;
    const int r = lane >> 4, c4 = (lane & 15) * 4;
    f32x4 t_[16];
#pragma unroll
    for (int i = 0; i < 16; ++i) t_[i] = (n0 + c4 < N) ? *(const f32x4*)(W + (size_t)(k0 + 4 * i + r) * N + n0 + c4) : (f32x4){0.f, 0.f, 0.f, 0.f};
#pragma unroll
    for (int i = 0; i < 16; ++i) { LAS float* d = scr + (4 * i + r) * 65 + c4; d[0] = t_[i].x; d[1] = t_[i].y; d[2] = t_[i].z; d[3] = t_[i].w; }
    LDS_WAIT(); asm volatile("" ::: "memory");
    const int c = lane & 7;
#pragma unroll
    for (int j = 0; j < 8; ++j) { const int n = (lane >> 3) + 8 * j; const LAS float* s = scr + (8 * c) * 65 + n;
        v4u o; o.x = pk2(s[0 * 65], s[1 * 65]); o.y = pk2(s[2 * 65], s[3 * 65]); o.z = pk2(s[4 * 65], s[5 * 65]); o.w = pk2(s[6 * 65], s[7 * 65]);
        *(v4u*)(WT + (size_t)rowmap(n0 + n) * K + k0 + 8 * c) = o; }
    LDS_WAIT(); asm volatile("" ::: "memory");
}
struct RowId { int off; __device__ __forceinline__ int operator()(int n) const { return off + n; } };
struct RowW13 { int e, w3; __device__ __forceinline__ int operator()(int n) const { return e * 2048 + (n >> 7) * 256 + w3 * 128 + (n & 127); } };

__device__ __forceinline__ void ph_prologue(Frame& F0) { Frame F = F0; LAUNDER(F);
    LAS float* scr = (LAS float*)(F.lds + F.wave * 16640);
    LAS float* sv = (LAS float*)F.lds;
    constexpr int I_IN = 16 * ((EVC + 63) / 64), I_O = 16 * 16, I_Q = 16 * (QKVC / 64);
    constexpr int PER_J = I_IN + I_O + I_Q + I_O, NT_ITEMS = 2 * PER_J;
    for (int it = F.gw; it < NT_ITEMS; it += F.NGW) {
        const int j = it / PER_J; int r = it % PER_J;
        if (r < I_IN) { transpose_item(INP(I_EVWIN) + (size_t)j * DM * EVC, DM, EVC, WSP(bf16, WS_WIN) + (size_t)j * EVCP * DM, RowId{0}, scr, r, F.lane); continue; } r -= I_IN;
        if (r < I_O) { transpose_item(INP(I_EVWOUT) + (size_t)j * DM * DM, DM, DM, WSP(bf16, WS_WOE) + (size_t)j * DM * DM, RowId{0}, scr, r, F.lane); continue; } r -= I_O;
        if (r < I_Q) { transpose_item(INP(I_WQKV) + (size_t)j * DM * QKVC, DM, QKVC, WSP(bf16, WS_WQKV) + (size_t)j * QKVC * DM, RowId{0}, scr, r, F.lane); continue; } r -= I_Q;
        transpose_item(INP(I_DAWOUT) + (size_t)j * DM * DM, DM, DM, WSP(bf16, WS_WOD) + (size_t)j * DM * DM, RowId{0}, scr, r, F.lane);
    }
    __syncthreads();
    for (int i = F.tid; i < 5 * 1024; i += NTHR) { const float x = i < 4096 ? INP(I_C)[i] : INP(I_CCTX)[i - 4096]; sv[i] = siluf_(x); }
    __syncthreads();
    for (int it = F.gw; it < 4 * 24 * 8; it += F.NGW) {
        const int kc = it & 7, cg = (it >> 3) % 24, i = it / (8 * 24); const int col = cg * 256 + F.lane * 4;
        const float* wp = INP(I_ADAW) + (size_t)i * DM * 6144 + (size_t)(kc * 128) * 6144 + col;
        f32x4 acc[5];
#pragma unroll
        for (int s = 0; s < 5; ++s) acc[s] = (f32x4){0.f, 0.f, 0.f, 0.f};
#pragma unroll 8
        for (int k = 0; k < 128; ++k) { const f32x4 w = *(const f32x4*)(wp + (size_t)k * 6144);
#pragma unroll
            for (int s = 0; s < 5; ++s) acc[s] = acc[s] + w * sv[s * 1024 + kc * 128 + k]; }
#pragma unroll
        for (int s = 0; s < 5; ++s) *(f32x4*)(WSP(float, WS_MODP) + ((size_t)(kc * 4 + i) * 5 + s) * 6144 + col) = acc[s];
    }
    for (int k = F.gw * 64 + F.lane; k < 8192; k += F.NGW * 64) { float s, c; sincospif((float)k * (1.0f / 4096.0f), &s, &c); WSP(f32x2, WS_TW)[k] = (f32x2){c, -s}; }
    for (int idx = F.gw * 64 + F.lane; idx < 2 * 224 * 64; idx += F.NGW * 64) {
        const int l = idx & 63, f = (idx >> 6) % 224, j = idx / (224 * 64); const int kb = 8 * (l >> 4), n = l & 15;
        const float* src; int col;
        if (f < 64) { const int d = f >> 5, nt = f & 31; src = INP(I_W2) + ((size_t)(j * 2 + d) * 32 + kb) * RWW; col = nt * 16 + n; }
        else if (f < 128) { const int d = (f - 64) >> 5, nt = (f - 64) & 31; src = INP(I_A2) + ((size_t)(j * 2 + d) * 32 + kb) * RWW; col = nt * 16 + n; }
        else { const int nt = (f - 128) / 3, ks = (f - 128) % 3; src = INP(I_G2) + ((size_t)j * 96 + ks * 32 + kb) * RWW; col = nt * 16 + n; }
        v4u o; o.x = pk2(src[0 * RWW + col], src[1 * RWW + col]); o.y = pk2(src[2 * RWW + col], src[3 * RWW + col]); o.z = pk2(src[4 * RWW + col], src[5 * RWW + col]); o.w = pk2(src[6 * RWW + col], src[7 * RWW + col]);
        WSP(v4u, WS_FRAGB)[idx] = o;
    }
}
__device__ __forceinline__ void ph_modred(Frame& F0) { Frame F = F0; LAUNDER(F);
    for (int idx = F.gw * 64 + F.lane; idx < 4 * 5 * 6144; idx += F.NGW * 64) {
        const int col = idx % 6144, i = idx / (5 * 6144); float a = INP(I_ADAB)[i * 6144 + col];
#pragma unroll
        for (int kc = 0; kc < 8; ++kc) a += WSP(float, WS_MODP)[(size_t)kc * 4 * 5 * 6144 + idx];
        WSP(float, WS_MODS)[idx] = a;
    }
}
__device__ __forceinline__ void ph_mod0(Frame& F0) { Frame F = F0; LAUNDER(F);
    const float* mods = WSP(float, WS_MODS);
    for (int row = F.gw; row < TT; row += F.NGW) {
        const float* src = row < TLAT ? INP(I_X) + (size_t)row * DM : INP(I_CTX) + (size_t)(row - TLAT) * DM;
        f32x4 v[4], h[4];
#pragma unroll
        for (int j = 0; j < 4; ++j) { v[j] = ((const f32x4*)src)[64 * j + F.lane]; ((f32x4*)(WSP(float, WS_X) + (size_t)row * DM))[64 * j + F.lane] = v[j]; }
        const int s = row_s(row);
        mod_row_store(v, INP(I_NORMG), mods + s * 6144, mods + s * 6144 + 1024, WSP(bf16, WS_HA) + (size_t)row * DM, F.lane, h);
    }
}
__device__ __forceinline__ float seq_pos(int row, int& L) { if (row < TLAT) { L = SEQ; return (float)(row & (SEQ - 1)); } L = CTXL; return (float)((row - TLAT) & (CTXL - 1)); }
__device__ __forceinline__ int seq_l(int row, int& L) { if (row < TLAT) { L = SEQ; return row & (SEQ - 1); } L = CTXL; return (row - TLAT) & (CTXL - 1); }

__device__ __forceinline__ f32x4 shift4(const float* P, size_t off, bool hp, bool hn, f32x4 m0, f32x4 m1) {
    const f32x4 u = *(const f32x4*)(P + off);
    const f32x4 up = hp ? *(const f32x4*)(P + off - EVCP) : (f32x4){0.f, 0.f, 0.f, 0.f};
    const f32x4 un = hn ? *(const f32x4*)(P + off + EVCP) : (f32x4){0.f, 0.f, 0.f, 0.f};
    return u + m0 * (up - u) + m1 * (un - u);
}

__device__ __forceinline__ void ph_evprep(Frame& F0, int j) { Frame F = F0; LAUNDER(F);
    const float* P = WSP(float, WS_P);
    const float* mu = INP(I_MU) + (size_t)j * 2 * RWC;
    TP_BEGIN();
    {
        float* Rr = (float*)(F.ws + WS_RW); float* Kk = (float*)(F.ws + WS_RW + RW_STRIDE); float* Vv = (float*)(F.ws + WS_RW + 2 * RW_STRIDE); float* KKn = (float*)(F.ws + WS_RW + 3 * RW_STRIDE);
        bf16* AOP = WSP(bf16, WS_AOP); const float* kkw = INP(I_KK) + (size_t)j * RWW;
        for (int row = F.gw; row < TT; row += F.NGW) {
            int L; const int l = seq_l(row, L); const bool hp = l > 0, hn = l < L - 1;
#pragma unroll
            for (int q = 0; q < 7; ++q) {
                const int g = F.lane + 64 * q;
                if (q < 6 || g < 440) {
                    const int col = 4 * g;
                    const f32x4 m0 = *(const f32x4*)(mu + col), m1 = *(const f32x4*)(mu + RWC + col);
                    f32x4 sv = shift4(P, (size_t)row * EVCP + col, hp, hn, m0, m1);
                    if (q < 2) *(f32x4*)(Rr + (size_t)row * RWW + col) = sv;
                    else if (q < 4) { const int c = col - 512; *(f32x4*)(Kk + (size_t)row * RWW + c) = sv;
                        const f32x4 kx = sv * *(const f32x4*)(kkw + c);
                        const float ss = sum16_f((kx.x * kx.x + kx.y * kx.y) + (kx.z * kx.z + kx.w * kx.w));
                        *(f32x4*)(KKn + (size_t)row * RWW + c) = kx * (1.0f / fmaxf(sqrtf(ss), 1e-12f)); }
                    else if (q < 6) *(f32x4*)(Vv + (size_t)row * RWW + (col - 1024)) = sv;
                    else { const int c = col - 1536;
                        if (c < 64) { sv.x = tanhf(sv.x); sv.y = tanhf(sv.y); sv.z = tanhf(sv.z); sv.w = tanhf(sv.w); }
                        else if (c >= 128) { sv.x = sigmoidf_(sv.x); sv.y = sigmoidf_(sv.y); sv.z = sigmoidf_(sv.z); sv.w = sigmoidf_(sv.w); }
                        v2u w; w.x = pk2(sv.x, sv.y); w.y = pk2(sv.z, sv.w); *(v2u*)(AOP + (size_t)row * 224 + c) = w; }
                }
            }
        }
    }
    __syncthreads(); TP_END(1);
#ifndef NO_EV_B
    {
        LAS float* scr = (LAS float*)(F.lds + F.wave * 16640);
        const float* cw = INP(I_CONVW) + (size_t)j * 3 * HYC; const float* cb = INP(I_CONVB) + (size_t)j * HYC;
        for (int it = F.gw; it < (TT / 64) * (HYC / 64); it += F.NGW) {
            const int rt = it / (HYC / 64), ct = it % (HYC / 64); const int r0 = rt * 64, c = ct * 64 + F.lane;
            const float w0 = cw[c], w1 = cw[HYC + c], w2 = cw[2 * HYC + c], bb = cb[c];
            int L; const int l0 = seq_l(r0, L);
            {
                const size_t o0 = (size_t)r0 * EVCP + RWC + c;
                float up = l0 > 0 ? P[o0 - EVCP] : 0.f, u = P[o0];
#pragma unroll 1
                for (int r8 = 0; r8 < 64; r8 += 8) {
                    float nx[8];
#pragma unroll
                    for (int k = 0; k < 8; ++k) { const int l = l0 + r8 + k; nx[k] = l < L - 1 ? P[o0 + (size_t)(r8 + k + 1) * EVCP] : 0.f; }
#pragma unroll
                    for (int k = 0; k < 8; ++k) { scr[F.lane * 65 + r8 + k] = up * w0 + u * w1 + nx[k] * w2 + bb; up = u; u = nx[k]; }
                }
            }
            LDS_WAIT(); asm volatile("" ::: "memory");
            float* dst; if (r0 < TLAT) dst = WSP(float, WS_UTL) + ((size_t)(r0 >> 12) * HYC + ct * 64) * SEQ + l0; else dst = WSP(float, WS_UTC) + ((size_t)((r0 - TLAT) >> 8) * HYC + ct * 64) * CTXL + l0;
            for (int cc = 0; cc < 64; ++cc) dst[(size_t)cc * L + F.lane] = scr[cc * 65 + F.lane];
            LDS_WAIT(); asm volatile("" ::: "memory");
        }
    }
#endif
    __syncthreads(); TP_END(2);
#ifndef NO_EV_C
    {
        LAS float* H1 = (LAS float*)F.lds; LAS float* H2 = (LAS float*)(F.lds + 16384);
        LAS float* W1s = (LAS float*)(F.lds + 32768); LAS float* B1s = (LAS float*)(F.lds + 41216); LAS float* B2s = (LAS float*)(F.lds + 41472); LAS float* FRs = (LAS float*)(F.lds + 41728);
        LAS float* W2s = (LAS float*)(F.lds + 42240); LAS float* W3s = (LAS float*)(F.lds + 58624);
        for (int i = F.tid; i < 33 * 64; i += NTHR) W1s[i] = INP(I_FW1)[(size_t)j * 33 * 64 + i];
        for (int i = F.tid; i < 64 * 64; i += NTHR) W2s[i] = INP(I_FW2)[(size_t)j * 64 * 64 + i];
        if (F.tid < 64) { B1s[F.tid] = INP(I_FB1)[j * 64 + F.tid]; B2s[F.tid] = INP(I_FB2)[j * 64 + F.tid]; }
        if (F.tid < 128) FRs[F.tid] = INP(I_FREQ)[j * 128 + F.tid];
        const float* w3 = INP(I_FW3) + (size_t)j * 64 * 2048;
        const int p = F.tid & 63, cg = F.wave;
        for (int it = F.vcu; it < 272; it += F.G) {
            const bool lat = it < 256; const int L = lat ? SEQ : CTXL; const int r = lat ? it : it - 256; const int pt = r >> 2, cq4 = r & 3; const int m = pt * 64 + p;
            float z[33];
            z[0] = (float)m / (float)(L - 1);
#pragma unroll
            for (int i = 0; i < 16; ++i) { const float band = 1e-4f + (float)i * ((15.0f - 1e-4f) / 15.0f); const float rev = (float)m * band / (float)L; const float fr_ = rev - floorf(rev);
                z[1 + i] = __builtin_amdgcn_cosf(fr_); z[17 + i] = -__builtin_amdgcn_sinf(fr_); }
            __syncthreads();
#pragma unroll 1
            for (int q = 0; q < 8; ++q) { const int n = cg * 8 + q; float a = B1s[n];
#pragma unroll
                for (int i = 0; i < 33; ++i) a += z[i] * W1s[i * 64 + n];
                H1[n * 64 + p] = __sinf(FRs[n] * a); }
            __syncthreads();
#pragma unroll 1
            for (int q = 0; q < 8; ++q) { const int n = cg * 8 + q; float a = B2s[n];
#pragma unroll 8
                for (int k = 0; k < 64; ++k) a += H1[k * 64 + p] * W2s[k * 64 + n];
                H2[n * 64 + p] = __sinf(FRs[64 + n] * a); }
            const float t = z[0];
            float* KC = lat ? WSP(float, WS_KCL) : WSP(float, WS_KCC); const int N2 = 2 * L;
#pragma unroll 1
            for (int c4 = 0; c4 < 4; ++c4) {
                const int ct = cq4 * 4 + c4;
                __syncthreads();
                for (int i = F.tid; i < 64 * 32; i += NTHR) { const int k = i >> 5, cc = i & 31; *(LAS f32x4*)(W3s + k * 128 + cc * 4) = *(const f32x4*)(w3 + (size_t)k * 2048 + ct * 128 + cc * 4); }
                __syncthreads();
                f32x4 acc[4];
#pragma unroll
                for (int q = 0; q < 4; ++q) acc[q] = (f32x4){0.f, 0.f, 0.f, 0.f};
#pragma unroll 2
                for (int k = 0; k < 64; ++k) { const float hv = H2[k * 64 + p]; const LAS f32x4* wr = (const LAS f32x4*)(W3s + k * 128 + cg * 16);
#pragma unroll
                    for (int q = 0; q < 4; ++q) acc[q] = acc[q] + wr[q] * hv; }
                const int colb = ct * 128 + cg * 16;
#pragma unroll
                for (int q = 0; q < 16; ++q) { const int col = colb + q; const int o = col >> 10, dirn = (col >> 9) & 1, c = col & 511;
                    const float d0 = -3.0701134573253945f, d1 = -15.350567286626973f; const float del = fabsf(d0 + (d1 - d0) * ((float)c / 511.0f));
                    const float val = acc[q >> 2][q & 3] * __expf(-t * del); float* kr = KC + (size_t)(o * 512 + c) * N2;
                    if (dirn == 0) kr[m] = val; else { if (m > 0) kr[N2 - m] = val; else kr[L] = 0.f; } }
            }
        }
        __syncthreads();
    }
#endif
    TP_END(3);
}

#define ZI(i) ((i) + ((i) >> 5))
__device__ __forceinline__ f32x2 cmul(f32x2 a, f32x2 b) { return (f32x2){a.x * b.x - a.y * b.y, a.x * b.y + a.y * b.x}; }
__device__ __forceinline__ f32x2 cmulc(f32x2 a, f32x2 b) { return (f32x2){a.x * b.x + a.y * b.y, a.y * b.x - a.x * b.y}; }
template <int LOGN, int NF> __device__ __forceinline__ void fft_r2_dif(LAS f32x2* Z, const LAS f32x2* TWL, int lt, int lh) {
    constexpr int N = 1 << LOGN, TPG = NTHR / NF; const int half = 1 << lh;
    for (int bf = lt; bf < N / 2; bf += TPG) { const int jx = bf & (half - 1), i = ((bf - jx) << 1) + jx;
        const f32x2 a = Z[ZI(i)], b = Z[ZI(i + half)]; Z[ZI(i)] = a + b; Z[ZI(i + half)] = cmul(a - b, TWL[half + jx]); }
    __syncthreads();
}
template <int LOGN, int NF> __device__ __forceinline__ void fft_r8_dif(LAS f32x2* Z, const LAS f32x2* TWL, int lt, int lh) {
    constexpr int N = 1 << LOGN, TPG = NTHR / NF, NG = N / 8, PT = (NG + TPG - 1) / TPG; const int h = 1 << lh, qd = h >> 2, lq = lh - 2;
    f32x2 x[PT][8]; int i0[PT], j0[PT];
#pragma unroll
    for (int t = 0; t < PT; ++t) { const int g = lt + TPG * t; j0[t] = g & (qd - 1); i0[t] = ((g >> lq) << (lq + 3)) + j0[t];
        if (g < NG) {
#pragma unroll
            for (int m = 0; m < 8; ++m) x[t][m] = Z[ZI(i0[t] + m * qd)]; } }
#pragma unroll
    for (int t = 0; t < PT; ++t) { const int g = lt + TPG * t; if (g < NG) {
#pragma unroll
        for (int m = 0; m < 4; ++m) { const f32x2 a = x[t][m], b = x[t][m + 4]; x[t][m] = a + b; x[t][m + 4] = cmul(a - b, TWL[h + j0[t] + m * qd]); }
#pragma unroll
        for (int mm = 0; mm < 4; ++mm) { const int m = (mm & 1) + 4 * (mm >> 1); const f32x2 a = x[t][m], b = x[t][m + 2]; x[t][m] = a + b; x[t][m + 2] = cmul(a - b, TWL[(h >> 1) + j0[t] + (m & 1) * qd]); }
        const f32x2 wc = TWL[qd + j0[t]];
#pragma unroll
        for (int m = 0; m < 8; m += 2) { const f32x2 a = x[t][m], b = x[t][m + 1]; x[t][m] = a + b; x[t][m + 1] = cmul(a - b, wc); }
#pragma unroll
        for (int m = 0; m < 8; ++m) Z[ZI(i0[t] + m * qd)] = x[t][m]; } }
    __syncthreads();
}
template <int LOGN, int NF, bool SKIP_R2 = false> __device__ __forceinline__ void fft_dif(LAS f32x2* Z, const LAS f32x2* TWL, int lt) {
    int lh = LOGN - 1;
    if (LOGN % 3 == 1) { if (!SKIP_R2) fft_r2_dif<LOGN, NF>(Z, TWL, lt, lh); lh -= 1; }
#pragma unroll 1
    for (; lh >= 2; lh -= 3) fft_r8_dif<LOGN, NF>(Z, TWL, lt, lh);
}
template <int LOGN, int NF> __device__ __forceinline__ void fft_r8_dit(LAS f32x2* Z, const LAS f32x2* TWL, int lt, int lq) {
    constexpr int N = 1 << LOGN, TPG = NTHR / NF, NG = N / 8, PT = (NG + TPG - 1) / TPG; const int qd = 1 << lq;
    f32x2 x[PT][8]; int i0[PT], j0[PT];
#pragma unroll
    for (int t = 0; t < PT; ++t) { const int g = lt + TPG * t; j0[t] = g & (qd - 1); i0[t] = ((g >> lq) << (lq + 3)) + j0[t];
        if (g < NG) {
#pragma unroll
            for (int m = 0; m < 8; ++m) x[t][m] = Z[ZI(i0[t] + m * qd)]; } }
#pragma unroll
    for (int t = 0; t < PT; ++t) { const int g = lt + TPG * t; if (g < NG) {
        const f32x2 wc = TWL[qd + j0[t]];
#pragma unroll
        for (int m = 0; m < 8; m += 2) { const f32x2 a = x[t][m], b = cmulc(x[t][m + 1], wc); x[t][m] = a + b; x[t][m + 1] = a - b; }
#pragma unroll
        for (int mm = 0; mm < 4; ++mm) { const int m = (mm & 1) + 4 * (mm >> 1); const f32x2 a = x[t][m], b = cmulc(x[t][m + 2], TWL[2 * qd + j0[t] + (m & 1) * qd]); x[t][m] = a + b; x[t][m + 2] = a - b; }
#pragma unroll
        for (int m = 0; m < 4; ++m) { const f32x2 a = x[t][m], b = cmulc(x[t][m + 4], TWL[4 * qd + j0[t] + m * qd]); x[t][m] = a + b; x[t][m + 4] = a - b; }
#pragma unroll
        for (int m = 0; m < 8; ++m) Z[ZI(i0[t] + m * qd)] = x[t][m]; } }
    __syncthreads();
}
template <int LOGN, int NF, bool SKIP_R2 = false> __device__ __forceinline__ void fft_dit_inv(LAS f32x2* Z, const LAS f32x2* TWL, int lt) {
    constexpr int N = 1 << LOGN, TPG = NTHR / NF; constexpr int NTRI = LOGN / 3;
#pragma unroll 1
    for (int k = 0; k < NTRI; ++k) fft_r8_dit<LOGN, NF>(Z, TWL, lt, 3 * k);
    if (LOGN % 3 == 1 && !SKIP_R2) { const int half = N / 2;
        for (int bf = lt; bf < N / 2; bf += TPG) { const f32x2 a = Z[ZI(bf)], b = cmulc(Z[ZI(bf + half)], TWL[half + bf]); Z[ZI(bf)] = a + b; Z[ZI(bf + half)] = a - b; }
        __syncthreads(); }
}
template <int LOGN> __device__ __forceinline__ int brev_n(int x) { return (int)(__brev((unsigned)x) >> (32 - LOGN)); }
template <int LOGN> __device__ __forceinline__ void load_tw(Frame& F, LAS f32x2* TWL) {
    constexpr int N = 1 << LOGN; const f32x2* TW = WSP(f32x2, WS_TW);
    for (int k = F.tid; k < N; k += NTHR) { if (k == 0) { TWL[0] = (f32x2){1.f, 0.f}; continue; }
        const int lh = 31 - __builtin_clz((unsigned)k), jx = k - (1 << lh);
        TWL[k] = TW[(size_t)jx << (12 - lh)]; }
}
__device__ __forceinline__ float block_sum(Frame& F, float v, LAS float* red) {
    v = wave_sum(v); __syncthreads(); if (F.lane == 0) red[F.wave] = v; __syncthreads();
    float t = 0.f;
#pragma unroll
    for (int w = 0; w < NWAVES; ++w) t += red[w];
    return t;
}
template <int LOGN, int NF> struct FftGeo { static constexpr int N = 1 << LOGN, TPG = NTHR / NF, ZS = N + N / 32; };

template <int LOGN, int NF> __device__ __forceinline__ void fftk_item(Frame& F, const float* KC, f32x4* KSP, int item) {
    constexpr int N = 1 << LOGN, TPG = NTHR / NF, ZS = FftGeo<LOGN, NF>::ZS;
    const int fi = F.tid / TPG, lt = F.tid % TPG; const int p8 = item * NF + fi, o = p8 >> 8, pr = p8 & 255;
    LAS f32x2* Z = (LAS f32x2*)F.lds + fi * ZS; LAS f32x2* TWL = (LAS f32x2*)(F.lds + 67584); LAS float* red = (LAS float*)(F.lds + 133120);
    const float* ka = KC + (size_t)(o * 512 + 2 * pr) * N; const float* kb = ka + N;
    float sa = 0.f, sb = 0.f;
    for (int i = lt; i < N; i += TPG) { const float a = ka[i], b = kb[i]; sa += fabsf(a); sb += fabsf(b); Z[ZI(i)] = (f32x2){a, b}; }
    float na, nb;
    if (NF == 1) { na = block_sum(F, sa, red) + 1e-6f; nb = block_sum(F, sb, red + 8) + 1e-6f; } else { static_assert(NF == 1 || NTHR / NF == 64, "one wave per transform"); na = wave_sum(sa) + 1e-6f; nb = wave_sum(sb) + 1e-6f; }
    __syncthreads();
    fft_dif<LOGN, NF>(Z, TWL, lt);
    const float ia = 0.5f / (na * (float)N), ib = 0.5f / (nb * (float)N);
    f32x4* dst = KSP + (size_t)(o * 256 + pr) * N;
    for (int p = lt; p < N; p += TPG) {
        const int k = brev_n<LOGN>(p), p2 = brev_n<LOGN>((N - k) & (N - 1));
        const f32x2 z1 = Z[ZI(p)], z2 = Z[ZI(p2)];
        const f32x2 Ka = (f32x2){(z1.x + z2.x) * ia, (z1.y - z2.y) * ia}, Kb = (f32x2){(z1.y + z2.y) * ib, -(z1.x - z2.x) * ib};
        dst[p] = (f32x4){0.5f * (Ka.x + Kb.x), 0.5f * (Ka.y + Kb.y), 0.5f * (Ka.x - Kb.x), 0.5f * (Ka.y - Kb.y)};
    }
    __syncthreads();
}

template <int LOGN, int NF> __device__ __forceinline__ void spec_mul(LAS f32x2* Z, const f32x4* KS, int lt) {
    constexpr int N = 1 << LOGN, TPG = NTHR / NF, PT = (N + TPG - 1) / TPG;
    f32x4 kv[PT]; f32x2 yv[PT];
#pragma unroll
    for (int t = 0; t < PT; ++t) { const int p = lt + TPG * t; if (p < N) kv[t] = KS[p]; }
#pragma unroll
    for (int t = 0; t < PT; ++t) { const int p = lt + TPG * t; if (p < N) {
        const int k = brev_n<LOGN>(p), p2 = brev_n<LOGN>((N - k) & (N - 1));
        const f32x2 z1 = Z[ZI(p)], z2 = Z[ZI(p2)];
        yv[t] = cmul(z1, (f32x2){kv[t].x, kv[t].y}) + cmul((f32x2){z2.x, -z2.y}, (f32x2){kv[t].z, kv[t].w}); } }
    __syncthreads();
#pragma unroll
    for (int t = 0; t < PT; ++t) { const int p = lt + TPG * t; if (p < N) Z[ZI(p)] = yv[t]; }
    __syncthreads();
}
template <int LOGN, int NF> __device__ __forceinline__ void hyena_item(Frame& F, const float* UTall, const f32x4* KSP, float* HYTall, const float* hyb, int item) {
    constexpr int N = 1 << LOGN, L = N / 2, TPG = NTHR / NF, PT = (L + TPG - 1) / TPG, ZS = FftGeo<LOGN, NF>::ZS;
    const int fi = F.tid / TPG, lt = F.tid % TPG; const int p8 = item * NF + fi, b = p8 >> 8, pr = p8 & 255;
    const float* UT = UTall + (size_t)b * HYC * L; float* HYT = HYTall + (size_t)b * 512 * L;
    LAS f32x2* Z = (LAS f32x2*)F.lds + fi * ZS; LAS f32x2* TWL = (LAS f32x2*)(F.lds + 67584);
    const int c0 = 2 * pr; const float b0a = hyb[c0], b0b = hyb[c0 + 1], b1a = hyb[512 + c0], b1b = hyb[512 + c0 + 1];
    const float* va = UT + (size_t)c0 * L; const float* vb = va + L;
    f32x2 keep[PT];
    const float* xa = UT + (size_t)(512 + c0) * L; const float* xb = xa + L;
    const float* x2a = UT + (size_t)(1024 + c0) * L; const float* x2b = x2a + L;
    float* oa = HYT + (size_t)c0 * L; float* ob = oa + L;
    if constexpr (LOGN % 3 == 1) {
#pragma unroll
        for (int q = 0; q < PT; ++q) { const int l = lt + TPG * q; keep[q] = (f32x2){va[l], vb[l]}; Z[ZI(l)] = keep[q]; Z[ZI(l + L)] = cmul(keep[q], TWL[L + l]); }
        __syncthreads();
        fft_dif<LOGN, NF, true>(Z, TWL, lt);
        spec_mul<LOGN, NF>(Z, KSP + (size_t)pr * N, lt);
        fft_dit_inv<LOGN, NF, true>(Z, TWL, lt);
        f32x2 x1v[PT];
#pragma unroll
        for (int q = 0; q < PT; ++q) { const int l = lt + TPG * q; x1v[q] = (f32x2){xa[l], xb[l]}; }
#pragma unroll
        for (int q = 0; q < PT; ++q) { const int l = lt + TPG * q; const f32x2 w = TWL[L + l]; const f32x2 y = Z[ZI(l)] + cmulc(Z[ZI(l + L)], w);
            keep[q] = (f32x2){x1v[q].x * (y.x + keep[q].x * b0a), x1v[q].y * (y.y + keep[q].y * b0b)};
            Z[ZI(l)] = keep[q]; Z[ZI(l + L)] = cmul(keep[q], w); }
        __syncthreads();
        fft_dif<LOGN, NF, true>(Z, TWL, lt);
        spec_mul<LOGN, NF>(Z, KSP + (size_t)(256 + pr) * N, lt);
        fft_dit_inv<LOGN, NF, true>(Z, TWL, lt);
#pragma unroll
        for (int q = 0; q < PT; ++q) { const int l = lt + TPG * q; x1v[q] = (f32x2){x2a[l], x2b[l]}; }
#pragma unroll
        for (int q = 0; q < PT; ++q) { const int l = lt + TPG * q; const f32x2 y = Z[ZI(l)] + cmulc(Z[ZI(l + L)], TWL[L + l]);
            oa[l] = x1v[q].x * (y.x + keep[q].x * b1a); ob[l] = x1v[q].y * (y.y + keep[q].y * b1b); }
        __syncthreads();
    } else {
#pragma unroll
        for (int q = 0; q < PT; ++q) { const int l = lt + TPG * q; if (l < L) { keep[q] = (f32x2){va[l], vb[l]}; Z[ZI(l)] = keep[q]; Z[ZI(l + L)] = (f32x2){0.f, 0.f}; } }
        __syncthreads();
        fft_dif<LOGN, NF>(Z, TWL, lt);
        spec_mul<LOGN, NF>(Z, KSP + (size_t)pr * N, lt);
        fft_dit_inv<LOGN, NF>(Z, TWL, lt);
#pragma unroll
        for (int q = 0; q < PT; ++q) { const int l = lt + TPG * q; if (l < L) { const f32x2 y = Z[ZI(l)]; keep[q] = (f32x2){xa[l] * (y.x + keep[q].x * b0a), xb[l] * (y.y + keep[q].y * b0b)}; } }
        __syncthreads();
#pragma unroll
        for (int q = 0; q < PT; ++q) { const int l = lt + TPG * q; if (l < L) { Z[ZI(l)] = keep[q]; Z[ZI(l + L)] = (f32x2){0.f, 0.f}; } }
        __syncthreads();
        fft_dif<LOGN, NF>(Z, TWL, lt);
        spec_mul<LOGN, NF>(Z, KSP + (size_t)(256 + pr) * N, lt);
        fft_dit_inv<LOGN, NF>(Z, TWL, lt);
#pragma unroll
        for (int q = 0; q < PT; ++q) { const int l = lt + TPG * q; if (l < L) { const f32x2 y = Z[ZI(l)]; oa[l] = x2a[l] * (y.x + keep[q].x * b1a); ob[l] = x2b[l] * (y.y + keep[q].y * b1b); } }
        __syncthreads();
    }
}
__device__ __forceinline__ void ph_hyena(Frame& F0, int j) { Frame F = F0; LAUNDER(F);
    LAS f32x2* TWL = (LAS f32x2*)(F.lds + 67584);
    const float* hyb = INP(I_HYB) + (size_t)j * 1024;
    load_tw<13>(F, TWL); __syncthreads();
    for (int it = F.vcu; it < 1024; it += F.G) hyena_item<13, 1>(F, WSP(float, WS_UTL), WSP(f32x4, WS_KSPL), WSP(float, WS_HYTL), hyb, it);
    __syncthreads(); load_tw<9>(F, TWL); __syncthreads();
    for (int it = F.vcu; it < 128; it += F.G) hyena_item<9, 8>(F, WSP(float, WS_UTC), WSP(f32x4, WS_KSPC), WSP(float, WS_HYTC), hyb, it);
    __syncthreads();
}

__device__ __forceinline__ void ph_readout(Frame& F0, int j) { Frame F = F0; LAUNDER(F);
    const float* Vv = (const float*)(F.ws + WS_RW + 2 * RW_STRIDE); const float* Gg = WSP(float, WS_G); const float* BON = WSP(float, WS_BON);
    const float* Y0 = WSP(float, WS_Y); const float* Y1 = Y0 + (size_t)TT * RWW;
    const float* gn = INP(I_GN) + (size_t)j * 2 * RWW;
    bf16* CAT = WSP(bf16, WS_CAT);
    for (int row = F.gw; row < TT; row += F.NGW) {
#pragma unroll
        for (int q = 0; q < 2; ++q) {
            const int c = 4 * F.lane + 256 * q; const size_t o = (size_t)row * RWW + c;
            const f32x4 y = *(const f32x4*)(Y0 + o) + *(const f32x4*)(Y1 + o);
            float s = (y.x + y.y) + (y.z + y.w);
            s = sum16_f(s);
            const float mu = s * (1.0f / 64.0f); const f32x4 dy = y - mu;
            float v2 = (dy.x * dy.x + dy.y * dy.y) + (dy.z * dy.z + dy.w * dy.w);
            v2 = sum16_f(v2);
            const float rstd = 1.0f / sqrtf(v2 * (1.0f / 64.0f) + 64e-5f);
            const f32x4 yn = dy * rstd * *(const f32x4*)(gn + c) + *(const f32x4*)(gn + RWW + c);
            const f32x4 v = *(const f32x4*)(Vv + o), g = *(const f32x4*)(Gg + o);
            const float bs = BON[(size_t)row * 8 + (c >> 6)];
            f32x4 ov = (yn + v * bs) * g;
#ifdef ABL_RW
            ov = ov * 0.0f;
#endif
            v2u w; w.x = pk2(ov.x, ov.y); w.y = pk2(ov.z, ov.w);
            *(v2u*)(CAT + (size_t)row * DM + c) = w;
        }
    }
    LAS float* scr = (LAS float*)(F.lds + F.wave * 16640);
    for (int it = F.gw; it < (TT / 64) * 8; it += F.NGW) {
        const int rt = it >> 3, ct = it & 7; const int r0 = rt * 64; int L; const int l0 = seq_l(r0, L);
        const float* src; if (r0 < TLAT) src = WSP(float, WS_HYTL) + ((size_t)(r0 >> 12) * 512 + ct * 64) * SEQ + l0; else src = WSP(float, WS_HYTC) + ((size_t)((r0 - TLAT) >> 8) * 512 + ct * 64) * CTXL + l0;
        for (int cc = 0; cc < 64; ++cc) scr[cc * 65 + F.lane] = src[(size_t)cc * L + F.lane];
        LDS_WAIT(); asm volatile("" ::: "memory");
        const int c2 = 2 * (F.lane & 31);
        for (int i2 = 0; i2 < 32; ++i2) { const int rr = 2 * i2 + (F.lane >> 5);
            unsigned pkv = pk2(scr[c2 * 65 + rr], scr[(c2 + 1) * 65 + rr]);
#ifdef ABL_HY
            pkv = 0u;
#endif
            *(unsigned*)(CAT + (size_t)(r0 + rr) * DM + 512 + ct * 64 + c2) = pkv; }
        LDS_WAIT(); asm volatile("" ::: "memory");
    }
}

__device__ __forceinline__ int chunk_base_row(int b, int d, int n) {
    if (n < 16) return TLAT + b * CTXL + 16 * (d ? 15 - n : n);
    const int m = n - 16; return b * SEQ + 16 * (d ? 255 - m : m);
}

__device__ __forceinline__ void ph_chunkprep(Frame& F0, int j) { Frame F = F0; LAUNDER(F);
    const float* Rr = (const float*)(F.ws + WS_RW); const float* Kk = (const float*)(F.ws + WS_RW + RW_STRIDE); const float* Vv = (const float*)(F.ws + WS_RW + 2 * RW_STRIDE); const float* KKn = (const float*)(F.ws + WS_RW + 3 * RW_STRIDE);
    const bf16* AOP = WSP(bf16, WS_AOP); float* Gg = WSP(float, WS_G); float* BON = WSP(float, WS_BON);
    LAS unsigned char* wl = F.lds + F.wave * 14336;
    LAS float* ST = (LAS float*)wl; LAS bf16* OPB = (LAS bf16*)(wl + 4096); LAS float* TM = (LAS float*)(wl + 12288); LAS float* M2s = (LAS float*)(wl + 13312);
    LAS v4u* FBL = (LAS v4u*)(F.lds + 8 * 14336);
    const int h = F.vcu & 7;
    {
        const v4u* FB = WSP(v4u, WS_FRAGB) + (size_t)j * 224 * 64;
        for (int i = F.tid; i < 28 * 64; i += NTHR) { const int f = i >> 6, l = i & 63; int src;
            if (f < 8) src = (f >> 2) * 32 + 4 * h + (f & 3); else if (f < 16) src = 64 + ((f - 8) >> 2) * 32 + 4 * h + (f & 3); else src = 128 + (4 * h + (f - 16) / 3) * 3 + (f - 16) % 3;
            FBL[i] = FB[src * 64 + l]; }
    }
    __syncthreads();
    const int lane = F.lane, n15 = lane & 15, q = lane >> 4;
    LAS float* BIAS = (LAS float*)(F.lds + LDSCTL_OFF + 1024);
    if (F.tid < 256) { const int which = F.tid >> 7, d = (F.tid >> 6) & 1, c = F.tid & 63; BIAS[F.tid] = (which ? INP(I_A0) : INP(I_W0))[(size_t)(j * 2 + d) * RWW + h * 64 + c]; }
    __syncthreads();
    const int col = h * 64 + lane;
    const float kav = INP(I_KA)[(size_t)j * RWW + col], rkv = INP(I_RK)[(size_t)j * RWW + col];
    for (int c16 = (F.vcu >> 3) * 8 + F.wave; c16 < TT / 16; c16 += (F.G >> 3) * 8) {
        const int base = c16 * 16;
        const bool lat = base < TLAT; const int b = lat ? (base >> 12) : ((base - TLAT) >> 8); const int cidx = lat ? ((base & (SEQ - 1)) >> 4) : (((base - TLAT) & (CTXL - 1)) >> 4);
        bf16x8 af[7];
#pragma unroll
        for (int f7 = 4; f7 < 7; ++f7) af[f7] = *(const bf16x8*)(AOP + (size_t)(base + n15) * 224 + f7 * 32 + 8 * q);
        float kkv[16], kxv[16], rxv[16];
#pragma unroll
        for (int s = 0; s < 16; ++s) { const size_t o = (size_t)(base + s) * RWW + col; kkv[s] = KKn[o]; kxv[s] = Kk[o]; rxv[s] = Rr[o]; }
#pragma unroll
        for (int nt = 0; nt < 4; ++nt) {
            f32x4 cg = __builtin_amdgcn_mfma_f32_16x16x32_bf16(af[4], __builtin_bit_cast(bf16x8, FBL[(16 + nt * 3 + 0) * 64 + lane]), (f32x4){0.f, 0.f, 0.f, 0.f}, 0, 0, 0);
            cg = __builtin_amdgcn_mfma_f32_16x16x32_bf16(af[5], __builtin_bit_cast(bf16x8, FBL[(16 + nt * 3 + 1) * 64 + lane]), cg, 0, 0, 0);
            cg = __builtin_amdgcn_mfma_f32_16x16x32_bf16(af[6], __builtin_bit_cast(bf16x8, FBL[(16 + nt * 3 + 2) * 64 + lane]), cg, 0, 0, 0);
#pragma unroll
            for (int r = 0; r < 4; ++r) Gg[(size_t)(base + 4 * q + r) * RWW + h * 64 + nt * 16 + n15] = cg[r];
        }
        float bon_mine = 0.f;
#pragma unroll 1
        for (int d = 0; d < 2; ++d) {
            float wv[16], av[16];
            const bf16x8 afw = *(const bf16x8*)(AOP + (size_t)(base + n15) * 224 + d * 32 + 8 * q), afa = *(const bf16x8*)(AOP + (size_t)(base + n15) * 224 + 64 + d * 32 + 8 * q);
#pragma unroll
            for (int which = 0; which < 2; ++which) {
#pragma unroll
                for (int nt = 0; nt < 4; ++nt) {
                    const bf16x8 aop = which ? afa : afw;
                    const f32x4 c4 = __builtin_amdgcn_mfma_f32_16x16x32_bf16(aop, __builtin_bit_cast(bf16x8, FBL[(8 * which + 4 * d + nt) * 64 + lane]), (f32x4){0.f, 0.f, 0.f, 0.f}, 0, 0, 0);
                    const float bias = BIAS[(which * 2 + d) * 64 + nt * 16 + n15];
#pragma unroll
                    for (int r = 0; r < 4; ++r) { const int tok = 4 * q + r, st = d ? 15 - tok : tok; const float x = bias + c4[r];
                        ST[st * 64 + nt * 16 + n15] = which ? sigmoidf_(x) : __expf(-0.6065306597126334f * sigmoidf_(x)); }
                }
                LDS_WAIT(); asm volatile("" ::: "memory");
#pragma unroll
                for (int s = 0; s < 16; ++s) { if (which) av[s] = ST[s * 64 + lane]; else wv[s] = ST[s * 64 + lane]; }
                LDS_WAIT(); asm volatile("" ::: "memory");
            }
            float kt[16];
            float p = 1.0f;
#pragma unroll
            for (int s = 0; s < 16; ++s) {
                const float kk = d ? kkv[15 - s] : kkv[s], kx = d ? kxv[15 - s] : kxv[s], rx = d ? rxv[15 - s] : rxv[s];
                const float kd = kx * (1.0f + (av[s] - 1.0f) * kav);
                { const float bt_ = wave_sum(rx * kd * rkv); if (lane == (d ? 15 - s : s)) bon_mine += bt_; }
                kt[s] = kk * p; p *= wv[s]; const float ip = 1.0f / p;
                OPB[0 * 1024 + s * 64 + lane] = (bf16)f2bf(kt[s]);
                OPB[1 * 1024 + s * 64 + lane] = (bf16)f2bf(rx * p);
                OPB[2 * 1024 + s * 64 + lane] = (bf16)f2bf(kd * ip);
                OPB[3 * 1024 + s * 64 + lane] = (bf16)f2bf(kk * av[s] * ip);
            }
            const float pc = p;
            LDS_WAIT(); asm volatile("" ::: "memory");
            {
                bf16x8 fk[2], fr[2], fb[2], fkk[2];
#pragma unroll
                for (int ks = 0; ks < 2; ++ks) { const int off = n15 * 64 + ks * 32 + 8 * q;
                    fk[ks] = *(const LAS bf16x8*)(OPB + 0 * 1024 + off); fr[ks] = *(const LAS bf16x8*)(OPB + 1 * 1024 + off);
                    fkk[ks] = *(const LAS bf16x8*)(OPB + 2 * 1024 + off); fb[ks] = *(const LAS bf16x8*)(OPB + 3 * 1024 + off); }
                f32x4 mA = (f32x4){0.f, 0.f, 0.f, 0.f}, mB = mA, mE = mA, mG = mA;
#pragma unroll
                for (int ks = 0; ks < 2; ++ks) {
                    mA = __builtin_amdgcn_mfma_f32_16x16x32_bf16(fk[ks], fb[ks], mA, 0, 0, 0);
                    mB = __builtin_amdgcn_mfma_f32_16x16x32_bf16(fk[ks], fkk[ks], mB, 0, 0, 0);
                    mE = __builtin_amdgcn_mfma_f32_16x16x32_bf16(fr[ks], fkk[ks], mE, 0, 0, 0);
                    mG = __builtin_amdgcn_mfma_f32_16x16x32_bf16(fr[ks], fb[ks], mG, 0, 0, 0);
                }
#pragma unroll
                for (int r = 0; r < 4; ++r) { const int sr = 4 * q + r;
                    ST[0 * 256 + sr * 16 + n15] = n15 < sr ? mA[r] : 0.f; ST[1 * 256 + sr * 16 + n15] = n15 < sr ? mB[r] : 0.f;
                    ST[2 * 256 + sr * 16 + n15] = n15 <= sr ? mE[r] : 0.f; ST[3 * 256 + sr * 16 + n15] = n15 <= sr ? mG[r] : 0.f; }
            }
            LDS_WAIT(); asm volatile("" ::: "memory");
            float vfa[2][8], vfb[2][8];
#pragma unroll
            for (int ig = 0; ig < 2; ++ig)
#pragma unroll
                for (int jj = 0; jj < 8; ++jj) { const int sg = (8 * q + jj) & 15; vfa[ig][jj] = Vv[(size_t)(base + (d ? 15 - sg : sg)) * RWW + h * 64 + ig * 16 + n15]; }
            {
                float tc[16];
#pragma unroll
                for (int s = 0; s < 16; ++s) { float acc = (s == n15) ? 1.0f : 0.0f;
#pragma unroll
                    for (int sg = 0; sg < s; ++sg) acc -= ST[0 * 256 + s * 16 + sg] * tc[sg];
                    tc[s] = acc; }
                if (q == 0) {
#pragma unroll
                    for (int s = 0; s < 16; ++s) TM[s * 16 + n15] = tc[s]; }
            }
            LDS_WAIT(); asm volatile("" ::: "memory");
            {
                float m1[16];
#pragma unroll
                for (int s = 0; s < 16; ++s) { float acc = 0.f;
#pragma unroll
                    for (int sg = 0; sg <= s; ++sg) acc += TM[s * 16 + sg] * kt[sg];
                    m1[s] = acc; }
#pragma unroll
                for (int s = 0; s < 16; ++s) OPB[0 * 1024 + s * 64 + lane] = (bf16)f2bf(m1[s]);
#pragma unroll
                for (int r = 0; r < 4; ++r) { const int sr = 4 * q + r; float acc = 0.f;
#pragma unroll
                    for (int sg = 0; sg < 16; ++sg) acc += TM[sr * 16 + sg] * ST[1 * 256 + sg * 16 + n15];
                    M2s[sr * 16 + n15] = acc; }
            }
            LDS_WAIT(); asm volatile("" ::: "memory");
#pragma unroll
            for (int ig = 0; ig < 2; ++ig)
#pragma unroll
                for (int jj = 0; jj < 8; ++jj) { const int sg = (8 * q + jj) & 15; vfb[ig][jj] = Vv[(size_t)(base + (d ? 15 - sg : sg)) * RWW + h * 64 + (2 + ig) * 16 + n15]; }
            {
                const int scan = b * 16 + h * 2 + d; const int npos = lat ? 16 + (d ? 255 - cidx : cidx) : (d ? 15 - cidx : cidx);
                unsigned char* rec = (unsigned char*)F.ws + WS_REC + ((size_t)scan * 272 + npos) * REC_BYTES;
                v4u* fo = (v4u*)rec + lane;
                unsigned short e8[8];
#define PACK_STORE(fi) do { v4u o_; o_.x = e8[0] | ((unsigned)e8[1] << 16); o_.y = e8[2] | ((unsigned)e8[3] << 16); o_.z = e8[4] | ((unsigned)e8[5] << 16); o_.w = e8[6] | ((unsigned)e8[7] << 16); fo[(fi) * 64] = o_; } while (0)
#pragma unroll
                for (int ks = 0; ks < 2; ++ks) {
#pragma unroll
                    for (int jj = 0; jj < 8; ++jj) e8[jj] = OPB[0 * 1024 + n15 * 64 + 32 * ks + 16 * (jj >> 2) + 4 * q + (jj & 3)];
                    PACK_STORE(ks);
#pragma unroll
                    for (int jj = 0; jj < 8; ++jj) e8[jj] = OPB[1 * 1024 + n15 * 64 + 32 * ks + 16 * (jj >> 2) + 4 * q + (jj & 3)];
                    PACK_STORE(2 + ks);
                }
#pragma unroll
                for (int jj = 0; jj < 8; ++jj) e8[jj] = q < 2 ? (unsigned short)f2bf(M2s[n15 * 16 + 8 * q + jj]) : (unsigned short)0;
                PACK_STORE(4);
#pragma unroll
                for (int jj = 0; jj < 8; ++jj) e8[jj] = q < 2 ? (unsigned short)f2bf(ST[2 * 256 + n15 * 16 + 8 * q + jj]) : (unsigned short)0;
                PACK_STORE(5);
#pragma unroll
                for (int jj = 0; jj < 8; ++jj) e8[jj] = jj < 4 ? (unsigned short)f2bf(-ST[3 * 256 + n15 * 16 + 4 * q + jj]) : (unsigned short)0;
                PACK_STORE(6);
#pragma unroll
                for (int tl = 0; tl < 4; ++tl) {
#pragma unroll
                    for (int jj = 0; jj < 8; ++jj) e8[jj] = q < 2 ? (unsigned short)OPB[2 * 1024 + (8 * q + jj) * 64 + 16 * tl + n15] : (unsigned short)0;
                    PACK_STORE(7 + tl);
#pragma unroll
                    for (int jj = 0; jj < 8; ++jj) e8[jj] = jj < 4 ? (unsigned short)(OPB[3 * 1024 + (4 * q + jj) * 64 + 16 * tl + n15] ^ 0x8000u) : (unsigned short)0;
                    PACK_STORE(11 + tl);
                }
#pragma unroll
                for (int ig = 0; ig < 4; ++ig) {
#pragma unroll
                    for (int jj = 0; jj < 8; ++jj) e8[jj] = q < 2 ? (unsigned short)f2bf(ig < 2 ? vfa[ig & 1][jj] : vfb[ig & 1][jj]) : (unsigned short)0;
                    PACK_STORE(15 + ig);
                }
#undef PACK_STORE
                ((float*)(rec + 19 * 1024))[lane] = pc;
            }
            LDS_WAIT(); asm volatile("" ::: "memory");
        }
        if (lane < 16) BON[(size_t)(base + lane) * 8 + h] = bon_mine;
    }
}

__device__ __forceinline__ void scan_unit(Frame& F, int scan) {
    constexpr int R = 7, D = 6, NCH = 272;
    const int b = scan >> 4, h = (scan >> 1) & 7, d = scan & 1;
    const int lane = F.lane, n15 = lane & 15, q = lane >> 4;
    const unsigned char* rec0 = (const unsigned char*)F.ws + WS_REC + (size_t)scan * NCH * REC_BYTES;
    const bool loader = F.wave >= 4; const int lw = F.wave & 3, ig = F.wave & 3;
    float* Yd = WSP(float, WS_Y) + (size_t)d * TT * RWW;
    f32x4 S[4];
#pragma unroll
    for (int t = 0; t < 4; ++t) S[t] = (f32x4){0.f, 0.f, 0.f, 0.f};
#define ISSUE(n_) do { const unsigned char* g_ = rec0 + (size_t)(n_) * REC_BYTES + lw * 1024 + lane * 16; LAS unsigned char* l_ = F.lds + ((n_) % R) * (int)REC_BYTES + lw * 1024; \
        _Pragma("unroll") for (int p_ = 0; p_ < 5; ++p_) __builtin_amdgcn_global_load_lds((const unsigned*)(g_ + p_ * 4096), (LAS unsigned*)(l_ + p_ * 4096), 16, 0, 0); } while (0)
#define BF8(x) __builtin_bit_cast(bf16x8, x)
    if (loader) {
#pragma unroll 1
        for (int n = 0; n < D; ++n) ISSUE(n);
        asm volatile("s_waitcnt vmcnt(25)" ::: "memory");
    }
    __builtin_amdgcn_s_barrier();
#pragma unroll 1
    for (int n = 0; n < NCH; ++n) {
        if (loader) {
            if (n + D < NCH) { ISSUE(n + D); asm volatile("s_waitcnt vmcnt(25)" ::: "memory"); }
            else asm volatile("s_waitcnt vmcnt(0)" ::: "memory");
        } else {
            const LAS unsigned char* sl = F.lds + (n % R) * (int)REC_BYTES; const LAS v4u* fp = (const LAS v4u*)sl + lane;
            v4u sb0, sb1; sb0.x = pk2(S[0][0], S[0][1]); sb0.y = pk2(S[0][2], S[0][3]); sb0.z = pk2(S[1][0], S[1][1]); sb0.w = pk2(S[1][2], S[1][3]);
            sb1.x = pk2(S[2][0], S[2][1]); sb1.y = pk2(S[2][2], S[2][3]); sb1.z = pk2(S[3][0], S[3][1]); sb1.w = pk2(S[3][2], S[3][3]);
            const f32x4 z4 = (f32x4){0.f, 0.f, 0.f, 0.f};
            const v4u fv = fp[(15 + ig) * 64];
            f32x4 U = __builtin_amdgcn_mfma_f32_16x16x32_bf16(BF8(fp[0]), BF8(sb0), z4, 0, 0, 0);
            f32x4 Y = __builtin_amdgcn_mfma_f32_16x16x32_bf16(BF8(fp[128]), BF8(sb0), z4, 0, 0, 0);
            U = __builtin_amdgcn_mfma_f32_16x16x32_bf16(BF8(fp[64]), BF8(sb1), U, 0, 0, 0);
            Y = __builtin_amdgcn_mfma_f32_16x16x32_bf16(BF8(fp[192]), BF8(sb1), Y, 0, 0, 0);
            U = __builtin_amdgcn_mfma_f32_16x16x32_bf16(BF8(fp[256]), BF8(fv), U, 0, 0, 0);
            Y = __builtin_amdgcn_mfma_f32_16x16x32_bf16(BF8(fp[320]), BF8(fv), Y, 0, 0, 0);
#pragma unroll
            for (int t = 0; t < 4; ++t) S[t] = __builtin_amdgcn_mfma_f32_16x16x32_bf16(BF8(fp[(7 + t) * 64]), BF8(fv), S[t], 0, 0, 0);
            v4u ub; ub.x = pk2(U[0], U[1]); ub.y = pk2(U[2], U[3]); ub.z = 0u; ub.w = 0u;
            Y = __builtin_amdgcn_mfma_f32_16x16x32_bf16(BF8(fp[384]), BF8(ub), Y, 0, 0, 0);
#pragma unroll
            for (int t = 0; t < 4; ++t) { S[t] = __builtin_amdgcn_mfma_f32_16x16x32_bf16(BF8(fp[(11 + t) * 64]), BF8(ub), S[t], 0, 0, 0);
                S[t] = S[t] * *(const LAS f32x4*)(sl + 19 * 1024 + (16 * t + 4 * q) * 4); }
            const int base = chunk_base_row(b, d, n);
#pragma unroll
            for (int r = 0; r < 4; ++r) { const int st = 4 * q + r; Yd[(size_t)(base + (d ? 15 - st : st)) * RWW + h * 64 + ig * 16 + n15] = Y[r]; }
            asm volatile("s_waitcnt lgkmcnt(0)" ::: "memory");
        }
        __builtin_amdgcn_s_barrier();
    }
#undef ISSUE
#undef BF8
    asm volatile("s_waitcnt vmcnt(0)" ::: "memory");
    __syncthreads();
}

__device__ __forceinline__ void subset_arrive(unsigned* ctr) {
    asm volatile("s_waitcnt vmcnt(0)" ::: "memory"); __syncthreads();
    if (threadIdx.x == 0) { __builtin_amdgcn_fence(__ATOMIC_RELEASE, "agent"); asm volatile("s_waitcnt vmcnt(0)" ::: "memory"); __hip_atomic_fetch_add(ctr, 1u, __ATOMIC_RELAXED, __HIP_MEMORY_SCOPE_AGENT); }
}
__device__ __forceinline__ void subset_wait(unsigned* ctr, unsigned n) {
    if (threadIdx.x == 0) { unsigned sp = 0;
        while (__hip_atomic_load(ctr, __ATOMIC_RELAXED, __HIP_MEMORY_SCOPE_AGENT) < n) { __builtin_amdgcn_s_sleep(4); if (++sp > (1u << 24)) break; }
        __builtin_amdgcn_fence(__ATOMIC_ACQUIRE, "agent"); asm volatile("s_waitcnt vmcnt(0)" ::: "memory"); }
    __syncthreads();
}
__device__ __forceinline__ void ph_scan_hyena(Frame& F0, int j, int i) { Frame F = F0; LAUNDER(F);
    unsigned* ctl = (unsigned*)(F.ws + WS_CTL) + 512 + 256 * i;
    LAS f32x2* TWL = (LAS f32x2*)(F.lds + 67584); LAS int* tick = (LAS int*)(F.lds + 133120 + 256);
    const float* hyb = INP(I_HYB) + (size_t)j * 1024;
    const bool split = F.G >= 128; const int nf = split ? F.G - 64 : F.G;
    TP_BEGIN();
    if (split && F.vcu < 64) { scan_unit(F, F.vcu); TP_END(6); }
    else {
        if (!split) { for (int sc = F.vcu; sc < 64; sc += F.G) scan_unit(F, sc); }
        const int id = split ? F.vcu - 64 : F.vcu;
        load_tw<13>(F, TWL); __syncthreads();
        for (int it = id; it < 512; it += nf) fftk_item<13, 1>(F, WSP(float, WS_KCL), WSP(f32x4, WS_KSPL), it);
        __syncthreads(); load_tw<9>(F, TWL); __syncthreads();
        for (int it = id; it < 64; it += nf) fftk_item<9, 8>(F, WSP(float, WS_KCC), WSP(f32x4, WS_KSPC), it);
        subset_arrive(ctl);
    }
    subset_wait(ctl, (unsigned)nf);
    int cur_n = 0;
    for (;;) {
        __syncthreads();
        if (F.tid == 0) tick[0] = (int)__hip_atomic_fetch_add(ctl + 64, 1u, __ATOMIC_RELAXED, __HIP_MEMORY_SCOPE_AGENT);
        __syncthreads();
        const int it = tick[0];
        if (it >= 1024 + 128) break;
        const int want = it < 1024 ? 13 : 9;
        if (cur_n != want) { __syncthreads(); if (want == 13) load_tw<13>(F, TWL); else load_tw<9>(F, TWL); cur_n = want; __syncthreads(); }
        if (it < 1024) hyena_item<13, 1>(F, WSP(float, WS_UTL), WSP(f32x4, WS_KSPL), WSP(float, WS_HYTL), hyb, it);
        else hyena_item<9, 8>(F, WSP(float, WS_UTC), WSP(f32x4, WS_KSPC), WSP(float, WS_HYTC), hyb, it - 1024);
    }
}
__device__ __forceinline__ void ph_mod2(Frame& F0, int i) { Frame F = F0; LAUNDER(F);
    LAS float* RL = (LAS float*)F.lds;
    const float* router = INP(I_ROUTER) + (size_t)i * DM * NE;
    for (int idx = F.tid; idx < DM * NE; idx += NTHR) { const int c = idx >> 4, e = idx & 15; RL[e * 1024 + c] = router[idx]; }
    __syncthreads();
    const float* mods = WSP(float, WS_MODS) + (size_t)i * 5 * 6144; const float* g = INP(I_NORMG) + (size_t)(i * 2 + 1) * DM;
    const int nrows = i + 1 < DEPTH ? TT : TLAT;
    f32x4 vn[4];
    if (F.gw < nrows) {
#pragma unroll
        for (int jj = 0; jj < 4; ++jj) vn[jj] = ((const f32x4*)(WSP(float, WS_X) + (size_t)F.gw * DM))[64 * jj + F.lane]; }
    for (int row = F.gw; row < nrows; row += F.NGW) {
        f32x4 v[4], h[4];
#pragma unroll
        for (int jj = 0; jj < 4; ++jj) v[jj] = vn[jj];
        if (row + F.NGW < nrows) {
#pragma unroll
            for (int jj = 0; jj < 4; ++jj) vn[jj] = ((const f32x4*)(WSP(float, WS_X) + (size_t)(row + F.NGW) * DM))[64 * jj + F.lane]; }
        const int s = row_s(row);
        mod_row_store(v, g, mods + s * 6144 + 3 * 1024, mods + s * 6144 + 4 * 1024, WSP(bf16, WS_HA) + (size_t)row * DM, F.lane, h);
        float mylg = -1e30f;
#pragma unroll 2
        for (int e = 0; e < 16; ++e) { float a = 0.f;
#pragma unroll
            for (int jj = 0; jj < 4; ++jj) { const f32x4 r4 = ((const LAS f32x4*)(RL + e * 1024))[64 * jj + F.lane]; a += (h[jj].x * r4.x + h[jj].y * r4.y) + (h[jj].z * r4.z + h[jj].w * r4.w); }
            a = wave_sum(a); if (F.lane == e) mylg = a; }
        const float mx = max16_f(mylg);
        const float ex = expf(mylg - mx); const float den = sum16_f(ex);
        const float mine = ex / den;
        if (F.lane < 16) WSP(float, WS_AFF)[(size_t)row * 16 + F.lane] = mine;
    }
}

__device__ __forceinline__ int block_excl_scan(Frame& F, int v, LAS int* sc, int& total) {
    LAS int* cnt = sc + 16;
    __syncthreads();
    cnt[F.tid] = v;
    const int ws = wave_sum_i(v);
    if (F.lane == 0) sc[F.wave] = ws;
    __syncthreads();
    int base = 0, tot = 0;
#pragma unroll
    for (int w = 0; w < NWAVES; ++w) { const int t = sc[w]; if (w < F.wave) base += t; tot += t; }
    int pre = 0;
    for (int k = 0; k < F.lane; ++k) pre += cnt[F.wave * 64 + k];
    total = tot; return base + pre;
}
__device__ __forceinline__ int block_sum_i(Frame& F, int v, LAS int* sc) {
    v = wave_sum_i(v);
    __syncthreads(); if (F.lane == 0) sc[F.wave] = v; __syncthreads();
    int t = 0;
#pragma unroll
    for (int w = 0; w < NWAVES; ++w) t += sc[w];
    return t;
}
__device__ __forceinline__ void topk_item(Frame& F, int set, int e) {
    LAS int* sc = (LAS int*)(F.lds + 133120);
    const bool lat = set < 4; const int L = lat ? SEQ : CTXL, cap = lat ? 512 : 32; const int rbase = lat ? set * SEQ : TLAT + (set - 4) * CTXL;
    const int sbase = e * EROWS + (lat ? set * 512 : 2048 + (set - 4) * 32);
    const float* aff = WSP(float, WS_AFF);
    unsigned key[8];
#pragma unroll
    for (int q = 0; q < 8; ++q) { const int l = F.tid * 8 + q; key[q] = l < L ? __builtin_bit_cast(unsigned, aff[(size_t)(rbase + l) * 16 + e]) : 0u; }
    unsigned thr = 0u;
    for (int bit = 30; bit >= 0; --bit) {
        const unsigned cand = thr | (1u << bit); int cnt = 0;
#pragma unroll
        for (int q = 0; q < 8; ++q) cnt += (key[q] >= cand) ? 1 : 0;
        if (block_sum_i(F, cnt, sc) >= cap) thr = cand;
    }
    int ngt = 0, neq = 0;
#pragma unroll
    for (int q = 0; q < 8; ++q) { ngt += key[q] > thr ? 1 : 0; neq += (key[q] == thr && (F.tid * 8 + q) < L) ? 1 : 0; }
    int tot_gt, tot_eq; const int bgt = block_excl_scan(F, ngt, sc, tot_gt); const int beq = block_excl_scan(F, neq, sc, tot_eq);
    const int need_eq = cap - tot_gt; int rg = bgt, re = beq;
    int* slotmap = WSP(int, WS_SLOT); int* idxo = WSP(int, WS_IDX); float* gate = WSP(float, WS_GATE);
#pragma unroll
    for (int q = 0; q < 8; ++q) { const int l = F.tid * 8 + q; if (l < L) {
        int slot = -1;
        if (key[q] > thr) { slot = rg; ++rg; } else if (key[q] == thr) { if (re < need_eq) slot = tot_gt + re; ++re; }
        slotmap[(size_t)(rbase + l) * 16 + e] = slot;
        if (slot >= 0) { idxo[sbase + slot] = rbase + l; gate[sbase + slot] = __builtin_bit_cast(float, key[q]); } } }
    if (set == 0) for (int p = F.tid; p < EROWS - 2176; p += NTHR) { idxo[e * EROWS + 2176 + p] = 0; gate[e * EROWS + 2176 + p] = 0.f; }
    __syncthreads();
}
__device__ __forceinline__ void ph_topk(Frame& F0, int i) { Frame F = F0; LAUNDER(F);
    TP_BEGIN();
    for (int it = F.vcu; it < (i + 1 < DEPTH ? 128 : 64); it += F.G) topk_item(F, it >> 4, it & 15);
    TP_END(4);
    LAS float* scr = (LAS float*)(F.lds + F.wave * 16640);
    const float* w1 = INP(I_MW1) + (size_t)i * NE * DM * FF; const float* w3 = INP(I_MW3) + (size_t)i * NE * DM * FF; const float* w2 = INP(I_MW2) + (size_t)i * NE * FF * DM;
    for (int it = F.gw; it < 3 * NE * 256; it += F.NGW) {
        const int which = it / (NE * 256), r = it % (NE * 256), e = r >> 8, item = r & 255;
        if (which == 0) transpose_item(w1 + (size_t)e * DM * FF, DM, FF, WSP(bf16, WS_W13), RowW13{e, 0}, scr, item, F.lane);
        else if (which == 1) transpose_item(w3 + (size_t)e * DM * FF, DM, FF, WSP(bf16, WS_W13), RowW13{e, 1}, scr, item, F.lane);
        else transpose_item(w2 + (size_t)e * FF * DM, FF, DM, WSP(bf16, WS_W2), RowId{e * 1024}, scr, item, F.lane);
    }
    TP_END(5);
}
__device__ __forceinline__ void ph_gather(Frame& F0, bool need_ctx) { Frame F = F0; LAUNDER(F);
    const int* idx = WSP(int, WS_IDX); const bf16* HA = WSP(bf16, WS_HA); bf16* XG = WSP(bf16, WS_XG);
    for (int r = F.gw; r < NE * EROWS; r += F.NGW) {
        if (!need_ctx && (r % EROWS) >= 2048) continue;
        const int src = idx[r]; const v4u* s = (const v4u*)(HA + (size_t)src * DM); v4u* d = (v4u*)(XG + (size_t)r * DM);
        d[F.lane] = s[F.lane]; d[64 + F.lane] = s[64 + F.lane];
    }
}
__device__ __forceinline__ void ph_combine(Frame& F0, int i) { Frame F = F0; LAUNDER(F);
    const int* slotmap = WSP(int, WS_SLOT); const bf16* YB = WSP(bf16, WS_YB);
    const float* mods = WSP(float, WS_MODS) + (size_t)i * 5 * 6144;
    const int nrows_c = i + 1 < DEPTH ? TT : TLAT;
    int slotn = -1; f32x4 xn[4];
    if (F.gw < nrows_c) { slotn = F.lane < 16 ? slotmap[(size_t)F.gw * 16 + F.lane] : -1;
#pragma unroll
        for (int jj = 0; jj < 4; ++jj) xn[jj] = ((const f32x4*)(WSP(float, WS_X) + (size_t)F.gw * DM))[64 * jj + F.lane]; }
    for (int row = F.gw; row < nrows_c; row += F.NGW) {
        f32x4 acc[4], xc[4];
#pragma unroll
        for (int jj = 0; jj < 4; ++jj) { acc[jj] = (f32x4){0.f, 0.f, 0.f, 0.f}; xc[jj] = xn[jj]; }
        const int myslot = slotn;
        if (row + F.NGW < nrows_c) { slotn = F.lane < 16 ? slotmap[(size_t)(row + F.NGW) * 16 + F.lane] : -1;
#pragma unroll
            for (int jj = 0; jj < 4; ++jj) xn[jj] = ((const f32x4*)(WSP(float, WS_X) + (size_t)(row + F.NGW) * DM))[64 * jj + F.lane]; }
        unsigned long long sel = __ballot(myslot >= 0);
        const int sbase = row < TLAT ? (row >> 12) * 512 : 2048 + ((row - TLAT) >> 8) * 32;
        while (sel) {
            const int e = __builtin_ctzll(sel); sel &= sel - 1;
            const int sl = __builtin_amdgcn_readlane(myslot, e);
            const v2u* yr = (const v2u*)(YB + (size_t)(e * EROWS + sbase + sl) * DM);
#pragma unroll
            for (int jj = 0; jj < 4; ++jj) { const v2u w = yr[64 * jj + F.lane];
                acc[jj].x += __builtin_bit_cast(float, w.x << 16); acc[jj].y += __builtin_bit_cast(float, w.x & 0xffff0000u);
                acc[jj].z += __builtin_bit_cast(float, w.y << 16); acc[jj].w += __builtin_bit_cast(float, w.y & 0xffff0000u); }
        }
#ifdef ABL_MOE
#pragma unroll
        for (int jj = 0; jj < 4; ++jj) acc[jj] = acc[jj] * 0.0f;
#endif
        const int s = row_s(row); f32x4 v[4], h[4];
        float* xr = WSP(float, WS_X) + (size_t)row * DM;
#pragma unroll
        for (int jj = 0; jj < 4; ++jj) { const f32x4 gm = ((const f32x4*)(mods + s * 6144 + 5 * 1024))[64 * jj + F.lane]; v[jj] = xc[jj] + gm * acc[jj]; ((f32x4*)xr)[64 * jj + F.lane] = v[jj]; }
        if (i + 1 < DEPTH) {
            const float* m2 = WSP(float, WS_MODS) + (size_t)(i + 1) * 5 * 6144;
            mod_row_store(v, INP(I_NORMG) + (size_t)((i + 1) * 2) * DM, m2 + s * 6144, m2 + s * 6144 + 1024, WSP(bf16, WS_HA) + (size_t)row * DM, F.lane, h);
        } else if (row < TLAT) {
            float ss = 0.f;
#pragma unroll
            for (int jj = 0; jj < 4; ++jj) ss += (v[jj].x * v[jj].x + v[jj].y * v[jj].y) + (v[jj].z * v[jj].z + v[jj].w * v[jj].w);
            const float rstd = 1.0f / sqrtf(wave_sum(ss) * (1.0f / 1024.0f) + 1e-6f);
#pragma unroll
            for (int jj = 0; jj < 4; ++jj) ((f32x4*)(F.out + (size_t)row * DM))[64 * jj + F.lane] = v[jj] * rstd * ((const f32x4*)INP(I_FINALG))[64 * jj + F.lane];
        }
    }
}
__device__ __forceinline__ void ph_rope(Frame& F0) { Frame F = F0; LAUNDER(F);
    const float* P = WSP(float, WS_P); bf16* QB = WSP(bf16, WS_QB); bf16* KB = WSP(bf16, WS_KB); bf16* VB = WSP(bf16, WS_VB);
    const int axis = (F.lane >> 1) & 1, half = F.lane & 1;
    float inv[16];
#pragma unroll
    for (int f = 0; f < 16; ++f) inv[f] = exp2f(-(float)f * (13.287712379549449f / 16.0f));
    for (int row = F.gw; row < TT; row += F.NGW) {
        const bool lat = row < TLAT; const int b = lat ? (row >> 12) : ((row - TLAT) >> 8); const int l = lat ? (row & (SEQ - 1)) : ((row - TLAT) & (CTXL - 1));
        const size_t krow = (size_t)b * KSEQ + (lat ? CTXL + l : l);
        float cs[16], sn[16];
        if (lat) { const float pos = (float)(axis ? (l & 63) : (l >> 6));
#pragma unroll
            for (int f = 0; f < 16; ++f) sincosf(pos * inv[f], &sn[f], &cs[f]); }
#pragma unroll
        for (int part = 0; part < 3; ++part) {
            float x[16];
            const float* src = P + (size_t)row * QKVC + part * 1024 + 16 * F.lane;
#pragma unroll
            for (int q = 0; q < 4; ++q) { const f32x4 t = *(const f32x4*)(src + 4 * q); x[4 * q] = t.x; x[4 * q + 1] = t.y; x[4 * q + 2] = t.z; x[4 * q + 3] = t.w; }
            if (part < 2 && lat) {
#pragma unroll
                for (int f = 0; f < 16; ++f) { const float o = xor1_f(x[f]);
                    x[f] = half ? (x[f] * cs[f] + o * sn[f]) : (x[f] * cs[f] - o * sn[f]); }
            }
            v4u w0, w1; w0.x = pk2(x[0], x[1]); w0.y = pk2(x[2], x[3]); w0.z = pk2(x[4], x[5]); w0.w = pk2(x[6], x[7]); w1.x = pk2(x[8], x[9]); w1.y = pk2(x[10], x[11]); w1.z = pk2(x[12], x[13]); w1.w = pk2(x[14], x[15]);
            bf16* dst = part == 0 ? QB + (size_t)row * DM : (part == 1 ? KB + krow * DM : VB + krow * DM);
            *(v4u*)(dst + 16 * F.lane) = w0; *(v4u*)(dst + 16 * F.lane + 8) = w1;
        }
    }
}

namespace att {
using s16x4 = __attribute__((ext_vector_type(4))) short;
using f32x16 = __attribute__((ext_vector_type(16))) float;
using u32x4 = __attribute__((ext_vector_type(4))) unsigned;
constexpr int DQ = 64, DV = 128, NW = 8, QBLK = 32, KVBLK = 64, LD = 1024;
constexpr float SCALE = 0.125f, THR = 8.f;
#ifndef ATT_SDEPTH
#define ATT_SDEPTH 1
#endif
constexpr int SDEPTH = ATT_SDEPTH;
constexpr size_t SHM_V = KVBLK * DV * 2, SHM_K = KVBLK * DQ * 2, SHM_ATTN = 2 * SHM_V + 2 * SHM_K + NW * 64 * 4;
#define KSWZ(row, colB) ((row) * 128 + ((colB) ^ (((row) & 7) << 4)))
#define SBAR() __builtin_amdgcn_sched_barrier(0)
__device__ __forceinline__ int crow(int r, int hi) { return (r & 3) + 8 * (r >> 2) + 4 * hi; }
__device__ __forceinline__ unsigned cvtpk(float lo, float hi) { unsigned r; asm volatile("v_cvt_pk_bf16_f32 %0, %1, %2" : "=v"(r) : "v"(lo), "v"(hi)); return r; }
__device__ __forceinline__ void partialSM(f32x16& p0, f32x16& p1, float& m_reg, float& mn, float& alpha) {
  constexpr float C = SCALE * 1.4426950408889634f;
  float pmax = p0[0]; for (int r = 1; r < 16; ++r) pmax = fmaxf(pmax, p0[r]); for (int r = 0; r < 16; ++r) pmax = fmaxf(pmax, p1[r]);
  { auto rr = __builtin_amdgcn_permlane32_swap(__float_as_uint(pmax), __float_as_uint(pmax), false, false);
    pmax = fmaxf(__uint_as_float(rr[0]), __uint_as_float(rr[1])); }
  if (__builtin_expect(__all(pmax - m_reg <= THR / SCALE), 1)) { mn = m_reg; alpha = 1.f; }
  else { mn = fmaxf(m_reg, pmax); alpha = __builtin_amdgcn_exp2f((m_reg - mn) * C); m_reg = mn; }
  float mnC = -mn * C;
  for (int r = 0; r < 16; ++r) p0[r] = fmaf(p0[r], C, mnC); for (int r = 0; r < 16; ++r) p1[r] = fmaf(p1[r], C, mnC);
  for (int r = 0; r < 16; ++r) p0[r] = __builtin_amdgcn_exp2f(p0[r]);
}
__device__ __forceinline__ void finishSM(f32x16& p0, f32x16& p1, float alpha, float& l_reg, bf16x8& pa0, bf16x8& pa1, bf16x8& pa2, bf16x8& pa3) {
  for (int r = 0; r < 16; ++r) p1[r] = __builtin_amdgcn_exp2f(p1[r]);
  float ps = 0; for (int r = 0; r < 16; ++r) ps += p0[r]; for (int r = 0; r < 16; ++r) ps += p1[r];
  { auto rr = __builtin_amdgcn_permlane32_swap(__float_as_uint(ps), __float_as_uint(ps), false, false);
    ps = __uint_as_float(rr[0]) + __uint_as_float(rr[1]); }
  l_reg = l_reg * alpha + ps;
#define PK4(P, BASE, OUT) do { unsigned a0 = cvtpk(P[BASE + 0], P[BASE + 1]), a1 = cvtpk(P[BASE + 2], P[BASE + 3]);   \
    unsigned b0 = cvtpk(P[BASE + 4], P[BASE + 5]), b1 = cvtpk(P[BASE + 6], P[BASE + 7]);                              \
    auto r0 = __builtin_amdgcn_permlane32_swap(a0, b0, false, false); auto r1 = __builtin_amdgcn_permlane32_swap(a1, b1, false, false); \
    u32x4 w = {r0[0], r1[0], r0[1], r1[1]}; OUT = *reinterpret_cast<bf16x8*>(&w); } while (0)
  PK4(p0, 0, pa0); PK4(p0, 8, pa1); PK4(p1, 0, pa2); PK4(p1, 8, pa3);
#undef PK4
}
__device__ __forceinline__ void qkt(f32x16& p0, f32x16& p1, const bf16* Ks, const bf16x8* qr, int r32, int hi) {
  p0 = f32x16{}; p1 = f32x16{};
#pragma unroll
  for (int d0 = 0; d0 < 4; ++d0) { int cb = (d0 * 16 + hi * 8) * 2;
    bf16x8 b0 = *reinterpret_cast<const bf16x8*>((const char*)Ks + KSWZ(r32, cb));
    bf16x8 b1 = *reinterpret_cast<const bf16x8*>((const char*)Ks + KSWZ(32 + r32, cb));
    p0 = __builtin_amdgcn_mfma_f32_32x32x16_bf16(b0, qr[d0], p0, 0, 0, 0);
    p1 = __builtin_amdgcn_mfma_f32_32x32x16_bf16(b1, qr[d0], p1, 0, 0, 0); }
}
__device__ __forceinline__ int v_st(int k, int c) { const int kk = (k & ~0xC) | ((k & 4) << 1) | ((k & 8) >> 1); return ((kk >> 3) * 4 + (c >> 5)) * 512 + ((kk & 7) * 32 + (c & 31)) * 2; }
__device__ __forceinline__ int v_rd_base(int lane) { return ((lane & 3) << 3) | (((lane >> 2) & 3) << 6) | (((lane >> 4) & 1) << 5) | (((lane >> 5) & 1) << 8); }
constexpr int v_rd_off(int d0, int ks, int half) { return d0 * 512 + ks * 4096 + half * 2048; }
template <int OFF> __device__ __forceinline__ s16x4 tr_read(int vb) {
  s16x4 r; asm volatile("ds_read_b64_tr_b16 %0, %1 offset:%2" : "=&v"(r) : "v"(vb), "i"(OFF) : "memory"); return r;
}
template <int D0> __device__ __forceinline__ void pv_one(f32x16& od, int vb, bf16x8 pa0, bf16x8 pa1, bf16x8 pa2, bf16x8 pa3) {
  const s16x4 l0 = tr_read<v_rd_off(D0, 0, 0)>(vb), h0 = tr_read<v_rd_off(D0, 0, 1)>(vb), l1 = tr_read<v_rd_off(D0, 1, 0)>(vb), h1 = tr_read<v_rd_off(D0, 1, 1)>(vb);
  const s16x4 l2 = tr_read<v_rd_off(D0, 2, 0)>(vb), h2 = tr_read<v_rd_off(D0, 2, 1)>(vb), l3 = tr_read<v_rd_off(D0, 3, 0)>(vb), h3 = tr_read<v_rd_off(D0, 3, 1)>(vb);
  asm volatile("s_waitcnt lgkmcnt(0)" ::: "memory"); SBAR();
#define PK(L, H) (bf16x8){L[0], L[1], L[2], L[3], H[0], H[1], H[2], H[3]}
  od = __builtin_amdgcn_mfma_f32_32x32x16_bf16(pa0, PK(l0, h0), od, 0, 0, 0);
  od = __builtin_amdgcn_mfma_f32_32x32x16_bf16(pa1, PK(l1, h1), od, 0, 0, 0);
  od = __builtin_amdgcn_mfma_f32_32x32x16_bf16(pa2, PK(l2, h2), od, 0, 0, 0);
  od = __builtin_amdgcn_mfma_f32_32x32x16_bf16(pa3, PK(l3, h3), od, 0, 0, 0);
#undef PK
}
__device__ __forceinline__ void pv_d0(f32x16* o, int vb, bf16x8 pa0, bf16x8 pa1, bf16x8 pa2, bf16x8 pa3) {
  pv_one<0>(o[0], vb, pa0, pa1, pa2, pa3); pv_one<1>(o[1], vb, pa0, pa1, pa2, pa3); pv_one<2>(o[2], vb, pa0, pa1, pa2, pa3); pv_one<3>(o[3], vb, pa0, pa1, pa2, pa3);
}
__device__ __forceinline__ void attn_body(const bf16* __restrict__ Qb, const bf16* __restrict__ Kh, const bf16* __restrict__ Vh, float* __restrict__ Ob, int ldo, int seq, char* lds) {
  int tid_ = threadIdx.x; asm volatile("" : "+v"(tid_));
  const int tid = tid_, wid = tid >> 6, lane = tid & 63, r32 = lane & 31, hi = lane >> 5;
  bf16* V_lds = (bf16*)lds; bf16* K_lds = (bf16*)(lds + 2 * SHM_V);
  float* ws = (float*)(lds + 2 * SHM_V + 2 * SHM_K) + wid * 64; float* li_l = ws; float* al_l = ws + 32;
  float m_reg = -1e30f, l_reg = 0; f32x16 o[4] = {}; bf16x8 qr[4];
  const bf16* Qw = Qb + (long)(wid * QBLK + r32) * LD + hi * 8;
#pragma unroll
  for (int d0 = 0; d0 < 4; ++d0) qr[d0] = *reinterpret_cast<const bf16x8*>(Qw + d0 * 16);
  const int sr = tid >> 4, sc = (tid & 15) * 8, vst0 = v_st(sr, sc), vst1 = v_st(32 + sr, sc);
  const int kr = tid >> 3, kc = (tid & 7) * 8;
  const int vb0 = (int)(uintptr_t)V_lds + v_rd_base(lane);
  struct { bf16x8 vs0, vs1, ks0; } sr_[SDEPTH];
#define SLOAD(i, k0) do { sr_[i].vs0 = *reinterpret_cast<const bf16x8*>(&Vh[(long)((k0) + sr) * LD + sc]); sr_[i].vs1 = *reinterpret_cast<const bf16x8*>(&Vh[(long)((k0) + 32 + sr) * LD + sc]); \
    sr_[i].ks0 = *reinterpret_cast<const bf16x8*>(&Kh[(long)((k0) + kr) * LD + kc]); } while (0)
#define SWRITE(b, i) do { *(bf16x8*)((char*)V_lds + (b) * SHM_V + vst0) = sr_[i].vs0;          \
    *(bf16x8*)((char*)V_lds + (b) * SHM_V + vst1) = sr_[i].vs1;               \
    *(bf16x8*)((char*)K_lds + (b) * SHM_K + KSWZ(kr, kc * 2)) = sr_[i].ks0; } while (0)
#define SWAIT() do { if constexpr (SDEPTH == 2) asm volatile("s_waitcnt vmcnt(3)" ::: "memory"); else asm volatile("s_waitcnt vmcnt(0)" ::: "memory"); } while (0)
#define RESC(a) do { if (__any((a) < 1.f)) { if (hi == 0) al_l[r32] = (a); asm volatile("s_waitcnt lgkmcnt(0)" ::: "memory"); \
    for (int d = 0; d < 4; ++d) for (int r = 0; r < 16; ++r) o[d][r] *= al_l[crow(r, hi)]; } } while (0)
  f32x16 pA0, pA1, pB0, pB1; float mnA, mnB, alA, alB; bf16x8 pa0, pa1, pa2, pa3; const int NT = seq / KVBLK;
  constexpr int SE = 0, SO = SDEPTH - 1;
  SLOAD(SE, 0); asm volatile("s_waitcnt vmcnt(0)" ::: "memory"); SWRITE(0, SE); __syncthreads();
  qkt(pA0, pA1, K_lds, qr, r32, hi); partialSM(pA0, pA1, m_reg, mnA, alA);
  SLOAD(SO, KVBLK); if constexpr (SDEPTH == 2) { if (2 < NT) SLOAD(SE, 2 * KVBLK); }
  SWAIT(); SWRITE(1, SO); __syncthreads();
  for (int j = 1; j + 1 < NT; j += 2) {
    SBAR(); qkt(pB0, pB1, (bf16*)((char*)K_lds + SHM_K), qr, r32, hi);
    finishSM(pA0, pA1, alA, l_reg, pa0, pa1, pa2, pa3); SBAR();
    SLOAD(SO, (j + SDEPTH) * KVBLK); SBAR();
    pv_d0(o, vb0, pa0, pa1, pa2, pa3); partialSM(pB0, pB1, m_reg, mnB, alB);
    __syncthreads(); SWAIT(); SWRITE(0, SE);
    RESC(alB); __syncthreads();
    SBAR(); qkt(pA0, pA1, K_lds, qr, r32, hi);
    finishSM(pB0, pB1, alB, l_reg, pa0, pa1, pa2, pa3); SBAR();
    if (SDEPTH == 1 || j + 3 < NT) SLOAD(SE, (j + 1 + SDEPTH) * KVBLK); SBAR();
    pv_d0(o, vb0 + (int)SHM_V, pa0, pa1, pa2, pa3); partialSM(pA0, pA1, m_reg, mnA, alA);
    __syncthreads(); SWAIT(); SWRITE(1, SO);
    RESC(alA); __syncthreads();
  }
  SBAR(); qkt(pB0, pB1, (bf16*)((char*)K_lds + SHM_K), qr, r32, hi);
  finishSM(pA0, pA1, alA, l_reg, pa0, pa1, pa2, pa3); SBAR();
  pv_d0(o, vb0, pa0, pa1, pa2, pa3); partialSM(pB0, pB1, m_reg, mnB, alB);
  __syncthreads(); RESC(alB);
  finishSM(pB0, pB1, alB, l_reg, pa0, pa1, pa2, pa3); SBAR();
  pv_d0(o, vb0 + (int)SHM_V, pa0, pa1, pa2, pa3);
  if (hi == 0) li_l[r32] = l_reg; asm volatile("s_waitcnt lgkmcnt(0)" ::: "memory");
  float rli[16];
#pragma unroll
  for (int r = 0; r < 16; ++r) rli[r] = __builtin_amdgcn_rcpf(li_l[crow(r, hi)]);
  float* Ow = Ob + (long)(wid * QBLK) * ldo;
#pragma unroll
  for (int r = 0; r < 16; ++r) { int orow = crow(r, hi);
    for (int d0 = 0; d0 < 4; ++d0) Ow[(long)orow * ldo + d0 * 32 + r32] = o[d0][r] * rli[r]; }
  __syncthreads();
#undef SLOAD
#undef SWRITE
#undef SWAIT
#undef RESC
}
#undef KSWZ
#undef SBAR
}

__device__ __forceinline__ void ph_attn(Frame& F0, bool need_ctx) { Frame F = F0; LAUNDER(F);
    const bf16* QB = WSP(bf16, WS_QB); const bf16* KB = WSP(bf16, WS_KB); const bf16* VB = WSP(bf16, WS_VB); float* OB = WSP(float, WS_OB);
    const int nun = 1024 + (need_ctx ? 64 : 0);
    for (int u = F.vcu; u < nun; u += F.G) {
        if (u < 1024) { const int qb = u & 15, hc = (u >> 4) & 15, b = u >> 8; const size_t qrow = (size_t)b * SEQ + qb * 256;
            att::attn_body(QB + qrow * DM + hc * 64, KB + (size_t)b * KSEQ * DM + hc * 64, VB + (size_t)b * KSEQ * DM + (hc >> 1) * 128, OB + qrow * 2048 + hc * 128, 2048, KSEQ, (char*)F.ldsg);
        } else { const int hc = (u - 1024) & 15, b = (u - 1024) >> 4; const size_t qrow = (size_t)TLAT + b * CTXL;
            att::attn_body(QB + qrow * DM + hc * 64, KB + (size_t)b * KSEQ * DM + hc * 64, VB + (size_t)b * KSEQ * DM + (hc >> 1) * 128, OB + qrow * 2048 + hc * 128, 2048, CTXL, (char*)F.ldsg);
        }
    }
}
__device__ __forceinline__ void ph_attnfin(Frame& F0, int i, bool need_ctx) { Frame F = F0; LAUNDER(F);
    const int j = i >> 1; const float* lv = INP(I_LAM) + (size_t)j * 256; const float* sg = INP(I_SUBLN) + (size_t)j * 128;
    const float linit = (i == 1) ? 0.35550906759096934f : 0.5560582041556406f;
    const float d1 = wave_sum(lv[F.lane] * lv[64 + F.lane]), d2 = wave_sum(lv[128 + F.lane] * lv[192 + F.lane]);
    const float lam = expf(d1) - expf(d2) + linit;
    const float* OB = WSP(float, WS_OB); bf16* CAT = WSP(bf16, WS_CAT);
    const int nrows = need_ctx ? TT : TLAT;
    for (int row = F.gw; row < nrows; row += F.NGW) {
        const int h = F.lane >> 3, e0 = 16 * (F.lane & 7);
        const float* o0 = OB + (size_t)row * 2048 + (2 * h) * 128 + e0; const float* o1 = o0 + 128;
        float x[16]; float ss = 0.f;
#pragma unroll
        for (int q = 0; q < 4; ++q) { const f32x4 a = *(const f32x4*)(o0 + 4 * q), bb = *(const f32x4*)(o1 + 4 * q); const f32x4 d = a - bb * lam;
            x[4 * q] = d.x; x[4 * q + 1] = d.y; x[4 * q + 2] = d.z; x[4 * q + 3] = d.w; ss += (d.x * d.x + d.y * d.y) + (d.z * d.z + d.w * d.w); }
        ss = sum8_f(ss);
        const float sc = (1.0f - linit) / sqrtf(ss * (1.0f / 128.0f) + 1e-5f);
#pragma unroll
        for (int q = 0; q < 16; ++q) x[q] = x[q] * sc * sg[e0 + q];
#ifdef ABL_ATT
#pragma unroll
        for (int q = 0; q < 16; ++q) x[q] = 0.f;
#endif
        v4u w0, w1; w0.x = pk2(x[0], x[1]); w0.y = pk2(x[2], x[3]); w0.z = pk2(x[4], x[5]); w0.w = pk2(x[6], x[7]); w1.x = pk2(x[8], x[9]); w1.y = pk2(x[10], x[11]); w1.z = pk2(x[12], x[13]); w1.w = pk2(x[14], x[15]);
        bf16* dst = CAT + (size_t)row * DM + h * 128 + e0;
        *(v4u*)dst = w0; *(v4u*)(dst + 8) = w1;
    }
}
#ifdef DBG_MOE
__device__ __forceinline__ void ph_debug_moe(Frame& F0, int i) { Frame F = F0; LAUNDER(F);
    LAS float* xs = (LAS float*)F.lds; LAS float* hs = xs + 1024; LAS float* red = hs + 1024;
    unsigned* dbg = (unsigned*)(F.ws + WS_CTL) + 100;
    for (int s = F.vcu; s < 64; s += F.G) {
        const int e = s & 15, slot = (s * 37) % 2176; const int r = e * EROWS + slot;
        const int tok = WSP(int, WS_IDX)[r]; const float gate = WSP(float, WS_GATE)[r];
        const bf16* hrow = WSP(bf16, WS_HA) + (size_t)tok * DM;
        __syncthreads();
        for (int k = F.tid; k < 1024; k += NTHR) xs[k] = bf2f(hrow[k]);
        __syncthreads();
        const float* w1 = INP(I_MW1) + ((size_t)i * NE + e) * DM * FF; const float* w3 = INP(I_MW3) + ((size_t)i * NE + e) * DM * FF; const float* w2 = INP(I_MW2) + ((size_t)i * NE + e) * FF * DM;
        for (int f = F.tid; f < 1024; f += NTHR) { float a = 0.f, b = 0.f; for (int k = 0; k < 1024; ++k) { a += xs[k] * w1[(size_t)k * FF + f]; b += xs[k] * w3[(size_t)k * FF + f]; }
            hs[f] = a / (1.0f + __expf(-a)) * b; }
        __syncthreads();
        float num = 0.f, den = 0.f;
        for (int d = F.tid; d < 1024; d += NTHR) { float y = 0.f; for (int f = 0; f < 1024; ++f) y += hs[f] * w2[(size_t)f * DM + d]; y *= gate;
            const float yk = bf2f(WSP(bf16, WS_YB)[(size_t)r * DM + d]); num += (y - yk) * (y - yk); den += y * y; }
        num = block_sum(F, num, red); den = block_sum(F, den, red + 8);
        const float rel = sqrtf(num / fmaxf(den, 1e-30f));
        if (F.tid == 0) atomicMax(dbg, __builtin_bit_cast(unsigned, rel));
        if (s < 64) {
            const int set = s >> 4; const int rbase = set * SEQ; int cnt = 0; float mn_sel = 1e30f, mx_uns = -1e30f;
            for (int l = F.tid; l < SEQ; l += NTHR) { const int sl = WSP(int, WS_SLOT)[(size_t)(rbase + l) * 16 + e]; const float a = WSP(float, WS_AFF)[(size_t)(rbase + l) * 16 + e];
                if (sl >= 0) { ++cnt; mn_sel = fminf(mn_sel, a); if (sl >= 512 || WSP(int, WS_IDX)[e * EROWS + set * 512 + sl] != rbase + l) atomicAdd(dbg + 1, 1u); } else mx_uns = fmaxf(mx_uns, a); }
            const float tc = block_sum(F, (float)cnt, red);
            float a1 = -mn_sel, a2 = mx_uns;
#pragma unroll
            for (int o = 1; o < 64; o <<= 1) { a1 = fmaxf(a1, __shfl_xor(a1, o)); a2 = fmaxf(a2, __shfl_xor(a2, o)); }
            __syncthreads(); if (F.lane == 0) { red[F.wave] = a1; red[8 + F.wave] = a2; } __syncthreads();
            float m1 = red[0], m2 = red[8];
            for (int w = 1; w < 8; ++w) { m1 = fmaxf(m1, red[w]); m2 = fmaxf(m2, red[8 + w]); }
            if (F.tid == 0) { if ((int)tc != 512) atomicAdd(dbg + 2, 1u); if (-m1 < m2) atomicAdd(dbg + 3, 1u); atomicAdd(dbg + 4, (unsigned)(int)tc); }
        }
    }
}
#endif
__device__ __forceinline__ void ph_debug_out(Frame& F0) { Frame F = F0; LAUNDER(F);
    const unsigned* dbg = (const unsigned*)(F.ws + WS_CTL) + 100;
    const float e1 = __builtin_bit_cast(float, dbg[0]); const unsigned v2 = dbg[1];
#ifdef DBG_SEL2
    const float d1 = 1.0f + (float)dbg[2] + 100.0f * (float)dbg[3];
#elif defined(DBG_SEL3)
    const float d1 = (float)dbg[4] / 64.0f / 16.0f;
#else
    const float d1 = 1.0f + 10.0f * fminf(e1, 3.0f);
#endif
    float d2 = 10.0f + (float)v2 * 0.1f; d2 = fminf(d2, 900.f);
    for (size_t idx = (size_t)F.gw * 64 + F.lane; idx < (size_t)TLAT * DM; idx += (size_t)F.NGW * 64) F.out[idx] = idx == 0 ? d2 : d1;
}
constexpr int PH_PER_LAYER = 13, N_PHASES = 3 + DEPTH * PH_PER_LAYER;
#ifndef PH_MASK
#define PH_MASK 0xFFFFFFFFu
#endif
#define PK_ON(k) ((PH_MASK >> (k)) & 1u)

__device__ __forceinline__ bool phase_is_nop(int ph) {
    if (ph < 3) return false; const int i = (ph - 3) / PH_PER_LAYER, p = (ph - 3) % PH_PER_LAYER; return p == 4 || p == 9 || ((i & 1) && (p == 1 || p == 5));
}

__device__ __forceinline__ int phase_kind(int ph) {
    if (ph < 3) return ph;
    const int i = (ph - 3) / PH_PER_LAYER, p = (ph - 3) % PH_PER_LAYER; const bool even = !(i & 1);
    switch (p) { case 0: return even ? 3 : 4; case 1: return even ? 5 : 6; case 2: return even ? 7 : 8; case 3: return even ? 9 : 10; case 4: return 11; case 5: return 12; case 6: return 13;
                 case 7: return 14; case 8: return 15; case 9: return 16; case 10: return 17; case 11: return 18; default: return 19; }
}
#ifndef PROBE_MASK
#define PROBE_MASK 0u
#endif
#ifndef PROBE_DIV
#define PROBE_DIV 100.0f
#endif
__global__ void __launch_bounds__(NTHR, 2) mega_fwd(Args args) {
    extern __shared__ __attribute__((aligned(16))) unsigned char lds[];
    Frame F;
    F.lds = (LAS unsigned char*)lds; F.ldsg = lds;
    F.MISC = (volatile LAS unsigned*)(F.lds + LDSCTL_OFF + 320);
    F.tid = threadIdx.x; F.lane = F.tid & 63; F.wave = __builtin_amdgcn_readfirstlane(F.tid >> 6);
    F.G = gridDim.x; { const int bx = blockIdx.x; F.vcu = (F.G % 8 == 0) ? (bx % 8) * (F.G / 8) + bx / 8 : bx; }
    F.gw = F.vcu * NWAVES + F.wave; F.NGW = F.G * NWAVES;
    F.tprobe = 0ull;
    F.in = (const GAS float* const __attribute__((address_space(4)))*)__builtin_amdgcn_kernarg_segment_ptr();
    F.ws = (GAS unsigned char*)args.ws; F.out = (GAS float*)args.out;
    for (int u = F.tid; u < (LDS_BYTES - LDSCTL_OFF) / 4; u += NTHR) ((LAS unsigned*)(F.lds + LDSCTL_OFF))[u] = 0u;
    __syncthreads();
    XcdBarrier bar; bar.bar = (unsigned*)(F.ws + WS_CTL) + CW_BAR; bar.x = 0; bar.st = nullptr;
    const int lo = args.ph_lo, hi = args.ph_hi;
    if (hi - lo > 1) bar = xcd_barrier_post((unsigned*)(F.ws + WS_CTL) + CW_BAR, F.MISC + 8);

    Frame F0 = F;
    unsigned long long t_prev = 0ull, t_acc = 0ull;
    if (PROBE_MASK) t_prev = __builtin_amdgcn_s_memrealtime();
    for (int ph = lo; ph < hi; ++ph) {
        if (phase_is_nop(ph)) continue;
        Frame F = F0; LAUNDER(F);
#ifdef DBG_MOE
        if (ph == 1000) { ph_debug_moe(F, 0); VM_WAIT(); continue; }
        if (ph == 1001) { ph_debug_out(F); VM_WAIT(); continue; }
#endif
        if (ph == 0) { if (PK_ON(0)) ph_prologue(F); }
        else if (ph == 1) { if (PK_ON(1)) ph_modred(F); }
        else if (ph == 2) { if (PK_ON(2)) ph_mod0(F); }
        else {
            const int i = (ph - 3) / PH_PER_LAYER, p = (ph - 3) % PH_PER_LAYER, j = i >> 1; const bool even = !(i & 1), need_ctx = i < DEPTH - 1;
            if (p == 0) {
                if (even) { if (PK_ON(3)) { pg8::Gemm g{WSP(bf16, WS_HA), WSP(bf16, WS_WIN) + (size_t)j * EVCP * DM, TT, EVCP, DM, nullptr}; pg8::StaticOrder S; S.init(TT, EVCP, F.G, (int)blockIdx.x);
                    pg8::EpiF32 E{WSP(float, WS_P), EVCP}; pg8::gemm_phase<pg8::EpiF32, pg8::StaticOrder, true, true>(F.lds, g, S, E); } }
                else if (PK_ON(4)) { pg8::Gemm g{WSP(bf16, WS_HA), WSP(bf16, WS_WQKV) + (size_t)j * QKVC * DM, TT, QKVC, DM, nullptr}; pg8::StaticOrder S; S.init(TT, QKVC, F.G, (int)blockIdx.x);
                    pg8::EpiQKV E{WSP(bf16, WS_QB), WSP(bf16, WS_KB), WSP(bf16, WS_VB)}; pg8::gemm_phase<pg8::EpiQKV, pg8::StaticOrder, true, true>(F.lds, g, S, E); }
            } else if (p == 1) { if (even) { if (PK_ON(5)) ph_evprep(F, j); } else {   } }
            else if (p == 2) { if (even) { if (PK_ON(7)) ph_chunkprep(F, j); } else { if (PK_ON(8)) ph_attn(F, need_ctx); } }
            else if (p == 3) { if (even) { if (PK_ON(9)) ph_scan_hyena(F, j, i); } else { if (PK_ON(10)) ph_attnfin(F, i, need_ctx); } }
            else if (p == 4) {   }
            else if (p == 5) { if (PK_ON(12)) ph_readout(F, j); }
            else if (p == 6) { if (PK_ON(13)) {
                pg8::Gemm g{WSP(bf16, WS_CAT), (even ? WSP(bf16, WS_WOE) : WSP(bf16, WS_WOD)) + (size_t)j * DM * DM, need_ctx ? TT : TLAT, DM, DM, nullptr}; pg8::StaticOrder S; S.init(need_ctx ? TT : TLAT, DM, F.G, (int)blockIdx.x);
                pg8::EpiResGate E{WSP(float, WS_X), WSP(float, WS_MODS) + (size_t)i * 5 * 6144}; pg8::gemm_phase<pg8::EpiResGate, pg8::StaticOrder, true, true>(F.lds, g, S, E); }
            } else if (p == 7) { if (PK_ON(14)) ph_mod2(F, i); }
            else if (p == 8) { if (PK_ON(15)) ph_topk(F, i); }
            else if (p == 9) {   }
            else if (p == 10) { if (PK_ON(17)) {
                pg8::Gemm g{WSP(bf16, WS_HA), WSP(bf16, WS_W13), NE * EROWS, NE * 2048, DM, WSP(int, WS_IDX)};     pg8::MoeOrder S{F.G, (int)blockIdx.x, 8, need_ctx ? 9 : 8};
                pg8::EpiSwiGLU E{WSP(bf16, WS_HB)}; pg8::gemm_phase<pg8::EpiSwiGLU, pg8::MoeOrder, true, true, true>(F.lds, g, S, E); }
            } else if (p == 11) { if (PK_ON(18)) {
                pg8::Gemm g{WSP(bf16, WS_HB), WSP(bf16, WS_W2), NE * EROWS, NE * 1024, FF, nullptr}; pg8::MoeOrder S{F.G, (int)blockIdx.x, 4, need_ctx ? 9 : 8};
                pg8::EpiGateBf16 E{WSP(bf16, WS_YB), WSP(float, WS_GATE)}; pg8::gemm_phase<pg8::EpiGateBf16, pg8::MoeOrder, true, true>(F.lds, g, S, E); }
            } else { if (PK_ON(19)) ph_combine(F, i); }
        }
        if (PROBE_SUB) F0.tprobe = F.tprobe;
        if (ph + 1 < hi) xcd_barrier(bar); else { VM_WAIT(); }
        if (PROBE_MASK) { const unsigned long long t_now = __builtin_amdgcn_s_memrealtime(); if ((PROBE_MASK >> phase_kind(ph)) & 1u) t_acc += t_now - t_prev; t_prev = t_now; }
    }
    if (PROBE_MASK) { if (blockIdx.x == 0 && threadIdx.x == 0 && hi == N_PHASES) { const float us = (float)(PROBE_SUB ? F0.tprobe : t_acc) * 0.01f; F0.out[0] += 2.0f + us / PROBE_DIV; } }
}

extern "C" void kernel_launch(void* const* d_in, const int* in_sizes, int n_in, void* d_out, int out_size, void* d_ws, size_t ws_size, hipStream_t stream) {
    static int grid = 0;
    if (grid == 0) {
        if (n_in != N_IN || out_size != TLAT * DM || ws_size < WS_END) { fprintf(stderr, "kernel_launch: unexpected shapes: n_in %d out %d ws %zu (need %zu)\n", n_in, out_size, ws_size, (size_t)WS_END); grid = -1; return; }
        int dev = 0, cus = 0, per_cu = 0;
        if (hipGetDevice(&dev) != hipSuccess || hipDeviceGetAttribute(&cus, hipDeviceAttributeMultiprocessorCount, dev) != hipSuccess) { grid = -1; return; }
        if (hipFuncSetAttribute((const void*)mega_fwd, hipFuncAttributeMaxDynamicSharedMemorySize, LDS_BYTES) != hipSuccess) { fprintf(stderr, "kernel_launch: hipFuncSetAttribute failed\n"); grid = -1; return; }
        if (hipOccupancyMaxActiveBlocksPerMultiprocessor(&per_cu, (const void*)mega_fwd, NTHR, LDS_BYTES) != hipSuccess || per_cu < 1) fprintf(stderr, "kernel_launch: occupancy query reports %d\n", per_cu);
        (void)hipGetLastError();
        grid = cus;
    }
    if (grid < 0) return;
    if (hipMemsetAsync((char*)d_ws + WS_CTL, 0, CTL_ZERO_BYTES, stream) != hipSuccess) { fprintf(stderr, "kernel_launch: memset failed\n"); return; }
    Args a{};
    for (int i = 0; i < N_IN; ++i) a.in[i] = (const float*)d_in[i];
    a.out = (float*)d_out; a.ws = (unsigned char*)d_ws;
#if MK_PER_PHASE
    for (int ph = 0; ph < N_PHASES; ++ph) {
#ifdef DBG_MOE
        if (ph == 3 + 12) { a.ph_lo = 1000; a.ph_hi = 1001; hipLaunchKernelGGL(mega_fwd, dim3(grid), dim3(NTHR), LDS_BYTES, stream, a); a.ph_lo = 1001; a.ph_hi = 1002; hipLaunchKernelGGL(mega_fwd, dim3(grid), dim3(NTHR), LDS_BYTES, stream, a); break; }
#endif
        if ((ph >= 3) && ((((ph - 3) % PH_PER_LAYER) == 4) || (((ph - 3) % PH_PER_LAYER) == 9) || ((((ph - 3) / PH_PER_LAYER) & 1) && (((ph - 3) % PH_PER_LAYER) == 1 || ((ph - 3) % PH_PER_LAYER) == 5)))) continue;
        a.ph_lo = ph; a.ph_hi = ph + 1;
        hipLaunchKernelGGL(mega_fwd, dim3(grid), dim3(NTHR), LDS_BYTES, stream, a);
    }
#else
    a.ph_lo = 0; a.ph_hi = N_PHASES;
    hipLaunchKernelGGL(mega_fwd, dim3(grid), dim3(NTHR), LDS_BYTES, stream, a);
#endif
    const hipError_t le = hipPeekAtLastError();
    if (le != hipSuccess) fprintf(stderr, "kernel_launch: launch failed: %s\n", hipGetErrorName(le));
}
```

```cpp
#define MK_PER_PHASE 0
#include <hip/hip_runtime.h>
#include <cstdio>
#include <cstdint>
#include <cmath>

#ifndef MK_PER_PHASE
#define MK_PER_PHASE 0
#endif

#define GAS __attribute__((address_space(1)))
#define LAS __attribute__((address_space(3)))
typedef unsigned short bf16;
typedef unsigned v4u __attribute__((ext_vector_type(4)));
typedef unsigned v2u __attribute__((ext_vector_type(2)));
typedef float f32x4 __attribute__((ext_vector_type(4)));
typedef float f32x2 __attribute__((ext_vector_type(2)));
typedef short bf16x8 __attribute__((ext_vector_type(8)));

constexpr int DM = 1024, NB = 4, SEQ = 4096, CTXL = 256, DEPTH = 4;
constexpr int TLAT = NB * SEQ, TCTX = NB * CTXL, TT = TLAT + TCTX;
constexpr int RWC = 1760, HYC = 1536, EVC = RWC + HYC, EVCP = 3328;
constexpr int RWW = 512, NH = 8, HD = 64;
constexpr int QKVC = 3072;
constexpr int NE = 16, FF = 1024, EROWS = 2304;
constexpr int NMOD = 6;
constexpr int KSEQ = CTXL + SEQ;

enum { I_X = 0, I_C, I_CTX, I_CCTX, I_ADAW, I_ADAB, I_NORMG, I_FINALG, I_EVWIN, I_EVWOUT, I_MU, I_W0, I_W2, I_A0, I_A2, I_G2, I_KK, I_KA, I_RK, I_GN,
       I_CONVW, I_CONVB, I_FW1, I_FB1, I_FW2, I_FB2, I_FW3, I_FREQ, I_HYB, I_WQKV, I_DAWOUT, I_LAM, I_SUBLN, I_ROUTER, I_MW1, I_MW3, I_MW2, N_IN };

struct Args { const float* in[N_IN]; float* out; unsigned char* ws; int ph_lo, ph_hi; };
static_assert(__builtin_offsetof(Args, in) == 0, "Args::in must be first");

constexpr size_t MiB = 1u << 20;
constexpr size_t WS_CTL = 0, CTL_ZERO_BYTES = 64 * 1024;
constexpr size_t WS_MODP = 384 * MiB;
constexpr size_t WS_MODS = 5 * MiB;
constexpr size_t WS_TW = 6 * MiB;
constexpr size_t WS_FRAGB = 7 * MiB;
constexpr size_t WS_AFF = 8 * MiB;
constexpr size_t WS_SLOT = 10 * MiB;
constexpr size_t WS_IDX = 12 * MiB;
constexpr size_t WS_GATE = 12 * MiB + 512 * 1024;
constexpr size_t WS_WIN = 16 * MiB;
constexpr size_t WS_WOE = 30 * MiB;
constexpr size_t WS_WQKV = 34 * MiB;
constexpr size_t WS_WOD = 46 * MiB;
constexpr size_t WS_W13 = 50 * MiB;
constexpr size_t WS_W2 = 114 * MiB;
constexpr size_t WS_UTL = 50 * MiB;
constexpr size_t WS_X = 146 * MiB;
constexpr size_t WS_HA = 214 * MiB;
constexpr size_t WS_CAT = 248 * MiB;
constexpr size_t WS_KSPL = 282 * MiB;
constexpr size_t WS_KSPC = 346 * MiB;
constexpr size_t WS_BIG = 384 * MiB;
constexpr size_t WS_P = WS_BIG;
constexpr size_t REC_BYTES = 12 * 1024;
constexpr size_t WS_REC = WS_BIG;
constexpr size_t WS_RW = WS_BIG + 340 * MiB;
constexpr size_t RW_STRIDE = 34 * MiB;
constexpr size_t WS_AOP = WS_BIG + 476 * MiB;
constexpr size_t WS_G = WS_BIG + 484 * MiB;
constexpr size_t WS_KCL = WS_BIG + 518 * MiB;
constexpr size_t WS_KCC = WS_BIG + 550 * MiB;
constexpr size_t WS_UTC = WS_BIG + 552 * MiB;
constexpr size_t WS_BON = WS_BIG + 558 * MiB;
constexpr size_t WS_Y = WS_BIG + 559 * MiB;
constexpr size_t WS_HYTL = WS_RW + 1 * RW_STRIDE;
constexpr size_t WS_HYTC = WS_RW + 3 * RW_STRIDE;
static_assert(WS_Y + 68 * MiB <= 1024 * MiB && 64 * 272 * REC_BYTES <= 340 * MiB, "ws map");
constexpr size_t WS_QB = WS_BIG + 204 * MiB;
constexpr size_t WS_KB = WS_QB + 34 * MiB;
constexpr size_t WS_VB = WS_KB + 34 * MiB;
constexpr size_t WS_OB = WS_VB + 34 * MiB;
static_assert(WS_OB + 136 * MiB <= 1024 * MiB, "ws map");
constexpr size_t WS_XG = WS_BIG;
constexpr size_t WS_HB = WS_BIG + 72 * MiB;
constexpr size_t WS_YB = WS_BIG + 144 * MiB;
constexpr size_t WS_END = 1024 * MiB;

constexpr int CW_BAR = 4096;

constexpr int RING_BYTES = 143360;
constexpr int LDSCTL_OFF = RING_BYTES;
constexpr int LDS_BYTES = 147456;
constexpr int NWAVES = 8, NTHR = 512;

__device__ __forceinline__ unsigned f2bf(float f) { unsigned u = __builtin_bit_cast(unsigned, f); return (u + 0x7fffu + ((u >> 16) & 1u)) >> 16; }
__device__ __forceinline__ unsigned pk2(float lo, float hi) { return f2bf(lo) | (f2bf(hi) << 16); }
__device__ __forceinline__ float bf2f(unsigned short h) { return __builtin_bit_cast(float, ((unsigned)h) << 16); }
template <int CTRL> __device__ __forceinline__ float dpp_f(float x) { return __builtin_bit_cast(float, __builtin_amdgcn_update_dpp(0, __builtin_bit_cast(int, x), CTRL, 0xF, 0xF, true)); }
template <int CTRL> __device__ __forceinline__ int dpp_i(int x) { return __builtin_amdgcn_update_dpp(0, x, CTRL, 0xF, 0xF, true); }
#define DPP_XOR1 0xB1
#define DPP_XOR2 0x4E
#define DPP_HMIRROR 0x141
#define DPP_MIRROR 0x140
__device__ __forceinline__ float xor1_f(float x) { return dpp_f<DPP_XOR1>(x); }
__device__ __forceinline__ float sum4_f(float x) { x += dpp_f<DPP_XOR1>(x); x += dpp_f<DPP_XOR2>(x); return x; }
__device__ __forceinline__ float sum8_f(float x) { x = sum4_f(x); x += dpp_f<DPP_HMIRROR>(x); return x; }
__device__ __forceinline__ float sum16_f(float x) { x = sum8_f(x); x += dpp_f<DPP_MIRROR>(x); return x; }
__device__ __forceinline__ float max16_f(float x) { x = fmaxf(x, dpp_f<DPP_XOR1>(x)); x = fmaxf(x, dpp_f<DPP_XOR2>(x)); x = fmaxf(x, dpp_f<DPP_HMIRROR>(x)); x = fmaxf(x, dpp_f<DPP_MIRROR>(x)); return x; }
__device__ __forceinline__ float wave_sum(float v) {
    v = sum16_f(v);
    v += __builtin_bit_cast(float, __builtin_amdgcn_ds_swizzle(__builtin_bit_cast(int, v), 0x401F));
    { auto rr = __builtin_amdgcn_permlane32_swap(__float_as_uint(v), __float_as_uint(v), false, false); const unsigned lo_ = rr[0], hi_ = rr[1];
      v = __uint_as_float(lo_) + __uint_as_float(hi_); }
    return v;
}
__device__ __forceinline__ int wave_sum_i(int v) {
    v += dpp_i<DPP_XOR1>(v); v += dpp_i<DPP_XOR2>(v); v += dpp_i<DPP_HMIRROR>(v); v += dpp_i<DPP_MIRROR>(v);
    v += __builtin_amdgcn_ds_swizzle(v, 0x401F);
    { auto rr = __builtin_amdgcn_permlane32_swap((unsigned)v, (unsigned)v, false, false); v = (int)rr[0] + (int)rr[1]; }
    return v;
}
__device__ __forceinline__ float sigmoidf_(float x) { return 1.0f / (1.0f + __expf(-x)); }
__device__ __forceinline__ float siluf_(float x) { return x / (1.0f + __expf(-x)); }
#define LDS_WAIT() asm volatile("s_waitcnt lgkmcnt(0)" ::: "memory")
#define VM_WAIT() asm volatile("s_waitcnt vmcnt(0)" ::: "memory")

namespace pg8 {
#define PG8_LAS __attribute__((address_space(3)))
typedef unsigned short bf16_t;
typedef short bf16x8 __attribute__((ext_vector_type(8)));
typedef float f32x4 __attribute__((ext_vector_type(4)));
typedef unsigned u32x4 __attribute__((ext_vector_type(4)));
constexpr int BM = 256, BK = 64, HALF = 128, HTB = HALF * BK * 2  , STAGE_BYTES = 8 * HTB, NXCD = 8, WGM = 8;

__host__ __device__ __forceinline__ int lds_byte(int r, int c) { const int st = (r >> 4) * 2 + (c >> 5), rr = r & 15, cc = c & 31, ob = rr * 64 + cc * 2; return st * 1024 + (ob ^ (((ob >> 9) & 1) << 5)); }
__host__ __device__ __forceinline__ void stage_rc(int b, int& R, int& C) { const int st = b / 1024, sb = b % 1024, swz = sb ^ (((sb >> 9) & 1) << 5); R = (st >> 1) * 16 + swz / 64; C = (st & 1) * 32 + (swz % 64) / 2; }
__host__ __device__ __forceinline__ int perm32(int rho) { const int n = rho >> 4, i = rho & 15; return 8 * (i >> 2) + 4 * n + (i & 3); }

struct Unit { int pm, pn; };
struct Gemm { const bf16_t* A; const bf16_t* Bt; int M, N, K; const int* gidx; };

struct StaticOrder {
    int nM, nN, nwg, G, c;
    __host__ __device__ void init(int M, int N, int G_, int c_) { nM = M / BM; nN = N / BM; nwg = nM * nN; G = G_; c = c_; }
    __host__ __device__ bool next(int i, Unit& u) const {
        const long L = (long)i * G + c; if (L >= nwg) return false;
        int wgid = (int)L; { const int q = nwg / NXCD, r = nwg % NXCD, xcd = wgid % NXCD, off = wgid / NXCD; wgid = (xcd < r ? xcd * (q + 1) : r * (q + 1) + (xcd - r) * q) + off; }
        const int nig = WGM * nN, gid = wgid / nig, fm = gid * WGM, gsz = (nM - fm) < WGM ? (nM - fm) : WGM;
        u.pm = fm + ((wgid % nig) % gsz); u.pn = (wgid % nig) / gsz; return true;
    }
    __device__ __forceinline__ void a_ready(const Unit&) const {}
    __device__ __forceinline__ void done(const Unit&) const {}
};

__device__ __forceinline__ unsigned cvt_pk_bf16(float lo, float hi) { unsigned r; asm volatile("v_cvt_pk_bf16_f32 %0, %1, %2" : "=v"(r) : "v"(lo), "v"(hi)); return r; }
typedef float f32x2 __attribute__((ext_vector_type(2)));
typedef unsigned u32x2v __attribute__((ext_vector_type(2)));

struct EpiF32 {
    static constexpr bool PERM = false, AFTER_DRAIN = false;
    float* O; int ldc;
    __device__ __forceinline__ void operator()(const f32x4 (&acc)[2][2][4][2], const Unit& u, int wr, int wc, int fr, int fq) const {
        const int col0 = u.pn * BM + wc * 32 + 4 * fq;
#pragma unroll
        for (int ai = 0; ai < 2; ++ai)
#pragma unroll
            for (int m = 0; m < 4; ++m) { float* rowp = O + (size_t)(u.pm * BM + ai * HALF + wr * 64 + m * 16 + fr) * ldc + col0;
#pragma unroll
                for (int bj = 0; bj < 2; ++bj)
#pragma unroll
                    for (int n = 0; n < 2; ++n) *(f32x4*)(rowp + bj * HALF + n * 16) = acc[ai][bj][m][n]; }
    }
};
struct EpiBf16S {
    static constexpr bool PERM = false, AFTER_DRAIN = false;
    bf16_t* O; int ldc;
    __device__ __forceinline__ void operator()(const f32x4 (&acc)[2][2][4][2], const Unit& u, int wr, int wc, int fr, int fq) const {
        const int col0 = u.pn * BM + wc * 32 + 4 * fq;
#pragma unroll
        for (int ai = 0; ai < 2; ++ai)
#pragma unroll
            for (int m = 0; m < 4; ++m) { bf16_t* rowp = O + (size_t)(u.pm * BM + ai * HALF + wr * 64 + m * 16 + fr) * ldc + col0;
#pragma unroll
                for (int bj = 0; bj < 2; ++bj)
#pragma unroll
                    for (int n = 0; n < 2; ++n) { const f32x4 v = acc[ai][bj][m][n]; u32x2v w; w.x = cvt_pk_bf16(v[0], v[1]); w.y = cvt_pk_bf16(v[2], v[3]); *(u32x2v*)(rowp + bj * HALF + n * 16) = w; } }
    }
};
struct EpiEven {
    static constexpr bool PERM = false, AFTER_DRAIN = false;
    float* P; int ldc; float* UTL; float* UTC;
    __device__ __forceinline__ void operator()(const f32x4 (&acc)[2][2][4][2], const Unit& u, int wr, int wc, int fr, int fq) const {
        const int col0 = u.pn * BM + wc * 32 + 4 * fq;
#pragma unroll
        for (int ai = 0; ai < 2; ++ai)
#pragma unroll
            for (int m = 0; m < 4; ++m) { const int row = u.pm * BM + ai * HALF + wr * 64 + m * 16 + fr; const bool lat = row < 16384;
                float* rowp = P + (size_t)row * ldc + col0;
                float* tp = lat ? UTL + ((size_t)(row >> 12) * 1536) * 4096 + (row & 4095) : UTC + ((size_t)((row - 16384) >> 8) * 1536) * 256 + ((row - 16384) & 255);
                const size_t ts = lat ? 4096 : 256;
#pragma unroll
                for (int bj = 0; bj < 2; ++bj)
#pragma unroll
                    for (int n = 0; n < 2; ++n) { const int c = col0 + bj * HALF + n * 16; const f32x4 v = acc[ai][bj][m][n];
                        if (c < 1760) *(f32x4*)(rowp + bj * HALF + n * 16) = v;
                        else if (c < 3296) { float* t0 = tp + (size_t)(c - 1760) * ts; t0[0] = v[0]; t0[ts] = v[1]; t0[2 * ts] = v[2]; t0[3 * ts] = v[3]; } } }
    }
};
struct EpiResGate {
    static constexpr bool PERM = false, AFTER_DRAIN = false;
    float* X; const float* mods;
    __device__ __forceinline__ void operator()(const f32x4 (&acc)[2][2][4][2], const Unit& u, int wr, int wc, int fr, int fq) const {
        const int col0 = u.pn * BM + wc * 32 + 4 * fq;
#pragma unroll
        for (int ai = 0; ai < 2; ++ai)
#pragma unroll
            for (int m = 0; m < 4; ++m) { const int row = u.pm * BM + ai * HALF + wr * 64 + m * 16 + fr; const int s = row < 16384 ? (row >> 12) : 4;
                float* rowp = X + (size_t)row * 1024 + col0; const float* gp = mods + s * 6144 + 2048 + col0;
#pragma unroll
                for (int bj = 0; bj < 2; ++bj)
#pragma unroll
                    for (int n = 0; n < 2; ++n) { const f32x4 g = *(const f32x4*)(gp + bj * HALF + n * 16); f32x4 x = *(f32x4*)(rowp + bj * HALF + n * 16);
                        x = x + g * acc[ai][bj][m][n]; *(f32x4*)(rowp + bj * HALF + n * 16) = x; } }
    }
};
struct EpiSwiGLU {
    static constexpr bool PERM = false, AFTER_DRAIN = false;
    bf16_t* H;
    __device__ __forceinline__ void operator()(const f32x4 (&acc)[2][2][4][2], const Unit& u, int wr, int wc, int fr, int fq) const {
        const int nt = u.pn & 7; const int col0 = nt * 128 + wc * 32 + 4 * fq;
#pragma unroll
        for (int ai = 0; ai < 2; ++ai)
#pragma unroll
            for (int m = 0; m < 4; ++m) { bf16_t* rowp = H + (size_t)(u.pm * BM + ai * HALF + wr * 64 + m * 16 + fr) * 1024 + col0;
#pragma unroll
                for (int n = 0; n < 2; ++n) { const f32x4 a = acc[ai][0][m][n], b = acc[ai][1][m][n]; f32x4 h;
#pragma unroll
                    for (int j = 0; j < 4; ++j) h[j] = a[j] / (1.0f + __expf(-a[j])) * b[j];
                    u32x2v w; w.x = cvt_pk_bf16(h[0], h[1]); w.y = cvt_pk_bf16(h[2], h[3]); *(u32x2v*)(rowp + n * 16) = w; } }
    }
};
struct EpiGateBf16 {
    static constexpr bool PERM = false, AFTER_DRAIN = false;
    bf16_t* Y; const float* gate;
    __device__ __forceinline__ void operator()(const f32x4 (&acc)[2][2][4][2], const Unit& u, int wr, int wc, int fr, int fq) const {
        const int nt = u.pn & 3; const int col0 = nt * 256 + wc * 32 + 4 * fq;
#pragma unroll
        for (int ai = 0; ai < 2; ++ai)
#pragma unroll
            for (int m = 0; m < 4; ++m) { const int row = u.pm * BM + ai * HALF + wr * 64 + m * 16 + fr; const float g = gate[row]; bf16_t* rowp = Y + (size_t)row * 1024 + col0;
#pragma unroll
                for (int bj = 0; bj < 2; ++bj)
#pragma unroll
                    for (int n = 0; n < 2; ++n) { const f32x4 v = acc[ai][bj][m][n] * g; u32x2v w; w.x = cvt_pk_bf16(v[0], v[1]); w.y = cvt_pk_bf16(v[2], v[3]); *(u32x2v*)(rowp + bj * HALF + n * 16) = w; } }
    }
};
struct EpiQKV {
    static constexpr bool PERM = false, AFTER_DRAIN = false;
    bf16_t* Q; bf16_t* Kb; bf16_t* Vb;
    __device__ __forceinline__ void operator()(const f32x4 (&acc)[2][2][4][2], const Unit& u, int wr, int wc, int fr, int fq) const {
        const int part = u.pn >> 2; const int col0 = (u.pn & 3) * BM + wc * 32 + 4 * fq; const bool lat = u.pm < 64;
        float invf[4];
#pragma unroll
        for (int j = 0; j < 4; ++j) invf[j] = exp2f(-(float)(4 * fq + j) * (13.287712379549449f / 16.0f)) * 0.15915494309189535f;
#pragma unroll
        for (int ai = 0; ai < 2; ++ai)
#pragma unroll
            for (int m = 0; m < 4; ++m) {
                const int row = u.pm * BM + ai * HALF + wr * 64 + m * 16 + fr;
                const int b = lat ? (row >> 12) : ((row - 16384) >> 8); const int l = lat ? (row & 4095) : ((row - 16384) & 255);
                float cs[4], sn[4];
                if (part < 2 && lat) { const float pos = (float)((wc & 1) ? (l & 63) : (l >> 6));
#pragma unroll
                    for (int j = 0; j < 4; ++j) { const float rev = pos * invf[j]; const float fr_ = rev - floorf(rev); cs[j] = __builtin_amdgcn_cosf(fr_); sn[j] = __builtin_amdgcn_sinf(fr_); } }
                bf16_t* rowp = (part == 0 ? Q + (size_t)row * 1024 : (part == 1 ? Kb : Vb) + ((size_t)b * 4352 + (lat ? 256 + l : l)) * 1024) + col0;
#pragma unroll
                for (int bj = 0; bj < 2; ++bj) {
                    f32x4 x1 = acc[ai][bj][m][0], x2 = acc[ai][bj][m][1];
                    if (part < 2 && lat) {
#pragma unroll
                        for (int j = 0; j < 4; ++j) { const float a = x1[j], bb = x2[j]; x1[j] = a * cs[j] - bb * sn[j]; x2[j] = bb * cs[j] + a * sn[j]; } }
                    u32x2v w; w.x = cvt_pk_bf16(x1[0], x1[1]); w.y = cvt_pk_bf16(x1[2], x1[3]); *(u32x2v*)(rowp + bj * HALF) = w;
                    w.x = cvt_pk_bf16(x2[0], x2[1]); w.y = cvt_pk_bf16(x2[2], x2[3]); *(u32x2v*)(rowp + bj * HALF + 16) = w;
                }
            }
    }
};
struct MoeOrder {
    int G, c, ntn, nmt;
    __device__ __forceinline__ bool next(int i, Unit& u) const {
        const int L = i * G + c; const int per_e = nmt * ntn; if (L >= 16 * per_e) return false;
        const int e = L / per_e, r = L % per_e; u.pm = e * 9 + (r % nmt); u.pn = e * ntn + (r / nmt); return true;
    }
    __device__ __forceinline__ void a_ready(const Unit&) const {}
    __device__ __forceinline__ void done(const Unit&) const {}
};
template <class Epi, class Sched, bool ALIGN_EPI = false, bool SP2 = false, bool GATHER = false>
__device__ __forceinline__ void gemm_phase(PG8_LAS unsigned char* lds, const Gemm g, const Sched& S, const Epi& E) {
    int tid_ = threadIdx.x; asm volatile("" : "+v"(tid_));
    const int tid = tid_, wid = __builtin_amdgcn_readfirstlane(tid >> 6), lane = tid & 63, wr = wid >> 2, wc = wid & 3, fr = lane & 15, fq = lane >> 4;
    const int K = g.K, nt = K / BK;
    unsigned voffA[2], voffB[2];
#pragma unroll
    for (int i = 0; i < 2; ++i) { int R, C; stage_rc(tid * 16 + i * 8192, R, C); const int Rb = Epi::PERM ? ((R & ~31) + perm32(R & 31)) : R;
        voffA[i] = (unsigned)(R * K + C) * 2u; voffB[i] = (unsigned)(Rb * K + C) * 2u; }
    unsigned vA0[2] = {0u, 0u}, vA1[2] = {0u, 0u}, nvA0[2] = {0u, 0u}, nvA1[2] = {0u, 0u};
#define PG8_GOFF(dst0, dst1, unit) do { _Pragma("unroll") for (int i_ = 0; i_ < 2; ++i_) { int R_, C_; stage_rc(tid * 16 + i_ * 8192, R_, C_); \
        dst0[i_] = (unsigned)g.gidx[(unit).pm * BM + R_] * (unsigned)(K * 2) + (unsigned)(C_ * 2); dst1[i_] = (unsigned)g.gidx[(unit).pm * BM + HALF + R_] * (unsigned)(K * 2) + (unsigned)(C_ * 2); } } while (0)
    const size_t kstep = (size_t)(BK * 2);
    const size_t hstep = (size_t)HALF * K * 2;
    const size_t tstep = 2 * hstep;
    const unsigned ldsw = (unsigned)wid * 1024u;
    const int aoff = lds_byte(wr * 64 + fr, fq * 8), boff = lds_byte(wc * 32 + fr, fq * 8);
#define PG8_SA(b, h) (((b) * 2 + (h)) * HTB)
#define PG8_SB(b, h) ((4 + (b) * 2 + (h)) * HTB)
#define PG8_STAGE(bufoff, gbase, voff) do { _Pragma("unroll") for (int _i = 0; _i < 2; ++_i) \
        __builtin_amdgcn_global_load_lds((const unsigned*)((const char*)(gbase) + (voff)[_i]), (PG8_LAS unsigned*)(lds + (bufoff) + ldsw + _i * 8192), 16, 0, 0); } while (0)
#define PG8_STAGE_AC(bufoff, kptr, half) do { if constexpr (GATHER) { if (half) PG8_STAGE(bufoff, kptr, vA1); else PG8_STAGE(bufoff, kptr, vA0); } else PG8_STAGE(bufoff, (kptr) + (half) * hstep, voffA); } while (0)
#define PG8_STAGE_AX(bufoff, kptr, half) do { if constexpr (GATHER) { unsigned s_[2]; _Pragma("unroll") for (int i_ = 0; i_ < 2; ++i_) s_[i_] = last ? ((half) ? nvA1[i_] : nvA0[i_]) : ((half) ? vA1[i_] : vA0[i_]); PG8_STAGE(bufoff, kptr, s_); } \
        else PG8_STAGE(bufoff, (kptr) + (half) * hstep, voffA); } while (0)
#define PG8_LDA(dst, b, h) do { _Pragma("unroll") for (int m = 0; m < 4; ++m) _Pragma("unroll") for (int k = 0; k < 2; ++k) dst[m][k] = *(const PG8_LAS bf16x8*)(lds + PG8_SA(b, h) + aoff + m * 2048 + k * 1024); } while (0)
#define PG8_LDB(dst, b, h) do { _Pragma("unroll") for (int n = 0; n < 2; ++n) _Pragma("unroll") for (int k = 0; k < 2; ++k) dst[n][k] = *(const PG8_LAS bf16x8*)(lds + PG8_SB(b, h) + boff + n * 2048 + k * 1024); } while (0)
#define PG8_MMA(ai, bj, At, Bt) do { __builtin_amdgcn_s_setprio(1); _Pragma("unroll") for (int m = 0; m < 4; ++m) _Pragma("unroll") for (int n = 0; n < 2; ++n) _Pragma("unroll") for (int k = 0; k < 2; ++k) \
        acc[ai][bj][m][n] = __builtin_amdgcn_mfma_f32_16x16x32_bf16(Bt[n][k], At[m][k], acc[ai][bj][m][n], 0, 0, 0); __builtin_amdgcn_s_setprio(0); } while (0)
#define PG8_WAIT_V(n) asm volatile("s_waitcnt vmcnt(" #n ")" ::: "memory")
#define PG8_WAIT_L(n) asm volatile("s_waitcnt lgkmcnt(" #n ")" ::: "memory")
#define PG8_BAR __builtin_amdgcn_s_barrier()
#define PG8_SCHED __builtin_amdgcn_sched_barrier(0)
    Unit cur, nxt; int ui = 0;
    if (!S.next(0, cur)) return;
    f32x4 acc[2][2][4][2];
#pragma unroll
    for (int a = 0; a < 2; ++a)
#pragma unroll
        for (int b = 0; b < 2; ++b)
#pragma unroll
            for (int m = 0; m < 4; ++m)
#pragma unroll
                for (int n = 0; n < 2; ++n) acc[a][b][m][n] = (f32x4){0.f, 0.f, 0.f, 0.f};
    bf16x8 At[4][2], B0[2][2], B1[2][2];
    const char* cA = (const char*)g.A + (GATHER ? (size_t)0 : (size_t)cur.pm * tstep); const char* cB = (const char*)g.Bt + (size_t)cur.pn * tstep;
    if constexpr (GATHER) PG8_GOFF(vA0, vA1, cur);
    S.a_ready(cur);
    if constexpr (SP2) {
        PG8_STAGE(PG8_SB(0, 0), cB, voffB); PG8_STAGE(PG8_SB(0, 1), cB + hstep, voffB); PG8_STAGE_AC(PG8_SA(0, 0), cA, 0); PG8_STAGE_AC(PG8_SA(0, 1), cA, 1);
        if (wr == 1) PG8_BAR;
        PG8_WAIT_V(2); PG8_BAR;
        PG8_STAGE(PG8_SB(1, 0), cB + kstep, voffB); PG8_STAGE_AC(PG8_SA(1, 0), cA + kstep, 0); PG8_STAGE(PG8_SB(1, 1), cB + hstep + kstep, voffB);
        PG8_WAIT_V(6); PG8_BAR;
    } else {
        PG8_STAGE(PG8_SB(0, 0), cB, voffB); PG8_STAGE_AC(PG8_SA(0, 0), cA, 0); PG8_STAGE(PG8_SB(0, 1), cB + hstep, voffB); PG8_STAGE_AC(PG8_SA(0, 1), cA, 1);
        if (wr == 1) PG8_BAR;
        PG8_WAIT_V(4); PG8_BAR;
        PG8_STAGE(PG8_SB(1, 0), cB + kstep, voffB); PG8_STAGE_AC(PG8_SA(1, 0), cA + kstep, 0); PG8_STAGE(PG8_SB(1, 1), cB + hstep + kstep, voffB);
        PG8_WAIT_V(6); PG8_BAR;
    }
    for (;;) {
        const bool has_next = S.next(ui + 1, nxt);
        if constexpr (GATHER) { if (has_next) PG8_GOFF(nvA0, nvA1, nxt); else { nvA0[0] = vA0[0]; nvA0[1] = vA0[1]; nvA1[0] = vA1[0]; nvA1[1] = vA1[1]; } }
        const char* nA = (has_next && !GATHER) ? (const char*)g.A + (size_t)nxt.pm * tstep : cA; const char* nB = has_next ? (const char*)g.Bt + (size_t)nxt.pn * tstep : cB;
        for (int t = 0; t < nt; t += 2) {
            const bool last = (t == nt - 2);
            const char* a1 = cA + (size_t)(t + 1) * kstep;
            const char* a2 = last ? nA : cA + (size_t)(t + 2) * kstep; const char* b2 = last ? nB : cB + (size_t)(t + 2) * kstep;
            const char* a3 = a2 + kstep; const char* b3 = b2 + kstep;
            if (last && has_next) S.a_ready(nxt);
            if constexpr (SP2) {
            PG8_LDB(B0, 0, 0); PG8_LDB(B1, 0, 1); PG8_SCHED; PG8_LDA(At, 0, 0); PG8_STAGE_AC(PG8_SA(1, 1), a1, 1);
            PG8_WAIT_V(8); PG8_WAIT_L(0); PG8_BAR; PG8_MMA(0, 0, At, B0); PG8_MMA(0, 1, At, B1); PG8_BAR; PG8_SCHED;
            PG8_LDA(At, 0, 1); PG8_STAGE(PG8_SB(0, 0), b2, voffB); PG8_STAGE(PG8_SB(0, 1), b2 + hstep, voffB); PG8_STAGE_AX(PG8_SA(0, 0), a2, 0);
            PG8_WAIT_V(8); PG8_WAIT_L(0); PG8_BAR; PG8_MMA(1, 0, At, B0); PG8_MMA(1, 1, At, B1); PG8_BAR; PG8_SCHED;
            PG8_LDB(B0, 1, 0); PG8_LDB(B1, 1, 1); PG8_SCHED; PG8_LDA(At, 1, 0); PG8_STAGE_AX(PG8_SA(0, 1), a2, 1);
            PG8_WAIT_V(8); PG8_WAIT_L(0); PG8_BAR; PG8_MMA(0, 0, At, B0); PG8_MMA(0, 1, At, B1); PG8_BAR; PG8_SCHED;
            PG8_LDA(At, 1, 1); PG8_STAGE(PG8_SB(1, 0), b3, voffB); PG8_STAGE(PG8_SB(1, 1), b3 + hstep, voffB); PG8_STAGE_AX(PG8_SA(1, 0), a3, 0);
            PG8_WAIT_V(8); PG8_WAIT_L(0); PG8_BAR; PG8_MMA(1, 0, At, B0); PG8_MMA(1, 1, At, B1); PG8_BAR; PG8_SCHED;
            } else {
            PG8_LDB(B0, 0, 0); PG8_SCHED; PG8_LDA(At, 0, 0); PG8_STAGE_AC(PG8_SA(1, 1), a1, 1);
            PG8_WAIT_L(8); PG8_BAR; PG8_WAIT_L(0); PG8_MMA(0, 0, At, B0); PG8_BAR; PG8_SCHED;
            PG8_LDB(B1, 0, 1); PG8_STAGE(PG8_SB(0, 0), b2, voffB);
            PG8_BAR; PG8_WAIT_L(0); PG8_MMA(0, 1, At, B1); PG8_BAR;
            PG8_LDA(At, 0, 1); PG8_STAGE_AX(PG8_SA(0, 0), a2, 0);
            PG8_BAR; PG8_WAIT_L(0); PG8_MMA(1, 0, At, B0); PG8_BAR; PG8_SCHED;
            PG8_STAGE(PG8_SB(0, 1), b2 + hstep, voffB);
            PG8_WAIT_V(6); PG8_BAR; PG8_MMA(1, 1, At, B1); PG8_BAR;
            PG8_LDB(B0, 1, 0); PG8_SCHED; PG8_LDA(At, 1, 0); PG8_STAGE_AX(PG8_SA(0, 1), a2, 1);
            PG8_WAIT_L(8); PG8_BAR; PG8_WAIT_L(0); PG8_MMA(0, 0, At, B0); PG8_BAR; PG8_SCHED;
            PG8_LDB(B1, 1, 1); PG8_STAGE(PG8_SB(1, 0), b3, voffB);
            PG8_BAR; PG8_WAIT_L(0); PG8_MMA(0, 1, At, B1); PG8_BAR;
            PG8_LDA(At, 1, 1); PG8_STAGE_AX(PG8_SA(1, 0), a3, 0);
            PG8_BAR; PG8_WAIT_L(0); PG8_MMA(1, 0, At, B0); PG8_BAR; PG8_SCHED;
            PG8_STAGE(PG8_SB(1, 1), b3 + hstep, voffB);
            PG8_WAIT_V(6); PG8_BAR; PG8_MMA(1, 1, At, B1); PG8_BAR;
            }
        }
        if constexpr (ALIGN_EPI) { if (wr == 0) PG8_BAR; }
        if constexpr (!Epi::AFTER_DRAIN) { E(acc, cur, wr, wc, fr, fq); S.done(cur); }
        if (!has_next) break;
#pragma unroll
        for (int a = 0; a < 2; ++a)
#pragma unroll
            for (int b = 0; b < 2; ++b)
#pragma unroll
                for (int m = 0; m < 4; ++m)
#pragma unroll
                    for (int n = 0; n < 2; ++n) acc[a][b][m][n] = (f32x4){0.f, 0.f, 0.f, 0.f};
        cur = nxt; cA = nA; cB = nB; ++ui;
        if constexpr (GATHER) { vA0[0] = nvA0[0]; vA0[1] = nvA0[1]; vA1[0] = nvA1[0]; vA1[1] = nvA1[1]; }
        if constexpr (ALIGN_EPI) { if (wr == 1) PG8_BAR; }
    }
    PG8_WAIT_V(0);
    if constexpr (!ALIGN_EPI) { if (wr == 0) PG8_BAR; }
    PG8_BAR;
    if constexpr (Epi::AFTER_DRAIN) { E.fused(acc, cur, wr, wc, fr, fq, lds, wid, lane); S.done(cur); }
#undef PG8_SA
#undef PG8_SB
#undef PG8_STAGE
#undef PG8_LDA
#undef PG8_STAGE_AC
#undef PG8_STAGE_AX
#undef PG8_GOFF
#undef PG8_LDB
#undef PG8_MMA
#undef PG8_WAIT_V
#undef PG8_WAIT_L
#undef PG8_BAR
#undef PG8_SCHED
}
}
#define XB_TMO      128
#define XB_XCNT(j)  (256  + 64 * (j))
#define XB_XSUB(j)  (1280 + 64 * (j))
#define XB_XGEN(j)  (2304 + 64 * (j))
#define XB_TOP      3328
#define XB_TOPGEN   3392
#define XCD_BAR_WORDS 3456
#define XB_SPIN_CAP (1u << 18)

__device__ __forceinline__ unsigned xb_ld(unsigned* p)              { return __hip_atomic_load(p, __ATOMIC_RELAXED, __HIP_MEMORY_SCOPE_AGENT); }
__device__ __forceinline__ unsigned xb_add(unsigned* p, unsigned v) { return __hip_atomic_fetch_add(p, v, __ATOMIC_RELAXED, __HIP_MEMORY_SCOPE_AGENT); }
__device__ __forceinline__ unsigned xb_xcc_id() { return (unsigned)__builtin_amdgcn_s_getreg((3 << 11) | 20) & 0xFu; }
#define XB_SPIN(cond, bar) do { unsigned _sp = 0; while (cond) { __builtin_amdgcn_s_sleep(1); \
    if ((++_sp & 255u) == 0u) { if (xb_ld(&(bar)[XB_TMO])) break; if (_sp > XB_SPIN_CAP) { atomicAdd(&(bar)[XB_TMO], 1u); break; } } } } while (0)

struct XcdBarrier {
    unsigned* bar; unsigned x;
    volatile LAS unsigned* st;
};

__device__ __forceinline__ XcdBarrier xcd_barrier_post(unsigned* bar, volatile LAS unsigned* st) {
    XcdBarrier b; b.bar = bar; b.x = xb_xcc_id(); b.st = st;
    if (threadIdx.x == 0) (void)xb_add(&bar[XB_XCNT(b.x)], 1u);
    return b;
}
__device__ __forceinline__ void xcd_barrier_complete(unsigned* bar, unsigned x, unsigned& nloc, unsigned& nx) {
    const unsigned G = gridDim.x * gridDim.y * gridDim.z;
    unsigned sum, cnt, mine, sp = 0u;
    for (;;) {
        sum = 0u; cnt = 0u; mine = 0u;
#pragma unroll
        for (unsigned j = 0; j < 16; ++j) { const unsigned c = xb_ld(&bar[XB_XCNT(j)]); sum += c; cnt += (c > 0u) ? 1u : 0u; mine = (j == x) ? c : mine; }
        if (sum == G) break;
        __builtin_amdgcn_s_sleep(1);
        if ((++sp & 255u) == 0u) { if (xb_ld(&bar[XB_TMO])) break; if (sp > XB_SPIN_CAP) { atomicAdd(&bar[XB_TMO], 1u); break; } }
    }
    nloc = mine > 0u ? mine : 1u; nx = cnt > 0u ? cnt : 1u;
}

__device__ __forceinline__ void xcd_barrier(const XcdBarrier& b) {
    asm volatile("s_waitcnt vmcnt(0)" ::: "memory");
    __syncthreads();
    if (threadIdx.x == 0) {
        unsigned* bar = b.bar;
        __builtin_amdgcn_s_waitcnt(0);
        unsigned nloc = b.st[0], nx = b.st[1];
        if (nloc == 0u) { xcd_barrier_complete(bar, b.x, nloc, nx); b.st[0] = nloc; b.st[1] = nx; }
        const unsigned old = xb_add(&bar[XB_XSUB(b.x)], 1u);
        const unsigned gen = old / nloc;
        if (old + 1u == (gen + 1u) * nloc) {
            __builtin_amdgcn_fence(__ATOMIC_RELEASE, "agent");
            asm volatile("s_waitcnt vmcnt(0)" ::: "memory");
            const unsigned og = xb_add(&bar[XB_TOP], 1u);
            const unsigned tg = og / nx;
            if (og + 1u == (tg + 1u) * nx) xb_add(&bar[XB_TOPGEN], 1u);
            else XB_SPIN(xb_ld(&bar[XB_TOPGEN]) == tg, bar);
            __builtin_amdgcn_fence(__ATOMIC_ACQUIRE, "agent");
            xb_add(&bar[XB_XGEN(b.x)], 1u);
            asm volatile("s_waitcnt vmcnt(0)" ::: "memory");
        } else {
            XB_SPIN(xb_ld(&bar[XB_XGEN(b.x)]) == gen, bar);
            __builtin_amdgcn_fence(__ATOMIC_ACQUIRE, "agent");
            asm volatile("s_waitcnt vmcnt(0)" ::: "memory");
        }
    }
    __syncthreads();
}
struct Frame {
    LAS unsigned char* lds;
    unsigned char* ldsg;
    volatile LAS unsigned* MISC;
    int tid, lane, wave, vcu, G, gw, NGW;
    const GAS float* const __attribute__((address_space(4)))* in;
    GAS unsigned char* ws;
    GAS float* out;
    unsigned long long tprobe;
};
#ifndef PROBE_SUB
#define PROBE_SUB 0
#endif
#define TP_BEGIN() unsigned long long tp0_ = PROBE_SUB ? __builtin_amdgcn_s_memrealtime() : 0ull
#define TP_END(id) do { if (PROBE_SUB == (id)) { const unsigned long long t1_ = __builtin_amdgcn_s_memrealtime(); F0.tprobe += t1_ - tp0_; } if (PROBE_SUB) tp0_ = __builtin_amdgcn_s_memrealtime(); } while (0)
#define WSP(T, off) ((T*)(F.ws + (off)))
#define INP(k) ((const float*)F.in[k])
#define LAUNDER(F) asm volatile("" : "+s"(F.ws), "+s"(F.in), "+s"(F.out), "+v"(F.tid), "+v"(F.lane), "+s"(F.wave), "+s"(F.gw), "+s"(F.vcu), "+s"(F.G), "+s"(F.NGW))

__device__ __forceinline__ int row_s(int row) { return row < TLAT ? (row >> 12) : 4; }

__device__ __forceinline__ void mod_row_store(const f32x4 (&v)[4], const float* g, const float* shift, const float* scale, bf16* orow, int lane, f32x4 (&h)[4]) {
    float s = 0.f;
#pragma unroll
    for (int j = 0; j < 4; ++j) s += (v[j].x * v[j].x + v[j].y * v[j].y) + (v[j].z * v[j].z + v[j].w * v[j].w);
    const float rstd = 1.0f / sqrtf(wave_sum(s) * (1.0f / 1024.0f) + 1e-6f);
#pragma unroll
    for (int j = 0; j < 4; ++j) {
        const f32x4 g4 = ((const f32x4*)g)[64 * j + lane], sh = ((const f32x4*)shift)[64 * j + lane], sc = ((const f32x4*)scale)[64 * j + lane];
        h[j] = (v[j] * rstd) * g4 * (sc + 1.0f) + sh;
        v2u o; o.x = pk2(h[j].x, h[j].y); o.y = pk2(h[j].z, h[j].w);
        ((v2u*)orow)[64 * j + lane] = o;
    }
}

template <class RowMap>
__device__ __forceinline__ void transpose_item(const float* W, int K, int N, bf16* WT, const RowMap& rowmap, LAS float* scr, int item, int lane) {
    const int nblk = (N + 63) / 64, kb = item / nblk, nb = item % nblk, k0 = 64 * kb, n0 = 64 * nb;
    const int r = lane >> 4, c4 = (lane & 15) * 4;
    f32x4 t_[16];
#pragma unroll
    for (int i = 0; i < 16; ++i) t_[i] = (n0 + c4 < N) ? *(const f32x4*)(W + (size_t)(k0 + 4 * i + r) * N + n0 + c4) : (f32x4){0.f, 0.f, 0.f, 0.f};
#pragma unroll
    for (int i = 0; i < 16; ++i) { LAS float* d = scr + (4 * i + r) * 65 + c4; d[0] = t_[i].x; d[1] = t_[i].y; d[2] = t_[i].z; d[3] = t_[i].w; }
    LDS_WAIT(); asm volatile("" ::: "memory");
    const int c = lane & 7;
#pragma unroll
    for (int j = 0; j < 8; ++j) { const int n = (lane >> 3) + 8 * j; const LAS float* s = scr + (8 * c) * 65 + n;
        v4u o; o.x = pk2(s[0 * 65], s[1 * 65]); o.y = pk2(s[2 * 65], s[3 * 65]); o.z = pk2(s[4 * 65], s[5 * 65]); o.w = pk2(s[6 * 65], s[7 * 65]);
        *(v4u*)(WT + (size_t)rowmap(n0 + n) * K + k0 + 8 * c) = o; }
    LDS_WAIT(); asm volatile("" ::: "memory");
}
struct RowId { int off; __device__ __forceinline__ int operator()(int n) const { return off + n; } };
struct RowW13 { int e, w3; __device__ __forceinline__ int operator()(int n) const { return e * 2048 + (n >> 7) * 256 + w3 * 128 + (n & 127); } };

__device__ __forceinline__ void ph_prologue(Frame& F0) { Frame F = F0; LAUNDER(F);
    LAS float* scr = (LAS float*)(F.lds + F.wave * 16640);
    LAS float* sv = (LAS float*)F.lds;
    constexpr int I_IN = 16 * ((EVC + 63) / 64), I_O = 16 * 16, I_Q = 16 * (QKVC / 64);
    constexpr int PER_J = I_IN + I_O + I_Q + I_O, NT_ITEMS = 2 * PER_J;
    for (int it = F.gw; it < NT_ITEMS; it += F.NGW) {
        const int j = it / PER_J; int r = it % PER_J;
        if (r < I_IN) { transpose_item(INP(I_EVWIN) + (size_t)j * DM * EVC, DM, EVC, WSP(bf16, WS_WIN) + (size_t)j * EVCP * DM, RowId{0}, scr, r, F.lane); continue; } r -= I_IN;
        if (r < I_O) { transpose_item(INP(I_EVWOUT) + (size_t)j * DM * DM, DM, DM, WSP(bf16, WS_WOE) + (size_t)j * DM * DM, RowId{0}, scr, r, F.lane); continue; } r -= I_O;
        if (r < I_Q) { transpose_item(INP(I_WQKV) + (size_t)j * DM * QKVC, DM, QKVC, WSP(bf16, WS_WQKV) + (size_t)j * QKVC * DM, RowId{0}, scr, r, F.lane); continue; } r -= I_Q;
        transpose_item(INP(I_DAWOUT) + (size_t)j * DM * DM, DM, DM, WSP(bf16, WS_WOD) + (size_t)j * DM * DM, RowId{0}, scr, r, F.lane);
    }
    __syncthreads();
    for (int i = F.tid; i < 5 * 1024; i += NTHR) { const float x = i < 4096 ? INP(I_C)[i] : INP(I_CCTX)[i - 4096]; sv[i] = siluf_(x); }
    __syncthreads();
    for (int it = F.gw; it < 4 * 24 * 16; it += F.NGW) {
        const int kc = it & 15, cg = (it >> 4) % 24, i = it / (16 * 24); const int col = cg * 256 + F.lane * 4;
        const float* wp = INP(I_ADAW) + (size_t)i * DM * 6144 + (size_t)(kc * 64) * 6144 + col;
        f32x4 acc[5];
#pragma unroll
        for (int s = 0; s < 5; ++s) acc[s] = (f32x4){0.f, 0.f, 0.f, 0.f};
#pragma unroll 1
        for (int k0 = 0; k0 < 64; k0 += 16) {
            f32x4 w[16];
#pragma unroll
            for (int k = 0; k < 16; ++k) w[k] = *(const f32x4*)(wp + (size_t)(k0 + k) * 6144);
#pragma unroll
            for (int k = 0; k < 16; ++k)
#pragma unroll
                for (int s = 0; s < 5; ++s) acc[s] = acc[s] + w[k] * sv[s * 1024 + kc * 64 + k0 + k];
        }
#pragma unroll
        for (int s = 0; s < 5; ++s) *(f32x4*)(WSP(float, WS_MODP) + ((size_t)(kc * 4 + i) * 5 + s) * 6144 + col) = acc[s];
    }
    for (int k = F.gw * 64 + F.lane; k < 8192; k += F.NGW * 64) { float s, c; sincospif((float)k * (1.0f / 4096.0f), &s, &c); WSP(f32x2, WS_TW)[k] = (f32x2){c, -s}; }
    for (int idx = F.gw * 64 + F.lane; idx < 2 * 224 * 64; idx += F.NGW * 64) {
        const int l = idx & 63, f = (idx >> 6) % 224, j = idx / (224 * 64); const int kb = 8 * (l >> 4), n = l & 15;
        const float* src; int col;
        if (f < 64) { const int d = f >> 5, nt = f & 31; src = INP(I_W2) + ((size_t)(j * 2 + d) * 32 + kb) * RWW; col = nt * 16 + n; }
        else if (f < 128) { const int d = (f - 64) >> 5, nt = (f - 64) & 31; src = INP(I_A2) + ((size_t)(j * 2 + d) * 32 + kb) * RWW; col = nt * 16 + n; }
        else { const int nt = (f - 128) / 3, ks = (f - 128) % 3; src = INP(I_G2) + ((size_t)j * 96 + ks * 32 + kb) * RWW; col = nt * 16 + n; }
        v4u o; o.x = pk2(src[0 * RWW + col], src[1 * RWW + col]); o.y = pk2(src[2 * RWW + col], src[3 * RWW + col]); o.z = pk2(src[4 * RWW + col], src[5 * RWW + col]); o.w = pk2(src[6 * RWW + col], src[7 * RWW + col]);
        WSP(v4u, WS_FRAGB)[idx] = o;
    }
}
__device__ __forceinline__ void ph_modred(Frame& F0) { Frame F = F0; LAUNDER(F);
    for (int idx = F.gw * 64 + F.lane; idx < 4 * 5 * 6144; idx += F.NGW * 64) {
        const int col = idx % 6144, i = idx / (5 * 6144); float a = INP(I_ADAB)[i * 6144 + col];
#pragma unroll
        for (int kc = 0; kc < 16; ++kc) a += WSP(float, WS_MODP)[(size_t)kc * 4 * 5 * 6144 + idx];
        WSP(float, WS_MODS)[idx] = a;
    }
}
__device__ __forceinline__ void ph_mod0(Frame& F0) { Frame F = F0; LAUNDER(F);
    const float* mods = WSP(float, WS_MODS);
    for (int row = F.gw; row < TT; row += F.NGW) {
        const float* src = row < TLAT ? INP(I_X) + (size_t)row * DM : INP(I_CTX) + (size_t)(row - TLAT) * DM;
        f32x4 v[4], h[4];
#pragma unroll
        for (int j = 0; j < 4; ++j) { v[j] = ((const f32x4*)src)[64 * j + F.lane]; ((f32x4*)(WSP(float, WS_X) + (size_t)row * DM))[64 * j + F.lane] = v[j]; }
        const int s = row_s(row);
        mod_row_store(v, INP(I_NORMG), mods + s * 6144, mods + s * 6144 + 1024, WSP(bf16, WS_HA) + (size_t)row * DM, F.lane, h);
    }
}
__device__ __forceinline__ float seq_pos(int row, int& L) { if (row < TLAT) { L = SEQ; return (float)(row & (SEQ - 1)); } L = CTXL; return (float)((row - TLAT) & (CTXL - 1)); }
__device__ __forceinline__ int seq_l(int row, int& L) { if (row < TLAT) { L = SEQ; return row & (SEQ - 1); } L = CTXL; return (row - TLAT) & (CTXL - 1); }

__device__ __forceinline__ f32x4 shift4(const float* P, size_t off, bool hp, bool hn, f32x4 m0, f32x4 m1) {
    const f32x4 u = *(const f32x4*)(P + off);
    const f32x4 up = hp ? *(const f32x4*)(P + off - EVCP) : (f32x4){0.f, 0.f, 0.f, 0.f};
    const f32x4 un = hn ? *(const f32x4*)(P + off + EVCP) : (f32x4){0.f, 0.f, 0.f, 0.f};
    return u + m0 * (up - u) + m1 * (un - u);
}

__device__ __forceinline__ void ph_evprep(Frame& F0, int j) { Frame F = F0; LAUNDER(F);
    const float* P = WSP(float, WS_P);
    const float* mu = INP(I_MU) + (size_t)j * 2 * RWC;
    TP_BEGIN();
    {
        float* Rr = (float*)(F.ws + WS_RW); float* Kk = (float*)(F.ws + WS_RW + RW_STRIDE); float* Vv = (float*)(F.ws + WS_RW + 2 * RW_STRIDE); float* KKn = (float*)(F.ws + WS_RW + 3 * RW_STRIDE);
        bf16* AOP = WSP(bf16, WS_AOP); const float* kkw = INP(I_KK) + (size_t)j * RWW;
        for (int row = F.gw; row < TT; row += F.NGW) {
            int L; const int l = seq_l(row, L); const bool hp = l > 0, hn = l < L - 1;
#pragma unroll
            for (int q = 0; q < 7; ++q) {
                const int g = F.lane + 64 * q;
                if (q < 6 || g < 440) {
                    const int col = 4 * g;
                    const f32x4 m0 = *(const f32x4*)(mu + col), m1 = *(const f32x4*)(mu + RWC + col);
                    f32x4 sv = shift4(P, (size_t)row * EVCP + col, hp, hn, m0, m1);
                    if (q < 2) *(f32x4*)(Rr + (size_t)row * RWW + col) = sv;
                    else if (q < 4) { const int c = col - 512; *(f32x4*)(Kk + (size_t)row * RWW + c) = sv;
                        const f32x4 kx = sv * *(const f32x4*)(kkw + c);
                        const float ss = sum16_f((kx.x * kx.x + kx.y * kx.y) + (kx.z * kx.z + kx.w * kx.w));
                        *(f32x4*)(KKn + (size_t)row * RWW + c) = kx * (1.0f / fmaxf(sqrtf(ss), 1e-12f)); }
                    else if (q < 6) *(f32x4*)(Vv + (size_t)row * RWW + (col - 1024)) = sv;
                    else { const int c = col - 1536;
                        if (c < 64) { sv.x = tanhf(sv.x); sv.y = tanhf(sv.y); sv.z = tanhf(sv.z); sv.w = tanhf(sv.w); }
                        else if (c >= 128) { sv.x = sigmoidf_(sv.x); sv.y = sigmoidf_(sv.y); sv.z = sigmoidf_(sv.z); sv.w = sigmoidf_(sv.w); }
                        v2u w; w.x = pk2(sv.x, sv.y); w.y = pk2(sv.z, sv.w); *(v2u*)(AOP + (size_t)row * 224 + c) = w; }
                }
            }
        }
    }
    __syncthreads(); TP_END(1);
    __syncthreads(); TP_END(2);
#ifndef NO_EV_C
    {
        LAS float* H1 = (LAS float*)F.lds; LAS float* H2 = (LAS float*)(F.lds + 16384);
        LAS float* W1s = (LAS float*)(F.lds + 32768); LAS float* B1s = (LAS float*)(F.lds + 41216); LAS float* B2s = (LAS float*)(F.lds + 41472); LAS float* FRs = (LAS float*)(F.lds + 41728);
        LAS float* W2s = (LAS float*)(F.lds + 42240); LAS float* W3s = (LAS float*)(F.lds + 58624);
        for (int i = F.tid; i < 33 * 64; i += NTHR) W1s[i] = INP(I_FW1)[(size_t)j * 33 * 64 + i];
        for (int i = F.tid; i < 64 * 64; i += NTHR) W2s[i] = INP(I_FW2)[(size_t)j * 64 * 64 + i];
        if (F.tid < 64) { B1s[F.tid] = INP(I_FB1)[j * 64 + F.tid]; B2s[F.tid] = INP(I_FB2)[j * 64 + F.tid]; }
        if (F.tid < 128) FRs[F.tid] = INP(I_FREQ)[j * 128 + F.tid];
        const float* w3 = INP(I_FW3) + (size_t)j * 64 * 2048;
        const int p = F.tid & 63, cg = F.wave;
        for (int it = F.vcu; it < 272; it += F.G) {
            const bool lat = it < 256; const int L = lat ? SEQ : CTXL; const int r = lat ? it : it - 256; const int pt = r >> 2, cq4 = r & 3; const int m = pt * 64 + p;
            float z[33];
            z[0] = (float)m / (float)(L - 1);
#pragma unroll
            for (int i = 0; i < 16; ++i) { const float band = 1e-4f + (float)i * ((15.0f - 1e-4f) / 15.0f); const float rev = (float)m * band / (float)L; const float fr_ = rev - floorf(rev);
                z[1 + i] = __builtin_amdgcn_cosf(fr_); z[17 + i] = -__builtin_amdgcn_sinf(fr_); }
            __syncthreads();
#pragma unroll 1
            for (int q = 0; q < 8; ++q) { const int n = cg * 8 + q; float a = B1s[n];
#pragma unroll
                for (int i = 0; i < 33; ++i) a += z[i] * W1s[i * 64 + n];
                H1[n * 64 + p] = __sinf(FRs[n] * a); }
            __syncthreads();
#pragma unroll 1
            for (int q = 0; q < 8; ++q) { const int n = cg * 8 + q; float a = B2s[n];
#pragma unroll 8
                for (int k = 0; k < 64; ++k) a += H1[k * 64 + p] * W2s[k * 64 + n];
                H2[n * 64 + p] = __sinf(FRs[64 + n] * a); }
            const float t = z[0];
            float* KC = lat ? WSP(float, WS_KCL) : WSP(float, WS_KCC); const int N2 = 2 * L;
#pragma unroll 1
            for (int c4 = 0; c4 < 4; ++c4) {
                const int ct = cq4 * 4 + c4;
                __syncthreads();
                for (int i = F.tid; i < 64 * 32; i += NTHR) { const int k = i >> 5, cc = i & 31; *(LAS f32x4*)(W3s + k * 128 + cc * 4) = *(const f32x4*)(w3 + (size_t)k * 2048 + ct * 128 + cc * 4); }
                __syncthreads();
                f32x4 acc[4];
#pragma unroll
                for (int q = 0; q < 4; ++q) acc[q] = (f32x4){0.f, 0.f, 0.f, 0.f};
#pragma unroll 2
                for (int k = 0; k < 64; ++k) { const float hv = H2[k * 64 + p]; const LAS f32x4* wr = (const LAS f32x4*)(W3s + k * 128 + cg * 16);
#pragma unroll
                    for (int q = 0; q < 4; ++q) acc[q] = acc[q] + wr[q] * hv; }
                const int colb = ct * 128 + cg * 16;
#pragma unroll
                for (int q = 0; q < 16; ++q) { const int col = colb + q; const int o = col >> 10, dirn = (col >> 9) & 1, c = col & 511;
                    const float d0 = -3.0701134573253945f, d1 = -15.350567286626973f; const float del = fabsf(d0 + (d1 - d0) * ((float)c / 511.0f));
                    const float val = acc[q >> 2][q & 3] * __expf(-t * del); float* kr = KC + (size_t)(o * 512 + c) * N2;
                    if (dirn == 0) kr[m] = val; else { if (m > 0) kr[N2 - m] = val; else kr[L] = 0.f; } }
            }
        }
        __syncthreads();
    }
#endif
    TP_END(3);
}

#define ZI(i) ((i) + ((i) >> 5))
__device__ __forceinline__ f32x2 cmul(f32x2 a, f32x2 b) { return (f32x2){a.x * b.x - a.y * b.y, a.x * b.y + a.y * b.x}; }
__device__ __forceinline__ f32x2 cmulc(f32x2 a, f32x2 b) { return (f32x2){a.x * b.x + a.y * b.y, a.y * b.x - a.x * b.y}; }
template <int LOGN, int NF> __device__ __forceinline__ void fft_r2_dif(LAS f32x2* Z, const LAS f32x2* TWL, int lt, int lh) {
    constexpr int N = 1 << LOGN, TPG = NTHR / NF; const int half = 1 << lh;
    for (int bf = lt; bf < N / 2; bf += TPG) { const int jx = bf & (half - 1), i = ((bf - jx) << 1) + jx;
        const f32x2 a = Z[ZI(i)], b = Z[ZI(i + half)]; Z[ZI(i)] = a + b; Z[ZI(i + half)] = cmul(a - b, TWL[half + jx]); }
    __syncthreads();
}
template <int LOGN, int NF> __device__ __forceinline__ void fft_r8_dif(LAS f32x2* Z, const LAS f32x2* TWL, int lt, int lh) {
    constexpr int N = 1 << LOGN, TPG = NTHR / NF, NG = N / 8, PT = (NG + TPG - 1) / TPG; const int h = 1 << lh, qd = h >> 2, lq = lh - 2;
    f32x2 x[PT][8]; int i0[PT], j0[PT];
#pragma unroll
    for (int t = 0; t < PT; ++t) { const int g = lt + TPG * t; j0[t] = g & (qd - 1); i0[t] = ((g >> lq) << (lq + 3)) + j0[t];
        if (g < NG) {
#pragma unroll
            for (int m = 0; m < 8; ++m) x[t][m] = Z[ZI(i0[t] + m * qd)]; } }
#pragma unroll
    for (int t = 0; t < PT; ++t) { const int g = lt + TPG * t; if (g < NG) {
#pragma unroll
        for (int m = 0; m < 4; ++m) { const f32x2 a = x[t][m], b = x[t][m + 4]; x[t][m] = a + b; x[t][m + 4] = cmul(a - b, TWL[h + j0[t] + m * qd]); }
#pragma unroll
        for (int mm = 0; mm < 4; ++mm) { const int m = (mm & 1) + 4 * (mm >> 1); const f32x2 a = x[t][m], b = x[t][m + 2]; x[t][m] = a + b; x[t][m + 2] = cmul(a - b, TWL[(h >> 1) + j0[t] + (m & 1) * qd]); }
        const f32x2 wc = TWL[qd + j0[t]];
#pragma unroll
        for (int m = 0; m < 8; m += 2) { const f32x2 a = x[t][m], b = x[t][m + 1]; x[t][m] = a + b; x[t][m + 1] = cmul(a - b, wc); }
#pragma unroll
        for (int m = 0; m < 8; ++m) Z[ZI(i0[t] + m * qd)] = x[t][m]; } }
    __syncthreads();
}
template <int LOGN, int NF, bool SKIP_R2 = false> __device__ __forceinline__ void fft_dif(LAS f32x2* Z, const LAS f32x2* TWL, int lt) {
    int lh = LOGN - 1;
    if (LOGN % 3 == 1) { if (!SKIP_R2) fft_r2_dif<LOGN, NF>(Z, TWL, lt, lh); lh -= 1; }
#pragma unroll 1
    for (; lh >= 2; lh -= 3) fft_r8_dif<LOGN, NF>(Z, TWL, lt, lh);
}
template <int LOGN, int NF> __device__ __forceinline__ void fft_r8_dit(LAS f32x2* Z, const LAS f32x2* TWL, int lt, int lq) {
    constexpr int N = 1 << LOGN, TPG = NTHR / NF, NG = N / 8, PT = (NG + TPG - 1) / TPG; const int qd = 1 << lq;
    f32x2 x[PT][8]; int i0[PT], j0[PT];
#pragma unroll
    for (int t = 0; t < PT; ++t) { const int g = lt + TPG * t; j0[t] = g & (qd - 1); i0[t] = ((g >> lq) << (lq + 3)) + j0[t];
        if (g < NG) {
#pragma unroll
            for (int m = 0; m < 8; ++m) x[t][m] = Z[ZI(i0[t] + m * qd)]; } }
#pragma unroll
    for (int t = 0; t < PT; ++t) { const int g = lt + TPG * t; if (g < NG) {
        const f32x2 wc = TWL[qd + j0[t]];
#pragma unroll
        for (int m = 0; m < 8; m += 2) { const f32x2 a = x[t][m], b = cmulc(x[t][m + 1], wc); x[t][m] = a + b; x[t][m + 1] = a - b; }
#pragma unroll
        for (int mm = 0; mm < 4; ++mm) { const int m = (mm & 1) + 4 * (mm >> 1); const f32x2 a = x[t][m], b = cmulc(x[t][m + 2], TWL[2 * qd + j0[t] + (m & 1) * qd]); x[t][m] = a + b; x[t][m + 2] = a - b; }
#pragma unroll
        for (int m = 0; m < 4; ++m) { const f32x2 a = x[t][m], b = cmulc(x[t][m + 4], TWL[4 * qd + j0[t] + m * qd]); x[t][m] = a + b; x[t][m + 4] = a - b; }
#pragma unroll
        for (int m = 0; m < 8; ++m) Z[ZI(i0[t] + m * qd)] = x[t][m]; } }
    __syncthreads();
}
template <int LOGN, int NF, bool SKIP_R2 = false> __device__ __forceinline__ void fft_dit_inv(LAS f32x2* Z, const LAS f32x2* TWL, int lt) {
    constexpr int N = 1 << LOGN, TPG = NTHR / NF; constexpr int NTRI = LOGN / 3;
#pragma unroll 1
    for (int k = 0; k < NTRI; ++k) fft_r8_dit<LOGN, NF>(Z, TWL, lt, 3 * k);
    if (LOGN % 3 == 1 && !SKIP_R2) { const int half = N / 2;
        for (int bf = lt; bf < N / 2; bf += TPG) { const f32x2 a = Z[ZI(bf)], b = cmulc(Z[ZI(bf + half)], TWL[half + bf]); Z[ZI(bf)] = a + b; Z[ZI(bf + half)] = a - b; }
        __syncthreads(); }
}
template <int LOGN> __device__ __forceinline__ int brev_n(int x) { return (int)(__brev((unsigned)x) >> (32 - LOGN)); }
template <int LOGN> __device__ __forceinline__ void load_tw(Frame& F, LAS f32x2* TWL) {
    constexpr int N = 1 << LOGN; const f32x2* TW = WSP(f32x2, WS_TW);
    for (int k = F.tid; k < N; k += NTHR) { if (k == 0) { TWL[0] = (f32x2){1.f, 0.f}; continue; }
        const int lh = 31 - __builtin_clz((unsigned)k), jx = k - (1 << lh);
        TWL[k] = TW[(size_t)jx << (12 - lh)]; }
}
__device__ __forceinline__ float block_sum(Frame& F, float v, LAS float* red) {
    v = wave_sum(v); __syncthreads(); if (F.lane == 0) red[F.wave] = v; __syncthreads();
    float t = 0.f;
#pragma unroll
    for (int w = 0; w < NWAVES; ++w) t += red[w];
    return t;
}
template <int LOGN, int NF> struct FftGeo { static constexpr int N = 1 << LOGN, TPG = NTHR / NF, ZS = N + N / 32; };

template <int LOGN, int NF> __device__ __forceinline__ void fftk_item(Frame& F, const float* KC, f32x4* KSP, int item) {
    constexpr int N = 1 << LOGN, TPG = NTHR / NF, ZS = FftGeo<LOGN, NF>::ZS;
    const int fi = F.tid / TPG, lt = F.tid % TPG; const int p8 = item * NF + fi, o = p8 >> 8, pr = p8 & 255;
    LAS f32x2* Z = (LAS f32x2*)F.lds + fi * ZS; LAS f32x2* TWL = (LAS f32x2*)(F.lds + 67584); LAS float* red = (LAS float*)(F.lds + 133120);
    const float* ka = KC + (size_t)(o * 512 + 2 * pr) * N; const float* kb = ka + N;
    float sa = 0.f, sb = 0.f;
    for (int i = lt; i < N; i += TPG) { const float a = ka[i], b = kb[i]; sa += fabsf(a); sb += fabsf(b); Z[ZI(i)] = (f32x2){a, b}; }
    float na, nb;
    if (NF == 1) { na = block_sum(F, sa, red) + 1e-6f; nb = block_sum(F, sb, red + 8) + 1e-6f; } else { static_assert(NF == 1 || NTHR / NF == 64, "one wave per transform"); na = wave_sum(sa) + 1e-6f; nb = wave_sum(sb) + 1e-6f; }
    __syncthreads();
    fft_dif<LOGN, NF>(Z, TWL, lt);
    const float ia = 0.5f / (na * (float)N), ib = 0.5f / (nb * (float)N);
    f32x4* dst = KSP + (size_t)(o * 256 + pr) * N;
    for (int p = lt; p < N; p += TPG) {
        const int k = brev_n<LOGN>(p), p2 = brev_n<LOGN>((N - k) & (N - 1));
        const f32x2 z1 = Z[ZI(p)], z2 = Z[ZI(p2)];
        const f32x2 Ka = (f32x2){(z1.x + z2.x) * ia, (z1.y - z2.y) * ia}, Kb = (f32x2){(z1.y + z2.y) * ib, -(z1.x - z2.x) * ib};
        dst[p] = (f32x4){0.5f * (Ka.x + Kb.x), 0.5f * (Ka.y + Kb.y), 0.5f * (Ka.x - Kb.x), 0.5f * (Ka.y - Kb.y)};
    }
    __syncthreads();
}

template <int LOGN, int NF> __device__ __forceinline__ void spec_mul(LAS f32x2* Z, const f32x4* KS, int lt) {
    constexpr int N = 1 << LOGN, TPG = NTHR / NF, PT = (N + TPG - 1) / TPG;
    f32x4 kv[PT]; f32x2 yv[PT];
#pragma unroll
    for (int t = 0; t < PT; ++t) { const int p = lt + TPG * t; if (p < N) kv[t] = KS[p]; }
#pragma unroll
    for (int t = 0; t < PT; ++t) { const int p = lt + TPG * t; if (p < N) {
        const int k = brev_n<LOGN>(p), p2 = brev_n<LOGN>((N - k) & (N - 1));
        const f32x2 z1 = Z[ZI(p)], z2 = Z[ZI(p2)];
        yv[t] = cmul(z1, (f32x2){kv[t].x, kv[t].y}) + cmul((f32x2){z2.x, -z2.y}, (f32x2){kv[t].z, kv[t].w}); } }
    __syncthreads();
#pragma unroll
    for (int t = 0; t < PT; ++t) { const int p = lt + TPG * t; if (p < N) Z[ZI(p)] = yv[t]; }
    __syncthreads();
}
__device__ __forceinline__ float conv3_at(const float* p, int l, int L, float w0, float w1, float w2, float bb) {
    const float up = l > 0 ? p[l - 1] : 0.f, u = p[l], un = l < L - 1 ? p[l + 1] : 0.f; return up * w0 + u * w1 + un * w2 + bb; }
template <int LOGN, int NF> __device__ __forceinline__ void hyena_item(Frame& F, const float* UTall, const f32x4* KSP, float* HYTall, const float* hyb, const float* cw, const float* cb, int item) {
    constexpr int N = 1 << LOGN, L = N / 2, TPG = NTHR / NF, PT = (L + TPG - 1) / TPG, ZS = FftGeo<LOGN, NF>::ZS;
    const int fi = F.tid / TPG, lt = F.tid % TPG; const int p8 = item * NF + fi, b = p8 >> 8, pr = p8 & 255;
    const float* UT = UTall + (size_t)b * HYC * L; float* HYT = HYTall + (size_t)b * 512 * L;
    LAS f32x2* Z = (LAS f32x2*)F.lds + fi * ZS; LAS f32x2* TWL = (LAS f32x2*)(F.lds + 67584);
    const int c0 = 2 * pr; const float b0a = hyb[c0], b0b = hyb[c0 + 1], b1a = hyb[512 + c0], b1b = hyb[512 + c0 + 1];
#define CV(ptr, l_, s3, ch) conv3_at(ptr, l_, L, cw[(s3) * 512 + c0 + (ch)], cw[HYC + (s3) * 512 + c0 + (ch)], cw[2 * HYC + (s3) * 512 + c0 + (ch)], cb[(s3) * 512 + c0 + (ch)])
    const float* va = UT + (size_t)c0 * L; const float* vb = va + L;
    f32x2 keep[PT];
    f32x2 zpair = (f32x2){0.f, 0.f}; asm volatile("" : "+v"(zpair));
    const float* xa = UT + (size_t)(512 + c0) * L; const float* xb = xa + L;
    const float* x2a = UT + (size_t)(1024 + c0) * L; const float* x2b = x2a + L;
    float* oa = HYT + (size_t)c0 * L; float* ob = oa + L;
    if constexpr (LOGN % 3 == 1) {
#pragma unroll
        for (int q = 0; q < PT; ++q) { const int l = lt + TPG * q; keep[q] = (f32x2){CV(va, l, 0, 0), CV(vb, l, 0, 1)}; Z[ZI(l)] = keep[q]; Z[ZI(l + L)] = cmul(keep[q], TWL[L + l]); }
        __syncthreads();
        fft_dif<LOGN, NF, true>(Z, TWL, lt);
        spec_mul<LOGN, NF>(Z, KSP + (size_t)pr * N, lt);
        fft_dit_inv<LOGN, NF, true>(Z, TWL, lt);
        f32x2 x1v[PT];
#pragma unroll
        for (int q = 0; q < PT; ++q) { const int l = lt + TPG * q; x1v[q] = (f32x2){CV(xa, l, 1, 0), CV(xb, l, 1, 1)}; }
#pragma unroll
        for (int q = 0; q < PT; ++q) { const int l = lt + TPG * q; const f32x2 w = TWL[L + l]; const f32x2 y = Z[ZI(l)] + cmulc(Z[ZI(l + L)], w);
            keep[q] = (f32x2){x1v[q].x * (y.x + keep[q].x * b0a), x1v[q].y * (y.y + keep[q].y * b0b)};
            Z[ZI(l)] = keep[q]; Z[ZI(l + L)] = cmul(keep[q], w); }
        __syncthreads();
        fft_dif<LOGN, NF, true>(Z, TWL, lt);
        spec_mul<LOGN, NF>(Z, KSP + (size_t)(256 + pr) * N, lt);
        fft_dit_inv<LOGN, NF, true>(Z, TWL, lt);
#pragma unroll
        for (int q = 0; q < PT; ++q) { const int l = lt + TPG * q; x1v[q] = (f32x2){CV(x2a, l, 2, 0), CV(x2b, l, 2, 1)}; }
#pragma unroll
        for (int q = 0; q < PT; ++q) { const int l = lt + TPG * q; const f32x2 y = Z[ZI(l)] + cmulc(Z[ZI(l + L)], TWL[L + l]);
            oa[l] = x1v[q].x * (y.x + keep[q].x * b1a); ob[l] = x1v[q].y * (y.y + keep[q].y * b1b); }
        __syncthreads();
    } else {
#pragma unroll
        for (int q = 0; q < PT; ++q) { const int l = lt + TPG * q; if (l < L) { keep[q] = (f32x2){CV(va, l, 0, 0), CV(vb, l, 0, 1)}; Z[ZI(l)] = keep[q]; Z[ZI(l + L)] = zpair; } }
        __syncthreads();
        fft_dif<LOGN, NF>(Z, TWL, lt);
        spec_mul<LOGN, NF>(Z, KSP + (size_t)pr * N, lt);
        fft_dit_inv<LOGN, NF>(Z, TWL, lt);
#pragma unroll
        for (int q = 0; q < PT; ++q) { const int l = lt + TPG * q; if (l < L) { const f32x2 y = Z[ZI(l)]; keep[q] = (f32x2){CV(xa, l, 1, 0) * (y.x + keep[q].x * b0a), CV(xb, l, 1, 1) * (y.y + keep[q].y * b0b)}; } }
        __syncthreads();
#pragma unroll
        for (int q = 0; q < PT; ++q) { const int l = lt + TPG * q; if (l < L) { Z[ZI(l)] = keep[q]; Z[ZI(l + L)] = zpair; } }
        __syncthreads();
        fft_dif<LOGN, NF>(Z, TWL, lt);
        spec_mul<LOGN, NF>(Z, KSP + (size_t)(256 + pr) * N, lt);
        fft_dit_inv<LOGN, NF>(Z, TWL, lt);
#pragma unroll
        for (int q = 0; q < PT; ++q) { const int l = lt + TPG * q; if (l < L) { const f32x2 y = Z[ZI(l)]; oa[l] = CV(x2a, l, 2, 0) * (y.x + keep[q].x * b1a); ob[l] = CV(x2b, l, 2, 1) * (y.y + keep[q].y * b1b); } }
        __syncthreads();
    }
#undef CV
}
__device__ __forceinline__ void ph_hyena(Frame& F0, int j) { Frame F = F0; LAUNDER(F);
    LAS f32x2* TWL = (LAS f32x2*)(F.lds + 67584);
    const float* hyb = INP(I_HYB) + (size_t)j * 1024;
    load_tw<13>(F, TWL); __syncthreads();
    for (int it = F.vcu; it < 1024; it += F.G) hyena_item<13, 1>(F, WSP(float, WS_UTL), WSP(f32x4, WS_KSPL), WSP(float, WS_HYTL), hyb, INP(I_CONVW) + (size_t)j * 3 * HYC, INP(I_CONVB) + (size_t)j * HYC, it);
    __syncthreads(); load_tw<9>(F, TWL); __syncthreads();
    for (int it = F.vcu; it < 128; it += F.G) hyena_item<9, 8>(F, WSP(float, WS_UTC), WSP(f32x4, WS_KSPC), WSP(float, WS_HYTC), hyb, INP(I_CONVW) + (size_t)j * 3 * HYC, INP(I_CONVB) + (size_t)j * HYC, it);
    __syncthreads();
}

__device__ __forceinline__ void ph_readout(Frame& F0, int j) { Frame F = F0; LAUNDER(F);
    const float* Vv = (const float*)(F.ws + WS_RW + 2 * RW_STRIDE); const float* Gg = WSP(float, WS_G); const float* BON = WSP(float, WS_BON);
    const float* Y0 = WSP(float, WS_Y); const float* Y1 = Y0 + (size_t)TT * RWW;
    const float* gn = INP(I_GN) + (size_t)j * 2 * RWW;
    bf16* CAT = WSP(bf16, WS_CAT);
    for (int row = F.gw; row < TT; row += F.NGW) {
#pragma unroll
        for (int q = 0; q < 2; ++q) {
            const int c = 4 * F.lane + 256 * q; const size_t o = (size_t)row * RWW + c;
            const f32x4 y = *(const f32x4*)(Y0 + o) + *(const f32x4*)(Y1 + o);
            float s = (y.x + y.y) + (y.z + y.w);
            s = sum16_f(s);
            const float mu = s * (1.0f / 64.0f); const f32x4 dy = y - mu;
            float v2 = (dy.x * dy.x + dy.y * dy.y) + (dy.z * dy.z + dy.w * dy.w);
            v2 = sum16_f(v2);
            const float rstd = 1.0f / sqrtf(v2 * (1.0f / 64.0f) + 64e-5f);
            const f32x4 yn = dy * rstd * *(const f32x4*)(gn + c) + *(const f32x4*)(gn + RWW + c);
            const f32x4 v = *(const f32x4*)(Vv + o), g = *(const f32x4*)(Gg + o);
            const float bs = BON[(size_t)row * 8 + (c >> 6)];
            f32x4 ov = (yn + v * bs) * g;
#ifdef ABL_RW
            ov = ov * 0.0f;
#endif
            v2u w; w.x = pk2(ov.x, ov.y); w.y = pk2(ov.z, ov.w);
            *(v2u*)(CAT + (size_t)row * DM + c) = w;
        }
    }
    LAS float* scr = (LAS float*)(F.lds + F.wave * 16640);
    for (int it = F.gw; it < (TT / 64) * 8; it += F.NGW) {
        const int rt = it >> 3, ct = it & 7; const int r0 = rt * 64; int L; const int l0 = seq_l(r0, L);
        const float* src; if (r0 < TLAT) src = WSP(float, WS_HYTL) + ((size_t)(r0 >> 12) * 512 + ct * 64) * SEQ + l0; else src = WSP(float, WS_HYTC) + ((size_t)((r0 - TLAT) >> 8) * 512 + ct * 64) * CTXL + l0;
        for (int cc = 0; cc < 64; ++cc) scr[cc * 65 + F.lane] = src[(size_t)cc * L + F.lane];
        LDS_WAIT(); asm volatile("" ::: "memory");
        const int c2 = 2 * (F.lane & 31);
        for (int i2 = 0; i2 < 32; ++i2) { const int rr = 2 * i2 + (F.lane >> 5);
            unsigned pkv = pk2(scr[c2 * 65 + rr], scr[(c2 + 1) * 65 + rr]);
#ifdef ABL_HY
            pkv = 0u;
#endif
            *(unsigned*)(CAT + (size_t)(r0 + rr) * DM + 512 + ct * 64 + c2) = pkv; }
        LDS_WAIT(); asm volatile("" ::: "memory");
    }
}

__device__ __forceinline__ int chunk_base_row(int b, int d, int n) {
    if (n < 16) return TLAT + b * CTXL + 16 * (d ? 15 - n : n);
    const int m = n - 16; return b * SEQ + 16 * (d ? 255 - m : m);
}

__device__ __forceinline__ void ph_chunkprep(Frame& F0, int j) { Frame F = F0; LAUNDER(F);
    const float* Rr = (const float*)(F.ws + WS_RW); const float* Kk = (const float*)(F.ws + WS_RW + RW_STRIDE); const float* Vv = (const float*)(F.ws + WS_RW + 2 * RW_STRIDE); const float* KKn = (const float*)(F.ws + WS_RW + 3 * RW_STRIDE);
    const bf16* AOP = WSP(bf16, WS_AOP); float* Gg = WSP(float, WS_G); float* BON = WSP(float, WS_BON);
    LAS unsigned char* wl = F.lds + F.wave * 14336;
    LAS float* ST = (LAS float*)wl; LAS bf16* OPB = (LAS bf16*)(wl + 4096); LAS float* TM = (LAS float*)(wl + 12288); LAS float* M2s = (LAS float*)(wl + 13312);
    LAS v4u* FBL = (LAS v4u*)(F.lds + 8 * 14336);
    const int h = F.vcu & 7;
    {
        const v4u* FB = WSP(v4u, WS_FRAGB) + (size_t)j * 224 * 64;
        for (int i = F.tid; i < 28 * 64; i += NTHR) { const int f = i >> 6, l = i & 63; int src;
            if (f < 8) src = (f >> 2) * 32 + 4 * h + (f & 3); else if (f < 16) src = 64 + ((f - 8) >> 2) * 32 + 4 * h + (f & 3); else src = 128 + (4 * h + (f - 16) / 3) * 3 + (f - 16) % 3;
            FBL[i] = FB[src * 64 + l]; }
    }
    __syncthreads();
    const int lane = F.lane, n15 = lane & 15, q = lane >> 4;
    LAS float* BIAS = (LAS float*)(F.lds + LDSCTL_OFF + 1024);
    if (F.tid < 256) { const int which = F.tid >> 7, d = (F.tid >> 6) & 1, c = F.tid & 63; BIAS[F.tid] = (which ? INP(I_A0) : INP(I_W0))[(size_t)(j * 2 + d) * RWW + h * 64 + c]; }
    __syncthreads();
    const int col = h * 64 + lane;
    const float kav = INP(I_KA)[(size_t)j * RWW + col], rkv = INP(I_RK)[(size_t)j * RWW + col];
    for (int c16 = (F.vcu >> 3) * 8 + F.wave; c16 < TT / 16; c16 += (F.G >> 3) * 8) {
        const int base = c16 * 16;
        const bool lat = base < TLAT; const int b = lat ? (base >> 12) : ((base - TLAT) >> 8); const int cidx = lat ? ((base & (SEQ - 1)) >> 4) : (((base - TLAT) & (CTXL - 1)) >> 4);
        bf16x8 af[7];
#pragma unroll
        for (int f7 = 4; f7 < 7; ++f7) af[f7] = *(const bf16x8*)(AOP + (size_t)(base + n15) * 224 + f7 * 32 + 8 * q);
        float kkv[16], kxv[16], rxv[16];
#pragma unroll
        for (int s = 0; s < 16; ++s) { const size_t o = (size_t)(base + s) * RWW + col; kkv[s] = KKn[o]; kxv[s] = Kk[o]; rxv[s] = Rr[o]; }
#pragma unroll
        for (int nt = 0; nt < 4; ++nt) {
            f32x4 cg = __builtin_amdgcn_mfma_f32_16x16x32_bf16(af[4], __builtin_bit_cast(bf16x8, FBL[(16 + nt * 3 + 0) * 64 + lane]), (f32x4){0.f, 0.f, 0.f, 0.f}, 0, 0, 0);
            cg = __builtin_amdgcn_mfma_f32_16x16x32_bf16(af[5], __builtin_bit_cast(bf16x8, FBL[(16 + nt * 3 + 1) * 64 + lane]), cg, 0, 0, 0);
            cg = __builtin_amdgcn_mfma_f32_16x16x32_bf16(af[6], __builtin_bit_cast(bf16x8, FBL[(16 + nt * 3 + 2) * 64 + lane]), cg, 0, 0, 0);
#pragma unroll
            for (int r = 0; r < 4; ++r) Gg[(size_t)(base + 4 * q + r) * RWW + h * 64 + nt * 16 + n15] = cg[r];
        }
        float bon_mine = 0.f;
#pragma unroll 1
        for (int d = 0; d < 2; ++d) {
            float wv[16], av[16];
            const bf16x8 afw = *(const bf16x8*)(AOP + (size_t)(base + n15) * 224 + d * 32 + 8 * q), afa = *(const bf16x8*)(AOP + (size_t)(base + n15) * 224 + 64 + d * 32 + 8 * q);
#pragma unroll
            for (int which = 0; which < 2; ++which) {
#pragma unroll
                for (int nt = 0; nt < 4; ++nt) {
                    const bf16x8 aop = which ? afa : afw;
                    const f32x4 c4 = __builtin_amdgcn_mfma_f32_16x16x32_bf16(aop, __builtin_bit_cast(bf16x8, FBL[(8 * which + 4 * d + nt) * 64 + lane]), (f32x4){0.f, 0.f, 0.f, 0.f}, 0, 0, 0);
                    const float bias = BIAS[(which * 2 + d) * 64 + nt * 16 + n15];
#pragma unroll
                    for (int r = 0; r < 4; ++r) { const int tok = 4 * q + r, st = d ? 15 - tok : tok; const float x = bias + c4[r];
                        ST[st * 64 + nt * 16 + n15] = which ? sigmoidf_(x) : __expf(-0.6065306597126334f * sigmoidf_(x)); }
                }
                LDS_WAIT(); asm volatile("" ::: "memory");
#pragma unroll
                for (int s = 0; s < 16; ++s) { if (which) av[s] = ST[s * 64 + lane]; else wv[s] = ST[s * 64 + lane]; }
                LDS_WAIT(); asm volatile("" ::: "memory");
            }
            float kt[16];
            float p = 1.0f;
#pragma unroll
            for (int s = 0; s < 16; ++s) {
                const float kk = d ? kkv[15 - s] : kkv[s], kx = d ? kxv[15 - s] : kxv[s], rx = d ? rxv[15 - s] : rxv[s];
                const float kd = kx * (1.0f + (av[s] - 1.0f) * kav);
                { const float bt_ = wave_sum(rx * kd * rkv); if (lane == (d ? 15 - s : s)) bon_mine += bt_; }
                kt[s] = kk * p; p *= wv[s]; const float ip = 1.0f / p;
                OPB[0 * 1024 + s * 64 + lane] = (bf16)f2bf(kt[s]);
                OPB[1 * 1024 + s * 64 + lane] = (bf16)f2bf(rx * p);
                OPB[2 * 1024 + s * 64 + lane] = (bf16)f2bf(kd * ip);
                OPB[3 * 1024 + s * 64 + lane] = (bf16)f2bf(kk * av[s] * ip);
            }
            const float pc = p;
            LDS_WAIT(); asm volatile("" ::: "memory");
            {
                bf16x8 fk[2], fr[2], fb[2], fkk[2];
#pragma unroll
                for (int ks = 0; ks < 2; ++ks) { const int off = n15 * 64 + ks * 32 + 8 * q;
                    fk[ks] = *(const LAS bf16x8*)(OPB + 0 * 1024 + off); fr[ks] = *(const LAS bf16x8*)(OPB + 1 * 1024 + off);
                    fkk[ks] = *(const LAS bf16x8*)(OPB + 2 * 1024 + off); fb[ks] = *(const LAS bf16x8*)(OPB + 3 * 1024 + off); }
                f32x4 mA = (f32x4){0.f, 0.f, 0.f, 0.f}, mB = mA, mE = mA, mG = mA;
#pragma unroll
                for (int ks = 0; ks < 2; ++ks) {
                    mA = __builtin_amdgcn_mfma_f32_16x16x32_bf16(fk[ks], fb[ks], mA, 0, 0, 0);
                    mB = __builtin_amdgcn_mfma_f32_16x16x32_bf16(fk[ks], fkk[ks], mB, 0, 0, 0);
                    mE = __builtin_amdgcn_mfma_f32_16x16x32_bf16(fr[ks], fkk[ks], mE, 0, 0, 0);
                    mG = __builtin_amdgcn_mfma_f32_16x16x32_bf16(fr[ks], fb[ks], mG, 0, 0, 0);
                }
#pragma unroll
                for (int r = 0; r < 4; ++r) { const int sr = 4 * q + r;
                    ST[0 * 256 + sr * 16 + n15] = n15 < sr ? mA[r] : 0.f; ST[1 * 256 + sr * 16 + n15] = n15 < sr ? mB[r] : 0.f;
                    ST[2 * 256 + sr * 16 + n15] = n15 <= sr ? mE[r] : 0.f; ST[3 * 256 + sr * 16 + n15] = n15 <= sr ? mG[r] : 0.f; }
            }
            LDS_WAIT(); asm volatile("" ::: "memory");
            float vfa[2][8], vfb[2][8];
#pragma unroll
            for (int ig = 0; ig < 2; ++ig)
#pragma unroll
                for (int jj = 0; jj < 8; ++jj) { const int sg = (8 * q + jj) & 15; vfa[ig][jj] = Vv[(size_t)(base + (d ? 15 - sg : sg)) * RWW + h * 64 + ig * 16 + n15]; }
            {
                float tc[16];
#pragma unroll
                for (int s = 0; s < 16; ++s) { float acc = (s == n15) ? 1.0f : 0.0f;
#pragma unroll
                    for (int sg = 0; sg < s; ++sg) acc -= ST[0 * 256 + s * 16 + sg] * tc[sg];
                    tc[s] = acc; }
                if (q == 0) {
#pragma unroll
                    for (int s = 0; s < 16; ++s) TM[s * 16 + n15] = tc[s]; }
            }
            LDS_WAIT(); asm volatile("" ::: "memory");
            {
                float m1[16];
#pragma unroll
                for (int s = 0; s < 16; ++s) { float acc = 0.f;
#pragma unroll
                    for (int sg = 0; sg <= s; ++sg) acc += TM[s * 16 + sg] * kt[sg];
                    m1[s] = acc; }
#pragma unroll
                for (int s = 0; s < 16; ++s) OPB[0 * 1024 + s * 64 + lane] = (bf16)f2bf(m1[s]);
#pragma unroll
                for (int r = 0; r < 4; ++r) { const int sr = 4 * q + r; float acc = 0.f;
#pragma unroll
                    for (int sg = 0; sg < 16; ++sg) acc += TM[sr * 16 + sg] * ST[1 * 256 + sg * 16 + n15];
                    M2s[sr * 16 + n15] = acc; }
            }
            LDS_WAIT(); asm volatile("" ::: "memory");
#pragma unroll
            for (int ig = 0; ig < 2; ++ig)
#pragma unroll
                for (int jj = 0; jj < 8; ++jj) { const int sg = (8 * q + jj) & 15; vfb[ig][jj] = Vv[(size_t)(base + (d ? 15 - sg : sg)) * RWW + h * 64 + (2 + ig) * 16 + n15]; }
            {
                const int scan = b * 16 + h * 2 + d; const int npos = lat ? 16 + (d ? 255 - cidx : cidx) : (d ? 15 - cidx : cidx);
                unsigned char* rec = (unsigned char*)F.ws + WS_REC + ((size_t)scan * 272 + npos) * REC_BYTES;
                unsigned short e8[8];
#define PK_LO() ((unsigned)e8[0] | ((unsigned)e8[1] << 16))
#define PK_HI() ((unsigned)e8[2] | ((unsigned)e8[3] << 16))
#define STORE_FULL(piece) do { v4u o_; o_.x = PK_LO(); o_.y = PK_HI(); o_.z = e8[4] | ((unsigned)e8[5] << 16); o_.w = e8[6] | ((unsigned)e8[7] << 16); *(v4u*)(rec + (piece) * 1024 + lane * 16) = o_; } while (0)
#define STORE_HALFLANES(piece, sel) do { if (q < 2) { v4u o_; o_.x = PK_LO(); o_.y = PK_HI(); o_.z = e8[4] | ((unsigned)e8[5] << 16); o_.w = e8[6] | ((unsigned)e8[7] << 16); *(v4u*)(rec + (piece) * 1024 + ((sel) * 32 + (lane & 31)) * 16) = o_; } } while (0)
#define STORE_HALFWIDTH(piece, sel) do { v2u o_; o_.x = PK_LO(); o_.y = PK_HI(); *(v2u*)(rec + (piece) * 1024 + lane * 16 + (sel) * 8) = o_; } while (0)
#pragma unroll
                for (int ks = 0; ks < 2; ++ks) {
#pragma unroll
                    for (int jj = 0; jj < 8; ++jj) e8[jj] = OPB[0 * 1024 + n15 * 64 + 32 * ks + 16 * (jj >> 2) + 4 * q + (jj & 3)];
                    STORE_FULL(ks);
#pragma unroll
                    for (int jj = 0; jj < 8; ++jj) e8[jj] = OPB[1 * 1024 + n15 * 64 + 32 * ks + 16 * (jj >> 2) + 4 * q + (jj & 3)];
                    STORE_FULL(2 + ks);
                }
#pragma unroll
                for (int jj = 0; jj < 8; ++jj) e8[jj] = (unsigned short)f2bf(M2s[n15 * 16 + ((8 * q + jj) & 15)]);
                STORE_HALFLANES(4, 0);
#pragma unroll
                for (int jj = 0; jj < 8; ++jj) e8[jj] = (unsigned short)f2bf(ST[2 * 256 + n15 * 16 + ((8 * q + jj) & 15)]);
                STORE_HALFLANES(4, 1);
#pragma unroll
                for (int jj = 0; jj < 4; ++jj) e8[jj] = (unsigned short)f2bf(-ST[3 * 256 + n15 * 16 + 4 * q + jj]);
                STORE_HALFWIDTH(9, 0);
#pragma unroll
                for (int tl = 0; tl < 4; ++tl) {
#pragma unroll
                    for (int jj = 0; jj < 8; ++jj) e8[jj] = (unsigned short)OPB[2 * 1024 + ((8 * q + jj) & 15) * 64 + 16 * tl + n15];
                    STORE_HALFLANES(5 + (tl >> 1), tl & 1);
#pragma unroll
                    for (int jj = 0; jj < 4; ++jj) e8[jj] = (unsigned short)(OPB[3 * 1024 + (4 * q + jj) * 64 + 16 * tl + n15] ^ 0x8000u);
                    if (tl == 0) STORE_HALFWIDTH(9, 1); else if (tl == 1) STORE_HALFWIDTH(10, 0); else if (tl == 2) STORE_HALFWIDTH(10, 1); else STORE_HALFWIDTH(11, 0);
                }
#pragma unroll
                for (int ig = 0; ig < 4; ++ig) {
#pragma unroll
                    for (int jj = 0; jj < 8; ++jj) e8[jj] = (unsigned short)f2bf(ig < 2 ? vfa[ig & 1][jj] : vfb[ig & 1][jj]);
                    STORE_HALFLANES(7 + (ig >> 1), ig & 1);
                }
#undef PK_LO
#undef PK_HI
#undef STORE_FULL
#undef STORE_HALFLANES
#undef STORE_HALFWIDTH
                *(float*)(rec + 11 * 1024 + (lane >> 1) * 16 + 8 + (lane & 1) * 4) = pc;
            }
            LDS_WAIT(); asm volatile("" ::: "memory");
        }
        if (lane < 16) BON[(size_t)(base + lane) * 8 + h] = bon_mine;
    }
}

__device__ __forceinline__ void scan_unit(Frame& F, int scan) {
    constexpr int R = 11, D = 10, NCH = 272;
    const int b = scan >> 4, h = (scan >> 1) & 7, d = scan & 1;
    const int lane = F.lane, n15 = lane & 15, q = lane >> 4, l31 = lane & 31;
    const unsigned char* rec0 = (const unsigned char*)F.ws + WS_REC + (size_t)scan * NCH * REC_BYTES;
    const bool loader = F.wave >= 4; const int lw = F.wave & 3, ig = F.wave & 3;
    float* Yd = WSP(float, WS_Y) + (size_t)d * TT * RWW;
    f32x4 S[4];
#pragma unroll
    for (int t = 0; t < 4; ++t) S[t] = (f32x4){0.f, 0.f, 0.f, 0.f};
#define ISSUE(n_) do { const unsigned char* g_ = rec0 + (size_t)(n_) * REC_BYTES + lw * 1024 + lane * 16; LAS unsigned char* l_ = F.lds + ((n_) % R) * (int)REC_BYTES + lw * 1024; \
        _Pragma("unroll") for (int p_ = 0; p_ < 3; ++p_) __builtin_amdgcn_global_load_lds((const unsigned*)(g_ + p_ * 4096), (LAS unsigned*)(l_ + p_ * 4096), 16, 0, 0); } while (0)
#define BF8(x) __builtin_bit_cast(bf16x8, x)
    if (loader) {
#pragma unroll 1
        for (int n = 0; n < D; ++n) ISSUE(n);
        asm volatile("s_waitcnt vmcnt(27)" ::: "memory");
    }
    __builtin_amdgcn_s_barrier();
    const v4u zf = (v4u){0u, 0u, 0u, 0u}; const bool vz = q >= 2;
#pragma unroll 1
    for (int n = 0; n < NCH; ++n) {
        if (loader) {
            if (n + D < NCH) { ISSUE(n + D); asm volatile("s_waitcnt vmcnt(27)" ::: "memory"); }
            else asm volatile("s_waitcnt vmcnt(0)" ::: "memory");
        } else {
            const LAS unsigned char* sl = F.lds + (n % R) * (int)REC_BYTES;
#define FULLP(p) (*(const LAS v4u*)(sl + (p) * 1024 + lane * 16))
#define HALFL(p, sel) (vz ? zf : *(const LAS v4u*)(sl + (p) * 1024 + ((sel) * 32 + l31) * 16))
#define HALFW(p, sel) ({ const v2u t_ = *(const LAS v2u*)(sl + (p) * 1024 + lane * 16 + (sel) * 8); (v4u){t_.x, t_.y, 0u, 0u}; })
            v4u sb0, sb1; sb0.x = pk2(S[0][0], S[0][1]); sb0.y = pk2(S[0][2], S[0][3]); sb0.z = pk2(S[1][0], S[1][1]); sb0.w = pk2(S[1][2], S[1][3]);
            sb1.x = pk2(S[2][0], S[2][1]); sb1.y = pk2(S[2][2], S[2][3]); sb1.z = pk2(S[3][0], S[3][1]); sb1.w = pk2(S[3][2], S[3][3]);
            const f32x4 z4 = (f32x4){0.f, 0.f, 0.f, 0.f};
            const v4u fv = HALFL(7 + (ig >> 1), ig & 1);
            f32x4 U = __builtin_amdgcn_mfma_f32_16x16x32_bf16(BF8(FULLP(0)), BF8(sb0), z4, 0, 0, 0);
            f32x4 Y = __builtin_amdgcn_mfma_f32_16x16x32_bf16(BF8(FULLP(2)), BF8(sb0), z4, 0, 0, 0);
            U = __builtin_amdgcn_mfma_f32_16x16x32_bf16(BF8(FULLP(1)), BF8(sb1), U, 0, 0, 0);
            Y = __builtin_amdgcn_mfma_f32_16x16x32_bf16(BF8(FULLP(3)), BF8(sb1), Y, 0, 0, 0);
            U = __builtin_amdgcn_mfma_f32_16x16x32_bf16(BF8(HALFL(4, 0)), BF8(fv), U, 0, 0, 0);
            Y = __builtin_amdgcn_mfma_f32_16x16x32_bf16(BF8(HALFL(4, 1)), BF8(fv), Y, 0, 0, 0);
#pragma unroll
            for (int t = 0; t < 4; ++t) S[t] = __builtin_amdgcn_mfma_f32_16x16x32_bf16(BF8(HALFL(5 + (t >> 1), t & 1)), BF8(fv), S[t], 0, 0, 0);
            v4u ub; ub.x = pk2(U[0], U[1]); ub.y = pk2(U[2], U[3]); ub.z = 0u; ub.w = 0u;
            Y = __builtin_amdgcn_mfma_f32_16x16x32_bf16(BF8(HALFW(9, 0)), BF8(ub), Y, 0, 0, 0);
            S[0] = __builtin_amdgcn_mfma_f32_16x16x32_bf16(BF8(HALFW(9, 1)), BF8(ub), S[0], 0, 0, 0);
            S[1] = __builtin_amdgcn_mfma_f32_16x16x32_bf16(BF8(HALFW(10, 0)), BF8(ub), S[1], 0, 0, 0);
            S[2] = __builtin_amdgcn_mfma_f32_16x16x32_bf16(BF8(HALFW(10, 1)), BF8(ub), S[2], 0, 0, 0);
            S[3] = __builtin_amdgcn_mfma_f32_16x16x32_bf16(BF8(HALFW(11, 0)), BF8(ub), S[3], 0, 0, 0);
#pragma unroll
            for (int t = 0; t < 4; ++t) { const LAS unsigned char* pp = sl + 11 * 1024 + (8 * t + 2 * q) * 16 + 8; const f32x2 p0 = *(const LAS f32x2*)pp, p1 = *(const LAS f32x2*)(pp + 16);
                S[t] = S[t] * (f32x4){p0.x, p0.y, p1.x, p1.y}; }
            const int base = chunk_base_row(b, d, n);
#pragma unroll
            for (int r = 0; r < 4; ++r) { const int st = 4 * q + r; Yd[(size_t)(base + (d ? 15 - st : st)) * RWW + h * 64 + ig * 16 + n15] = Y[r]; }
            asm volatile("s_waitcnt lgkmcnt(0)" ::: "memory");
#undef FULLP
#undef HALFL
#undef HALFW
        }
        __builtin_amdgcn_s_barrier();
    }
#undef ISSUE
#undef BF8
    asm volatile("s_waitcnt vmcnt(0)" ::: "memory");
    __syncthreads();
}

__device__ __forceinline__ void subset_arrive(unsigned* ctr) {
    asm volatile("s_waitcnt vmcnt(0)" ::: "memory"); __syncthreads();
    if (threadIdx.x == 0) { __builtin_amdgcn_fence(__ATOMIC_RELEASE, "agent"); asm volatile("s_waitcnt vmcnt(0)" ::: "memory"); __hip_atomic_fetch_add(ctr, 1u, __ATOMIC_RELAXED, __HIP_MEMORY_SCOPE_AGENT); }
}
__device__ __forceinline__ void subset_wait(unsigned* ctr, unsigned n) {
    if (threadIdx.x == 0) { unsigned sp = 0;
        while (__hip_atomic_load(ctr, __ATOMIC_RELAXED, __HIP_MEMORY_SCOPE_AGENT) < n) { __builtin_amdgcn_s_sleep(4); if (++sp > (1u << 24)) break; }
        __builtin_amdgcn_fence(__ATOMIC_ACQUIRE, "agent"); asm volatile("s_waitcnt vmcnt(0)" ::: "memory"); }
    __syncthreads();
}
__device__ __forceinline__ void ph_scan_hyena(Frame& F0, int j, int i) { Frame F = F0; LAUNDER(F);
    unsigned* ctl = (unsigned*)(F.ws + WS_CTL) + 512 + 256 * i;
    LAS f32x2* TWL = (LAS f32x2*)(F.lds + 67584); LAS int* tick = (LAS int*)(F.lds + 133120 + 256);
    const float* hyb = INP(I_HYB) + (size_t)j * 1024;
    const bool split = F.G >= 128; const int nf = split ? F.G - 64 : F.G;
    TP_BEGIN();
    if (split && F.vcu < 64) { scan_unit(F, F.vcu); TP_END(6); }
    else {
        if (!split) { for (int sc = F.vcu; sc < 64; sc += F.G) scan_unit(F, sc); }
        const int id = split ? F.vcu - 64 : F.vcu;
        load_tw<13>(F, TWL); __syncthreads();
        for (int it = id; it < 512; it += nf) fftk_item<13, 1>(F, WSP(float, WS_KCL), WSP(f32x4, WS_KSPL), it);
        __syncthreads(); load_tw<9>(F, TWL); __syncthreads();
        for (int it = id; it < 64; it += nf) fftk_item<9, 8>(F, WSP(float, WS_KCC), WSP(f32x4, WS_KSPC), it);
        subset_arrive(ctl);
    }
    subset_wait(ctl, (unsigned)nf);
    int cur_n = 0;
    for (;;) {
        __syncthreads();
        if (F.tid == 0) tick[0] = (int)__hip_atomic_fetch_add(ctl + 64, 1u, __ATOMIC_RELAXED, __HIP_MEMORY_SCOPE_AGENT);
        __syncthreads();
        const int it = tick[0];
        if (it >= 1024 + 128) break;
        const int want = it < 1024 ? 13 : 9;
        if (cur_n != want) { __syncthreads(); if (want == 13) load_tw<13>(F, TWL); else load_tw<9>(F, TWL); cur_n = want; __syncthreads(); }
        if (it < 1024) hyena_item<13, 1>(F, WSP(float, WS_UTL), WSP(f32x4, WS_KSPL), WSP(float, WS_HYTL), hyb, INP(I_CONVW) + (size_t)j * 3 * HYC, INP(I_CONVB) + (size_t)j * HYC, it);
        else hyena_item<9, 8>(F, WSP(float, WS_UTC), WSP(f32x4, WS_KSPC), WSP(float, WS_HYTC), hyb, INP(I_CONVW) + (size_t)j * 3 * HYC, INP(I_CONVB) + (size_t)j * HYC, it - 1024);
    }
}
__device__ __forceinline__ void ph_mod2(Frame& F0, int i) { Frame F = F0; LAUNDER(F);
    LAS float* RL = (LAS float*)F.lds;
    const float* router = INP(I_ROUTER) + (size_t)i * DM * NE;
    for (int idx = F.tid; idx < DM * NE; idx += NTHR) { const int c = idx >> 4, e = idx & 15; RL[e * 1024 + c] = router[idx]; }
    __syncthreads();
    const float* mods = WSP(float, WS_MODS) + (size_t)i * 5 * 6144; const float* g = INP(I_NORMG) + (size_t)(i * 2 + 1) * DM;
    const int nrows = i + 1 < DEPTH ? TT : TLAT;
    f32x4 vn[4];
    if (F.gw < nrows) {
#pragma unroll
        for (int jj = 0; jj < 4; ++jj) vn[jj] = ((const f32x4*)(WSP(float, WS_X) + (size_t)F.gw * DM))[64 * jj + F.lane]; }
    for (int row = F.gw; row < nrows; row += F.NGW) {
        f32x4 v[4], h[4];
#pragma unroll
        for (int jj = 0; jj < 4; ++jj) v[jj] = vn[jj];
        if (row + F.NGW < nrows) {
#pragma unroll
            for (int jj = 0; jj < 4; ++jj) vn[jj] = ((const f32x4*)(WSP(float, WS_X) + (size_t)(row + F.NGW) * DM))[64 * jj + F.lane]; }
        const int s = row_s(row);
        mod_row_store(v, g, mods + s * 6144 + 3 * 1024, mods + s * 6144 + 4 * 1024, WSP(bf16, WS_HA) + (size_t)row * DM, F.lane, h);
        float mylg = 0.f;
#pragma unroll 1
        for (int g4 = 0; g4 < 4; ++g4) {
            float a4[4];
#pragma unroll
            for (int k = 0; k < 4; ++k) { float a = 0.f;
#pragma unroll
                for (int jj = 0; jj < 4; ++jj) { const f32x4 r4 = ((const LAS f32x4*)(RL + (4 * g4 + k) * 1024))[64 * jj + F.lane]; a += (h[jj].x * r4.x + h[jj].y * r4.y) + (h[jj].z * r4.z + h[jj].w * r4.w); }
                a4[k] = a; }
#pragma unroll
            for (int k = 0; k < 4; ++k) a4[k] += dpp_f<DPP_XOR1>(a4[k]);
#pragma unroll
            for (int k = 0; k < 4; ++k) a4[k] += dpp_f<DPP_XOR2>(a4[k]);
#pragma unroll
            for (int k = 0; k < 4; ++k) a4[k] += dpp_f<DPP_HMIRROR>(a4[k]);
#pragma unroll
            for (int k = 0; k < 4; ++k) a4[k] += dpp_f<DPP_MIRROR>(a4[k]);
#pragma unroll
            for (int k = 0; k < 4; ++k) if ((F.lane & 15) == 4 * g4 + k) mylg = a4[k];
        }
        mylg += __builtin_bit_cast(float, __builtin_amdgcn_ds_swizzle(__builtin_bit_cast(int, mylg), 0x401F));
        { auto rr = __builtin_amdgcn_permlane32_swap(__float_as_uint(mylg), __float_as_uint(mylg), false, false); const unsigned lo_ = rr[0], hi_ = rr[1]; mylg = __uint_as_float(lo_) + __uint_as_float(hi_); }
        if (F.lane >= 16) mylg = -1e30f;
        const float mx = max16_f(mylg);
        const float ex = expf(mylg - mx); const float den = sum16_f(ex);
        const float mine = ex / den;
        if (F.lane < 16) WSP(float, WS_AFF)[(size_t)row * 16 + F.lane] = mine;
    }
}

__device__ __forceinline__ int block_excl_scan(Frame& F, int v, LAS int* sc, int& total) {
    LAS int* cnt = sc + 16;
    __syncthreads();
    cnt[F.tid] = v;
    const int ws = wave_sum_i(v);
    if (F.lane == 0) sc[F.wave] = ws;
    __syncthreads();
    int base = 0, tot = 0;
#pragma unroll
    for (int w = 0; w < NWAVES; ++w) { const int t = sc[w]; if (w < F.wave) base += t; tot += t; }
    int pre = 0;
    for (int k = 0; k < F.lane; ++k) pre += cnt[F.wave * 64 + k];
    total = tot; return base + pre;
}
__device__ __forceinline__ int block_sum_i(Frame& F, int v, LAS int* sc) {
    v = wave_sum_i(v);
    __syncthreads(); if (F.lane == 0) sc[F.wave] = v; __syncthreads();
    int t = 0;
#pragma unroll
    for (int w = 0; w < NWAVES; ++w) t += sc[w];
    return t;
}
__device__ __forceinline__ void topk_item(Frame& F, int set, int e) {
    LAS int* sc = (LAS int*)(F.lds + 133120);
    const bool lat = set < 4; const int L = lat ? SEQ : CTXL, cap = lat ? 512 : 32; const int rbase = lat ? set * SEQ : TLAT + (set - 4) * CTXL;
    const int sbase = e * EROWS + (lat ? set * 512 : 2048 + (set - 4) * 32);
    const float* aff = WSP(float, WS_AFF);
    unsigned key[8];
#pragma unroll
    for (int q = 0; q < 8; ++q) { const int l = F.tid * 8 + q; key[q] = l < L ? __builtin_bit_cast(unsigned, aff[(size_t)(rbase + l) * 16 + e]) : 0u; }
    unsigned thr = 0u;
    for (int bit = 30; bit >= 0; --bit) {
        const unsigned cand = thr | (1u << bit); int cnt = 0;
#pragma unroll
        for (int q = 0; q < 8; ++q) cnt += (key[q] >= cand) ? 1 : 0;
        if (block_sum_i(F, cnt, sc) >= cap) thr = cand;
    }
    int ngt = 0, neq = 0;
#pragma unroll
    for (int q = 0; q < 8; ++q) { ngt += key[q] > thr ? 1 : 0; neq += (key[q] == thr && (F.tid * 8 + q) < L) ? 1 : 0; }
    int tot_gt, tot_eq; const int bgt = block_excl_scan(F, ngt, sc, tot_gt); const int beq = block_excl_scan(F, neq, sc, tot_eq);
    const int need_eq = cap - tot_gt; int rg = bgt, re = beq;
    int* slotmap = WSP(int, WS_SLOT); int* idxo = WSP(int, WS_IDX); float* gate = WSP(float, WS_GATE);
#pragma unroll
    for (int q = 0; q < 8; ++q) { const int l = F.tid * 8 + q; if (l < L) {
        int slot = -1;
        if (key[q] > thr) { slot = rg; ++rg; } else if (key[q] == thr) { if (re < need_eq) slot = tot_gt + re; ++re; }
        slotmap[(size_t)(rbase + l) * 16 + e] = slot;
        if (slot >= 0) { idxo[sbase + slot] = rbase + l; gate[sbase + slot] = __builtin_bit_cast(float, key[q]); } } }
    if (set == 0) for (int p = F.tid; p < EROWS - 2176; p += NTHR) { idxo[e * EROWS + 2176 + p] = 0; gate[e * EROWS + 2176 + p] = 0.f; }
    __syncthreads();
}
__device__ __forceinline__ void ph_topk(Frame& F0, int i) { Frame F = F0; LAUNDER(F);
    TP_BEGIN();
    for (int it = F.vcu; it < (i + 1 < DEPTH ? 128 : 64); it += F.G) topk_item(F, it >> 4, it & 15);
    TP_END(4);
    LAS float* scr = (LAS float*)(F.lds + F.wave * 16640);
    const float* w1 = INP(I_MW1) + (size_t)i * NE * DM * FF; const float* w3 = INP(I_MW3) + (size_t)i * NE * DM * FF; const float* w2 = INP(I_MW2) + (size_t)i * NE * FF * DM;
    for (int it = F.gw; it < 3 * NE * 256; it += F.NGW) {
        const int which = it / (NE * 256), r = it % (NE * 256), e = r >> 8, item = r & 255;
        if (which == 0) transpose_item(w1 + (size_t)e * DM * FF, DM, FF, WSP(bf16, WS_W13), RowW13{e, 0}, scr, item, F.lane);
        else if (which == 1) transpose_item(w3 + (size_t)e * DM * FF, DM, FF, WSP(bf16, WS_W13), RowW13{e, 1}, scr, item, F.lane);
        else transpose_item(w2 + (size_t)e * FF * DM, FF, DM, WSP(bf16, WS_W2), RowId{e * 1024}, scr, item, F.lane);
    }
    TP_END(5);
}
__device__ __forceinline__ void ph_gather(Frame& F0, bool need_ctx) { Frame F = F0; LAUNDER(F);
    const int* idx = WSP(int, WS_IDX); const bf16* HA = WSP(bf16, WS_HA); bf16* XG = WSP(bf16, WS_XG);
    for (int r = F.gw; r < NE * EROWS; r += F.NGW) {
        if (!need_ctx && (r % EROWS) >= 2048) continue;
        const int src = idx[r]; const v4u* s = (const v4u*)(HA + (size_t)src * DM); v4u* d = (v4u*)(XG + (size_t)r * DM);
        d[F.lane] = s[F.lane]; d[64 + F.lane] = s[64 + F.lane];
    }
}
__device__ __forceinline__ void ph_combine(Frame& F0, int i) { Frame F = F0; LAUNDER(F);
    const int* slotmap = WSP(int, WS_SLOT); const bf16* YB = WSP(bf16, WS_YB);
    const float* mods = WSP(float, WS_MODS) + (size_t)i * 5 * 6144;
    const int nrows_c = i + 1 < DEPTH ? TT : TLAT;
    int slotn = -1; f32x4 xn[4];
    if (F.gw < nrows_c) { slotn = F.lane < 16 ? slotmap[(size_t)F.gw * 16 + F.lane] : -1;
#pragma unroll
        for (int jj = 0; jj < 4; ++jj) xn[jj] = ((const f32x4*)(WSP(float, WS_X) + (size_t)F.gw * DM))[64 * jj + F.lane]; }
    for (int row = F.gw; row < nrows_c; row += F.NGW) {
        f32x4 acc[4], xc[4];
#pragma unroll
        for (int jj = 0; jj < 4; ++jj) { acc[jj] = (f32x4){0.f, 0.f, 0.f, 0.f}; xc[jj] = xn[jj]; }
        const int myslot = slotn;
        if (row + F.NGW < nrows_c) { slotn = F.lane < 16 ? slotmap[(size_t)(row + F.NGW) * 16 + F.lane] : -1;
#pragma unroll
            for (int jj = 0; jj < 4; ++jj) xn[jj] = ((const f32x4*)(WSP(float, WS_X) + (size_t)(row + F.NGW) * DM))[64 * jj + F.lane]; }
        unsigned long long sel = __ballot(myslot >= 0);
        const int sbase = row < TLAT ? (row >> 12) * 512 : 2048 + ((row - TLAT) >> 8) * 32;
        while (sel) {
            const int e = __builtin_ctzll(sel); sel &= sel - 1;
            const int sl = __builtin_amdgcn_readlane(myslot, e);
            const v2u* yr = (const v2u*)(YB + (size_t)(e * EROWS + sbase + sl) * DM);
#pragma unroll
            for (int jj = 0; jj < 4; ++jj) { const v2u w = yr[64 * jj + F.lane];
                acc[jj].x += __builtin_bit_cast(float, w.x << 16); acc[jj].y += __builtin_bit_cast(float, w.x & 0xffff0000u);
                acc[jj].z += __builtin_bit_cast(float, w.y << 16); acc[jj].w += __builtin_bit_cast(float, w.y & 0xffff0000u); }
        }
#ifdef ABL_MOE
#pragma unroll
        for (int jj = 0; jj < 4; ++jj) acc[jj] = acc[jj] * 0.0f;
#endif
        const int s = row_s(row); f32x4 v[4], h[4];
        float* xr = WSP(float, WS_X) + (size_t)row * DM;
#pragma unroll
        for (int jj = 0; jj < 4; ++jj) { const f32x4 gm = ((const f32x4*)(mods + s * 6144 + 5 * 1024))[64 * jj + F.lane]; v[jj] = xc[jj] + gm * acc[jj]; ((f32x4*)xr)[64 * jj + F.lane] = v[jj]; }
        if (i + 1 < DEPTH) {
            const float* m2 = WSP(float, WS_MODS) + (size_t)(i + 1) * 5 * 6144;
            mod_row_store(v, INP(I_NORMG) + (size_t)((i + 1) * 2) * DM, m2 + s * 6144, m2 + s * 6144 + 1024, WSP(bf16, WS_HA) + (size_t)row * DM, F.lane, h);
        } else if (row < TLAT) {
            float ss = 0.f;
#pragma unroll
            for (int jj = 0; jj < 4; ++jj) ss += (v[jj].x * v[jj].x + v[jj].y * v[jj].y) + (v[jj].z * v[jj].z + v[jj].w * v[jj].w);
            const float rstd = 1.0f / sqrtf(wave_sum(ss) * (1.0f / 1024.0f) + 1e-6f);
#pragma unroll
            for (int jj = 0; jj < 4; ++jj) ((f32x4*)(F.out + (size_t)row * DM))[64 * jj + F.lane] = v[jj] * rstd * ((const f32x4*)INP(I_FINALG))[64 * jj + F.lane];
        }
    }
}
__device__ __forceinline__ void ph_rope(Frame& F0) { Frame F = F0; LAUNDER(F);
    const float* P = WSP(float, WS_P); bf16* QB = WSP(bf16, WS_QB); bf16* KB = WSP(bf16, WS_KB); bf16* VB = WSP(bf16, WS_VB);
    const int axis = (F.lane >> 1) & 1, half = F.lane & 1;
    float inv[16];
#pragma unroll
    for (int f = 0; f < 16; ++f) inv[f] = exp2f(-(float)f * (13.287712379549449f / 16.0f));
    for (int row = F.gw; row < TT; row += F.NGW) {
        const bool lat = row < TLAT; const int b = lat ? (row >> 12) : ((row - TLAT) >> 8); const int l = lat ? (row & (SEQ - 1)) : ((row - TLAT) & (CTXL - 1));
        const size_t krow = (size_t)b * KSEQ + (lat ? CTXL + l : l);
        float cs[16], sn[16];
        if (lat) { const float pos = (float)(axis ? (l & 63) : (l >> 6));
#pragma unroll
            for (int f = 0; f < 16; ++f) sincosf(pos * inv[f], &sn[f], &cs[f]); }
#pragma unroll
        for (int part = 0; part < 3; ++part) {
            float x[16];
            const float* src = P + (size_t)row * QKVC + part * 1024 + 16 * F.lane;
#pragma unroll
            for (int q = 0; q < 4; ++q) { const f32x4 t = *(const f32x4*)(src + 4 * q); x[4 * q] = t.x; x[4 * q + 1] = t.y; x[4 * q + 2] = t.z; x[4 * q + 3] = t.w; }
            if (part < 2 && lat) {
#pragma unroll
                for (int f = 0; f < 16; ++f) { const float o = xor1_f(x[f]);
                    x[f] = half ? (x[f] * cs[f] + o * sn[f]) : (x[f] * cs[f] - o * sn[f]); }
            }
            v4u w0, w1; w0.x = pk2(x[0], x[1]); w0.y = pk2(x[2], x[3]); w0.z = pk2(x[4], x[5]); w0.w = pk2(x[6], x[7]); w1.x = pk2(x[8], x[9]); w1.y = pk2(x[10], x[11]); w1.z = pk2(x[12], x[13]); w1.w = pk2(x[14], x[15]);
            bf16* dst = part == 0 ? QB + (size_t)row * DM : (part == 1 ? KB + krow * DM : VB + krow * DM);
            *(v4u*)(dst + 16 * F.lane) = w0; *(v4u*)(dst + 16 * F.lane + 8) = w1;
        }
    }
}

namespace att {
using s16x4 = __attribute__((ext_vector_type(4))) short;
using f32x16 = __attribute__((ext_vector_type(16))) float;
using u32x4 = __attribute__((ext_vector_type(4))) unsigned;
constexpr int DQ = 64, DV = 128, NW = 8, QBLK = 32, KVBLK = 64, LD = 1024;
constexpr float SCALE = 0.125f, THR = 8.f;
#ifndef ATT_SDEPTH
#define ATT_SDEPTH 1
#endif
constexpr int SDEPTH = ATT_SDEPTH;
constexpr size_t SHM_V = KVBLK * DV * 2, SHM_K = KVBLK * DQ * 2, SHM_ATTN = 2 * SHM_V + 2 * SHM_K + NW * 64 * 4;
#define KSWZ(row, colB) ((row) * 128 + ((colB) ^ (((row) & 7) << 4)))
#define SBAR() __builtin_amdgcn_sched_barrier(0)
__device__ __forceinline__ int crow(int r, int hi) { return (r & 3) + 8 * (r >> 2) + 4 * hi; }
__device__ __forceinline__ unsigned cvtpk(float lo, float hi) { unsigned r; asm volatile("v_cvt_pk_bf16_f32 %0, %1, %2" : "=v"(r) : "v"(lo), "v"(hi)); return r; }
__device__ __forceinline__ void partialSM(f32x16& p0, f32x16& p1, float& m_reg, float& mn, float& alpha) {
  constexpr float C = SCALE * 1.4426950408889634f;
  float pmax = p0[0]; for (int r = 1; r < 16; ++r) pmax = fmaxf(pmax, p0[r]); for (int r = 0; r < 16; ++r) pmax = fmaxf(pmax, p1[r]);
  { auto rr = __builtin_amdgcn_permlane32_swap(__float_as_uint(pmax), __float_as_uint(pmax), false, false);
    pmax = fmaxf(__uint_as_float(rr[0]), __uint_as_float(rr[1])); }
  if (__builtin_expect(__all(pmax - m_reg <= THR / SCALE), 1)) { mn = m_reg; alpha = 1.f; }
  else { mn = fmaxf(m_reg, pmax); alpha = __builtin_amdgcn_exp2f((m_reg - mn) * C); m_reg = mn; }
  float mnC = -mn * C;
  for (int r = 0; r < 16; ++r) p0[r] = fmaf(p0[r], C, mnC); for (int r = 0; r < 16; ++r) p1[r] = fmaf(p1[r], C, mnC);
  for (int r = 0; r < 16; ++r) p0[r] = __builtin_amdgcn_exp2f(p0[r]);
}
__device__ __forceinline__ void finishSM(f32x16& p0, f32x16& p1, float alpha, float& l_reg, bf16x8& pa0, bf16x8& pa1, bf16x8& pa2, bf16x8& pa3) {
  for (int r = 0; r < 16; ++r) p1[r] = __builtin_amdgcn_exp2f(p1[r]);
  float ps = 0; for (int r = 0; r < 16; ++r) ps += p0[r]; for (int r = 0; r < 16; ++r) ps += p1[r];
  { auto rr = __builtin_amdgcn_permlane32_swap(__float_as_uint(ps), __float_as_uint(ps), false, false);
    ps = __uint_as_float(rr[0]) + __uint_as_float(rr[1]); }
  l_reg = l_reg * alpha + ps;
#define PK4(P, BASE, OUT) do { unsigned a0 = cvtpk(P[BASE + 0], P[BASE + 1]), a1 = cvtpk(P[BASE + 2], P[BASE + 3]);   \
    unsigned b0 = cvtpk(P[BASE + 4], P[BASE + 5]), b1 = cvtpk(P[BASE + 6], P[BASE + 7]);                              \
    auto r0 = __builtin_amdgcn_permlane32_swap(a0, b0, false, false); auto r1 = __builtin_amdgcn_permlane32_swap(a1, b1, false, false); \
    u32x4 w = {r0[0], r1[0], r0[1], r1[1]}; OUT = *reinterpret_cast<bf16x8*>(&w); } while (0)
  PK4(p0, 0, pa0); PK4(p0, 8, pa1); PK4(p1, 0, pa2); PK4(p1, 8, pa3);
#undef PK4
}
__device__ __forceinline__ void qkt(f32x16& p0, f32x16& p1, const bf16* Ks, const bf16x8* qr, int r32, int hi) {
  p0 = f32x16{}; p1 = f32x16{};
#pragma unroll
  for (int d0 = 0; d0 < 4; ++d0) { int cb = (d0 * 16 + hi * 8) * 2;
    bf16x8 b0 = *reinterpret_cast<const bf16x8*>((const char*)Ks + KSWZ(r32, cb));
    bf16x8 b1 = *reinterpret_cast<const bf16x8*>((const char*)Ks + KSWZ(32 + r32, cb));
    p0 = __builtin_amdgcn_mfma_f32_32x32x16_bf16(b0, qr[d0], p0, 0, 0, 0);
    p1 = __builtin_amdgcn_mfma_f32_32x32x16_bf16(b1, qr[d0], p1, 0, 0, 0); }
}
__device__ __forceinline__ int v_st(int k, int c) { const int kk = (k & ~0xC) | ((k & 4) << 1) | ((k & 8) >> 1); return ((kk >> 3) * 4 + (c >> 5)) * 512 + ((kk & 7) * 32 + (c & 31)) * 2; }
__device__ __forceinline__ int v_rd_base(int lane) { return ((lane & 3) << 3) | (((lane >> 2) & 3) << 6) | (((lane >> 4) & 1) << 5) | (((lane >> 5) & 1) << 8); }
constexpr int v_rd_off(int d0, int ks, int half) { return d0 * 512 + ks * 4096 + half * 2048; }
template <int OFF> __device__ __forceinline__ s16x4 tr_read(int vb) {
  s16x4 r; asm volatile("ds_read_b64_tr_b16 %0, %1 offset:%2" : "=&v"(r) : "v"(vb), "i"(OFF) : "memory"); return r;
}
template <int D0> __device__ __forceinline__ void pv_one(f32x16& od, int vb, bf16x8 pa0, bf16x8 pa1, bf16x8 pa2, bf16x8 pa3) {
  const s16x4 l0 = tr_read<v_rd_off(D0, 0, 0)>(vb), h0 = tr_read<v_rd_off(D0, 0, 1)>(vb), l1 = tr_read<v_rd_off(D0, 1, 0)>(vb), h1 = tr_read<v_rd_off(D0, 1, 1)>(vb);
  const s16x4 l2 = tr_read<v_rd_off(D0, 2, 0)>(vb), h2 = tr_read<v_rd_off(D0, 2, 1)>(vb), l3 = tr_read<v_rd_off(D0, 3, 0)>(vb), h3 = tr_read<v_rd_off(D0, 3, 1)>(vb);
  asm volatile("s_waitcnt lgkmcnt(0)" ::: "memory"); SBAR();
#define PK(L, H) (bf16x8){L[0], L[1], L[2], L[3], H[0], H[1], H[2], H[3]}
  od = __builtin_amdgcn_mfma_f32_32x32x16_bf16(pa0, PK(l0, h0), od, 0, 0, 0);
  od = __builtin_amdgcn_mfma_f32_32x32x16_bf16(pa1, PK(l1, h1), od, 0, 0, 0);
  od = __builtin_amdgcn_mfma_f32_32x32x16_bf16(pa2, PK(l2, h2), od, 0, 0, 0);
  od = __builtin_amdgcn_mfma_f32_32x32x16_bf16(pa3, PK(l3, h3), od, 0, 0, 0);
#undef PK
}
__device__ __forceinline__ void pv_d0(f32x16* o, int vb, bf16x8 pa0, bf16x8 pa1, bf16x8 pa2, bf16x8 pa3) {
  pv_one<0>(o[0], vb, pa0, pa1, pa2, pa3); pv_one<1>(o[1], vb, pa0, pa1, pa2, pa3); pv_one<2>(o[2], vb, pa0, pa1, pa2, pa3); pv_one<3>(o[3], vb, pa0, pa1, pa2, pa3);
}
struct Fin { float lam, scale; const float* sg; bf16* cat; };
template <int MODE>
__device__ __forceinline__ void attn_body(const bf16* __restrict__ Qb, const bf16* __restrict__ Kh, const bf16* __restrict__ Vh, float* Ob, int ldo, int seq, char* lds, const Fin fin) {
  int tid_ = threadIdx.x; asm volatile("" : "+v"(tid_));
  const int tid = tid_, wid = tid >> 6, lane = tid & 63, r32 = lane & 31, hi = lane >> 5;
  bf16* V_lds = (bf16*)lds; bf16* K_lds = (bf16*)(lds + 2 * SHM_V);
  float* ws = (float*)(lds + 2 * SHM_V + 2 * SHM_K) + wid * 64; float* li_l = ws; float* al_l = ws + 32;
  float m_reg = -1e30f, l_reg = 0; f32x16 o[4] = {}; bf16x8 qr[4];
  const bf16* Qw = Qb + (long)(wid * QBLK + r32) * LD + hi * 8;
#pragma unroll
  for (int d0 = 0; d0 < 4; ++d0) qr[d0] = *reinterpret_cast<const bf16x8*>(Qw + d0 * 16);
  const int sr = tid >> 4, sc = (tid & 15) * 8, vst0 = v_st(sr, sc), vst1 = v_st(32 + sr, sc);
  const int kr = tid >> 3, kc = (tid & 7) * 8;
  const int vb0 = (int)(uintptr_t)V_lds + v_rd_base(lane);
  struct { bf16x8 vs0, vs1, ks0; } sr_[SDEPTH];
#define SLOAD(i, k0) do { sr_[i].vs0 = *reinterpret_cast<const bf16x8*>(&Vh[(long)((k0) + sr) * LD + sc]); sr_[i].vs1 = *reinterpret_cast<const bf16x8*>(&Vh[(long)((k0) + 32 + sr) * LD + sc]); \
    sr_[i].ks0 = *reinterpret_cast<const bf16x8*>(&Kh[(long)((k0) + kr) * LD + kc]); } while (0)
#define SWRITE(b, i) do { *(bf16x8*)((char*)V_lds + (b) * SHM_V + vst0) = sr_[i].vs0;          \
    *(bf16x8*)((char*)V_lds + (b) * SHM_V + vst1) = sr_[i].vs1;               \
    *(bf16x8*)((char*)K_lds + (b) * SHM_K + KSWZ(kr, kc * 2)) = sr_[i].ks0; } while (0)
#define SWAIT() do { if constexpr (SDEPTH == 2) asm volatile("s_waitcnt vmcnt(3)" ::: "memory"); else asm volatile("s_waitcnt vmcnt(0)" ::: "memory"); } while (0)
#define RESC(a) do { if (__any((a) < 1.f)) { if (hi == 0) al_l[r32] = (a); asm volatile("s_waitcnt lgkmcnt(0)" ::: "memory"); \
    for (int d = 0; d < 4; ++d) for (int r = 0; r < 16; ++r) o[d][r] *= al_l[crow(r, hi)]; } } while (0)
  f32x16 pA0, pA1, pB0, pB1; float mnA, mnB, alA, alB; bf16x8 pa0, pa1, pa2, pa3; const int NT = seq / KVBLK;
  constexpr int SE = 0, SO = SDEPTH - 1;
  SLOAD(SE, 0); asm volatile("s_waitcnt vmcnt(0)" ::: "memory"); SWRITE(0, SE); __syncthreads();
  qkt(pA0, pA1, K_lds, qr, r32, hi); partialSM(pA0, pA1, m_reg, mnA, alA);
  SLOAD(SO, KVBLK); if constexpr (SDEPTH == 2) { if (2 < NT) SLOAD(SE, 2 * KVBLK); }
  SWAIT(); SWRITE(1, SO); __syncthreads();
  for (int j = 1; j + 1 < NT; j += 2) {
    SBAR(); qkt(pB0, pB1, (bf16*)((char*)K_lds + SHM_K), qr, r32, hi);
    finishSM(pA0, pA1, alA, l_reg, pa0, pa1, pa2, pa3); SBAR();
    SLOAD(SO, (j + SDEPTH) * KVBLK); SBAR();
    pv_d0(o, vb0, pa0, pa1, pa2, pa3); partialSM(pB0, pB1, m_reg, mnB, alB);
    __syncthreads(); SWAIT(); SWRITE(0, SE);
    RESC(alB); __syncthreads();
    SBAR(); qkt(pA0, pA1, K_lds, qr, r32, hi);
    finishSM(pB0, pB1, alB, l_reg, pa0, pa1, pa2, pa3); SBAR();
    if (SDEPTH == 1 || j + 3 < NT) SLOAD(SE, (j + 1 + SDEPTH) * KVBLK); SBAR();
    pv_d0(o, vb0 + (int)SHM_V, pa0, pa1, pa2, pa3); partialSM(pA0, pA1, m_reg, mnA, alA);
    __syncthreads(); SWAIT(); SWRITE(1, SO);
    RESC(alA); __syncthreads();
  }
  SBAR(); qkt(pB0, pB1, (bf16*)((char*)K_lds + SHM_K), qr, r32, hi);
  finishSM(pA0, pA1, alA, l_reg, pa0, pa1, pa2, pa3); SBAR();
  pv_d0(o, vb0, pa0, pa1, pa2, pa3); partialSM(pB0, pB1, m_reg, mnB, alB);
  __syncthreads(); RESC(alB);
  finishSM(pB0, pB1, alB, l_reg, pa0, pa1, pa2, pa3); SBAR();
  pv_d0(o, vb0 + (int)SHM_V, pa0, pa1, pa2, pa3);
  if (hi == 0) li_l[r32] = l_reg; asm volatile("s_waitcnt lgkmcnt(0)" ::: "memory");
  float rli[16];
#pragma unroll
  for (int r = 0; r < 16; ++r) rli[r] = __builtin_amdgcn_rcpf(li_l[crow(r, hi)]);
  float* Ow = Ob + (long)(wid * QBLK) * ldo;
  if constexpr (MODE == 0) {
#pragma unroll
    for (int r = 0; r < 16; ++r) { int orow = crow(r, hi);
      for (int d0 = 0; d0 < 4; ++d0) Ow[(long)orow * ldo + d0 * 32 + r32] = o[d0][r] * rli[r]; }
  } else {
    float sgv[4];
#pragma unroll
    for (int d0 = 0; d0 < 4; ++d0) sgv[d0] = fin.sg[d0 * 32 + r32] * fin.scale;
    bf16* Cw = fin.cat + (long)(wid * QBLK) * 1024;
#pragma unroll
    for (int r = 0; r < 16; ++r) { const int orow = crow(r, hi); float ss = 0.f;
#pragma unroll
      for (int d0 = 0; d0 < 4; ++d0) { const float dv = Ow[(long)orow * ldo + d0 * 32 + r32] - fin.lam * (o[d0][r] * rli[r]); o[d0][r] = dv; ss += dv * dv; }
      ss = sum16_f(ss); ss += __builtin_bit_cast(float, __builtin_amdgcn_ds_swizzle(__builtin_bit_cast(int, ss), 0x401F));
      const float sc = 1.0f / sqrtf(ss * (1.0f / 128.0f) + 1e-5f);
#pragma unroll
      for (int d0 = 0; d0 < 4; ++d0) Cw[(long)orow * 1024 + d0 * 32 + r32] = (bf16)f2bf(o[d0][r] * sc * sgv[d0]); }
  }
  __syncthreads();
#undef SLOAD
#undef SWRITE
#undef SWAIT
#undef RESC
}
#undef KSWZ
#undef SBAR
}

__device__ __forceinline__ void ph_attn(Frame& F0, int i, bool need_ctx) { Frame F = F0; LAUNDER(F);
    const bf16* QB = WSP(bf16, WS_QB); const bf16* KB = WSP(bf16, WS_KB); const bf16* VB = WSP(bf16, WS_VB); float* OB = WSP(float, WS_OB); bf16* CAT = WSP(bf16, WS_CAT);
    const int j = i >> 1; const float* lv = INP(I_LAM) + (size_t)j * 256;
    const float linit = (i == 1) ? 0.35550906759096934f : 0.5560582041556406f;
    const float d1 = wave_sum(lv[F.lane] * lv[64 + F.lane]), d2 = wave_sum(lv[128 + F.lane] * lv[192 + F.lane]);
    const float lam = expf(d1) - expf(d2) + linit;
    const int nun = 512 + (need_ctx ? 32 : 0);
    for (int u = F.vcu; u < nun; u += F.G) {
        const bool lat = u < 512; const int uu = lat ? u : u - 512;
        const int qb = lat ? (uu & 15) : 0, h = lat ? ((uu >> 4) & 7) : (uu & 7), b = lat ? (uu >> 7) : (uu >> 3);
        const size_t qrow = lat ? (size_t)b * SEQ + qb * 256 : (size_t)TLAT + b * CTXL; const int seq = lat ? KSEQ : CTXL;
        const bf16* kb = KB + (size_t)b * KSEQ * DM + h * 128; const bf16* vb = VB + (size_t)b * KSEQ * DM + h * 128;
        const att::Fin fin{lam, 1.0f - linit, INP(I_SUBLN) + (size_t)j * 128, CAT + qrow * DM + h * 128};
        att::attn_body<0>(QB + qrow * DM + h * 128, kb, vb, OB + qrow * DM + h * 128, DM, seq, (char*)F.ldsg, fin);
        att::attn_body<1>(QB + qrow * DM + h * 128 + 64, kb + 64, vb, OB + qrow * DM + h * 128, DM, seq, (char*)F.ldsg, fin);
    }
}
__device__ __forceinline__ void ph_attnfin(Frame& F0, int i, bool need_ctx) { Frame F = F0; LAUNDER(F);
    const int j = i >> 1; const float* lv = INP(I_LAM) + (size_t)j * 256; const float* sg = INP(I_SUBLN) + (size_t)j * 128;
    const float linit = (i == 1) ? 0.35550906759096934f : 0.5560582041556406f;
    const float d1 = wave_sum(lv[F.lane] * lv[64 + F.lane]), d2 = wave_sum(lv[128 + F.lane] * lv[192 + F.lane]);
    const float lam = expf(d1) - expf(d2) + linit;
    const float* OB = WSP(float, WS_OB); bf16* CAT = WSP(bf16, WS_CAT);
    const int nrows = need_ctx ? TT : TLAT;
    for (int row = F.gw; row < nrows; row += F.NGW) {
        const int h = F.lane >> 3, e0 = 16 * (F.lane & 7);
        const float* o0 = OB + (size_t)row * 2048 + (2 * h) * 128 + e0; const float* o1 = o0 + 128;
        float x[16]; float ss = 0.f;
#pragma unroll
        for (int q = 0; q < 4; ++q) { const f32x4 a = *(const f32x4*)(o0 + 4 * q), bb = *(const f32x4*)(o1 + 4 * q); const f32x4 d = a - bb * lam;
            x[4 * q] = d.x; x[4 * q + 1] = d.y; x[4 * q + 2] = d.z; x[4 * q + 3] = d.w; ss += (d.x * d.x + d.y * d.y) + (d.z * d.z + d.w * d.w); }
        ss = sum8_f(ss);
        const float sc = (1.0f - linit) / sqrtf(ss * (1.0f / 128.0f) + 1e-5f);
#pragma unroll
        for (int q = 0; q < 16; ++q) x[q] = x[q] * sc * sg[e0 + q];
#ifdef ABL_ATT
#pragma unroll
        for (int q = 0; q < 16; ++q) x[q] = 0.f;
#endif
        v4u w0, w1; w0.x = pk2(x[0], x[1]); w0.y = pk2(x[2], x[3]); w0.z = pk2(x[4], x[5]); w0.w = pk2(x[6], x[7]); w1.x = pk2(x[8], x[9]); w1.y = pk2(x[10], x[11]); w1.z = pk2(x[12], x[13]); w1.w = pk2(x[14], x[15]);
        bf16* dst = CAT + (size_t)row * DM + h * 128 + e0;
        *(v4u*)dst = w0; *(v4u*)(dst + 8) = w1;
    }
}
#ifdef DBG_MOE
__device__ __forceinline__ void ph_debug_moe(Frame& F0, int i) { Frame F = F0; LAUNDER(F);
    LAS float* xs = (LAS float*)F.lds; LAS float* hs = xs + 1024; LAS float* red = hs + 1024;
    unsigned* dbg = (unsigned*)(F.ws + WS_CTL) + 100;
    for (int s = F.vcu; s < 64; s += F.G) {
        const int e = s & 15, slot = (s * 37) % 2176; const int r = e * EROWS + slot;
        const int tok = WSP(int, WS_IDX)[r]; const float gate = WSP(float, WS_GATE)[r];
        const bf16* hrow = WSP(bf16, WS_HA) + (size_t)tok * DM;
        __syncthreads();
        for (int k = F.tid; k < 1024; k += NTHR) xs[k] = bf2f(hrow[k]);
        __syncthreads();
        const float* w1 = INP(I_MW1) + ((size_t)i * NE + e) * DM * FF; const float* w3 = INP(I_MW3) + ((size_t)i * NE + e) * DM * FF; const float* w2 = INP(I_MW2) + ((size_t)i * NE + e) * FF * DM;
        for (int f = F.tid; f < 1024; f += NTHR) { float a = 0.f, b = 0.f; for (int k = 0; k < 1024; ++k) { a += xs[k] * w1[(size_t)k * FF + f]; b += xs[k] * w3[(size_t)k * FF + f]; }
            hs[f] = a / (1.0f + __expf(-a)) * b; }
        __syncthreads();
        float num = 0.f, den = 0.f;
        for (int d = F.tid; d < 1024; d += NTHR) { float y = 0.f; for (int f = 0; f < 1024; ++f) y += hs[f] * w2[(size_t)f * DM + d]; y *= gate;
            const float yk = bf2f(WSP(bf16, WS_YB)[(size_t)r * DM + d]); num += (y - yk) * (y - yk); den += y * y; }
        num = block_sum(F, num, red); den = block_sum(F, den, red + 8);
        const float rel = sqrtf(num / fmaxf(den, 1e-30f));
        if (F.tid == 0) atomicMax(dbg, __builtin_bit_cast(unsigned, rel));
        if (s < 64) {
            const int set = s >> 4; const int rbase = set * SEQ; int cnt = 0; float mn_sel = 1e30f, mx_uns = -1e30f;
            for (int l = F.tid; l < SEQ; l += NTHR) { const int sl = WSP(int, WS_SLOT)[(size_t)(rbase + l) * 16 + e]; const float a = WSP(float, WS_AFF)[(size_t)(rbase + l) * 16 + e];
                if (sl >= 0) { ++cnt; mn_sel = fminf(mn_sel, a); if (sl >= 512 || WSP(int, WS_IDX)[e * EROWS + set * 512 + sl] != rbase + l) atomicAdd(dbg + 1, 1u); } else mx_uns = fmaxf(mx_uns, a); }
            const float tc = block_sum(F, (float)cnt, red);
            float a1 = -mn_sel, a2 = mx_uns;
#pragma unroll
            for (int o = 1; o < 64; o <<= 1) { a1 = fmaxf(a1, __shfl_xor(a1, o)); a2 = fmaxf(a2, __shfl_xor(a2, o)); }
            __syncthreads(); if (F.lane == 0) { red[F.wave] = a1; red[8 + F.wave] = a2; } __syncthreads();
            float m1 = red[0], m2 = red[8];
            for (int w = 1; w < 8; ++w) { m1 = fmaxf(m1, red[w]); m2 = fmaxf(m2, red[8 + w]); }
            if (F.tid == 0) { if ((int)tc != 512) atomicAdd(dbg + 2, 1u); if (-m1 < m2) atomicAdd(dbg + 3, 1u); atomicAdd(dbg + 4, (unsigned)(int)tc); }
        }
    }
}
#endif
__device__ __forceinline__ void ph_debug_out(Frame& F0) { Frame F = F0; LAUNDER(F);
    const unsigned* dbg = (const unsigned*)(F.ws + WS_CTL) + 100;
    const float e1 = __builtin_bit_cast(float, dbg[0]); const unsigned v2 = dbg[1];
#ifdef DBG_SEL2
    const float d1 = 1.0f + (float)dbg[2] + 100.0f * (float)dbg[3];
#elif defined(DBG_SEL3)
    const float d1 = (float)dbg[4] / 64.0f / 16.0f;
#else
    const float d1 = 1.0f + 10.0f * fminf(e1, 3.0f);
#endif
    float d2 = 10.0f + (float)v2 * 0.1f; d2 = fminf(d2, 900.f);
    for (size_t idx = (size_t)F.gw * 64 + F.lane; idx < (size_t)TLAT * DM; idx += (size_t)F.NGW * 64) F.out[idx] = idx == 0 ? d2 : d1;
}
constexpr int PH_PER_LAYER = 13, N_PHASES = 3 + DEPTH * PH_PER_LAYER;
#ifndef PH_MASK
#define PH_MASK 0xFFFFFFFFu
#endif
#define PK_ON(k) ((PH_MASK >> (k)) & 1u)

__device__ __forceinline__ bool phase_is_nop(int ph) {
    if (ph < 3) return false; const int i = (ph - 3) / PH_PER_LAYER, p = (ph - 3) % PH_PER_LAYER; return p == 4 || p == 9 || ((i & 1) && (p == 1 || p == 3 || p == 5));
}

__device__ __forceinline__ int phase_kind(int ph) {
    if (ph < 3) return ph;
    const int i = (ph - 3) / PH_PER_LAYER, p = (ph - 3) % PH_PER_LAYER; const bool even = !(i & 1);
    switch (p) { case 0: return even ? 3 : 4; case 1: return even ? 5 : 6; case 2: return even ? 7 : 8; case 3: return even ? 9 : 10; case 4: return 11; case 5: return 12; case 6: return 13;
                 case 7: return 14; case 8: return 15; case 9: return 16; case 10: return 17; case 11: return 18; default: return 19; }
}
#ifndef PROBE_MASK
#define PROBE_MASK 0u
#endif
#ifndef PROBE_DIV
#define PROBE_DIV 100.0f
#endif
__global__ void __launch_bounds__(NTHR, 2) mega_fwd(Args args) {
    extern __shared__ __attribute__((aligned(16))) unsigned char lds[];
    Frame F;
    F.lds = (LAS unsigned char*)lds; F.ldsg = lds;
    F.MISC = (volatile LAS unsigned*)(F.lds + LDSCTL_OFF + 320);
    F.tid = threadIdx.x; F.lane = F.tid & 63; F.wave = __builtin_amdgcn_readfirstlane(F.tid >> 6);
    F.G = gridDim.x; { const int bx = blockIdx.x; F.vcu = (F.G % 8 == 0) ? (bx % 8) * (F.G / 8) + bx / 8 : bx; }
    F.gw = F.vcu * NWAVES + F.wave; F.NGW = F.G * NWAVES;
    F.tprobe = 0ull;
    F.in = (const GAS float* const __attribute__((address_space(4)))*)__builtin_amdgcn_kernarg_segment_ptr();
    F.ws = (GAS unsigned char*)args.ws; F.out = (GAS float*)args.out;
    for (int u = F.tid; u < (LDS_BYTES - LDSCTL_OFF) / 4; u += NTHR) ((LAS unsigned*)(F.lds + LDSCTL_OFF))[u] = 0u;
    __syncthreads();
    XcdBarrier bar; bar.bar = (unsigned*)(F.ws + WS_CTL) + CW_BAR; bar.x = 0; bar.st = nullptr;
    const int lo = args.ph_lo, hi = args.ph_hi;
    if (hi - lo > 1) bar = xcd_barrier_post((unsigned*)(F.ws + WS_CTL) + CW_BAR, F.MISC + 8);

    Frame F0 = F;
    unsigned long long t_prev = 0ull, t_acc = 0ull;
    if (PROBE_MASK) t_prev = __builtin_amdgcn_s_memrealtime();
    for (int ph = lo; ph < hi; ++ph) {
        if (phase_is_nop(ph)) continue;
        Frame F = F0; LAUNDER(F);
#ifdef DBG_MOE
        if (ph == 1000) { ph_debug_moe(F, 0); VM_WAIT(); continue; }
        if (ph == 1001) { ph_debug_out(F); VM_WAIT(); continue; }
#endif
        if (ph == 0) { if (PK_ON(0)) ph_prologue(F); }
        else if (ph == 1) { if (PK_ON(1)) ph_modred(F); }
        else if (ph == 2) { if (PK_ON(2)) ph_mod0(F); }
        else {
            const int i = (ph - 3) / PH_PER_LAYER, p = (ph - 3) % PH_PER_LAYER, j = i >> 1; const bool even = !(i & 1), need_ctx = i < DEPTH - 1;
            if (p == 0) {
                if (even) { if (PK_ON(3)) { pg8::Gemm g{WSP(bf16, WS_HA), WSP(bf16, WS_WIN) + (size_t)j * EVCP * DM, TT, EVCP, DM, nullptr}; pg8::StaticOrder S; S.init(TT, EVCP, F.G, (int)blockIdx.x);
                    pg8::EpiEven E{WSP(float, WS_P), EVCP, WSP(float, WS_UTL), WSP(float, WS_UTC)}; pg8::gemm_phase<pg8::EpiEven, pg8::StaticOrder, true, true>(F.lds, g, S, E); } }
                else if (PK_ON(4)) { pg8::Gemm g{WSP(bf16, WS_HA), WSP(bf16, WS_WQKV) + (size_t)j * QKVC * DM, TT, QKVC, DM, nullptr}; pg8::StaticOrder S; S.init(TT, QKVC, F.G, (int)blockIdx.x);
                    pg8::EpiQKV E{WSP(bf16, WS_QB), WSP(bf16, WS_KB), WSP(bf16, WS_VB)}; pg8::gemm_phase<pg8::EpiQKV, pg8::StaticOrder, true, true>(F.lds, g, S, E); }
            } else if (p == 1) { if (even) { if (PK_ON(5)) ph_evprep(F, j); } else {   } }
            else if (p == 2) { if (even) { if (PK_ON(7)) ph_chunkprep(F, j); } else { if (PK_ON(8)) ph_attn(F, i, need_ctx); } }
            else if (p == 3) { if (even) { if (PK_ON(9)) ph_scan_hyena(F, j, i); } else {   } }
            else if (p == 4) {   }
            else if (p == 5) { if (PK_ON(12)) ph_readout(F, j); }
            else if (p == 6) { if (PK_ON(13)) {
                pg8::Gemm g{WSP(bf16, WS_CAT), (even ? WSP(bf16, WS_WOE) : WSP(bf16, WS_WOD)) + (size_t)j * DM * DM, need_ctx ? TT : TLAT, DM, DM, nullptr}; pg8::StaticOrder S; S.init(need_ctx ? TT : TLAT, DM, F.G, (int)blockIdx.x);
                pg8::EpiResGate E{WSP(float, WS_X), WSP(float, WS_MODS) + (size_t)i * 5 * 6144}; pg8::gemm_phase<pg8::EpiResGate, pg8::StaticOrder, true, true>(F.lds, g, S, E); }
            } else if (p == 7) { if (PK_ON(14)) ph_mod2(F, i); }
            else if (p == 8) { if (PK_ON(15)) ph_topk(F, i); }
            else if (p == 9) {   }
            else if (p == 10) { if (PK_ON(17)) {
                pg8::Gemm g{WSP(bf16, WS_HA), WSP(bf16, WS_W13), NE * EROWS, NE * 2048, DM, WSP(int, WS_IDX)};     pg8::MoeOrder S{F.G, (int)blockIdx.x, 8, need_ctx ? 9 : 8};
                pg8::EpiSwiGLU E{WSP(bf16, WS_HB)}; pg8::gemm_phase<pg8::EpiSwiGLU, pg8::MoeOrder, true, true, true>(F.lds, g, S, E); }
            } else if (p == 11) { if (PK_ON(18)) {
                pg8::Gemm g{WSP(bf16, WS_HB), WSP(bf16, WS_W2), NE * EROWS, NE * 1024, FF, nullptr}; pg8::MoeOrder S{F.G, (int)blockIdx.x, 4, need_ctx ? 9 : 8};
                pg8::EpiGateBf16 E{WSP(bf16, WS_YB), WSP(float, WS_GATE)}; pg8::gemm_phase<pg8::EpiGateBf16, pg8::MoeOrder, true, true>(F.lds, g, S, E); }
            } else { if (PK_ON(19)) ph_combine(F, i); }
        }
        if (PROBE_SUB) F0.tprobe = F.tprobe;
        if (ph + 1 < hi) xcd_barrier(bar); else { VM_WAIT(); }
        if (PROBE_MASK) { const unsigned long long t_now = __builtin_amdgcn_s_memrealtime(); if ((PROBE_MASK >> phase_kind(ph)) & 1u) t_acc += t_now - t_prev; t_prev = t_now; }
    }
    if (PROBE_MASK) { if (blockIdx.x == 0 && threadIdx.x == 0 && hi == N_PHASES) { const float us = (float)(PROBE_SUB ? F0.tprobe : t_acc) * 0.01f; F0.out[0] += 2.0f + us / PROBE_DIV; } }
}

extern "C" void kernel_launch(void* const* d_in, const int* in_sizes, int n_in, void* d_out, int out_size, void* d_ws, size_t ws_size, hipStream_t stream) {
    static int grid = 0;
    if (grid == 0) {
        if (n_in != N_IN || out_size != TLAT * DM || ws_size < WS_END) { fprintf(stderr, "kernel_launch: unexpected shapes: n_in %d out %d ws %zu (need %zu)\n", n_in, out_size, ws_size, (size_t)WS_END); grid = -1; return; }
        int dev = 0, cus = 0, per_cu = 0;
        if (hipGetDevice(&dev) != hipSuccess || hipDeviceGetAttribute(&cus, hipDeviceAttributeMultiprocessorCount, dev) != hipSuccess) { grid = -1; return; }
        if (hipFuncSetAttribute((const void*)mega_fwd, hipFuncAttributeMaxDynamicSharedMemorySize, LDS_BYTES) != hipSuccess) { fprintf(stderr, "kernel_launch: hipFuncSetAttribute failed\n"); grid = -1; return; }
        if (hipOccupancyMaxActiveBlocksPerMultiprocessor(&per_cu, (const void*)mega_fwd, NTHR, LDS_BYTES) != hipSuccess || per_cu < 1) fprintf(stderr, "kernel_launch: occupancy query reports %d\n", per_cu);
        (void)hipGetLastError();
        grid = cus;
    }
    if (grid < 0) return;
    if (hipMemsetAsync((char*)d_ws + WS_CTL, 0, CTL_ZERO_BYTES, stream) != hipSuccess) { fprintf(stderr, "kernel_launch: memset failed\n"); return; }
    Args a{};
    for (int i = 0; i < N_IN; ++i) a.in[i] = (const float*)d_in[i];
    a.out = (float*)d_out; a.ws = (unsigned char*)d_ws;
#if MK_PER_PHASE
    for (int ph = 0; ph < N_PHASES; ++ph) {
#ifdef DBG_MOE
        if (ph == 3 + 12) { a.ph_lo = 1000; a.ph_hi = 1001; hipLaunchKernelGGL(mega_fwd, dim3(grid), dim3(NTHR), LDS_BYTES, stream, a); a.ph_lo = 1001; a.ph_hi = 1002; hipLaunchKernelGGL(mega_fwd, dim3(grid), dim3(NTHR), LDS_BYTES, stream, a); break; }
#endif
        if ((ph >= 3) && ((((ph - 3) % PH_PER_LAYER) == 4) || (((ph - 3) % PH_PER_LAYER) == 9) || ((((ph - 3) / PH_PER_LAYER) & 1) && (((ph - 3) % PH_PER_LAYER) == 1 || ((ph - 3) % PH_PER_LAYER) == 3 || ((ph - 3) % PH_PER_LAYER) == 5)))) continue;
        a.ph_lo = ph; a.ph_hi = ph + 1;
        hipLaunchKernelGGL(mega_fwd, dim3(grid), dim3(NTHR), LDS_BYTES, stream, a);
    }
#else
    a.ph_lo = 0; a.ph_hi = N_PHASES;
    hipLaunchKernelGGL(mega_fwd, dim3(grid), dim3(NTHR), LDS_BYTES, stream, a);
#endif
    const hipError_t le = hipPeekAtLastError();
    if (le != hipSuccess) fprintf(stderr, "kernel_launch: launch failed: %s\n", hipGetErrorName(le));
}
```

```cpp
#define MK_PER_PHASE 0
#include <hip/hip_runtime.h>
#include <cstdio>
#include <cstdint>
#include <cmath>

#ifndef MK_PER_PHASE
#define MK_PER_PHASE 0
#endif

#define GAS __attribute__((address_space(1)))
#define LAS __attribute__((address_space(3)))
typedef unsigned short bf16;
typedef unsigned v4u __attribute__((ext_vector_type(4)));
typedef unsigned v2u __attribute__((ext_vector_type(2)));
typedef float f32x4 __attribute__((ext_vector_type(4)));
typedef float f32x2 __attribute__((ext_vector_type(2)));
typedef short bf16x8 __attribute__((ext_vector_type(8)));

constexpr int DM = 1024, NB = 4, SEQ = 4096, CTXL = 256, DEPTH = 4;
constexpr int TLAT = NB * SEQ, TCTX = NB * CTXL, TT = TLAT + TCTX;
constexpr int RWC = 1760, HYC = 1536, EVC = RWC + HYC, EVCP = 3328;
constexpr int RWW = 512, NH = 8, HD = 64;
constexpr int QKVC = 3072;
constexpr int NE = 16, FF = 1024, EROWS = 2304;
constexpr int NMOD = 6;
constexpr int KSEQ = CTXL + SEQ;

enum { I_X = 0, I_C, I_CTX, I_CCTX, I_ADAW, I_ADAB, I_NORMG, I_FINALG, I_EVWIN, I_EVWOUT, I_MU, I_W0, I_W2, I_A0, I_A2, I_G2, I_KK, I_KA, I_RK, I_GN,
       I_CONVW, I_CONVB, I_FW1, I_FB1, I_FW2, I_FB2, I_FW3, I_FREQ, I_HYB, I_WQKV, I_DAWOUT, I_LAM, I_SUBLN, I_ROUTER, I_MW1, I_MW3, I_MW2, N_IN };

struct Args { const float* in[N_IN]; float* out; unsigned char* ws; int ph_lo, ph_hi; };
static_assert(__builtin_offsetof(Args, in) == 0, "Args::in must be first");

constexpr size_t MiB = 1u << 20;
constexpr size_t WS_CTL = 0, CTL_ZERO_BYTES = 64 * 1024;
constexpr size_t WS_MODP = 384 * MiB;
constexpr size_t WS_MODS = 5 * MiB;
constexpr size_t WS_TW = 6 * MiB;
constexpr size_t WS_FRAGB = 7 * MiB;
constexpr size_t WS_AFF = 8 * MiB;
constexpr size_t WS_SLOT = 10 * MiB;
constexpr size_t WS_IDX = 12 * MiB;
constexpr size_t WS_GATE = 12 * MiB + 512 * 1024;
constexpr size_t WS_WIN = 16 * MiB;
constexpr size_t WS_WOE = 30 * MiB;
constexpr size_t WS_WQKV = 34 * MiB;
constexpr size_t WS_WOD = 46 * MiB;
constexpr size_t WS_W13 = 50 * MiB;
constexpr size_t WS_W2 = 114 * MiB;
constexpr size_t WS_UTL = 50 * MiB;
constexpr size_t WS_X = 146 * MiB;
constexpr size_t WS_HA = 214 * MiB;
constexpr size_t WS_CAT = 248 * MiB;
constexpr size_t WS_KSPL = 282 * MiB;
constexpr size_t WS_KSPC = 346 * MiB;
constexpr size_t WS_BIG = 384 * MiB;
constexpr size_t WS_P = WS_BIG;
constexpr size_t REC_BYTES = 12 * 1024;
constexpr size_t WS_REC = WS_BIG;
constexpr size_t WS_RW = WS_BIG + 340 * MiB;
constexpr size_t RW_STRIDE = 34 * MiB;
constexpr size_t WS_AOP = WS_BIG + 476 * MiB;
constexpr size_t WS_G = WS_BIG + 484 * MiB;
constexpr size_t WS_KCL = WS_BIG + 518 * MiB;
constexpr size_t WS_KCC = WS_BIG + 550 * MiB;
constexpr size_t WS_UTC = WS_BIG + 552 * MiB;
constexpr size_t WS_BON = WS_BIG + 558 * MiB;
constexpr size_t WS_Y = WS_BIG + 559 * MiB;
constexpr size_t WS_HYTL = WS_RW + 1 * RW_STRIDE;
constexpr size_t WS_HYTC = WS_RW + 3 * RW_STRIDE;
static_assert(WS_Y + 68 * MiB <= 1024 * MiB && 64 * 272 * REC_BYTES <= 340 * MiB, "ws map");
constexpr size_t WS_QB = WS_BIG + 204 * MiB;
constexpr size_t WS_KB = WS_QB + 34 * MiB;
constexpr size_t WS_VB = WS_KB + 34 * MiB;
constexpr size_t WS_OB = WS_VB + 34 * MiB;
static_assert(WS_OB + 136 * MiB <= 1024 * MiB, "ws map");
constexpr size_t WS_XG = WS_BIG;
constexpr size_t WS_HB = WS_BIG + 72 * MiB;
constexpr size_t WS_YB = WS_BIG + 144 * MiB;
constexpr size_t WS_END = 1024 * MiB;

constexpr int CW_BAR = 4096;

constexpr int RING_BYTES = 143360;
constexpr int LDSCTL_OFF = RING_BYTES;
constexpr int LDS_BYTES = 147456;
constexpr int NWAVES = 8, NTHR = 512;

__device__ __forceinline__ unsigned f2bf(float f) { unsigned u = __builtin_bit_cast(unsigned, f); return (u + 0x7fffu + ((u >> 16) & 1u)) >> 16; }
__device__ __forceinline__ unsigned pk2(float lo, float hi) { return f2bf(lo) | (f2bf(hi) << 16); }
__device__ __forceinline__ float bf2f(unsigned short h) { return __builtin_bit_cast(float, ((unsigned)h) << 16); }
template <int CTRL> __device__ __forceinline__ float dpp_f(float x) { return __builtin_bit_cast(float, __builtin_amdgcn_update_dpp(0, __builtin_bit_cast(int, x), CTRL, 0xF, 0xF, true)); }
template <int CTRL> __device__ __forceinline__ int dpp_i(int x) { return __builtin_amdgcn_update_dpp(0, x, CTRL, 0xF, 0xF, true); }
#define DPP_XOR1 0xB1
#define DPP_XOR2 0x4E
#define DPP_HMIRROR 0x141
#define DPP_MIRROR 0x140
__device__ __forceinline__ float xor1_f(float x) { return dpp_f<DPP_XOR1>(x); }
__device__ __forceinline__ float sum4_f(float x) { x += dpp_f<DPP_XOR1>(x); x += dpp_f<DPP_XOR2>(x); return x; }
__device__ __forceinline__ float sum8_f(float x) { x = sum4_f(x); x += dpp_f<DPP_HMIRROR>(x); return x; }
__device__ __forceinline__ float sum16_f(float x) { x = sum8_f(x); x += dpp_f<DPP_MIRROR>(x); return x; }
__device__ __forceinline__ float max16_f(float x) { x = fmaxf(x, dpp_f<DPP_XOR1>(x)); x = fmaxf(x, dpp_f<DPP_XOR2>(x)); x = fmaxf(x, dpp_f<DPP_HMIRROR>(x)); x = fmaxf(x, dpp_f<DPP_MIRROR>(x)); return x; }
__device__ __forceinline__ float wave_sum(float v) {
    v = sum16_f(v);
    v += __builtin_bit_cast(float, __builtin_amdgcn_ds_swizzle(__builtin_bit_cast(int, v), 0x401F));
    { auto rr = __builtin_amdgcn_permlane32_swap(__float_as_uint(v), __float_as_uint(v), false, false); const unsigned lo_ = rr[0], hi_ = rr[1];
      v = __uint_as_float(lo_) + __uint_as_float(hi_); }
    return v;
}
__device__ __forceinline__ int wave_sum_i(int v) {
    v += dpp_i<DPP_XOR1>(v); v += dpp_i<DPP_XOR2>(v); v += dpp_i<DPP_HMIRROR>(v); v += dpp_i<DPP_MIRROR>(v);
    v += __builtin_amdgcn_ds_swizzle(v, 0x401F);
    { auto rr = __builtin_amdgcn_permlane32_swap((unsigned)v, (unsigned)v, false, false); v = (int)rr[0] + (int)rr[1]; }
    return v;
}
__device__ __forceinline__ float sigmoidf_(float x) { return 1.0f / (1.0f + __expf(-x)); }
__device__ __forceinline__ float siluf_(float x) { return x / (1.0f + __expf(-x)); }
#define LDS_WAIT() asm volatile("s_waitcnt lgkmcnt(0)" ::: "memory")
#define VM_WAIT() asm volatile("s_waitcnt vmcnt(0)" ::: "memory")

namespace pg8 {
#define PG8_LAS __attribute__((address_space(3)))
typedef unsigned short bf16_t;
typedef short bf16x8 __attribute__((ext_vector_type(8)));
typedef float f32x4 __attribute__((ext_vector_type(4)));
typedef unsigned u32x4 __attribute__((ext_vector_type(4)));
constexpr int BM = 256, BK = 64, HALF = 128, HTB = HALF * BK * 2  , STAGE_BYTES = 8 * HTB, NXCD = 8, WGM = 8;

__host__ __device__ __forceinline__ int lds_byte(int r, int c) { const int st = (r >> 4) * 2 + (c >> 5), rr = r & 15, cc = c & 31, ob = rr * 64 + cc * 2; return st * 1024 + (ob ^ (((ob >> 9) & 1) << 5)); }
__host__ __device__ __forceinline__ void stage_rc(int b, int& R, int& C) { const int st = b / 1024, sb = b % 1024, swz = sb ^ (((sb >> 9) & 1) << 5); R = (st >> 1) * 16 + swz / 64; C = (st & 1) * 32 + (swz % 64) / 2; }
__host__ __device__ __forceinline__ int perm32(int rho) { const int n = rho >> 4, i = rho & 15; return 8 * (i >> 2) + 4 * n + (i & 3); }

struct Unit { int pm, pn; };
struct Gemm { const bf16_t* A; const bf16_t* Bt; int M, N, K; const int* gidx; };

struct StaticOrder {
    int nM, nN, nwg, G, c;
    __host__ __device__ void init(int M, int N, int G_, int c_) { nM = M / BM; nN = N / BM; nwg = nM * nN; G = G_; c = c_; }
    __host__ __device__ bool next(int i, Unit& u) const {
        const long L = (long)i * G + c; if (L >= nwg) return false;
        int wgid = (int)L; { const int q = nwg / NXCD, r = nwg % NXCD, xcd = wgid % NXCD, off = wgid / NXCD; wgid = (xcd < r ? xcd * (q + 1) : r * (q + 1) + (xcd - r) * q) + off; }
        const int nig = WGM * nN, gid = wgid / nig, fm = gid * WGM, gsz = (nM - fm) < WGM ? (nM - fm) : WGM;
        u.pm = fm + ((wgid % nig) % gsz); u.pn = (wgid % nig) / gsz; return true;
    }
    __device__ __forceinline__ void a_ready(const Unit&) const {}
    __device__ __forceinline__ void done(const Unit&) const {}
};

__device__ __forceinline__ unsigned cvt_pk_bf16(float lo, float hi) { unsigned r; asm volatile("v_cvt_pk_bf16_f32 %0, %1, %2" : "=v"(r) : "v"(lo), "v"(hi)); return r; }
typedef float f32x2 __attribute__((ext_vector_type(2)));
typedef unsigned u32x2v __attribute__((ext_vector_type(2)));

struct EpiF32 {
    static constexpr bool PERM = false, AFTER_DRAIN = false;
    float* O; int ldc;
    __device__ __forceinline__ void operator()(const f32x4 (&acc)[2][2][4][2], const Unit& u, int wr, int wc, int fr, int fq) const {
        const int col0 = u.pn * BM + wc * 32 + 4 * fq;
#pragma unroll
        for (int ai = 0; ai < 2; ++ai)
#pragma unroll
            for (int m = 0; m < 4; ++m) { float* rowp = O + (size_t)(u.pm * BM + ai * HALF + wr * 64 + m * 16 + fr) * ldc + col0;
#pragma unroll
                for (int bj = 0; bj < 2; ++bj)
#pragma unroll
                    for (int n = 0; n < 2; ++n) *(f32x4*)(rowp + bj * HALF + n * 16) = acc[ai][bj][m][n]; }
    }
};
struct EpiBf16S {
    static constexpr bool PERM = false, AFTER_DRAIN = false;
    bf16_t* O; int ldc;
    __device__ __forceinline__ void operator()(const f32x4 (&acc)[2][2][4][2], const Unit& u, int wr, int wc, int fr, int fq) const {
        const int col0 = u.pn * BM + wc * 32 + 4 * fq;
#pragma unroll
        for (int ai = 0; ai < 2; ++ai)
#pragma unroll
            for (int m = 0; m < 4; ++m) { bf16_t* rowp = O + (size_t)(u.pm * BM + ai * HALF + wr * 64 + m * 16 + fr) * ldc + col0;
#pragma unroll
                for (int bj = 0; bj < 2; ++bj)
#pragma unroll
                    for (int n = 0; n < 2; ++n) { const f32x4 v = acc[ai][bj][m][n]; u32x2v w; w.x = cvt_pk_bf16(v[0], v[1]); w.y = cvt_pk_bf16(v[2], v[3]); *(u32x2v*)(rowp + bj * HALF + n * 16) = w; } }
    }
};
struct EpiEven {
    static constexpr bool PERM = false, AFTER_DRAIN = false;
    float* P; int ldc; float* UTL; float* UTC;
    __device__ __forceinline__ void operator()(const f32x4 (&acc)[2][2][4][2], const Unit& u, int wr, int wc, int fr, int fq) const {
        const int col0 = u.pn * BM + wc * 32 + 4 * fq;
#pragma unroll
        for (int ai = 0; ai < 2; ++ai)
#pragma unroll
            for (int m = 0; m < 4; ++m) { const int row = u.pm * BM + ai * HALF + wr * 64 + m * 16 + fr; const bool lat = row < 16384;
                float* rowp = P + (size_t)row * ldc + col0;
                float* tp = lat ? UTL + ((size_t)(row >> 12) * 1536) * 4096 + (row & 4095) : UTC + ((size_t)((row - 16384) >> 8) * 1536) * 256 + ((row - 16384) & 255);
                const size_t ts = lat ? 4096 : 256;
#pragma unroll
                for (int bj = 0; bj < 2; ++bj)
#pragma unroll
                    for (int n = 0; n < 2; ++n) { const int c = col0 + bj * HALF + n * 16; const f32x4 v = acc[ai][bj][m][n];
                        if (c < 1760) *(f32x4*)(rowp + bj * HALF + n * 16) = v;
                        else if (c < 3296) { float* t0 = tp + (size_t)(c - 1760) * ts; t0[0] = v[0]; t0[ts] = v[1]; t0[2 * ts] = v[2]; t0[3 * ts] = v[3]; } } }
    }
};
struct EpiResGate {
    static constexpr bool PERM = false, AFTER_DRAIN = false;
    float* X; const float* mods;
    __device__ __forceinline__ void operator()(const f32x4 (&acc)[2][2][4][2], const Unit& u, int wr, int wc, int fr, int fq) const {
        const int col0 = u.pn * BM + wc * 32 + 4 * fq;
#pragma unroll
        for (int ai = 0; ai < 2; ++ai)
#pragma unroll
            for (int m = 0; m < 4; ++m) { const int row = u.pm * BM + ai * HALF + wr * 64 + m * 16 + fr; const int s = row < 16384 ? (row >> 12) : 4;
                float* rowp = X + (size_t)row * 1024 + col0; const float* gp = mods + s * 6144 + 2048 + col0;
#pragma unroll
                for (int bj = 0; bj < 2; ++bj)
#pragma unroll
                    for (int n = 0; n < 2; ++n) { const f32x4 g = *(const f32x4*)(gp + bj * HALF + n * 16); f32x4 x = *(f32x4*)(rowp + bj * HALF + n * 16);
                        x = x + g * acc[ai][bj][m][n]; *(f32x4*)(rowp + bj * HALF + n * 16) = x; } }
    }
};
struct EpiSwiGLU {
    static constexpr bool PERM = false, AFTER_DRAIN = false;
    bf16_t* H;
    __device__ __forceinline__ void operator()(const f32x4 (&acc)[2][2][4][2], const Unit& u, int wr, int wc, int fr, int fq) const {
        const int nt = u.pn & 7; const int col0 = nt * 128 + wc * 32 + 4 * fq;
#pragma unroll
        for (int ai = 0; ai < 2; ++ai)
#pragma unroll
            for (int m = 0; m < 4; ++m) { bf16_t* rowp = H + (size_t)(u.pm * BM + ai * HALF + wr * 64 + m * 16 + fr) * 1024 + col0;
#pragma unroll
                for (int n = 0; n < 2; ++n) { const f32x4 a = acc[ai][0][m][n], b = acc[ai][1][m][n]; f32x4 h;
#pragma unroll
                    for (int j = 0; j < 4; ++j) h[j] = a[j] / (1.0f + __expf(-a[j])) * b[j];
                    u32x2v w; w.x = cvt_pk_bf16(h[0], h[1]); w.y = cvt_pk_bf16(h[2], h[3]); *(u32x2v*)(rowp + n * 16) = w; } }
    }
};
struct EpiGateBf16 {
    static constexpr bool PERM = false, AFTER_DRAIN = false;
    bf16_t* Y; const float* gate;
    __device__ __forceinline__ void operator()(const f32x4 (&acc)[2][2][4][2], const Unit& u, int wr, int wc, int fr, int fq) const {
        const int nt = u.pn & 3; const int col0 = nt * 256 + wc * 32 + 4 * fq;
#pragma unroll
        for (int ai = 0; ai < 2; ++ai)
#pragma unroll
            for (int m = 0; m < 4; ++m) { const int row = u.pm * BM + ai * HALF + wr * 64 + m * 16 + fr; const float g = gate[row]; bf16_t* rowp = Y + (size_t)row * 1024 + col0;
#pragma unroll
                for (int bj = 0; bj < 2; ++bj)
#pragma unroll
                    for (int n = 0; n < 2; ++n) { const f32x4 v = acc[ai][bj][m][n] * g; u32x2v w; w.x = cvt_pk_bf16(v[0], v[1]); w.y = cvt_pk_bf16(v[2], v[3]); *(u32x2v*)(rowp + bj * HALF + n * 16) = w; } }
    }
};
struct EpiQKV {
    static constexpr bool PERM = false, AFTER_DRAIN = false;
    bf16_t* Q; bf16_t* Kb; bf16_t* Vb;
    __device__ __forceinline__ void operator()(const f32x4 (&acc)[2][2][4][2], const Unit& u, int wr, int wc, int fr, int fq) const {
        const int part = u.pn >> 2; const int col0 = (u.pn & 3) * BM + wc * 32 + 4 * fq; const bool lat = u.pm < 64;
        float invf[4];
#pragma unroll
        for (int j = 0; j < 4; ++j) invf[j] = exp2f(-(float)(4 * fq + j) * (13.287712379549449f / 16.0f)) * 0.15915494309189535f;
#pragma unroll
        for (int ai = 0; ai < 2; ++ai)
#pragma unroll
            for (int m = 0; m < 4; ++m) {
                const int row = u.pm * BM + ai * HALF + wr * 64 + m * 16 + fr;
                const int b = lat ? (row >> 12) : ((row - 16384) >> 8); const int l = lat ? (row & 4095) : ((row - 16384) & 255);
                float cs[4], sn[4];
                if (part < 2 && lat) { const float pos = (float)((wc & 1) ? (l & 63) : (l >> 6));
#pragma unroll
                    for (int j = 0; j < 4; ++j) { const float rev = pos * invf[j]; const float fr_ = rev - floorf(rev); cs[j] = __builtin_amdgcn_cosf(fr_); sn[j] = __builtin_amdgcn_sinf(fr_); } }
                bf16_t* rowp = (part == 0 ? Q + (size_t)row * 1024 : (part == 1 ? Kb : Vb) + ((size_t)b * 4352 + (lat ? 256 + l : l)) * 1024) + col0;
#pragma unroll
                for (int bj = 0; bj < 2; ++bj) {
                    f32x4 x1 = acc[ai][bj][m][0], x2 = acc[ai][bj][m][1];
                    if (part < 2 && lat) {
#pragma unroll
                        for (int j = 0; j < 4; ++j) { const float a = x1[j], bb = x2[j]; x1[j] = a * cs[j] - bb * sn[j]; x2[j] = bb * cs[j] + a * sn[j]; } }
                    u32x2v w; w.x = cvt_pk_bf16(x1[0], x1[1]); w.y = cvt_pk_bf16(x1[2], x1[3]); *(u32x2v*)(rowp + bj * HALF) = w;
                    w.x = cvt_pk_bf16(x2[0], x2[1]); w.y = cvt_pk_bf16(x2[2], x2[3]); *(u32x2v*)(rowp + bj * HALF + 16) = w;
                }
            }
    }
};
struct OneUnit { int pm, pn;
    __device__ __forceinline__ bool next(int i, Unit& u) const { if (i != 0) return false; u.pm = pm; u.pn = pn; return true; }
    __device__ __forceinline__ void a_ready(const Unit&) const {}
    __device__ __forceinline__ void done(const Unit&) const {}
};
struct Moe2Order {
    int w; unsigned* ctr;
    __device__ __forceinline__ bool next(int i, Unit& u) const {
        if (w < 128) {
            if (i == 0) { const int e = w >> 5, r = w & 31; u.pm = e * 9 + (r & 7); u.pn = e * 4 + (r >> 3); return true; }
            if (i == 1 && w < 64) { const int e = w >> 2; u.pm = e * 9 + 8; u.pn = e * 4 + (w & 3); return true; }
            return false;
        }
        if (i >= 3) return false;
        const int L = 128 + (w - 128) * 3 + i; const int e = L >> 5, r = L & 31; u.pm = e * 9 + (r & 7); u.pn = e * 4 + (r >> 3); return true;
    }
    __device__ __forceinline__ void a_ready(const Unit& u) const {
        if ((u.pm % 9) != 8) return;
        if ((threadIdx.x & 63) == 0) { unsigned sp = 0; while (__hip_atomic_load(ctr, __ATOMIC_RELAXED, __HIP_MEMORY_SCOPE_AGENT) < 128u) { __builtin_amdgcn_s_sleep(4); if (++sp > (1u << 24)) break; } }
        __builtin_amdgcn_fence(__ATOMIC_ACQUIRE, "agent");
    }
    __device__ __forceinline__ void done(const Unit&) const {}
};
struct MoeOrder {
    int G, c, ntn, nmt;
    __device__ __forceinline__ bool next(int i, Unit& u) const {
        const int L = i * G + c; const int per_e = nmt * ntn; if (L >= 16 * per_e) return false;
        const int e = L / per_e, r = L % per_e; u.pm = e * 9 + (r % nmt); u.pn = e * ntn + (r / nmt); return true;
    }
    __device__ __forceinline__ void a_ready(const Unit&) const {}
    __device__ __forceinline__ void done(const Unit&) const {}
};
template <class Epi, class Sched, bool ALIGN_EPI = false, bool SP2 = false, bool GATHER = false>
__device__ __forceinline__ void gemm_phase(PG8_LAS unsigned char* lds, const Gemm g, const Sched& S, const Epi& E) {
    int tid_ = threadIdx.x; asm volatile("" : "+v"(tid_));
    const int tid = tid_, wid = __builtin_amdgcn_readfirstlane(tid >> 6), lane = tid & 63, wr = wid >> 2, wc = wid & 3, fr = lane & 15, fq = lane >> 4;
    const int K = g.K, nt = K / BK;
    unsigned voffA[2], voffB[2];
#pragma unroll
    for (int i = 0; i < 2; ++i) { int R, C; stage_rc(tid * 16 + i * 8192, R, C); const int Rb = Epi::PERM ? ((R & ~31) + perm32(R & 31)) : R;
        voffA[i] = (unsigned)(R * K + C) * 2u; voffB[i] = (unsigned)(Rb * K + C) * 2u; }
    unsigned vA0[2] = {0u, 0u}, vA1[2] = {0u, 0u}, nvA0[2] = {0u, 0u}, nvA1[2] = {0u, 0u};
#define PG8_GOFF(dst0, dst1, unit) do { _Pragma("unroll") for (int i_ = 0; i_ < 2; ++i_) { int R_, C_; stage_rc(tid * 16 + i_ * 8192, R_, C_); \
        dst0[i_] = (unsigned)g.gidx[(unit).pm * BM + R_] * (unsigned)(K * 2) + (unsigned)(C_ * 2); dst1[i_] = (unsigned)g.gidx[(unit).pm * BM + HALF + R_] * (unsigned)(K * 2) + (unsigned)(C_ * 2); } } while (0)
    const size_t kstep = (size_t)(BK * 2);
    const size_t hstep = (size_t)HALF * K * 2;
    const size_t tstep = 2 * hstep;
    const unsigned ldsw = (unsigned)wid * 1024u;
    const int aoff = lds_byte(wr * 64 + fr, fq * 8), boff = lds_byte(wc * 32 + fr, fq * 8);
#define PG8_SA(b, h) (((b) * 2 + (h)) * HTB)
#define PG8_SB(b, h) ((4 + (b) * 2 + (h)) * HTB)
#define PG8_STAGE(bufoff, gbase, voff) do { _Pragma("unroll") for (int _i = 0; _i < 2; ++_i) \
        __builtin_amdgcn_global_load_lds((const unsigned*)((const char*)(gbase) + (voff)[_i]), (PG8_LAS unsigned*)(lds + (bufoff) + ldsw + _i * 8192), 16, 0, 0); } while (0)
#define PG8_STAGE_AC(bufoff, kptr, half) do { if constexpr (GATHER) { if (half) PG8_STAGE(bufoff, kptr, vA1); else PG8_STAGE(bufoff, kptr, vA0); } else PG8_STAGE(bufoff, (kptr) + (half) * hstep, voffA); } while (0)
#define PG8_STAGE_AX(bufoff, kptr, half) do { if constexpr (GATHER) { unsigned s_[2]; _Pragma("unroll") for (int i_ = 0; i_ < 2; ++i_) s_[i_] = last ? ((half) ? nvA1[i_] : nvA0[i_]) : ((half) ? vA1[i_] : vA0[i_]); PG8_STAGE(bufoff, kptr, s_); } \
        else PG8_STAGE(bufoff, (kptr) + (half) * hstep, voffA); } while (0)
#define PG8_LDA(dst, b, h) do { _Pragma("unroll") for (int m = 0; m < 4; ++m) _Pragma("unroll") for (int k = 0; k < 2; ++k) dst[m][k] = *(const PG8_LAS bf16x8*)(lds + PG8_SA(b, h) + aoff + m * 2048 + k * 1024); } while (0)
#define PG8_LDB(dst, b, h) do { _Pragma("unroll") for (int n = 0; n < 2; ++n) _Pragma("unroll") for (int k = 0; k < 2; ++k) dst[n][k] = *(const PG8_LAS bf16x8*)(lds + PG8_SB(b, h) + boff + n * 2048 + k * 1024); } while (0)
#define PG8_MMA(ai, bj, At, Bt) do { __builtin_amdgcn_s_setprio(1); _Pragma("unroll") for (int m = 0; m < 4; ++m) _Pragma("unroll") for (int n = 0; n < 2; ++n) _Pragma("unroll") for (int k = 0; k < 2; ++k) \
        acc[ai][bj][m][n] = __builtin_amdgcn_mfma_f32_16x16x32_bf16(Bt[n][k], At[m][k], acc[ai][bj][m][n], 0, 0, 0); __builtin_amdgcn_s_setprio(0); } while (0)
#define PG8_WAIT_V(n) asm volatile("s_waitcnt vmcnt(" #n ")" ::: "memory")
#define PG8_WAIT_L(n) asm volatile("s_waitcnt lgkmcnt(" #n ")" ::: "memory")
#define PG8_BAR __builtin_amdgcn_s_barrier()
#define PG8_SCHED __builtin_amdgcn_sched_barrier(0)
    Unit cur, nxt; int ui = 0;
    if (!S.next(0, cur)) return;
    f32x4 acc[2][2][4][2];
#pragma unroll
    for (int a = 0; a < 2; ++a)
#pragma unroll
        for (int b = 0; b < 2; ++b)
#pragma unroll
            for (int m = 0; m < 4; ++m)
#pragma unroll
                for (int n = 0; n < 2; ++n) acc[a][b][m][n] = (f32x4){0.f, 0.f, 0.f, 0.f};
    bf16x8 At[4][2], B0[2][2], B1[2][2];
    const char* cA = (const char*)g.A + (GATHER ? (size_t)0 : (size_t)cur.pm * tstep); const char* cB = (const char*)g.Bt + (size_t)cur.pn * tstep;
    if constexpr (GATHER) PG8_GOFF(vA0, vA1, cur);
    S.a_ready(cur);
    if constexpr (SP2) {
        PG8_STAGE(PG8_SB(0, 0), cB, voffB); PG8_STAGE(PG8_SB(0, 1), cB + hstep, voffB); PG8_STAGE_AC(PG8_SA(0, 0), cA, 0); PG8_STAGE_AC(PG8_SA(0, 1), cA, 1);
        if (wr == 1) PG8_BAR;
        PG8_WAIT_V(2); PG8_BAR;
        PG8_STAGE(PG8_SB(1, 0), cB + kstep, voffB); PG8_STAGE_AC(PG8_SA(1, 0), cA + kstep, 0); PG8_STAGE(PG8_SB(1, 1), cB + hstep + kstep, voffB);
        PG8_WAIT_V(6); PG8_BAR;
    } else {
        PG8_STAGE(PG8_SB(0, 0), cB, voffB); PG8_STAGE_AC(PG8_SA(0, 0), cA, 0); PG8_STAGE(PG8_SB(0, 1), cB + hstep, voffB); PG8_STAGE_AC(PG8_SA(0, 1), cA, 1);
        if (wr == 1) PG8_BAR;
        PG8_WAIT_V(4); PG8_BAR;
        PG8_STAGE(PG8_SB(1, 0), cB + kstep, voffB); PG8_STAGE_AC(PG8_SA(1, 0), cA + kstep, 0); PG8_STAGE(PG8_SB(1, 1), cB + hstep + kstep, voffB);
        PG8_WAIT_V(6); PG8_BAR;
    }
    for (;;) {
        const bool has_next = S.next(ui + 1, nxt);
        if constexpr (GATHER) { if (has_next) PG8_GOFF(nvA0, nvA1, nxt); else { nvA0[0] = vA0[0]; nvA0[1] = vA0[1]; nvA1[0] = vA1[0]; nvA1[1] = vA1[1]; } }
        const char* nA = (has_next && !GATHER) ? (const char*)g.A + (size_t)nxt.pm * tstep : cA; const char* nB = has_next ? (const char*)g.Bt + (size_t)nxt.pn * tstep : cB;
        for (int t = 0; t < nt; t += 2) {
            const bool last = (t == nt - 2);
            const char* a1 = cA + (size_t)(t + 1) * kstep;
            const char* a2 = last ? nA : cA + (size_t)(t + 2) * kstep; const char* b2 = last ? nB : cB + (size_t)(t + 2) * kstep;
            const char* a3 = a2 + kstep; const char* b3 = b2 + kstep;
            if (last && has_next) S.a_ready(nxt);
            if constexpr (SP2) {
            PG8_LDB(B0, 0, 0); PG8_LDB(B1, 0, 1); PG8_SCHED; PG8_LDA(At, 0, 0); PG8_STAGE_AC(PG8_SA(1, 1), a1, 1);
            PG8_WAIT_V(8); PG8_WAIT_L(0); PG8_BAR; PG8_MMA(0, 0, At, B0); PG8_MMA(0, 1, At, B1); PG8_BAR; PG8_SCHED;
            PG8_LDA(At, 0, 1); PG8_STAGE(PG8_SB(0, 0), b2, voffB); PG8_STAGE(PG8_SB(0, 1), b2 + hstep, voffB); PG8_STAGE_AX(PG8_SA(0, 0), a2, 0);
            PG8_WAIT_V(8); PG8_WAIT_L(0); PG8_BAR; PG8_MMA(1, 0, At, B0); PG8_MMA(1, 1, At, B1); PG8_BAR; PG8_SCHED;
            PG8_LDB(B0, 1, 0); PG8_LDB(B1, 1, 1); PG8_SCHED; PG8_LDA(At, 1, 0); PG8_STAGE_AX(PG8_SA(0, 1), a2, 1);
            PG8_WAIT_V(8); PG8_WAIT_L(0); PG8_BAR; PG8_MMA(0, 0, At, B0); PG8_MMA(0, 1, At, B1); PG8_BAR; PG8_SCHED;
            PG8_LDA(At, 1, 1); PG8_STAGE(PG8_SB(1, 0), b3, voffB); PG8_STAGE(PG8_SB(1, 1), b3 + hstep, voffB); PG8_STAGE_AX(PG8_SA(1, 0), a3, 0);
            PG8_WAIT_V(8); PG8_WAIT_L(0); PG8_BAR; PG8_MMA(1, 0, At, B0); PG8_MMA(1, 1, At, B1); PG8_BAR; PG8_SCHED;
            } else {
            PG8_LDB(B0, 0, 0); PG8_SCHED; PG8_LDA(At, 0, 0); PG8_STAGE_AC(PG8_SA(1, 1), a1, 1);
            PG8_WAIT_L(8); PG8_BAR; PG8_WAIT_L(0); PG8_MMA(0, 0, At, B0); PG8_BAR; PG8_SCHED;
            PG8_LDB(B1, 0, 1); PG8_STAGE(PG8_SB(0, 0), b2, voffB);
            PG8_BAR; PG8_WAIT_L(0); PG8_MMA(0, 1, At, B1); PG8_BAR;
            PG8_LDA(At, 0, 1); PG8_STAGE_AX(PG8_SA(0, 0), a2, 0);
            PG8_BAR; PG8_WAIT_L(0); PG8_MMA(1, 0, At, B0); PG8_BAR; PG8_SCHED;
            PG8_STAGE(PG8_SB(0, 1), b2 + hstep, voffB);
            PG8_WAIT_V(6); PG8_BAR; PG8_MMA(1, 1, At, B1); PG8_BAR;
            PG8_LDB(B0, 1, 0); PG8_SCHED; PG8_LDA(At, 1, 0); PG8_STAGE_AX(PG8_SA(0, 1), a2, 1);
            PG8_WAIT_L(8); PG8_BAR; PG8_WAIT_L(0); PG8_MMA(0, 0, At, B0); PG8_BAR; PG8_SCHED;
            PG8_LDB(B1, 1, 1); PG8_STAGE(PG8_SB(1, 0), b3, voffB);
            PG8_BAR; PG8_WAIT_L(0); PG8_MMA(0, 1, At, B1); PG8_BAR;
            PG8_LDA(At, 1, 1); PG8_STAGE_AX(PG8_SA(1, 0), a3, 0);
            PG8_BAR; PG8_WAIT_L(0); PG8_MMA(1, 0, At, B0); PG8_BAR; PG8_SCHED;
            PG8_STAGE(PG8_SB(1, 1), b3 + hstep, voffB);
            PG8_WAIT_V(6); PG8_BAR; PG8_MMA(1, 1, At, B1); PG8_BAR;
            }
        }
        if constexpr (ALIGN_EPI) { if (wr == 0) PG8_BAR; }
        if constexpr (!Epi::AFTER_DRAIN) { E(acc, cur, wr, wc, fr, fq); S.done(cur); }
        if (!has_next) break;
#pragma unroll
        for (int a = 0; a < 2; ++a)
#pragma unroll
            for (int b = 0; b < 2; ++b)
#pragma unroll
                for (int m = 0; m < 4; ++m)
#pragma unroll
                    for (int n = 0; n < 2; ++n) acc[a][b][m][n] = (f32x4){0.f, 0.f, 0.f, 0.f};
        cur = nxt; cA = nA; cB = nB; ++ui;
        if constexpr (GATHER) { vA0[0] = nvA0[0]; vA0[1] = nvA0[1]; vA1[0] = nvA1[0]; vA1[1] = nvA1[1]; }
        if constexpr (ALIGN_EPI) { if (wr == 1) PG8_BAR; }
    }
    PG8_WAIT_V(0);
    if constexpr (!ALIGN_EPI) { if (wr == 0) PG8_BAR; }
    PG8_BAR;
    if constexpr (Epi::AFTER_DRAIN) { E.fused(acc, cur, wr, wc, fr, fq, lds, wid, lane); S.done(cur); }
#undef PG8_SA
#undef PG8_SB
#undef PG8_STAGE
#undef PG8_LDA
#undef PG8_STAGE_AC
#undef PG8_STAGE_AX
#undef PG8_GOFF
#undef PG8_LDB
#undef PG8_MMA
#undef PG8_WAIT_V
#undef PG8_WAIT_L
#undef PG8_BAR
#undef PG8_SCHED
}
}
#define XB_TMO      128
#define XB_XCNT(j)  (256  + 64 * (j))
#define XB_XSUB(j)  (1280 + 64 * (j))
#define XB_XGEN(j)  (2304 + 64 * (j))
#define XB_TOP      3328
#define XB_TOPGEN   3392
#define XCD_BAR_WORDS 3456
#define XB_SPIN_CAP (1u << 18)

__device__ __forceinline__ unsigned xb_ld(unsigned* p)              { return __hip_atomic_load(p, __ATOMIC_RELAXED, __HIP_MEMORY_SCOPE_AGENT); }
__device__ __forceinline__ unsigned xb_add(unsigned* p, unsigned v) { return __hip_atomic_fetch_add(p, v, __ATOMIC_RELAXED, __HIP_MEMORY_SCOPE_AGENT); }
__device__ __forceinline__ unsigned xb_xcc_id() { return (unsigned)__builtin_amdgcn_s_getreg((3 << 11) | 20) & 0xFu; }
#define XB_SPIN(cond, bar) do { unsigned _sp = 0; while (cond) { __builtin_amdgcn_s_sleep(1); \
    if ((++_sp & 255u) == 0u) { if (xb_ld(&(bar)[XB_TMO])) break; if (_sp > XB_SPIN_CAP) { atomicAdd(&(bar)[XB_TMO], 1u); break; } } } } while (0)

struct XcdBarrier {
    unsigned* bar; unsigned x;
    volatile LAS unsigned* st;
};

__device__ __forceinline__ XcdBarrier xcd_barrier_post(unsigned* bar, volatile LAS unsigned* st) {
    XcdBarrier b; b.bar = bar; b.x = xb_xcc_id(); b.st = st;
    if (threadIdx.x == 0) (void)xb_add(&bar[XB_XCNT(b.x)], 1u);
    return b;
}
__device__ __forceinline__ void xcd_barrier_complete(unsigned* bar, unsigned x, unsigned& nloc, unsigned& nx) {
    const unsigned G = gridDim.x * gridDim.y * gridDim.z;
    unsigned sum, cnt, mine, sp = 0u;
    for (;;) {
        sum = 0u; cnt = 0u; mine = 0u;
#pragma unroll
        for (unsigned j = 0; j < 16; ++j) { const unsigned c = xb_ld(&bar[XB_XCNT(j)]); sum += c; cnt += (c > 0u) ? 1u : 0u; mine = (j == x) ? c : mine; }
        if (sum == G) break;
        __builtin_amdgcn_s_sleep(1);
        if ((++sp & 255u) == 0u) { if (xb_ld(&bar[XB_TMO])) break; if (sp > XB_SPIN_CAP) { atomicAdd(&bar[XB_TMO], 1u); break; } }
    }
    nloc = mine > 0u ? mine : 1u; nx = cnt > 0u ? cnt : 1u;
}

__device__ __forceinline__ void xcd_barrier(const XcdBarrier& b) {
    asm volatile("s_waitcnt vmcnt(0)" ::: "memory");
    __syncthreads();
    if (threadIdx.x == 0) {
        unsigned* bar = b.bar;
        __builtin_amdgcn_s_waitcnt(0);
        unsigned nloc = b.st[0], nx = b.st[1];
        if (nloc == 0u) { xcd_barrier_complete(bar, b.x, nloc, nx); b.st[0] = nloc; b.st[1] = nx; }
        const unsigned old = xb_add(&bar[XB_XSUB(b.x)], 1u);
        const unsigned gen = old / nloc;
        if (old + 1u == (gen + 1u) * nloc) {
            __builtin_amdgcn_fence(__ATOMIC_RELEASE, "agent");
            asm volatile("s_waitcnt vmcnt(0)" ::: "memory");
            const unsigned og = xb_add(&bar[XB_TOP], 1u);
            const unsigned tg = og / nx;
            if (og + 1u == (tg + 1u) * nx) xb_add(&bar[XB_TOPGEN], 1u);
            else XB_SPIN(xb_ld(&bar[XB_TOPGEN]) == tg, bar);
            __builtin_amdgcn_fence(__ATOMIC_ACQUIRE, "agent");
            xb_add(&bar[XB_XGEN(b.x)], 1u);
            asm volatile("s_waitcnt vmcnt(0)" ::: "memory");
        } else {
            XB_SPIN(xb_ld(&bar[XB_XGEN(b.x)]) == gen, bar);
            __builtin_amdgcn_fence(__ATOMIC_ACQUIRE, "agent");
            asm volatile("s_waitcnt vmcnt(0)" ::: "memory");
        }
    }
    __syncthreads();
}
struct Frame {
    LAS unsigned char* lds;
    unsigned char* ldsg;
    volatile LAS unsigned* MISC;
    int tid, lane, wave, vcu, G, gw, NGW;
    const GAS float* const __attribute__((address_space(4)))* in;
    GAS unsigned char* ws;
    GAS float* out;
    unsigned long long tprobe;
};
#ifndef PROBE_SUB
#define PROBE_SUB 0
#endif
#define TP_BEGIN() unsigned long long tp0_ = PROBE_SUB ? __builtin_amdgcn_s_memrealtime() : 0ull
#define TP_END(id) do { if (PROBE_SUB == (id)) { const unsigned long long t1_ = __builtin_amdgcn_s_memrealtime(); F0.tprobe += t1_ - tp0_; } if (PROBE_SUB) tp0_ = __builtin_amdgcn_s_memrealtime(); } while (0)
#define WSP(T, off) ((T*)(F.ws + (off)))
#define INP(k) ((const float*)F.in[k])
#define LAUNDER(F) asm volatile("" : "+s"(F.ws), "+s"(F.in), "+s"(F.out), "+v"(F.tid), "+v"(F.lane), "+s"(F.wave), "+s"(F.gw), "+s"(F.vcu), "+s"(F.G), "+s"(F.NGW))

__device__ __forceinline__ int row_s(int row) { return row < TLAT ? (row >> 12) : 4; }

__device__ __forceinline__ void mod_row_store(const f32x4 (&v)[4], const float* g, const float* shift, const float* scale, bf16* orow, int lane, f32x4 (&h)[4]) {
    float s = 0.f;
#pragma unroll
    for (int j = 0; j < 4; ++j) s += (v[j].x * v[j].x + v[j].y * v[j].y) + (v[j].z * v[j].z + v[j].w * v[j].w);
    const float rstd = 1.0f / sqrtf(wave_sum(s) * (1.0f / 1024.0f) + 1e-6f);
#pragma unroll
    for (int j = 0; j < 4; ++j) {
        const f32x4 g4 = ((const f32x4*)g)[64 * j + lane], sh = ((const f32x4*)shift)[64 * j + lane], sc = ((const f32x4*)scale)[64 * j + lane];
        h[j] = (v[j] * rstd) * g4 * (sc + 1.0f) + sh;
        v2u o; o.x = pk2(h[j].x, h[j].y); o.y = pk2(h[j].z, h[j].w);
        ((v2u*)orow)[64 * j + lane] = o;
    }
}

template <class RowMap>
__device__ __forceinline__ void transpose_item(const float* W, int K, int N, bf16* WT, const RowMap& rowmap, LAS float* scr, int item, int lane) {
    const int nblk = (N + 63) / 64, kb = item / nblk, nb = item % nblk, k0 = 64 * kb, n0 = 64 * nb;
    const int r = lane >> 4, c4 = (lane & 15) * 4;
    f32x4 t_[16];
#pragma unroll
    for (int i = 0; i < 16; ++i) t_[i] = (n0 + c4 < N) ? *(const f32x4*)(W + (size_t)(k0 + 4 * i + r) * N + n0 + c4) : (f32x4){0.f, 0.f, 0.f, 0.f};
#pragma unroll
    for (int i = 0; i < 16; ++i) { LAS float* d = scr + (4 * i + r) * 65 + c4; d[0] = t_[i].x; d[1] = t_[i].y; d[2] = t_[i].z; d[3] = t_[i].w; }
    LDS_WAIT(); asm volatile("" ::: "memory");
    const int c = lane & 7;
#pragma unroll
    for (int j = 0; j < 8; ++j) { const int n = (lane >> 3) + 8 * j; const LAS float* s = scr + (8 * c) * 65 + n;
        v4u o; o.x = pk2(s[0 * 65], s[1 * 65]); o.y = pk2(s[2 * 65], s[3 * 65]); o.z = pk2(s[4 * 65], s[5 * 65]); o.w = pk2(s[6 * 65], s[7 * 65]);
        *(v4u*)(WT + (size_t)rowmap(n0 + n) * K + k0 + 8 * c) = o; }
    LDS_WAIT(); asm volatile("" ::: "memory");
}
struct RowId { int off; __device__ __forceinline__ int operator()(int n) const { return off + n; } };
struct RowW13 { int e, w3; __device__ __forceinline__ int operator()(int n) const { return e * 2048 + (n >> 7) * 256 + w3 * 128 + (n & 127); } };

__device__ __forceinline__ void ph_filters(Frame& F, int j);
__device__ __forceinline__ void ph_prologue(Frame& F0) { Frame F = F0; LAUNDER(F);
    const bool filt_first = (F.vcu & 1) != 0;
    if (filt_first) { ph_filters(F, 0); __syncthreads(); }
    LAS float* scr = (LAS float*)(F.lds + F.wave * 16640);
    LAS float* sv = (LAS float*)F.lds;
    constexpr int I_IN = 16 * ((EVC + 63) / 64), I_O = 16 * 16, I_Q = 16 * (QKVC / 64);
    constexpr int PER_J = I_IN + I_O + I_Q + I_O, NT_ITEMS = 2 * PER_J;
    for (int it = F.gw; it < NT_ITEMS; it += F.NGW) {
        const int j = it / PER_J; int r = it % PER_J;
        if (r < I_IN) { transpose_item(INP(I_EVWIN) + (size_t)j * DM * EVC, DM, EVC, WSP(bf16, WS_WIN) + (size_t)j * EVCP * DM, RowId{0}, scr, r, F.lane); continue; } r -= I_IN;
        if (r < I_O) { transpose_item(INP(I_EVWOUT) + (size_t)j * DM * DM, DM, DM, WSP(bf16, WS_WOE) + (size_t)j * DM * DM, RowId{0}, scr, r, F.lane); continue; } r -= I_O;
        if (r < I_Q) { transpose_item(INP(I_WQKV) + (size_t)j * DM * QKVC, DM, QKVC, WSP(bf16, WS_WQKV) + (size_t)j * QKVC * DM, RowId{0}, scr, r, F.lane); continue; } r -= I_Q;
        transpose_item(INP(I_DAWOUT) + (size_t)j * DM * DM, DM, DM, WSP(bf16, WS_WOD) + (size_t)j * DM * DM, RowId{0}, scr, r, F.lane);
    }
    __syncthreads();
    for (int i = F.tid; i < 5 * 1024; i += NTHR) { const float x = i < 4096 ? INP(I_C)[i] : INP(I_CCTX)[i - 4096]; sv[i] = siluf_(x); }
    __syncthreads();
    for (int it = F.gw; it < 4 * 24 * 16; it += F.NGW) {
        const int kc = it & 15, cg = (it >> 4) % 24, i = it / (16 * 24); const int col = cg * 256 + F.lane * 4;
        const float* wp = INP(I_ADAW) + (size_t)i * DM * 6144 + (size_t)(kc * 64) * 6144 + col;
        f32x4 acc[5];
#pragma unroll
        for (int s = 0; s < 5; ++s) acc[s] = (f32x4){0.f, 0.f, 0.f, 0.f};
#pragma unroll 1
        for (int k0 = 0; k0 < 64; k0 += 16) {
            f32x4 w[16];
#pragma unroll
            for (int k = 0; k < 16; ++k) w[k] = *(const f32x4*)(wp + (size_t)(k0 + k) * 6144);
#pragma unroll
            for (int k = 0; k < 16; ++k)
#pragma unroll
                for (int s = 0; s < 5; ++s) acc[s] = acc[s] + w[k] * sv[s * 1024 + kc * 64 + k0 + k];
        }
#pragma unroll
        for (int s = 0; s < 5; ++s) *(f32x4*)(WSP(float, WS_MODP) + ((size_t)(kc * 4 + i) * 5 + s) * 6144 + col) = acc[s];
    }
    for (int k = F.gw * 64 + F.lane; k < 8192; k += F.NGW * 64) { float s, c; sincospif((float)k * (1.0f / 4096.0f), &s, &c); WSP(f32x2, WS_TW)[k] = (f32x2){c, -s}; }
    for (int idx = F.gw * 64 + F.lane; idx < 2 * 224 * 64; idx += F.NGW * 64) {
        const int l = idx & 63, f = (idx >> 6) % 224, j = idx / (224 * 64); const int kb = 8 * (l >> 4), n = l & 15;
        const float* src; int col;
        if (f < 64) { const int d = f >> 5, nt = f & 31; src = INP(I_W2) + ((size_t)(j * 2 + d) * 32 + kb) * RWW; col = nt * 16 + n; }
        else if (f < 128) { const int d = (f - 64) >> 5, nt = (f - 64) & 31; src = INP(I_A2) + ((size_t)(j * 2 + d) * 32 + kb) * RWW; col = nt * 16 + n; }
        else { const int nt = (f - 128) / 3, ks = (f - 128) % 3; src = INP(I_G2) + ((size_t)j * 96 + ks * 32 + kb) * RWW; col = nt * 16 + n; }
        v4u o; o.x = pk2(src[0 * RWW + col], src[1 * RWW + col]); o.y = pk2(src[2 * RWW + col], src[3 * RWW + col]); o.z = pk2(src[4 * RWW + col], src[5 * RWW + col]); o.w = pk2(src[6 * RWW + col], src[7 * RWW + col]);
        WSP(v4u, WS_FRAGB)[idx] = o;
    }
    if (!filt_first) { __syncthreads(); ph_filters(F, 0); }
}
__device__ __forceinline__ void ph_modred(Frame& F0) { Frame F = F0; LAUNDER(F);
    for (int idx = F.gw * 64 + F.lane; idx < 4 * 5 * 6144; idx += F.NGW * 64) {
        const int col = idx % 6144, i = idx / (5 * 6144); float a = INP(I_ADAB)[i * 6144 + col];
#pragma unroll
        for (int kc = 0; kc < 16; ++kc) a += WSP(float, WS_MODP)[(size_t)kc * 4 * 5 * 6144 + idx];
        WSP(float, WS_MODS)[idx] = a;
    }
}
__device__ __forceinline__ void ph_mod0(Frame& F0) { Frame F = F0; LAUNDER(F);
    const float* mods = WSP(float, WS_MODS);
    for (int row = F.gw; row < TT; row += F.NGW) {
        const float* src = row < TLAT ? INP(I_X) + (size_t)row * DM : INP(I_CTX) + (size_t)(row - TLAT) * DM;
        f32x4 v[4], h[4];
#pragma unroll
        for (int j = 0; j < 4; ++j) { v[j] = ((const f32x4*)src)[64 * j + F.lane]; ((f32x4*)(WSP(float, WS_X) + (size_t)row * DM))[64 * j + F.lane] = v[j]; }
        const int s = row_s(row);
        mod_row_store(v, INP(I_NORMG), mods + s * 6144, mods + s * 6144 + 1024, WSP(bf16, WS_HA) + (size_t)row * DM, F.lane, h);
    }
}
__device__ __forceinline__ float seq_pos(int row, int& L) { if (row < TLAT) { L = SEQ; return (float)(row & (SEQ - 1)); } L = CTXL; return (float)((row - TLAT) & (CTXL - 1)); }
__device__ __forceinline__ int seq_l(int row, int& L) { if (row < TLAT) { L = SEQ; return row & (SEQ - 1); } L = CTXL; return (row - TLAT) & (CTXL - 1); }

__device__ __forceinline__ f32x4 shift4(const float* P, size_t off, bool hp, bool hn, f32x4 m0, f32x4 m1) {
    const f32x4 u = *(const f32x4*)(P + off);
    const f32x4 up = hp ? *(const f32x4*)(P + off - EVCP) : (f32x4){0.f, 0.f, 0.f, 0.f};
    const f32x4 un = hn ? *(const f32x4*)(P + off + EVCP) : (f32x4){0.f, 0.f, 0.f, 0.f};
    return u + m0 * (up - u) + m1 * (un - u);
}

__device__ __forceinline__ void ph_evprep(Frame& F0, int j) { Frame F = F0; LAUNDER(F);
    const float* P = WSP(float, WS_P);
    const float* mu = INP(I_MU) + (size_t)j * 2 * RWC;
    TP_BEGIN();
    {
        float* Rr = (float*)(F.ws + WS_RW); float* Kk = (float*)(F.ws + WS_RW + RW_STRIDE); float* Vv = (float*)(F.ws + WS_RW + 2 * RW_STRIDE); float* KKn = (float*)(F.ws + WS_RW + 3 * RW_STRIDE);
        bf16* AOP = WSP(bf16, WS_AOP); const float* kkw = INP(I_KK) + (size_t)j * RWW;
        for (int row = F.gw; row < TT; row += F.NGW) {
            int L; const int l = seq_l(row, L); const bool hp = l > 0, hn = l < L - 1;
#pragma unroll
            for (int q = 0; q < 7; ++q) {
                const int g = F.lane + 64 * q;
                if (q < 6 || g < 440) {
                    const int col = 4 * g;
                    const f32x4 m0 = *(const f32x4*)(mu + col), m1 = *(const f32x4*)(mu + RWC + col);
                    f32x4 sv = shift4(P, (size_t)row * EVCP + col, hp, hn, m0, m1);
                    if (q < 2) *(f32x4*)(Rr + (size_t)row * RWW + col) = sv;
                    else if (q < 4) { const int c = col - 512; *(f32x4*)(Kk + (size_t)row * RWW + c) = sv;
                        const f32x4 kx = sv * *(const f32x4*)(kkw + c);
                        const float ss = sum16_f((kx.x * kx.x + kx.y * kx.y) + (kx.z * kx.z + kx.w * kx.w));
                        *(f32x4*)(KKn + (size_t)row * RWW + c) = kx * (1.0f / fmaxf(sqrtf(ss), 1e-12f)); }
                    else if (q < 6) *(f32x4*)(Vv + (size_t)row * RWW + (col - 1024)) = sv;
                    else { const int c = col - 1536;
                        if (c < 64) { sv.x = tanhf(sv.x); sv.y = tanhf(sv.y); sv.z = tanhf(sv.z); sv.w = tanhf(sv.w); }
                        else if (c >= 128) { sv.x = sigmoidf_(sv.x); sv.y = sigmoidf_(sv.y); sv.z = sigmoidf_(sv.z); sv.w = sigmoidf_(sv.w); }
                        v2u w; w.x = pk2(sv.x, sv.y); w.y = pk2(sv.z, sv.w); *(v2u*)(AOP + (size_t)row * 224 + c) = w; }
                }
            }
        }
    }
    __syncthreads(); TP_END(1);
    __syncthreads(); TP_END(2);

}


__device__ __forceinline__ void ph_filters(Frame& F, int j) {
    __syncthreads();
    {
        LAS float* H1 = (LAS float*)F.lds; LAS float* H2 = (LAS float*)(F.lds + 16384);
        LAS float* W1s = (LAS float*)(F.lds + 32768); LAS float* B1s = (LAS float*)(F.lds + 41216); LAS float* B2s = (LAS float*)(F.lds + 41472); LAS float* FRs = (LAS float*)(F.lds + 41728);
        LAS float* W2s = (LAS float*)(F.lds + 42240); LAS float* W3s = (LAS float*)(F.lds + 58624);
        for (int i = F.tid; i < 33 * 64; i += NTHR) W1s[i] = INP(I_FW1)[(size_t)j * 33 * 64 + i];
        for (int i = F.tid; i < 64 * 64; i += NTHR) W2s[i] = INP(I_FW2)[(size_t)j * 64 * 64 + i];
        if (F.tid < 64) { B1s[F.tid] = INP(I_FB1)[j * 64 + F.tid]; B2s[F.tid] = INP(I_FB2)[j * 64 + F.tid]; }
        if (F.tid < 128) FRs[F.tid] = INP(I_FREQ)[j * 128 + F.tid];
        const float* w3 = INP(I_FW3) + (size_t)j * 64 * 2048;
        const int p = F.tid & 63, cg = F.wave;
        for (int it = F.vcu; it < 272; it += F.G) {
            const bool lat = it < 256; const int L = lat ? SEQ : CTXL; const int r = lat ? it : it - 256; const int pt = r >> 2, cq4 = r & 3; const int m = pt * 64 + p;
            float z[33];
            z[0] = (float)m / (float)(L - 1);
#pragma unroll
            for (int i = 0; i < 16; ++i) { const float band = 1e-4f + (float)i * ((15.0f - 1e-4f) / 15.0f); const float rev = (float)m * band / (float)L; const float fr_ = rev - floorf(rev);
                z[1 + i] = __builtin_amdgcn_cosf(fr_); z[17 + i] = -__builtin_amdgcn_sinf(fr_); }
            __syncthreads();
#pragma unroll 1
            for (int q = 0; q < 8; ++q) { const int n = cg * 8 + q; float a = B1s[n];
#pragma unroll
                for (int i = 0; i < 33; ++i) a += z[i] * W1s[i * 64 + n];
                H1[n * 64 + p] = __sinf(FRs[n] * a); }
            __syncthreads();
#pragma unroll 1
            for (int q = 0; q < 8; ++q) { const int n = cg * 8 + q; float a = B2s[n];
#pragma unroll 8
                for (int k = 0; k < 64; ++k) a += H1[k * 64 + p] * W2s[k * 64 + n];
                H2[n * 64 + p] = __sinf(FRs[64 + n] * a); }
            const float t = z[0];
            float* KC = lat ? WSP(float, WS_KCL) : WSP(float, WS_KCC); const int N2 = 2 * L;
#pragma unroll 1
            for (int c4 = 0; c4 < 4; ++c4) {
                const int ct = cq4 * 4 + c4;
                __syncthreads();
                for (int i = F.tid; i < 64 * 32; i += NTHR) { const int k = i >> 5, cc = i & 31; *(LAS f32x4*)(W3s + k * 128 + cc * 4) = *(const f32x4*)(w3 + (size_t)k * 2048 + ct * 128 + cc * 4); }
                __syncthreads();
                f32x4 acc[4];
#pragma unroll
                for (int q = 0; q < 4; ++q) acc[q] = (f32x4){0.f, 0.f, 0.f, 0.f};
#pragma unroll 2
                for (int k = 0; k < 64; ++k) { const float hv = H2[k * 64 + p]; const LAS f32x4* wr = (const LAS f32x4*)(W3s + k * 128 + cg * 16);
#pragma unroll
                    for (int q = 0; q < 4; ++q) acc[q] = acc[q] + wr[q] * hv; }
                const int colb = ct * 128 + cg * 16;
#pragma unroll
                for (int q = 0; q < 16; ++q) { const int col = colb + q; const int o = col >> 10, dirn = (col >> 9) & 1, c = col & 511;
                    const float d0 = -3.0701134573253945f, d1 = -15.350567286626973f; const float del = fabsf(d0 + (d1 - d0) * ((float)c / 511.0f));
                    const float val = acc[q >> 2][q & 3] * __expf(-t * del); float* kr = KC + (size_t)(o * 512 + c) * N2;
                    if (dirn == 0) kr[m] = val; else { if (m > 0) kr[N2 - m] = val; else kr[L] = 0.f; } }
            }
        }
        __syncthreads();
    }
}
#define ZI(i) ((i) + ((i) >> 5))
__device__ __forceinline__ f32x2 cmul(f32x2 a, f32x2 b) { return (f32x2){a.x * b.x - a.y * b.y, a.x * b.y + a.y * b.x}; }
__device__ __forceinline__ f32x2 cmulc(f32x2 a, f32x2 b) { return (f32x2){a.x * b.x + a.y * b.y, a.y * b.x - a.x * b.y}; }
template <int LOGN, int NF> __device__ __forceinline__ void fft_r2_dif(LAS f32x2* Z, const LAS f32x2* TWL, int lt, int lh) {
    constexpr int N = 1 << LOGN, TPG = NTHR / NF; const int half = 1 << lh;
    for (int bf = lt; bf < N / 2; bf += TPG) { const int jx = bf & (half - 1), i = ((bf - jx) << 1) + jx;
        const f32x2 a = Z[ZI(i)], b = Z[ZI(i + half)]; Z[ZI(i)] = a + b; Z[ZI(i + half)] = cmul(a - b, TWL[half + jx]); }
    __syncthreads();
}
template <int LOGN, int NF> __device__ __forceinline__ void fft_r8_dif(LAS f32x2* Z, const LAS f32x2* TWL, int lt, int lh) {
    constexpr int N = 1 << LOGN, TPG = NTHR / NF, NG = N / 8, PT = (NG + TPG - 1) / TPG; const int h = 1 << lh, qd = h >> 2, lq = lh - 2;
    f32x2 x[PT][8]; int i0[PT], j0[PT];
#pragma unroll
    for (int t = 0; t < PT; ++t) { const int g = lt + TPG * t; j0[t] = g & (qd - 1); i0[t] = ((g >> lq) << (lq + 3)) + j0[t];
        if (g < NG) {
#pragma unroll
            for (int m = 0; m < 8; ++m) x[t][m] = Z[ZI(i0[t] + m * qd)]; } }
#pragma unroll
    for (int t = 0; t < PT; ++t) { const int g = lt + TPG * t; if (g < NG) {
#pragma unroll
        for (int m = 0; m < 4; ++m) { const f32x2 a = x[t][m], b = x[t][m + 4]; x[t][m] = a + b; x[t][m + 4] = cmul(a - b, TWL[h + j0[t] + m * qd]); }
#pragma unroll
        for (int mm = 0; mm < 4; ++mm) { const int m = (mm & 1) + 4 * (mm >> 1); const f32x2 a = x[t][m], b = x[t][m + 2]; x[t][m] = a + b; x[t][m + 2] = cmul(a - b, TWL[(h >> 1) + j0[t] + (m & 1) * qd]); }
        const f32x2 wc = TWL[qd + j0[t]];
#pragma unroll
        for (int m = 0; m < 8; m += 2) { const f32x2 a = x[t][m], b = x[t][m + 1]; x[t][m] = a + b; x[t][m + 1] = cmul(a - b, wc); }
#pragma unroll
        for (int m = 0; m < 8; ++m) Z[ZI(i0[t] + m * qd)] = x[t][m]; } }
    __syncthreads();
}
template <int LOGN, int NF, bool SKIP_R2 = false> __device__ __forceinline__ void fft_dif(LAS f32x2* Z, const LAS f32x2* TWL, int lt) {
    int lh = LOGN - 1;
    if (LOGN % 3 == 1) { if (!SKIP_R2) fft_r2_dif<LOGN, NF>(Z, TWL, lt, lh); lh -= 1; }
#pragma unroll 1
    for (; lh >= 2; lh -= 3) fft_r8_dif<LOGN, NF>(Z, TWL, lt, lh);
}
template <int LOGN, int NF> __device__ __forceinline__ void fft_r8_dit(LAS f32x2* Z, const LAS f32x2* TWL, int lt, int lq) {
    constexpr int N = 1 << LOGN, TPG = NTHR / NF, NG = N / 8, PT = (NG + TPG - 1) / TPG; const int qd = 1 << lq;
    f32x2 x[PT][8]; int i0[PT], j0[PT];
#pragma unroll
    for (int t = 0; t < PT; ++t) { const int g = lt + TPG * t; j0[t] = g & (qd - 1); i0[t] = ((g >> lq) << (lq + 3)) + j0[t];
        if (g < NG) {
#pragma unroll
            for (int m = 0; m < 8; ++m) x[t][m] = Z[ZI(i0[t] + m * qd)]; } }
#pragma unroll
    for (int t = 0; t < PT; ++t) { const int g = lt + TPG * t; if (g < NG) {
        const f32x2 wc = TWL[qd + j0[t]];
#pragma unroll
        for (int m = 0; m < 8; m += 2) { const f32x2 a = x[t][m], b = cmulc(x[t][m + 1], wc); x[t][m] = a + b; x[t][m + 1] = a - b; }
#pragma unroll
        for (int mm = 0; mm < 4; ++mm) { const int m = (mm & 1) + 4 * (mm >> 1); const f32x2 a = x[t][m], b = cmulc(x[t][m + 2], TWL[2 * qd + j0[t] + (m & 1) * qd]); x[t][m] = a + b; x[t][m + 2] = a - b; }
#pragma unroll
        for (int m = 0; m < 4; ++m) { const f32x2 a = x[t][m], b = cmulc(x[t][m + 4], TWL[4 * qd + j0[t] + m * qd]); x[t][m] = a + b; x[t][m + 4] = a - b; }
#pragma unroll
        for (int m = 0; m < 8; ++m) Z[ZI(i0[t] + m * qd)] = x[t][m]; } }
    __syncthreads();
}
template <int LOGN, int NF, bool SKIP_R2 = false> __device__ __forceinline__ void fft_dit_inv(LAS f32x2* Z, const LAS f32x2* TWL, int lt) {
    constexpr int N = 1 << LOGN, TPG = NTHR / NF; constexpr int NTRI = LOGN / 3;
#pragma unroll 1
    for (int k = 0; k < NTRI; ++k) fft_r8_dit<LOGN, NF>(Z, TWL, lt, 3 * k);
    if (LOGN % 3 == 1 && !SKIP_R2) { const int half = N / 2;
        for (int bf = lt; bf < N / 2; bf += TPG) { const f32x2 a = Z[ZI(bf)], b = cmulc(Z[ZI(bf + half)], TWL[half + bf]); Z[ZI(bf)] = a + b; Z[ZI(bf + half)] = a - b; }
        __syncthreads(); }
}
template <int LOGN> __device__ __forceinline__ int brev_n(int x) { return (int)(__brev((unsigned)x) >> (32 - LOGN)); }
template <int LOGN> __device__ __forceinline__ void load_tw(Frame& F, LAS f32x2* TWL) {
    constexpr int N = 1 << LOGN; const f32x2* TW = WSP(f32x2, WS_TW);
    for (int k = F.tid; k < N; k += NTHR) { if (k == 0) { TWL[0] = (f32x2){1.f, 0.f}; continue; }
        const int lh = 31 - __builtin_clz((unsigned)k), jx = k - (1 << lh);
        TWL[k] = TW[(size_t)jx << (12 - lh)]; }
}
__device__ __forceinline__ float block_sum(Frame& F, float v, LAS float* red) {
    v = wave_sum(v); __syncthreads(); if (F.lane == 0) red[F.wave] = v; __syncthreads();
    float t = 0.f;
#pragma unroll
    for (int w = 0; w < NWAVES; ++w) t += red[w];
    return t;
}
template <int LOGN, int NF> struct FftGeo { static constexpr int N = 1 << LOGN, TPG = NTHR / NF, ZS = N + N / 32; };

template <int LOGN, int NF> __device__ __forceinline__ void fftk_item(Frame& F, const float* KC, f32x4* KSP, int item) {
    constexpr int N = 1 << LOGN, TPG = NTHR / NF, ZS = FftGeo<LOGN, NF>::ZS;
    const int fi = F.tid / TPG, lt = F.tid % TPG; const int p8 = item * NF + fi, o = p8 >> 8, pr = p8 & 255;
    LAS f32x2* Z = (LAS f32x2*)F.lds + fi * ZS; LAS f32x2* TWL = (LAS f32x2*)(F.lds + 67584); LAS float* red = (LAS float*)(F.lds + 133120);
    const float* ka = KC + (size_t)(o * 512 + 2 * pr) * N; const float* kb = ka + N;
    float sa = 0.f, sb = 0.f;
    for (int i = lt; i < N; i += TPG) { const float a = ka[i], b = kb[i]; sa += fabsf(a); sb += fabsf(b); Z[ZI(i)] = (f32x2){a, b}; }
    float na, nb;
    if (NF == 1) { na = block_sum(F, sa, red) + 1e-6f; nb = block_sum(F, sb, red + 8) + 1e-6f; } else { static_assert(NF == 1 || NTHR / NF == 64, "one wave per transform"); na = wave_sum(sa) + 1e-6f; nb = wave_sum(sb) + 1e-6f; }
    __syncthreads();
    fft_dif<LOGN, NF>(Z, TWL, lt);
    const float ia = 0.5f / (na * (float)N), ib = 0.5f / (nb * (float)N);
    f32x4* dst = KSP + (size_t)(o * 256 + pr) * N;
    for (int p = lt; p < N; p += TPG) {
        const int k = brev_n<LOGN>(p), p2 = brev_n<LOGN>((N - k) & (N - 1));
        const f32x2 z1 = Z[ZI(p)], z2 = Z[ZI(p2)];
        const f32x2 Ka = (f32x2){(z1.x + z2.x) * ia, (z1.y - z2.y) * ia}, Kb = (f32x2){(z1.y + z2.y) * ib, -(z1.x - z2.x) * ib};
        dst[p] = (f32x4){0.5f * (Ka.x + Kb.x), 0.5f * (Ka.y + Kb.y), 0.5f * (Ka.x - Kb.x), 0.5f * (Ka.y - Kb.y)};
    }
    __syncthreads();
}

template <int LOGN, int NF> __device__ __forceinline__ void spec_mul(LAS f32x2* Z, const f32x4* KS, int lt) {
    constexpr int N = 1 << LOGN, TPG = NTHR / NF, PT = (N + TPG - 1) / TPG;
    f32x4 kv[PT]; f32x2 yv[PT];
#pragma unroll
    for (int t = 0; t < PT; ++t) { const int p = lt + TPG * t; if (p < N) kv[t] = KS[p]; }
#pragma unroll
    for (int t = 0; t < PT; ++t) { const int p = lt + TPG * t; if (p < N) {
        const int k = brev_n<LOGN>(p), p2 = brev_n<LOGN>((N - k) & (N - 1));
        const f32x2 z1 = Z[ZI(p)], z2 = Z[ZI(p2)];
        yv[t] = cmul(z1, (f32x2){kv[t].x, kv[t].y}) + cmul((f32x2){z2.x, -z2.y}, (f32x2){kv[t].z, kv[t].w}); } }
    __syncthreads();
#pragma unroll
    for (int t = 0; t < PT; ++t) { const int p = lt + TPG * t; if (p < N) Z[ZI(p)] = yv[t]; }
    __syncthreads();
}
__device__ __forceinline__ float conv3_at(const float* p, int l, int L, float w0, float w1, float w2, float bb) {
    const float up = l > 0 ? p[l - 1] : 0.f, u = p[l], un = l < L - 1 ? p[l + 1] : 0.f; return up * w0 + u * w1 + un * w2 + bb; }
template <int LOGN, int NF> __device__ __forceinline__ void hyena_item(Frame& F, const float* UTall, const f32x4* KSP, float* HYTall, const float* hyb, const float* cw, const float* cb, int item) {
    constexpr int N = 1 << LOGN, L = N / 2, TPG = NTHR / NF, PT = (L + TPG - 1) / TPG, ZS = FftGeo<LOGN, NF>::ZS;
    const int fi = F.tid / TPG, lt = F.tid % TPG; const int p8 = item * NF + fi, b = p8 >> 8, pr = p8 & 255;
    const float* UT = UTall + (size_t)b * HYC * L; float* HYT = HYTall + (size_t)b * 512 * L;
    LAS f32x2* Z = (LAS f32x2*)F.lds + fi * ZS; LAS f32x2* TWL = (LAS f32x2*)(F.lds + 67584);
    const int c0 = 2 * pr; const float b0a = hyb[c0], b0b = hyb[c0 + 1], b1a = hyb[512 + c0], b1b = hyb[512 + c0 + 1];
#define CV(ptr, l_, s3, ch) conv3_at(ptr, l_, L, cw[(s3) * 512 + c0 + (ch)], cw[HYC + (s3) * 512 + c0 + (ch)], cw[2 * HYC + (s3) * 512 + c0 + (ch)], cb[(s3) * 512 + c0 + (ch)])
    const float* va = UT + (size_t)c0 * L; const float* vb = va + L;
    f32x2 keep[PT];
    f32x2 zpair = (f32x2){0.f, 0.f}; asm volatile("" : "+v"(zpair));
    const float* xa = UT + (size_t)(512 + c0) * L; const float* xb = xa + L;
    const float* x2a = UT + (size_t)(1024 + c0) * L; const float* x2b = x2a + L;
    float* oa = HYT + (size_t)c0 * L; float* ob = oa + L;
    if constexpr (LOGN % 3 == 1) {
#pragma unroll
        for (int q = 0; q < PT; ++q) { const int l = lt + TPG * q; keep[q] = (f32x2){CV(va, l, 0, 0), CV(vb, l, 0, 1)}; Z[ZI(l)] = keep[q]; Z[ZI(l + L)] = cmul(keep[q], TWL[L + l]); }
        __syncthreads();
        fft_dif<LOGN, NF, true>(Z, TWL, lt);
        spec_mul<LOGN, NF>(Z, KSP + (size_t)pr * N, lt);
        fft_dit_inv<LOGN, NF, true>(Z, TWL, lt);
        f32x2 x1v[PT];
#pragma unroll
        for (int q = 0; q < PT; ++q) { const int l = lt + TPG * q; x1v[q] = (f32x2){CV(xa, l, 1, 0), CV(xb, l, 1, 1)}; }
#pragma unroll
        for (int q = 0; q < PT; ++q) { const int l = lt + TPG * q; const f32x2 w = TWL[L + l]; const f32x2 y = Z[ZI(l)] + cmulc(Z[ZI(l + L)], w);
            keep[q] = (f32x2){x1v[q].x * (y.x + keep[q].x * b0a), x1v[q].y * (y.y + keep[q].y * b0b)};
            Z[ZI(l)] = keep[q]; Z[ZI(l + L)] = cmul(keep[q], w); }
        __syncthreads();
        fft_dif<LOGN, NF, true>(Z, TWL, lt);
        spec_mul<LOGN, NF>(Z, KSP + (size_t)(256 + pr) * N, lt);
        fft_dit_inv<LOGN, NF, true>(Z, TWL, lt);
#pragma unroll
        for (int q = 0; q < PT; ++q) { const int l = lt + TPG * q; x1v[q] = (f32x2){CV(x2a, l, 2, 0), CV(x2b, l, 2, 1)}; }
#pragma unroll
        for (int q = 0; q < PT; ++q) { const int l = lt + TPG * q; const f32x2 y = Z[ZI(l)] + cmulc(Z[ZI(l + L)], TWL[L + l]);
            oa[l] = x1v[q].x * (y.x + keep[q].x * b1a); ob[l] = x1v[q].y * (y.y + keep[q].y * b1b); }
        __syncthreads();
    } else {
#pragma unroll
        for (int q = 0; q < PT; ++q) { const int l = lt + TPG * q; if (l < L) { keep[q] = (f32x2){CV(va, l, 0, 0), CV(vb, l, 0, 1)}; Z[ZI(l)] = keep[q]; Z[ZI(l + L)] = zpair; } }
        __syncthreads();
        fft_dif<LOGN, NF>(Z, TWL, lt);
        spec_mul<LOGN, NF>(Z, KSP + (size_t)pr * N, lt);
        fft_dit_inv<LOGN, NF>(Z, TWL, lt);
#pragma unroll
        for (int q = 0; q < PT; ++q) { const int l = lt + TPG * q; if (l < L) { const f32x2 y = Z[ZI(l)]; keep[q] = (f32x2){CV(xa, l, 1, 0) * (y.x + keep[q].x * b0a), CV(xb, l, 1, 1) * (y.y + keep[q].y * b0b)}; } }
        __syncthreads();
#pragma unroll
        for (int q = 0; q < PT; ++q) { const int l = lt + TPG * q; if (l < L) { Z[ZI(l)] = keep[q]; Z[ZI(l + L)] = zpair; } }
        __syncthreads();
        fft_dif<LOGN, NF>(Z, TWL, lt);
        spec_mul<LOGN, NF>(Z, KSP + (size_t)(256 + pr) * N, lt);
        fft_dit_inv<LOGN, NF>(Z, TWL, lt);
#pragma unroll
        for (int q = 0; q < PT; ++q) { const int l = lt + TPG * q; if (l < L) { const f32x2 y = Z[ZI(l)]; oa[l] = CV(x2a, l, 2, 0) * (y.x + keep[q].x * b1a); ob[l] = CV(x2b, l, 2, 1) * (y.y + keep[q].y * b1b); } }
        __syncthreads();
    }
#undef CV
}
__device__ __forceinline__ void ph_hyena(Frame& F0, int j) { Frame F = F0; LAUNDER(F);
    LAS f32x2* TWL = (LAS f32x2*)(F.lds + 67584);
    const float* hyb = INP(I_HYB) + (size_t)j * 1024;
    load_tw<13>(F, TWL); __syncthreads();
    for (int it = F.vcu; it < 1024; it += F.G) hyena_item<13, 1>(F, WSP(float, WS_UTL), WSP(f32x4, WS_KSPL), WSP(float, WS_HYTL), hyb, INP(I_CONVW) + (size_t)j * 3 * HYC, INP(I_CONVB) + (size_t)j * HYC, it);
    __syncthreads(); load_tw<9>(F, TWL); __syncthreads();
    for (int it = F.vcu; it < 128; it += F.G) hyena_item<9, 8>(F, WSP(float, WS_UTC), WSP(f32x4, WS_KSPC), WSP(float, WS_HYTC), hyb, INP(I_CONVW) + (size_t)j * 3 * HYC, INP(I_CONVB) + (size_t)j * HYC, it);
    __syncthreads();
}

__device__ __forceinline__ void ph_readout(Frame& F0, int j) { Frame F = F0; LAUNDER(F);
    const float* Vv = (const float*)(F.ws + WS_RW + 2 * RW_STRIDE); const float* Gg = WSP(float, WS_G); const float* BON = WSP(float, WS_BON);
    const float* Y0 = WSP(float, WS_Y); const float* Y1 = Y0 + (size_t)TT * RWW;
    const float* gn = INP(I_GN) + (size_t)j * 2 * RWW;
    bf16* CAT = WSP(bf16, WS_CAT);
    for (int row = F.gw; row < TT; row += F.NGW) {
#pragma unroll
        for (int q = 0; q < 2; ++q) {
            const int c = 4 * F.lane + 256 * q; const size_t o = (size_t)row * RWW + c;
            const f32x4 y = *(const f32x4*)(Y0 + o) + *(const f32x4*)(Y1 + o);
            float s = (y.x + y.y) + (y.z + y.w);
            s = sum16_f(s);
            const float mu = s * (1.0f / 64.0f); const f32x4 dy = y - mu;
            float v2 = (dy.x * dy.x + dy.y * dy.y) + (dy.z * dy.z + dy.w * dy.w);
            v2 = sum16_f(v2);
            const float rstd = 1.0f / sqrtf(v2 * (1.0f / 64.0f) + 64e-5f);
            const f32x4 yn = dy * rstd * *(const f32x4*)(gn + c) + *(const f32x4*)(gn + RWW + c);
            const f32x4 v = *(const f32x4*)(Vv + o), g = *(const f32x4*)(Gg + o);
            const float bs = BON[(size_t)row * 8 + (c >> 6)];
            f32x4 ov = (yn + v * bs) * g;
#ifdef ABL_RW
            ov = ov * 0.0f;
#endif
            v2u w; w.x = pk2(ov.x, ov.y); w.y = pk2(ov.z, ov.w);
            *(v2u*)(CAT + (size_t)row * DM + c) = w;
        }
    }
    LAS float* scr = (LAS float*)(F.lds + F.wave * 16640);
    for (int it = F.gw; it < (TT / 64) * 8; it += F.NGW) {
        const int rt = it >> 3, ct = it & 7; const int r0 = rt * 64; int L; const int l0 = seq_l(r0, L);
        const float* src; if (r0 < TLAT) src = WSP(float, WS_HYTL) + ((size_t)(r0 >> 12) * 512 + ct * 64) * SEQ + l0; else src = WSP(float, WS_HYTC) + ((size_t)((r0 - TLAT) >> 8) * 512 + ct * 64) * CTXL + l0;
        for (int cc = 0; cc < 64; ++cc) scr[cc * 65 + F.lane] = src[(size_t)cc * L + F.lane];
        LDS_WAIT(); asm volatile("" ::: "memory");
        const int c2 = 2 * (F.lane & 31);
        for (int i2 = 0; i2 < 32; ++i2) { const int rr = 2 * i2 + (F.lane >> 5);
            unsigned pkv = pk2(scr[c2 * 65 + rr], scr[(c2 + 1) * 65 + rr]);
#ifdef ABL_HY
            pkv = 0u;
#endif
            *(unsigned*)(CAT + (size_t)(r0 + rr) * DM + 512 + ct * 64 + c2) = pkv; }
        LDS_WAIT(); asm volatile("" ::: "memory");
    }
}

__device__ __forceinline__ int chunk_base_row(int b, int d, int n) {
    if (n < 16) return TLAT + b * CTXL + 16 * (d ? 15 - n : n);
    const int m = n - 16; return b * SEQ + 16 * (d ? 255 - m : m);
}

__device__ __forceinline__ void ph_chunkprep(Frame& F0, int j) { Frame F = F0; LAUNDER(F);
    const float* Rr = (const float*)(F.ws + WS_RW); const float* Kk = (const float*)(F.ws + WS_RW + RW_STRIDE); const float* Vv = (const float*)(F.ws + WS_RW + 2 * RW_STRIDE); const float* KKn = (const float*)(F.ws + WS_RW + 3 * RW_STRIDE);
    const bf16* AOP = WSP(bf16, WS_AOP); float* Gg = WSP(float, WS_G); float* BON = WSP(float, WS_BON);
    LAS unsigned char* wl = F.lds + F.wave * 14336;
    LAS float* ST = (LAS float*)wl; LAS bf16* OPB = (LAS bf16*)(wl + 4096); LAS float* TM = (LAS float*)(wl + 12288); LAS float* M2s = (LAS float*)(wl + 13312);
    LAS v4u* FBL = (LAS v4u*)(F.lds + 8 * 14336);
    const int h = F.vcu & 7;
    {
        const v4u* FB = WSP(v4u, WS_FRAGB) + (size_t)j * 224 * 64;
        for (int i = F.tid; i < 28 * 64; i += NTHR) { const int f = i >> 6, l = i & 63; int src;
            if (f < 8) src = (f >> 2) * 32 + 4 * h + (f & 3); else if (f < 16) src = 64 + ((f - 8) >> 2) * 32 + 4 * h + (f & 3); else src = 128 + (4 * h + (f - 16) / 3) * 3 + (f - 16) % 3;
            FBL[i] = FB[src * 64 + l]; }
    }
    __syncthreads();
    const int lane = F.lane, n15 = lane & 15, q = lane >> 4;
    LAS float* BIAS = (LAS float*)(F.lds + LDSCTL_OFF + 1024);
    if (F.tid < 256) { const int which = F.tid >> 7, d = (F.tid >> 6) & 1, c = F.tid & 63; BIAS[F.tid] = (which ? INP(I_A0) : INP(I_W0))[(size_t)(j * 2 + d) * RWW + h * 64 + c]; }
    __syncthreads();
    const int col = h * 64 + lane;
    const float kav = INP(I_KA)[(size_t)j * RWW + col], rkv = INP(I_RK)[(size_t)j * RWW + col];
    for (int c16 = (F.vcu >> 3) * 8 + F.wave; c16 < TT / 16; c16 += (F.G >> 3) * 8) {
        const int base = c16 * 16;
        const bool lat = base < TLAT; const int b = lat ? (base >> 12) : ((base - TLAT) >> 8); const int cidx = lat ? ((base & (SEQ - 1)) >> 4) : (((base - TLAT) & (CTXL - 1)) >> 4);
        bf16x8 af[7];
#pragma unroll
        for (int f7 = 4; f7 < 7; ++f7) af[f7] = *(const bf16x8*)(AOP + (size_t)(base + n15) * 224 + f7 * 32 + 8 * q);
        float kkv[16], kxv[16], rxv[16];
#pragma unroll
        for (int s = 0; s < 16; ++s) { const size_t o = (size_t)(base + s) * RWW + col; kkv[s] = KKn[o]; kxv[s] = Kk[o]; rxv[s] = Rr[o]; }
#pragma unroll
        for (int nt = 0; nt < 4; ++nt) {
            f32x4 cg = __builtin_amdgcn_mfma_f32_16x16x32_bf16(af[4], __builtin_bit_cast(bf16x8, FBL[(16 + nt * 3 + 0) * 64 + lane]), (f32x4){0.f, 0.f, 0.f, 0.f}, 0, 0, 0);
            cg = __builtin_amdgcn_mfma_f32_16x16x32_bf16(af[5], __builtin_bit_cast(bf16x8, FBL[(16 + nt * 3 + 1) * 64 + lane]), cg, 0, 0, 0);
            cg = __builtin_amdgcn_mfma_f32_16x16x32_bf16(af[6], __builtin_bit_cast(bf16x8, FBL[(16 + nt * 3 + 2) * 64 + lane]), cg, 0, 0, 0);
#pragma unroll
            for (int r = 0; r < 4; ++r) Gg[(size_t)(base + 4 * q + r) * RWW + h * 64 + nt * 16 + n15] = cg[r];
        }
        float bon_mine = 0.f;
#pragma unroll 1
        for (int d = 0; d < 2; ++d) {
            float wv[16], av[16];
            const bf16x8 afw = *(const bf16x8*)(AOP + (size_t)(base + n15) * 224 + d * 32 + 8 * q), afa = *(const bf16x8*)(AOP + (size_t)(base + n15) * 224 + 64 + d * 32 + 8 * q);
#pragma unroll
            for (int which = 0; which < 2; ++which) {
#pragma unroll
                for (int nt = 0; nt < 4; ++nt) {
                    const bf16x8 aop = which ? afa : afw;
                    const f32x4 c4 = __builtin_amdgcn_mfma_f32_16x16x32_bf16(aop, __builtin_bit_cast(bf16x8, FBL[(8 * which + 4 * d + nt) * 64 + lane]), (f32x4){0.f, 0.f, 0.f, 0.f}, 0, 0, 0);
                    const float bias = BIAS[(which * 2 + d) * 64 + nt * 16 + n15];
#pragma unroll
                    for (int r = 0; r < 4; ++r) { const int tok = 4 * q + r, st = d ? 15 - tok : tok; const float x = bias + c4[r];
                        ST[st * 64 + nt * 16 + n15] = which ? sigmoidf_(x) : __expf(-0.6065306597126334f * sigmoidf_(x)); }
                }
                LDS_WAIT(); asm volatile("" ::: "memory");
#pragma unroll
                for (int s = 0; s < 16; ++s) { if (which) av[s] = ST[s * 64 + lane]; else wv[s] = ST[s * 64 + lane]; }
                LDS_WAIT(); asm volatile("" ::: "memory");
            }
            float kt[16];
            float p = 1.0f;
#pragma unroll
            for (int s = 0; s < 16; ++s) {
                const float kk = d ? kkv[15 - s] : kkv[s], kx = d ? kxv[15 - s] : kxv[s], rx = d ? rxv[15 - s] : rxv[s];
                const float kd = kx * (1.0f + (av[s] - 1.0f) * kav);
                { const float bt_ = wave_sum(rx * kd * rkv); if (lane == (d ? 15 - s : s)) bon_mine += bt_; }
                kt[s] = kk * p; p *= wv[s]; const float ip = 1.0f / p;
                OPB[0 * 1024 + s * 64 + lane] = (bf16)f2bf(kt[s]);
                OPB[1 * 1024 + s * 64 + lane] = (bf16)f2bf(rx * p);
                OPB[2 * 1024 + s * 64 + lane] = (bf16)f2bf(kd * ip);
                OPB[3 * 1024 + s * 64 + lane] = (bf16)f2bf(kk * av[s] * ip);
            }
            const float pc = p;
            LDS_WAIT(); asm volatile("" ::: "memory");
            {
                bf16x8 fk[2], fr[2], fb[2], fkk[2];
#pragma unroll
                for (int ks = 0; ks < 2; ++ks) { const int off = n15 * 64 + ks * 32 + 8 * q;
                    fk[ks] = *(const LAS bf16x8*)(OPB + 0 * 1024 + off); fr[ks] = *(const LAS bf16x8*)(OPB + 1 * 1024 + off);
                    fkk[ks] = *(const LAS bf16x8*)(OPB + 2 * 1024 + off); fb[ks] = *(const LAS bf16x8*)(OPB + 3 * 1024 + off); }
                f32x4 mA = (f32x4){0.f, 0.f, 0.f, 0.f}, mB = mA, mE = mA, mG = mA;
#pragma unroll
                for (int ks = 0; ks < 2; ++ks) {
                    mA = __builtin_amdgcn_mfma_f32_16x16x32_bf16(fk[ks], fb[ks], mA, 0, 0, 0);
                    mB = __builtin_amdgcn_mfma_f32_16x16x32_bf16(fk[ks], fkk[ks], mB, 0, 0, 0);
                    mE = __builtin_amdgcn_mfma_f32_16x16x32_bf16(fr[ks], fkk[ks], mE, 0, 0, 0);
                    mG = __builtin_amdgcn_mfma_f32_16x16x32_bf16(fr[ks], fb[ks], mG, 0, 0, 0);
                }
#pragma unroll
                for (int r = 0; r < 4; ++r) { const int sr = 4 * q + r;
                    ST[0 * 256 + sr * 16 + n15] = n15 < sr ? mA[r] : 0.f; ST[1 * 256 + sr * 16 + n15] = n15 < sr ? mB[r] : 0.f;
                    ST[2 * 256 + sr * 16 + n15] = n15 <= sr ? mE[r] : 0.f; ST[3 * 256 + sr * 16 + n15] = n15 <= sr ? mG[r] : 0.f; }
            }
            LDS_WAIT(); asm volatile("" ::: "memory");
            float vfa[2][8], vfb[2][8];
#pragma unroll
            for (int ig = 0; ig < 2; ++ig)
#pragma unroll
                for (int jj = 0; jj < 8; ++jj) { const int sg = (8 * q + jj) & 15; vfa[ig][jj] = Vv[(size_t)(base + (d ? 15 - sg : sg)) * RWW + h * 64 + ig * 16 + n15]; }
            {
                float tc[16];
#pragma unroll
                for (int s = 0; s < 16; ++s) { float acc = (s == n15) ? 1.0f : 0.0f;
#pragma unroll
                    for (int sg = 0; sg < s; ++sg) acc -= ST[0 * 256 + s * 16 + sg] * tc[sg];
                    tc[s] = acc; }
                if (q == 0) {
#pragma unroll
                    for (int s = 0; s < 16; ++s) TM[s * 16 + n15] = tc[s]; }
            }
            LDS_WAIT(); asm volatile("" ::: "memory");
            {
                float m1[16];
#pragma unroll
                for (int s = 0; s < 16; ++s) { float acc = 0.f;
#pragma unroll
                    for (int sg = 0; sg <= s; ++sg) acc += TM[s * 16 + sg] * kt[sg];
                    m1[s] = acc; }
#pragma unroll
                for (int s = 0; s < 16; ++s) OPB[0 * 1024 + s * 64 + lane] = (bf16)f2bf(m1[s]);
#pragma unroll
                for (int r = 0; r < 4; ++r) { const int sr = 4 * q + r; float acc = 0.f;
#pragma unroll
                    for (int sg = 0; sg < 16; ++sg) acc += TM[sr * 16 + sg] * ST[1 * 256 + sg * 16 + n15];
                    M2s[sr * 16 + n15] = acc; }
            }
            LDS_WAIT(); asm volatile("" ::: "memory");
#pragma unroll
            for (int ig = 0; ig < 2; ++ig)
#pragma unroll
                for (int jj = 0; jj < 8; ++jj) { const int sg = (8 * q + jj) & 15; vfb[ig][jj] = Vv[(size_t)(base + (d ? 15 - sg : sg)) * RWW + h * 64 + (2 + ig) * 16 + n15]; }
            {
                const int scan = b * 16 + h * 2 + d; const int npos = lat ? 16 + (d ? 255 - cidx : cidx) : (d ? 15 - cidx : cidx);
                unsigned char* rec = (unsigned char*)F.ws + WS_REC + ((size_t)scan * 272 + npos) * REC_BYTES;
                unsigned short e8[8];
#define PK_LO() ((unsigned)e8[0] | ((unsigned)e8[1] << 16))
#define PK_HI() ((unsigned)e8[2] | ((unsigned)e8[3] << 16))
#define STORE_FULL(piece) do { v4u o_; o_.x = PK_LO(); o_.y = PK_HI(); o_.z = e8[4] | ((unsigned)e8[5] << 16); o_.w = e8[6] | ((unsigned)e8[7] << 16); *(v4u*)(rec + (piece) * 1024 + lane * 16) = o_; } while (0)
#define STORE_HALFLANES(piece, sel) do { if (q < 2) { v4u o_; o_.x = PK_LO(); o_.y = PK_HI(); o_.z = e8[4] | ((unsigned)e8[5] << 16); o_.w = e8[6] | ((unsigned)e8[7] << 16); *(v4u*)(rec + (piece) * 1024 + ((sel) * 32 + (lane & 31)) * 16) = o_; } } while (0)
#define STORE_HALFWIDTH(piece, sel) do { v2u o_; o_.x = PK_LO(); o_.y = PK_HI(); *(v2u*)(rec + (piece) * 1024 + lane * 16 + (sel) * 8) = o_; } while (0)
#pragma unroll
                for (int ks = 0; ks < 2; ++ks) {
#pragma unroll
                    for (int jj = 0; jj < 8; ++jj) e8[jj] = OPB[0 * 1024 + n15 * 64 + 32 * ks + 16 * (jj >> 2) + 4 * q + (jj & 3)];
                    STORE_FULL(ks);
#pragma unroll
                    for (int jj = 0; jj < 8; ++jj) e8[jj] = OPB[1 * 1024 + n15 * 64 + 32 * ks + 16 * (jj >> 2) + 4 * q + (jj & 3)];
                    STORE_FULL(2 + ks);
                }
#pragma unroll
                for (int jj = 0; jj < 8; ++jj) e8[jj] = (unsigned short)f2bf(M2s[n15 * 16 + ((8 * q + jj) & 15)]);
                STORE_HALFLANES(4, 0);
#pragma unroll
                for (int jj = 0; jj < 8; ++jj) e8[jj] = (unsigned short)f2bf(ST[2 * 256 + n15 * 16 + ((8 * q + jj) & 15)]);
                STORE_HALFLANES(4, 1);
#pragma unroll
                for (int jj = 0; jj < 4; ++jj) e8[jj] = (unsigned short)f2bf(-ST[3 * 256 + n15 * 16 + 4 * q + jj]);
                STORE_HALFWIDTH(9, 0);
#pragma unroll
                for (int tl = 0; tl < 4; ++tl) {
#pragma unroll
                    for (int jj = 0; jj < 8; ++jj) e8[jj] = (unsigned short)OPB[2 * 1024 + ((8 * q + jj) & 15) * 64 + 16 * tl + n15];
                    STORE_HALFLANES(5 + (tl >> 1), tl & 1);
#pragma unroll
                    for (int jj = 0; jj < 4; ++jj) e8[jj] = (unsigned short)(OPB[3 * 1024 + (4 * q + jj) * 64 + 16 * tl + n15] ^ 0x8000u);
                    if (tl == 0) STORE_HALFWIDTH(9, 1); else if (tl == 1) STORE_HALFWIDTH(10, 0); else if (tl == 2) STORE_HALFWIDTH(10, 1); else STORE_HALFWIDTH(11, 0);
                }
#pragma unroll
                for (int ig = 0; ig < 4; ++ig) {
#pragma unroll
                    for (int jj = 0; jj < 8; ++jj) e8[jj] = (unsigned short)f2bf(ig < 2 ? vfa[ig & 1][jj] : vfb[ig & 1][jj]);
                    STORE_HALFLANES(7 + (ig >> 1), ig & 1);
                }
#undef PK_LO
#undef PK_HI
#undef STORE_FULL
#undef STORE_HALFLANES
#undef STORE_HALFWIDTH
                *(float*)(rec + 11 * 1024 + (lane >> 1) * 16 + 8 + (lane & 1) * 4) = pc;
            }
            LDS_WAIT(); asm volatile("" ::: "memory");
        }
        if (lane < 16) BON[(size_t)(base + lane) * 8 + h] = bon_mine;
    }
}

__device__ __forceinline__ void scan_unit(Frame& F, int scan) {
    constexpr int R = 11, D = 10, NCH = 272;
    const int b = scan >> 4, h = (scan >> 1) & 7, d = scan & 1;
    const int lane = F.lane, n15 = lane & 15, q = lane >> 4, l31 = lane & 31;
    const unsigned char* rec0 = (const unsigned char*)F.ws + WS_REC + (size_t)scan * NCH * REC_BYTES;
    const bool loader = F.wave >= 4; const int lw = F.wave & 3, ig = F.wave & 3;
    float* Yd = WSP(float, WS_Y) + (size_t)d * TT * RWW;
    f32x4 S[4];
#pragma unroll
    for (int t = 0; t < 4; ++t) S[t] = (f32x4){0.f, 0.f, 0.f, 0.f};
#define ISSUE(n_) do { const unsigned char* g_ = rec0 + (size_t)(n_) * REC_BYTES + lw * 1024 + lane * 16; LAS unsigned char* l_ = F.lds + ((n_) % R) * (int)REC_BYTES + lw * 1024; \
        _Pragma("unroll") for (int p_ = 0; p_ < 3; ++p_) __builtin_amdgcn_global_load_lds((const unsigned*)(g_ + p_ * 4096), (LAS unsigned*)(l_ + p_ * 4096), 16, 0, 0); } while (0)
#define BF8(x) __builtin_bit_cast(bf16x8, x)
    if (loader) {
#pragma unroll 1
        for (int n = 0; n < D; ++n) ISSUE(n);
        asm volatile("s_waitcnt vmcnt(27)" ::: "memory");
    }
    __builtin_amdgcn_s_barrier();
    const v4u zf = (v4u){0u, 0u, 0u, 0u}; const bool vz = q >= 2;
#pragma unroll 1
    for (int n = 0; n < NCH; ++n) {
        if (loader) {
            if (n + D < NCH) { ISSUE(n + D); asm volatile("s_waitcnt vmcnt(27)" ::: "memory"); }
            else asm volatile("s_waitcnt vmcnt(0)" ::: "memory");
        } else {
            const LAS unsigned char* sl = F.lds + (n % R) * (int)REC_BYTES;
#define FULLP(p) (*(const LAS v4u*)(sl + (p) * 1024 + lane * 16))
#define HALFL(p, sel) (vz ? zf : *(const LAS v4u*)(sl + (p) * 1024 + ((sel) * 32 + l31) * 16))
#define HALFW(p, sel) ({ const v2u t_ = *(const LAS v2u*)(sl + (p) * 1024 + lane * 16 + (sel) * 8); (v4u){t_.x, t_.y, 0u, 0u}; })
            v4u sb0, sb1; sb0.x = pk2(S[0][0], S[0][1]); sb0.y = pk2(S[0][2], S[0][3]); sb0.z = pk2(S[1][0], S[1][1]); sb0.w = pk2(S[1][2], S[1][3]);
            sb1.x = pk2(S[2][0], S[2][1]); sb1.y = pk2(S[2][2], S[2][3]); sb1.z = pk2(S[3][0], S[3][1]); sb1.w = pk2(S[3][2], S[3][3]);
            const f32x4 z4 = (f32x4){0.f, 0.f, 0.f, 0.f};
            const v4u fv = HALFL(7 + (ig >> 1), ig & 1);
            f32x4 U = __builtin_amdgcn_mfma_f32_16x16x32_bf16(BF8(FULLP(0)), BF8(sb0), z4, 0, 0, 0);
            f32x4 Y = __builtin_amdgcn_mfma_f32_16x16x32_bf16(BF8(FULLP(2)), BF8(sb0), z4, 0, 0, 0);
            U = __builtin_amdgcn_mfma_f32_16x16x32_bf16(BF8(FULLP(1)), BF8(sb1), U, 0, 0, 0);
            Y = __builtin_amdgcn_mfma_f32_16x16x32_bf16(BF8(FULLP(3)), BF8(sb1), Y, 0, 0, 0);
            U = __builtin_amdgcn_mfma_f32_16x16x32_bf16(BF8(HALFL(4, 0)), BF8(fv), U, 0, 0, 0);
            Y = __builtin_amdgcn_mfma_f32_16x16x32_bf16(BF8(HALFL(4, 1)), BF8(fv), Y, 0, 0, 0);
#pragma unroll
            for (int t = 0; t < 4; ++t) S[t] = __builtin_amdgcn_mfma_f32_16x16x32_bf16(BF8(HALFL(5 + (t >> 1), t & 1)), BF8(fv), S[t], 0, 0, 0);
            v4u ub; ub.x = pk2(U[0], U[1]); ub.y = pk2(U[2], U[3]); ub.z = 0u; ub.w = 0u;
            Y = __builtin_amdgcn_mfma_f32_16x16x32_bf16(BF8(HALFW(9, 0)), BF8(ub), Y, 0, 0, 0);
            S[0] = __builtin_amdgcn_mfma_f32_16x16x32_bf16(BF8(HALFW(9, 1)), BF8(ub), S[0], 0, 0, 0);
            S[1] = __builtin_amdgcn_mfma_f32_16x16x32_bf16(BF8(HALFW(10, 0)), BF8(ub), S[1], 0, 0, 0);
            S[2] = __builtin_amdgcn_mfma_f32_16x16x32_bf16(BF8(HALFW(10, 1)), BF8(ub), S[2], 0, 0, 0);
            S[3] = __builtin_amdgcn_mfma_f32_16x16x32_bf16(BF8(HALFW(11, 0)), BF8(ub), S[3], 0, 0, 0);
#pragma unroll
            for (int t = 0; t < 4; ++t) { const LAS unsigned char* pp = sl + 11 * 1024 + (8 * t + 2 * q) * 16 + 8; const f32x2 p0 = *(const LAS f32x2*)pp, p1 = *(const LAS f32x2*)(pp + 16);
                S[t] = S[t] * (f32x4){p0.x, p0.y, p1.x, p1.y}; }
            const int base = chunk_base_row(b, d, n);
#pragma unroll
            for (int r = 0; r < 4; ++r) { const int st = 4 * q + r; Yd[(size_t)(base + (d ? 15 - st : st)) * RWW + h * 64 + ig * 16 + n15] = Y[r]; }
            asm volatile("s_waitcnt lgkmcnt(0)" ::: "memory");
#undef FULLP
#undef HALFL
#undef HALFW
        }
        __builtin_amdgcn_s_barrier();
    }
#undef ISSUE
#undef BF8
    asm volatile("s_waitcnt vmcnt(0)" ::: "memory");
    __syncthreads();
}

__device__ __forceinline__ void subset_arrive(unsigned* ctr) {
    asm volatile("s_waitcnt vmcnt(0)" ::: "memory"); __syncthreads();
    if (threadIdx.x == 0) { __builtin_amdgcn_fence(__ATOMIC_RELEASE, "agent"); asm volatile("s_waitcnt vmcnt(0)" ::: "memory"); __hip_atomic_fetch_add(ctr, 1u, __ATOMIC_RELAXED, __HIP_MEMORY_SCOPE_AGENT); }
}
__device__ __forceinline__ void subset_wait(unsigned* ctr, unsigned n) {
    if (threadIdx.x == 0) { unsigned sp = 0;
        while (__hip_atomic_load(ctr, __ATOMIC_RELAXED, __HIP_MEMORY_SCOPE_AGENT) < n) { __builtin_amdgcn_s_sleep(4); if (++sp > (1u << 24)) break; }
        __builtin_amdgcn_fence(__ATOMIC_ACQUIRE, "agent"); asm volatile("s_waitcnt vmcnt(0)" ::: "memory"); }
    __syncthreads();
}
__device__ __forceinline__ void ph_scan_hyena(Frame& F0, int j, int i) { Frame F = F0; LAUNDER(F);
    unsigned* ctl = (unsigned*)(F.ws + WS_CTL) + 512 + 256 * i;
    LAS f32x2* TWL = (LAS f32x2*)(F.lds + 67584); LAS int* tick = (LAS int*)(F.lds + 133120 + 256);
    const float* hyb = INP(I_HYB) + (size_t)j * 1024;
    const bool split = F.G >= 128; const int nf = split ? F.G - 64 : F.G;
    TP_BEGIN();
    if (split && F.vcu < 64) { scan_unit(F, F.vcu); TP_END(6); }
    else {
        if (!split) { for (int sc = F.vcu; sc < 64; sc += F.G) scan_unit(F, sc); }
        const int id = split ? F.vcu - 64 : F.vcu;
        load_tw<13>(F, TWL); __syncthreads();
        for (int it = id; it < 512; it += nf) fftk_item<13, 1>(F, WSP(float, WS_KCL), WSP(f32x4, WS_KSPL), it);
        __syncthreads(); load_tw<9>(F, TWL); __syncthreads();
        for (int it = id; it < 64; it += nf) fftk_item<9, 8>(F, WSP(float, WS_KCC), WSP(f32x4, WS_KSPC), it);
        subset_arrive(ctl);
    }
    subset_wait(ctl, (unsigned)nf);
    int cur_n = 0;
    for (;;) {
        __syncthreads();
        if (F.tid == 0) tick[0] = (int)__hip_atomic_fetch_add(ctl + 64, 1u, __ATOMIC_RELAXED, __HIP_MEMORY_SCOPE_AGENT);
        __syncthreads();
        const int it = tick[0];
        if (it >= 1024 + 128) break;
        const int want = it < 1024 ? 13 : 9;
        if (cur_n != want) { __syncthreads(); if (want == 13) load_tw<13>(F, TWL); else load_tw<9>(F, TWL); cur_n = want; __syncthreads(); }
        if (it < 1024) hyena_item<13, 1>(F, WSP(float, WS_UTL), WSP(f32x4, WS_KSPL), WSP(float, WS_HYTL), hyb, INP(I_CONVW) + (size_t)j * 3 * HYC, INP(I_CONVB) + (size_t)j * HYC, it);
        else hyena_item<9, 8>(F, WSP(float, WS_UTC), WSP(f32x4, WS_KSPC), WSP(float, WS_HYTC), hyb, INP(I_CONVW) + (size_t)j * 3 * HYC, INP(I_CONVB) + (size_t)j * HYC, it - 1024);
    }
}
__device__ __forceinline__ void ph_mod2(Frame& F0, int i, const bf16* wout_t) { Frame F = F0; LAUNDER(F);
    const bool need_ctx = i + 1 < DEPTH; const bool split = need_ctx && F.G >= 64;
    unsigned* cctr = (unsigned*)(F.ws + WS_CTL) + 2048 + 64 * i;
    if (need_ctx && (!split || F.vcu < 16)) {
        for (int uu = split ? F.vcu : F.vcu; uu < 16; uu += split ? 16 : F.G) {
            pg8::Gemm g{WSP(bf16, WS_CAT), wout_t, TT, DM, DM, nullptr}; pg8::OneUnit S{64 + (uu >> 2), uu & 3};
            pg8::EpiResGate E{WSP(float, WS_X), WSP(float, WS_MODS) + (size_t)i * 5 * 6144}; pg8::gemm_phase<pg8::EpiResGate, pg8::OneUnit, true, true>(F.lds, g, S, E);
        }
        __syncthreads();
        if (split) subset_arrive(cctr);
    }
    LAS float* RL = (LAS float*)F.lds;
    const float* router = INP(I_ROUTER) + (size_t)i * DM * NE;
    for (int idx = F.tid; idx < DM * NE; idx += NTHR) { const int c = idx >> 4, e = idx & 15; RL[e * 1024 + c] = router[idx]; }
    __syncthreads();
    const float* mods = WSP(float, WS_MODS) + (size_t)i * 5 * 6144; const float* g = INP(I_NORMG) + (size_t)(i * 2 + 1) * DM;
#pragma unroll 1
    for (int part = 0; part < 2; ++part) {
    int r0, r1, gwp, ngwp;
    if (part == 0) { r0 = 0; r1 = TLAT; if (split) { if (F.vcu < 16) continue; gwp = (F.vcu - 16) * NWAVES + F.wave; ngwp = (F.G - 16) * NWAVES; } else { gwp = F.gw; ngwp = F.NGW; } }
    else { if (!need_ctx) break; if (split) subset_wait(cctr, 16u); else __syncthreads(); r0 = TLAT; r1 = TT; gwp = F.gw; ngwp = F.NGW; }
    const int nrows = r1;
    f32x4 vn[4];
    if (r0 + gwp < nrows) {
#pragma unroll
        for (int jj = 0; jj < 4; ++jj) vn[jj] = ((const f32x4*)(WSP(float, WS_X) + (size_t)(r0 + gwp) * DM))[64 * jj + F.lane]; }
    for (int row = r0 + gwp; row < nrows; row += ngwp) {
        f32x4 v[4], h[4];
#pragma unroll
        for (int jj = 0; jj < 4; ++jj) v[jj] = vn[jj];
        if (row + ngwp < nrows) {
#pragma unroll
            for (int jj = 0; jj < 4; ++jj) vn[jj] = ((const f32x4*)(WSP(float, WS_X) + (size_t)(row + ngwp) * DM))[64 * jj + F.lane]; }
        const int s = row_s(row);
        mod_row_store(v, g, mods + s * 6144 + 3 * 1024, mods + s * 6144 + 4 * 1024, WSP(bf16, WS_HA) + (size_t)row * DM, F.lane, h);
        float mylg = 0.f;
#pragma unroll 1
        for (int g4 = 0; g4 < 4; ++g4) {
            float a4[4];
#pragma unroll
            for (int k = 0; k < 4; ++k) { float a = 0.f;
#pragma unroll
                for (int jj = 0; jj < 4; ++jj) { const f32x4 r4 = ((const LAS f32x4*)(RL + (4 * g4 + k) * 1024))[64 * jj + F.lane]; a += (h[jj].x * r4.x + h[jj].y * r4.y) + (h[jj].z * r4.z + h[jj].w * r4.w); }
                a4[k] = a; }
#pragma unroll
            for (int k = 0; k < 4; ++k) a4[k] += dpp_f<DPP_XOR1>(a4[k]);
#pragma unroll
            for (int k = 0; k < 4; ++k) a4[k] += dpp_f<DPP_XOR2>(a4[k]);
#pragma unroll
            for (int k = 0; k < 4; ++k) a4[k] += dpp_f<DPP_HMIRROR>(a4[k]);
#pragma unroll
            for (int k = 0; k < 4; ++k) a4[k] += dpp_f<DPP_MIRROR>(a4[k]);
#pragma unroll
            for (int k = 0; k < 4; ++k) if ((F.lane & 15) == 4 * g4 + k) mylg = a4[k];
        }
        mylg += __builtin_bit_cast(float, __builtin_amdgcn_ds_swizzle(__builtin_bit_cast(int, mylg), 0x401F));
        { auto rr = __builtin_amdgcn_permlane32_swap(__float_as_uint(mylg), __float_as_uint(mylg), false, false); const unsigned lo_ = rr[0], hi_ = rr[1]; mylg = __uint_as_float(lo_) + __uint_as_float(hi_); }
        if (F.lane >= 16) mylg = -1e30f;
        const float mx = max16_f(mylg);
        const float ex = expf(mylg - mx); const float den = sum16_f(ex);
        const float mine = ex / den;
        if (F.lane < 16) WSP(float, WS_AFF)[(size_t)row * 16 + F.lane] = mine;
    }
    }
}

__device__ __forceinline__ int block_excl_scan(Frame& F, int v, LAS int* sc, int& total) {
    LAS int* cnt = sc + 16;
    __syncthreads();
    cnt[F.tid] = v;
    const int ws = wave_sum_i(v);
    if (F.lane == 0) sc[F.wave] = ws;
    __syncthreads();
    int base = 0, tot = 0;
#pragma unroll
    for (int w = 0; w < NWAVES; ++w) { const int t = sc[w]; if (w < F.wave) base += t; tot += t; }
    int pre = 0;
    for (int k = 0; k < F.lane; ++k) pre += cnt[F.wave * 64 + k];
    total = tot; return base + pre;
}
__device__ __forceinline__ int block_sum_i(Frame& F, int v, LAS int* sc) {
    v = wave_sum_i(v);
    __syncthreads(); if (F.lane == 0) sc[F.wave] = v; __syncthreads();
    int t = 0;
#pragma unroll
    for (int w = 0; w < NWAVES; ++w) t += sc[w];
    return t;
}
__device__ __forceinline__ void topk_item(Frame& F, int set, int e) {
    LAS int* sc = (LAS int*)(F.lds + 133120);
    const bool lat = set < 4; const int L = lat ? SEQ : CTXL, cap = lat ? 512 : 32; const int rbase = lat ? set * SEQ : TLAT + (set - 4) * CTXL;
    const int sbase = e * EROWS + (lat ? set * 512 : 2048 + (set - 4) * 32);
    const float* aff = WSP(float, WS_AFF);
    unsigned key[8];
#pragma unroll
    for (int q = 0; q < 8; ++q) { const int l = F.tid * 8 + q; key[q] = l < L ? __builtin_bit_cast(unsigned, aff[(size_t)(rbase + l) * 16 + e]) : 0u; }
    unsigned thr = 0u;
    for (int bit = 30; bit >= 0; --bit) {
        const unsigned cand = thr | (1u << bit); int cnt = 0;
#pragma unroll
        for (int q = 0; q < 8; ++q) cnt += (key[q] >= cand) ? 1 : 0;
        if (block_sum_i(F, cnt, sc) >= cap) thr = cand;
    }
    int ngt = 0, neq = 0;
#pragma unroll
    for (int q = 0; q < 8; ++q) { ngt += key[q] > thr ? 1 : 0; neq += (key[q] == thr && (F.tid * 8 + q) < L) ? 1 : 0; }
    int tot_gt, tot_eq; const int bgt = block_excl_scan(F, ngt, sc, tot_gt); const int beq = block_excl_scan(F, neq, sc, tot_eq);
    const int need_eq = cap - tot_gt; int rg = bgt, re = beq;
    int* slotmap = WSP(int, WS_SLOT); int* idxo = WSP(int, WS_IDX); float* gate = WSP(float, WS_GATE);
#pragma unroll
    for (int q = 0; q < 8; ++q) { const int l = F.tid * 8 + q; if (l < L) {
        int slot = -1;
        if (key[q] > thr) { slot = rg; ++rg; } else if (key[q] == thr) { if (re < need_eq) slot = tot_gt + re; ++re; }
        slotmap[(size_t)(rbase + l) * 16 + e] = slot;
        if (slot >= 0) { idxo[sbase + slot] = rbase + l; gate[sbase + slot] = __builtin_bit_cast(float, key[q]); } } }
    if (set == 0) for (int p = F.tid; p < EROWS - 2176; p += NTHR) { idxo[e * EROWS + 2176 + p] = 0; gate[e * EROWS + 2176 + p] = 0.f; }
    __syncthreads();
}
__device__ __forceinline__ void ph_topk(Frame& F0, int i) { Frame F = F0; LAUNDER(F);
    const bool filt = (i == 1);
    const bool filt_first = filt && (F.vcu & 1) != 0;
    if (filt_first) { ph_filters(F, 1); __syncthreads(); }
    TP_BEGIN();
    for (int it = F.vcu; it < (i + 1 < DEPTH ? 128 : 64); it += F.G) topk_item(F, it >> 4, it & 15);
    TP_END(4);
    LAS float* scr = (LAS float*)(F.lds + F.wave * 16640);
    const float* w1 = INP(I_MW1) + (size_t)i * NE * DM * FF; const float* w3 = INP(I_MW3) + (size_t)i * NE * DM * FF; const float* w2 = INP(I_MW2) + (size_t)i * NE * FF * DM;
    for (int it = F.gw; it < 3 * NE * 256; it += F.NGW) {
        const int which = it / (NE * 256), r = it % (NE * 256), e = r >> 8, item = r & 255;
        if (which == 0) transpose_item(w1 + (size_t)e * DM * FF, DM, FF, WSP(bf16, WS_W13), RowW13{e, 0}, scr, item, F.lane);
        else if (which == 1) transpose_item(w3 + (size_t)e * DM * FF, DM, FF, WSP(bf16, WS_W13), RowW13{e, 1}, scr, item, F.lane);
        else transpose_item(w2 + (size_t)e * FF * DM, FF, DM, WSP(bf16, WS_W2), RowId{e * 1024}, scr, item, F.lane);
    }
    TP_END(5);
    if (filt && !filt_first) { __syncthreads(); ph_filters(F, 1); }
}
__device__ __forceinline__ void ph_gather(Frame& F0, bool need_ctx) { Frame F = F0; LAUNDER(F);
    const int* idx = WSP(int, WS_IDX); const bf16* HA = WSP(bf16, WS_HA); bf16* XG = WSP(bf16, WS_XG);
    for (int r = F.gw; r < NE * EROWS; r += F.NGW) {
        if (!need_ctx && (r % EROWS) >= 2048) continue;
        const int src = idx[r]; const v4u* s = (const v4u*)(HA + (size_t)src * DM); v4u* d = (v4u*)(XG + (size_t)r * DM);
        d[F.lane] = s[F.lane]; d[64 + F.lane] = s[64 + F.lane];
    }
}
__device__ __forceinline__ void ph_combine(Frame& F0, int i) { Frame F = F0; LAUNDER(F);
    const int* slotmap = WSP(int, WS_SLOT); const bf16* YB = WSP(bf16, WS_YB);
    const float* mods = WSP(float, WS_MODS) + (size_t)i * 5 * 6144;
    const int nrows_c = i + 1 < DEPTH ? TT : TLAT;
    int slotn = -1; f32x4 xn[4];
    if (F.gw < nrows_c) { slotn = F.lane < 16 ? slotmap[(size_t)F.gw * 16 + F.lane] : -1;
#pragma unroll
        for (int jj = 0; jj < 4; ++jj) xn[jj] = ((const f32x4*)(WSP(float, WS_X) + (size_t)F.gw * DM))[64 * jj + F.lane]; }
    for (int row = F.gw; row < nrows_c; row += F.NGW) {
        f32x4 acc[4], xc[4];
#pragma unroll
        for (int jj = 0; jj < 4; ++jj) { acc[jj] = (f32x4){0.f, 0.f, 0.f, 0.f}; xc[jj] = xn[jj]; }
        const int myslot = slotn;
        if (row + F.NGW < nrows_c) { slotn = F.lane < 16 ? slotmap[(size_t)(row + F.NGW) * 16 + F.lane] : -1;
#pragma unroll
            for (int jj = 0; jj < 4; ++jj) xn[jj] = ((const f32x4*)(WSP(float, WS_X) + (size_t)(row + F.NGW) * DM))[64 * jj + F.lane]; }
        unsigned long long sel = __ballot(myslot >= 0);
        const int sbase = row < TLAT ? (row >> 12) * 512 : 2048 + ((row - TLAT) >> 8) * 32;
        while (sel) {
            const int e = __builtin_ctzll(sel); sel &= sel - 1;
            const int sl = __builtin_amdgcn_readlane(myslot, e);
            const v2u* yr = (const v2u*)(YB + (size_t)(e * EROWS + sbase + sl) * DM);
#pragma unroll
            for (int jj = 0; jj < 4; ++jj) { const v2u w = yr[64 * jj + F.lane];
                acc[jj].x += __builtin_bit_cast(float, w.x << 16); acc[jj].y += __builtin_bit_cast(float, w.x & 0xffff0000u);
                acc[jj].z += __builtin_bit_cast(float, w.y << 16); acc[jj].w += __builtin_bit_cast(float, w.y & 0xffff0000u); }
        }
#ifdef ABL_MOE
#pragma unroll
        for (int jj = 0; jj < 4; ++jj) acc[jj] = acc[jj] * 0.0f;
#endif
        const int s = row_s(row); f32x4 v[4], h[4];
        float* xr = WSP(float, WS_X) + (size_t)row * DM;
#pragma unroll
        for (int jj = 0; jj < 4; ++jj) { const f32x4 gm = ((const f32x4*)(mods + s * 6144 + 5 * 1024))[64 * jj + F.lane]; v[jj] = xc[jj] + gm * acc[jj]; ((f32x4*)xr)[64 * jj + F.lane] = v[jj]; }
        if (i + 1 < DEPTH) {
            const float* m2 = WSP(float, WS_MODS) + (size_t)(i + 1) * 5 * 6144;
            mod_row_store(v, INP(I_NORMG) + (size_t)((i + 1) * 2) * DM, m2 + s * 6144, m2 + s * 6144 + 1024, WSP(bf16, WS_HA) + (size_t)row * DM, F.lane, h);
        } else if (row < TLAT) {
            float ss = 0.f;
#pragma unroll
            for (int jj = 0; jj < 4; ++jj) ss += (v[jj].x * v[jj].x + v[jj].y * v[jj].y) + (v[jj].z * v[jj].z + v[jj].w * v[jj].w);
            const float rstd = 1.0f / sqrtf(wave_sum(ss) * (1.0f / 1024.0f) + 1e-6f);
#pragma unroll
            for (int jj = 0; jj < 4; ++jj) ((f32x4*)(F.out + (size_t)row * DM))[64 * jj + F.lane] = v[jj] * rstd * ((const f32x4*)INP(I_FINALG))[64 * jj + F.lane];
        }
    }
}
__device__ __forceinline__ void ph_rope(Frame& F0) { Frame F = F0; LAUNDER(F);
    const float* P = WSP(float, WS_P); bf16* QB = WSP(bf16, WS_QB); bf16* KB = WSP(bf16, WS_KB); bf16* VB = WSP(bf16, WS_VB);
    const int axis = (F.lane >> 1) & 1, half = F.lane & 1;
    float inv[16];
#pragma unroll
    for (int f = 0; f < 16; ++f) inv[f] = exp2f(-(float)f * (13.287712379549449f / 16.0f));
    for (int row = F.gw; row < TT; row += F.NGW) {
        const bool lat = row < TLAT; const int b = lat ? (row >> 12) : ((row - TLAT) >> 8); const int l = lat ? (row & (SEQ - 1)) : ((row - TLAT) & (CTXL - 1));
        const size_t krow = (size_t)b * KSEQ + (lat ? CTXL + l : l);
        float cs[16], sn[16];
        if (lat) { const float pos = (float)(axis ? (l & 63) : (l >> 6));
#pragma unroll
            for (int f = 0; f < 16; ++f) sincosf(pos * inv[f], &sn[f], &cs[f]); }
#pragma unroll
        for (int part = 0; part < 3; ++part) {
            float x[16];
            const float* src = P + (size_t)row * QKVC + part * 1024 + 16 * F.lane;
#pragma unroll
            for (int q = 0; q < 4; ++q) { const f32x4 t = *(const f32x4*)(src + 4 * q); x[4 * q] = t.x; x[4 * q + 1] = t.y; x[4 * q + 2] = t.z; x[4 * q + 3] = t.w; }
            if (part < 2 && lat) {
#pragma unroll
                for (int f = 0; f < 16; ++f) { const float o = xor1_f(x[f]);
                    x[f] = half ? (x[f] * cs[f] + o * sn[f]) : (x[f] * cs[f] - o * sn[f]); }
            }
            v4u w0, w1; w0.x = pk2(x[0], x[1]); w0.y = pk2(x[2], x[3]); w0.z = pk2(x[4], x[5]); w0.w = pk2(x[6], x[7]); w1.x = pk2(x[8], x[9]); w1.y = pk2(x[10], x[11]); w1.z = pk2(x[12], x[13]); w1.w = pk2(x[14], x[15]);
            bf16* dst = part == 0 ? QB + (size_t)row * DM : (part == 1 ? KB + krow * DM : VB + krow * DM);
            *(v4u*)(dst + 16 * F.lane) = w0; *(v4u*)(dst + 16 * F.lane + 8) = w1;
        }
    }
}

namespace att {
using s16x4 = __attribute__((ext_vector_type(4))) short;
using f32x16 = __attribute__((ext_vector_type(16))) float;
using u32x4 = __attribute__((ext_vector_type(4))) unsigned;
constexpr int DQ = 64, DV = 128, NW = 8, QBLK = 32, KVBLK = 64, LD = 1024;
constexpr float SCALE = 0.125f, THR = 8.f;
#ifndef ATT_SDEPTH
#define ATT_SDEPTH 1
#endif
constexpr int SDEPTH = ATT_SDEPTH;
constexpr size_t SHM_V = KVBLK * DV * 2, SHM_K = KVBLK * DQ * 2, SHM_ATTN = 2 * SHM_V + 2 * SHM_K + NW * 64 * 4;
#define KSWZ(row, colB) ((row) * 128 + ((colB) ^ (((row) & 7) << 4)))
#define SBAR() __builtin_amdgcn_sched_barrier(0)
__device__ __forceinline__ int crow(int r, int hi) { return (r & 3) + 8 * (r >> 2) + 4 * hi; }
__device__ __forceinline__ unsigned cvtpk(float lo, float hi) { unsigned r; asm volatile("v_cvt_pk_bf16_f32 %0, %1, %2" : "=v"(r) : "v"(lo), "v"(hi)); return r; }
__device__ __forceinline__ void partialSM(f32x16& p0, f32x16& p1, float& m_reg, float& mn, float& alpha) {
  constexpr float C = SCALE * 1.4426950408889634f;
  float pmax = p0[0]; for (int r = 1; r < 16; ++r) pmax = fmaxf(pmax, p0[r]); for (int r = 0; r < 16; ++r) pmax = fmaxf(pmax, p1[r]);
  { auto rr = __builtin_amdgcn_permlane32_swap(__float_as_uint(pmax), __float_as_uint(pmax), false, false);
    pmax = fmaxf(__uint_as_float(rr[0]), __uint_as_float(rr[1])); }
  if (__builtin_expect(__all(pmax - m_reg <= THR / SCALE), 1)) { mn = m_reg; alpha = 1.f; }
  else { mn = fmaxf(m_reg, pmax); alpha = __builtin_amdgcn_exp2f((m_reg - mn) * C); m_reg = mn; }
  float mnC = -mn * C;
  for (int r = 0; r < 16; ++r) p0[r] = fmaf(p0[r], C, mnC); for (int r = 0; r < 16; ++r) p1[r] = fmaf(p1[r], C, mnC);
  for (int r = 0; r < 16; ++r) p0[r] = __builtin_amdgcn_exp2f(p0[r]);
}
__device__ __forceinline__ void finishSM(f32x16& p0, f32x16& p1, float alpha, float& l_reg, bf16x8& pa0, bf16x8& pa1, bf16x8& pa2, bf16x8& pa3) {
  for (int r = 0; r < 16; ++r) p1[r] = __builtin_amdgcn_exp2f(p1[r]);
  float ps = 0; for (int r = 0; r < 16; ++r) ps += p0[r]; for (int r = 0; r < 16; ++r) ps += p1[r];
  { auto rr = __builtin_amdgcn_permlane32_swap(__float_as_uint(ps), __float_as_uint(ps), false, false);
    ps = __uint_as_float(rr[0]) + __uint_as_float(rr[1]); }
  l_reg = l_reg * alpha + ps;
#define PK4(P, BASE, OUT) do { unsigned a0 = cvtpk(P[BASE + 0], P[BASE + 1]), a1 = cvtpk(P[BASE + 2], P[BASE + 3]);   \
    unsigned b0 = cvtpk(P[BASE + 4], P[BASE + 5]), b1 = cvtpk(P[BASE + 6], P[BASE + 7]);                              \
    auto r0 = __builtin_amdgcn_permlane32_swap(a0, b0, false, false); auto r1 = __builtin_amdgcn_permlane32_swap(a1, b1, false, false); \
    u32x4 w = {r0[0], r1[0], r0[1], r1[1]}; OUT = *reinterpret_cast<bf16x8*>(&w); } while (0)
  PK4(p0, 0, pa0); PK4(p0, 8, pa1); PK4(p1, 0, pa2); PK4(p1, 8, pa3);
#undef PK4
}
__device__ __forceinline__ void qkt(f32x16& p0, f32x16& p1, const bf16* Ks, const bf16x8* qr, int r32, int hi) {
  p0 = f32x16{}; p1 = f32x16{};
#pragma unroll
  for (int d0 = 0; d0 < 4; ++d0) { int cb = (d0 * 16 + hi * 8) * 2;
    bf16x8 b0 = *reinterpret_cast<const bf16x8*>((const char*)Ks + KSWZ(r32, cb));
    bf16x8 b1 = *reinterpret_cast<const bf16x8*>((const char*)Ks + KSWZ(32 + r32, cb));
    p0 = __builtin_amdgcn_mfma_f32_32x32x16_bf16(b0, qr[d0], p0, 0, 0, 0);
    p1 = __builtin_amdgcn_mfma_f32_32x32x16_bf16(b1, qr[d0], p1, 0, 0, 0); }
}
__device__ __forceinline__ int v_st(int k, int c) { const int kk = (k & ~0xC) | ((k & 4) << 1) | ((k & 8) >> 1); return ((kk >> 3) * 4 + (c >> 5)) * 512 + ((kk & 7) * 32 + (c & 31)) * 2; }
__device__ __forceinline__ int v_rd_base(int lane) { return ((lane & 3) << 3) | (((lane >> 2) & 3) << 6) | (((lane >> 4) & 1) << 5) | (((lane >> 5) & 1) << 8); }
constexpr int v_rd_off(int d0, int ks, int half) { return d0 * 512 + ks * 4096 + half * 2048; }
template <int OFF> __device__ __forceinline__ s16x4 tr_read(int vb) {
  s16x4 r; asm volatile("ds_read_b64_tr_b16 %0, %1 offset:%2" : "=&v"(r) : "v"(vb), "i"(OFF) : "memory"); return r;
}
template <int D0> __device__ __forceinline__ void pv_one(f32x16& od, int vb, bf16x8 pa0, bf16x8 pa1, bf16x8 pa2, bf16x8 pa3) {
  const s16x4 l0 = tr_read<v_rd_off(D0, 0, 0)>(vb), h0 = tr_read<v_rd_off(D0, 0, 1)>(vb), l1 = tr_read<v_rd_off(D0, 1, 0)>(vb), h1 = tr_read<v_rd_off(D0, 1, 1)>(vb);
  const s16x4 l2 = tr_read<v_rd_off(D0, 2, 0)>(vb), h2 = tr_read<v_rd_off(D0, 2, 1)>(vb), l3 = tr_read<v_rd_off(D0, 3, 0)>(vb), h3 = tr_read<v_rd_off(D0, 3, 1)>(vb);
  asm volatile("s_waitcnt lgkmcnt(0)" ::: "memory"); SBAR();
#define PK(L, H) (bf16x8){L[0], L[1], L[2], L[3], H[0], H[1], H[2], H[3]}
  od = __builtin_amdgcn_mfma_f32_32x32x16_bf16(pa0, PK(l0, h0), od, 0, 0, 0);
  od = __builtin_amdgcn_mfma_f32_32x32x16_bf16(pa1, PK(l1, h1), od, 0, 0, 0);
  od = __builtin_amdgcn_mfma_f32_32x32x16_bf16(pa2, PK(l2, h2), od, 0, 0, 0);
  od = __builtin_amdgcn_mfma_f32_32x32x16_bf16(pa3, PK(l3, h3), od, 0, 0, 0);
#undef PK
}
__device__ __forceinline__ void pv_d0(f32x16* o, int vb, bf16x8 pa0, bf16x8 pa1, bf16x8 pa2, bf16x8 pa3) {
  pv_one<0>(o[0], vb, pa0, pa1, pa2, pa3); pv_one<1>(o[1], vb, pa0, pa1, pa2, pa3); pv_one<2>(o[2], vb, pa0, pa1, pa2, pa3); pv_one<3>(o[3], vb, pa0, pa1, pa2, pa3);
}
struct Fin { float lam, scale; const float* sg; bf16* cat; };
template <int MODE>
__device__ __forceinline__ void attn_body(const bf16* __restrict__ Qb, const bf16* __restrict__ Kh, const bf16* __restrict__ Vh, float* Ob, int ldo, int seq, char* lds, const Fin fin) {
  int tid_ = threadIdx.x; asm volatile("" : "+v"(tid_));
  const int tid = tid_, wid = tid >> 6, lane = tid & 63, r32 = lane & 31, hi = lane >> 5;
  bf16* V_lds = (bf16*)lds; bf16* K_lds = (bf16*)(lds + 2 * SHM_V);
  float* ws = (float*)(lds + 2 * SHM_V + 2 * SHM_K) + wid * 64; float* li_l = ws; float* al_l = ws + 32;
  float m_reg = -1e30f, l_reg = 0; f32x16 o[4] = {}; bf16x8 qr[4];
  const bf16* Qw = Qb + (long)(wid * QBLK + r32) * LD + hi * 8;
#pragma unroll
  for (int d0 = 0; d0 < 4; ++d0) qr[d0] = *reinterpret_cast<const bf16x8*>(Qw + d0 * 16);
  const int sr = tid >> 4, sc = (tid & 15) * 8, vst0 = v_st(sr, sc), vst1 = v_st(32 + sr, sc);
  const int kr = tid >> 3, kc = (tid & 7) * 8;
  const int vb0 = (int)(uintptr_t)V_lds + v_rd_base(lane);
  struct { bf16x8 vs0, vs1, ks0; } sr_[SDEPTH];
#define SLOAD(i, k0) do { sr_[i].vs0 = *reinterpret_cast<const bf16x8*>(&Vh[(long)((k0) + sr) * LD + sc]); sr_[i].vs1 = *reinterpret_cast<const bf16x8*>(&Vh[(long)((k0) + 32 + sr) * LD + sc]); \
    sr_[i].ks0 = *reinterpret_cast<const bf16x8*>(&Kh[(long)((k0) + kr) * LD + kc]); } while (0)
#define SWRITE(b, i) do { *(bf16x8*)((char*)V_lds + (b) * SHM_V + vst0) = sr_[i].vs0;          \
    *(bf16x8*)((char*)V_lds + (b) * SHM_V + vst1) = sr_[i].vs1;               \
    *(bf16x8*)((char*)K_lds + (b) * SHM_K + KSWZ(kr, kc * 2)) = sr_[i].ks0; } while (0)
#define SWAIT() do { if constexpr (SDEPTH == 2) asm volatile("s_waitcnt vmcnt(3)" ::: "memory"); else asm volatile("s_waitcnt vmcnt(0)" ::: "memory"); } while (0)
#define RESC(a) do { if (__any((a) < 1.f)) { if (hi == 0) al_l[r32] = (a); asm volatile("s_waitcnt lgkmcnt(0)" ::: "memory"); \
    for (int d = 0; d < 4; ++d) for (int r = 0; r < 16; ++r) o[d][r] *= al_l[crow(r, hi)]; } } while (0)
  f32x16 pA0, pA1, pB0, pB1; float mnA, mnB, alA, alB; bf16x8 pa0, pa1, pa2, pa3; const int NT = seq / KVBLK;
  constexpr int SE = 0, SO = SDEPTH - 1;
  SLOAD(SE, 0); asm volatile("s_waitcnt vmcnt(0)" ::: "memory"); SWRITE(0, SE); __syncthreads();
  qkt(pA0, pA1, K_lds, qr, r32, hi); partialSM(pA0, pA1, m_reg, mnA, alA);
  SLOAD(SO, KVBLK); if constexpr (SDEPTH == 2) { if (2 < NT) SLOAD(SE, 2 * KVBLK); }
  SWAIT(); SWRITE(1, SO); __syncthreads();
  for (int j = 1; j + 1 < NT; j += 2) {
    SBAR(); qkt(pB0, pB1, (bf16*)((char*)K_lds + SHM_K), qr, r32, hi);
    finishSM(pA0, pA1, alA, l_reg, pa0, pa1, pa2, pa3); SBAR();
    SLOAD(SO, (j + SDEPTH) * KVBLK); SBAR();
    pv_d0(o, vb0, pa0, pa1, pa2, pa3); partialSM(pB0, pB1, m_reg, mnB, alB);
    __syncthreads(); SWAIT(); SWRITE(0, SE);
    RESC(alB); __syncthreads();
    SBAR(); qkt(pA0, pA1, K_lds, qr, r32, hi);
    finishSM(pB0, pB1, alB, l_reg, pa0, pa1, pa2, pa3); SBAR();
    if (SDEPTH == 1 || j + 3 < NT) SLOAD(SE, (j + 1 + SDEPTH) * KVBLK); SBAR();
    pv_d0(o, vb0 + (int)SHM_V, pa0, pa1, pa2, pa3); partialSM(pA0, pA1, m_reg, mnA, alA);
    __syncthreads(); SWAIT(); SWRITE(1, SO);
    RESC(alA); __syncthreads();
  }
  SBAR(); qkt(pB0, pB1, (bf16*)((char*)K_lds + SHM_K), qr, r32, hi);
  finishSM(pA0, pA1, alA, l_reg, pa0, pa1, pa2, pa3); SBAR();
  pv_d0(o, vb0, pa0, pa1, pa2, pa3); partialSM(pB0, pB1, m_reg, mnB, alB);
  __syncthreads(); RESC(alB);
  finishSM(pB0, pB1, alB, l_reg, pa0, pa1, pa2, pa3); SBAR();
  pv_d0(o, vb0 + (int)SHM_V, pa0, pa1, pa2, pa3);
  if (hi == 0) li_l[r32] = l_reg; asm volatile("s_waitcnt lgkmcnt(0)" ::: "memory");
  float rli[16];
#pragma unroll
  for (int r = 0; r < 16; ++r) rli[r] = __builtin_amdgcn_rcpf(li_l[crow(r, hi)]);
  float* Ow = Ob + (long)(wid * QBLK) * ldo;
  if constexpr (MODE == 0) {
#pragma unroll
    for (int r = 0; r < 16; ++r) { int orow = crow(r, hi);
      for (int d0 = 0; d0 < 4; ++d0) Ow[(long)orow * ldo + d0 * 32 + r32] = o[d0][r] * rli[r]; }
  } else {
    float sgv[4];
#pragma unroll
    for (int d0 = 0; d0 < 4; ++d0) sgv[d0] = fin.sg[d0 * 32 + r32] * fin.scale;
    bf16* Cw = fin.cat + (long)(wid * QBLK) * 1024;
#pragma unroll
    for (int r = 0; r < 16; ++r) { const int orow = crow(r, hi); float ss = 0.f;
#pragma unroll
      for (int d0 = 0; d0 < 4; ++d0) { const float dv = Ow[(long)orow * ldo + d0 * 32 + r32] - fin.lam * (o[d0][r] * rli[r]); o[d0][r] = dv; ss += dv * dv; }
      ss = sum16_f(ss); ss += __builtin_bit_cast(float, __builtin_amdgcn_ds_swizzle(__builtin_bit_cast(int, ss), 0x401F));
      const float sc = 1.0f / sqrtf(ss * (1.0f / 128.0f) + 1e-5f);
#pragma unroll
      for (int d0 = 0; d0 < 4; ++d0) Cw[(long)orow * 1024 + d0 * 32 + r32] = (bf16)f2bf(o[d0][r] * sc * sgv[d0]); }
  }
  __syncthreads();
#undef SLOAD
#undef SWRITE
#undef SWAIT
#undef RESC
}
#undef KSWZ
#undef SBAR
}

__device__ __forceinline__ void ph_attn(Frame& F0, int i, bool need_ctx) { Frame F = F0; LAUNDER(F);
    const bf16* QB = WSP(bf16, WS_QB); const bf16* KB = WSP(bf16, WS_KB); const bf16* VB = WSP(bf16, WS_VB); float* OB = WSP(float, WS_OB); bf16* CAT = WSP(bf16, WS_CAT);
    const int j = i >> 1; const float* lv = INP(I_LAM) + (size_t)j * 256;
    const float linit = (i == 1) ? 0.35550906759096934f : 0.5560582041556406f;
    const float d1 = wave_sum(lv[F.lane] * lv[64 + F.lane]), d2 = wave_sum(lv[128 + F.lane] * lv[192 + F.lane]);
    const float lam = expf(d1) - expf(d2) + linit;
    const int nun = 512 + (need_ctx ? 32 : 0);
    for (int u = F.vcu; u < nun; u += F.G) {
        const bool lat = u < 512; const int uu = lat ? u : u - 512;
        const int qb = lat ? (uu & 15) : 0, h = lat ? ((uu >> 4) & 7) : (uu & 7), b = lat ? (uu >> 7) : (uu >> 3);
        const size_t qrow = lat ? (size_t)b * SEQ + qb * 256 : (size_t)TLAT + b * CTXL; const int seq = lat ? KSEQ : CTXL;
        const bf16* kb = KB + (size_t)b * KSEQ * DM + h * 128; const bf16* vb = VB + (size_t)b * KSEQ * DM + h * 128;
        const att::Fin fin{lam, 1.0f - linit, INP(I_SUBLN) + (size_t)j * 128, CAT + qrow * DM + h * 128};
        att::attn_body<0>(QB + qrow * DM + h * 128, kb, vb, OB + qrow * DM + h * 128, DM, seq, (char*)F.ldsg, fin);
        att::attn_body<1>(QB + qrow * DM + h * 128 + 64, kb + 64, vb, OB + qrow * DM + h * 128, DM, seq, (char*)F.ldsg, fin);
    }
}
__device__ __forceinline__ void ph_attnfin(Frame& F0, int i, bool need_ctx) { Frame F = F0; LAUNDER(F);
    const int j = i >> 1; const float* lv = INP(I_LAM) + (size_t)j * 256; const float* sg = INP(I_SUBLN) + (size_t)j * 128;
    const float linit = (i == 1) ? 0.35550906759096934f : 0.5560582041556406f;
    const float d1 = wave_sum(lv[F.lane] * lv[64 + F.lane]), d2 = wave_sum(lv[128 + F.lane] * lv[192 + F.lane]);
    const float lam = expf(d1) - expf(d2) + linit;
    const float* OB = WSP(float, WS_OB); bf16* CAT = WSP(bf16, WS_CAT);
    const int nrows = need_ctx ? TT : TLAT;
    for (int row = F.gw; row < nrows; row += F.NGW) {
        const int h = F.lane >> 3, e0 = 16 * (F.lane & 7);
        const float* o0 = OB + (size_t)row * 2048 + (2 * h) * 128 + e0; const float* o1 = o0 + 128;
        float x[16]; float ss = 0.f;
#pragma unroll
        for (int q = 0; q < 4; ++q) { const f32x4 a = *(const f32x4*)(o0 + 4 * q), bb = *(const f32x4*)(o1 + 4 * q); const f32x4 d = a - bb * lam;
            x[4 * q] = d.x; x[4 * q + 1] = d.y; x[4 * q + 2] = d.z; x[4 * q + 3] = d.w; ss += (d.x * d.x + d.y * d.y) + (d.z * d.z + d.w * d.w); }
        ss = sum8_f(ss);
        const float sc = (1.0f - linit) / sqrtf(ss * (1.0f / 128.0f) + 1e-5f);
#pragma unroll
        for (int q = 0; q < 16; ++q) x[q] = x[q] * sc * sg[e0 + q];
#ifdef ABL_ATT
#pragma unroll
        for (int q = 0; q < 16; ++q) x[q] = 0.f;
#endif
        v4u w0, w1; w0.x = pk2(x[0], x[1]); w0.y = pk2(x[2], x[3]); w0.z = pk2(x[4], x[5]); w0.w = pk2(x[6], x[7]); w1.x = pk2(x[8], x[9]); w1.y = pk2(x[10], x[11]); w1.z = pk2(x[12], x[13]); w1.w = pk2(x[14], x[15]);
        bf16* dst = CAT + (size_t)row * DM + h * 128 + e0;
        *(v4u*)dst = w0; *(v4u*)(dst + 8) = w1;
    }
}
#ifdef DBG_MOE
__device__ __forceinline__ void ph_debug_moe(Frame& F0, int i) { Frame F = F0; LAUNDER(F);
    LAS float* xs = (LAS float*)F.lds; LAS float* hs = xs + 1024; LAS float* red = hs + 1024;
    unsigned* dbg = (unsigned*)(F.ws + WS_CTL) + 100;
    for (int s = F.vcu; s < 64; s += F.G) {
        const int e = s & 15, slot = (s * 37) % 2176; const int r = e * EROWS + slot;
        const int tok = WSP(int, WS_IDX)[r]; const float gate = WSP(float, WS_GATE)[r];
        const bf16* hrow = WSP(bf16, WS_HA) + (size_t)tok * DM;
        __syncthreads();
        for (int k = F.tid; k < 1024; k += NTHR) xs[k] = bf2f(hrow[k]);
        __syncthreads();
        const float* w1 = INP(I_MW1) + ((size_t)i * NE + e) * DM * FF; const float* w3 = INP(I_MW3) + ((size_t)i * NE + e) * DM * FF; const float* w2 = INP(I_MW2) + ((size_t)i * NE + e) * FF * DM;
        for (int f = F.tid; f < 1024; f += NTHR) { float a = 0.f, b = 0.f; for (int k = 0; k < 1024; ++k) { a += xs[k] * w1[(size_t)k * FF + f]; b += xs[k] * w3[(size_t)k * FF + f]; }
            hs[f] = a / (1.0f + __expf(-a)) * b; }
        __syncthreads();
        float num = 0.f, den = 0.f;
        for (int d = F.tid; d < 1024; d += NTHR) { float y = 0.f; for (int f = 0; f < 1024; ++f) y += hs[f] * w2[(size_t)f * DM + d]; y *= gate;
            const float yk = bf2f(WSP(bf16, WS_YB)[(size_t)r * DM + d]); num += (y - yk) * (y - yk); den += y * y; }
        num = block_sum(F, num, red); den = block_sum(F, den, red + 8);
        const float rel = sqrtf(num / fmaxf(den, 1e-30f));
        if (F.tid == 0) atomicMax(dbg, __builtin_bit_cast(unsigned, rel));
        if (s < 64) {
            const int set = s >> 4; const int rbase = set * SEQ; int cnt = 0; float mn_sel = 1e30f, mx_uns = -1e30f;
            for (int l = F.tid; l < SEQ; l += NTHR) { const int sl = WSP(int, WS_SLOT)[(size_t)(rbase + l) * 16 + e]; const float a = WSP(float, WS_AFF)[(size_t)(rbase + l) * 16 + e];
                if (sl >= 0) { ++cnt; mn_sel = fminf(mn_sel, a); if (sl >= 512 || WSP(int, WS_IDX)[e * EROWS + set * 512 + sl] != rbase + l) atomicAdd(dbg + 1, 1u); } else mx_uns = fmaxf(mx_uns, a); }
            const float tc = block_sum(F, (float)cnt, red);
            float a1 = -mn_sel, a2 = mx_uns;
#pragma unroll
            for (int o = 1; o < 64; o <<= 1) { a1 = fmaxf(a1, __shfl_xor(a1, o)); a2 = fmaxf(a2, __shfl_xor(a2, o)); }
            __syncthreads(); if (F.lane == 0) { red[F.wave] = a1; red[8 + F.wave] = a2; } __syncthreads();
            float m1 = red[0], m2 = red[8];
            for (int w = 1; w < 8; ++w) { m1 = fmaxf(m1, red[w]); m2 = fmaxf(m2, red[8 + w]); }
            if (F.tid == 0) { if ((int)tc != 512) atomicAdd(dbg + 2, 1u); if (-m1 < m2) atomicAdd(dbg + 3, 1u); atomicAdd(dbg + 4, (unsigned)(int)tc); }
        }
    }
}
#endif
__device__ __forceinline__ void ph_debug_out(Frame& F0) { Frame F = F0; LAUNDER(F);
    const unsigned* dbg = (const unsigned*)(F.ws + WS_CTL) + 100;
    const float e1 = __builtin_bit_cast(float, dbg[0]); const unsigned v2 = dbg[1];
#ifdef DBG_SEL2
    const float d1 = 1.0f + (float)dbg[2] + 100.0f * (float)dbg[3];
#elif defined(DBG_SEL3)
    const float d1 = (float)dbg[4] / 64.0f / 16.0f;
#else
    const float d1 = 1.0f + 10.0f * fminf(e1, 3.0f);
#endif
    float d2 = 10.0f + (float)v2 * 0.1f; d2 = fminf(d2, 900.f);
    for (size_t idx = (size_t)F.gw * 64 + F.lane; idx < (size_t)TLAT * DM; idx += (size_t)F.NGW * 64) F.out[idx] = idx == 0 ? d2 : d1;
}
constexpr int PH_PER_LAYER = 13, N_PHASES = 3 + DEPTH * PH_PER_LAYER;
#ifndef PH_MASK
#define PH_MASK 0xFFFFFFFFu
#endif
#define PK_ON(k) ((PH_MASK >> (k)) & 1u)

__device__ __forceinline__ bool phase_is_nop(int ph) {
    if (ph < 3) return false; const int i = (ph - 3) / PH_PER_LAYER, p = (ph - 3) % PH_PER_LAYER; return p == 4 || p == 9 || ((i & 1) && (p == 1 || p == 3 || p == 5));
}

__device__ __forceinline__ int phase_kind(int ph) {
    if (ph < 3) return ph;
    const int i = (ph - 3) / PH_PER_LAYER, p = (ph - 3) % PH_PER_LAYER; const bool even = !(i & 1);
    switch (p) { case 0: return even ? 3 : 4; case 1: return even ? 5 : 6; case 2: return even ? 7 : 8; case 3: return even ? 9 : 10; case 4: return 11; case 5: return 12; case 6: return 13;
                 case 7: return 14; case 8: return 15; case 9: return 16; case 10: return 17; case 11: return 18; default: return 19; }
}
#ifndef PROBE_MASK
#define PROBE_MASK 0u
#endif
#ifndef PROBE_DIV
#define PROBE_DIV 100.0f
#endif
__global__ void __launch_bounds__(NTHR, 2) mega_fwd(Args args) {
    extern __shared__ __attribute__((aligned(16))) unsigned char lds[];
    Frame F;
    F.lds = (LAS unsigned char*)lds; F.ldsg = lds;
    F.MISC = (volatile LAS unsigned*)(F.lds + LDSCTL_OFF + 320);
    F.tid = threadIdx.x; F.lane = F.tid & 63; F.wave = __builtin_amdgcn_readfirstlane(F.tid >> 6);
    F.G = gridDim.x; { const int bx = blockIdx.x; F.vcu = (F.G % 8 == 0) ? (bx % 8) * (F.G / 8) + bx / 8 : bx; }
    F.gw = F.vcu * NWAVES + F.wave; F.NGW = F.G * NWAVES;
    F.tprobe = 0ull;
    F.in = (const GAS float* const __attribute__((address_space(4)))*)__builtin_amdgcn_kernarg_segment_ptr();
    F.ws = (GAS unsigned char*)args.ws; F.out = (GAS float*)args.out;
    for (int u = F.tid; u < (LDS_BYTES - LDSCTL_OFF) / 4; u += NTHR) ((LAS unsigned*)(F.lds + LDSCTL_OFF))[u] = 0u;
    __syncthreads();
    XcdBarrier bar; bar.bar = (unsigned*)(F.ws + WS_CTL) + CW_BAR; bar.x = 0; bar.st = nullptr;
    const int lo = args.ph_lo, hi = args.ph_hi;
    if (hi - lo > 1) bar = xcd_barrier_post((unsigned*)(F.ws + WS_CTL) + CW_BAR, F.MISC + 8);

    Frame F0 = F;
    unsigned long long t_prev = 0ull, t_acc = 0ull;
    if (PROBE_MASK) t_prev = __builtin_amdgcn_s_memrealtime();
    for (int ph = lo; ph < hi; ++ph) {
        if (phase_is_nop(ph)) continue;
        Frame F = F0; LAUNDER(F);
#ifdef DBG_MOE
        if (ph == 1000) { ph_debug_moe(F, 0); VM_WAIT(); continue; }
        if (ph == 1001) { ph_debug_out(F); VM_WAIT(); continue; }
#endif
        if (ph == 0) { if (PK_ON(0)) ph_prologue(F); }
        else if (ph == 1) { if (PK_ON(1)) ph_modred(F); }
        else if (ph == 2) { if (PK_ON(2)) ph_mod0(F); }
        else {
            const int i = (ph - 3) / PH_PER_LAYER, p = (ph - 3) % PH_PER_LAYER, j = i >> 1; const bool even = !(i & 1), need_ctx = i < DEPTH - 1;
            if (p == 0) {
                if (even) { if (PK_ON(3)) { pg8::Gemm g{WSP(bf16, WS_HA), WSP(bf16, WS_WIN) + (size_t)j * EVCP * DM, TT, EVCP, DM, nullptr}; pg8::StaticOrder S; S.init(TT, EVCP, F.G, (int)blockIdx.x);
                    pg8::EpiEven E{WSP(float, WS_P), EVCP, WSP(float, WS_UTL), WSP(float, WS_UTC)}; pg8::gemm_phase<pg8::EpiEven, pg8::StaticOrder, true, true>(F.lds, g, S, E); } }
                else if (PK_ON(4)) { pg8::Gemm g{WSP(bf16, WS_HA), WSP(bf16, WS_WQKV) + (size_t)j * QKVC * DM, TT, QKVC, DM, nullptr}; pg8::StaticOrder S; S.init(TT, QKVC, F.G, (int)blockIdx.x);
                    pg8::EpiQKV E{WSP(bf16, WS_QB), WSP(bf16, WS_KB), WSP(bf16, WS_VB)}; pg8::gemm_phase<pg8::EpiQKV, pg8::StaticOrder, true, true>(F.lds, g, S, E); }
            } else if (p == 1) { if (even) { if (PK_ON(5)) ph_evprep(F, j); } else {   } }
            else if (p == 2) { if (even) { if (PK_ON(7)) ph_chunkprep(F, j); } else { if (PK_ON(8)) ph_attn(F, i, need_ctx); } }
            else if (p == 3) { if (even) { if (PK_ON(9)) ph_scan_hyena(F, j, i); } else {   } }
            else if (p == 4) {   }
            else if (p == 5) { if (PK_ON(12)) ph_readout(F, j); }
            else if (p == 6) { if (PK_ON(13)) {
                pg8::Gemm g{WSP(bf16, WS_CAT), (even ? WSP(bf16, WS_WOE) : WSP(bf16, WS_WOD)) + (size_t)j * DM * DM, TLAT, DM, DM, nullptr}; pg8::StaticOrder S; S.init(TLAT, DM, F.G, (int)blockIdx.x);
                pg8::EpiResGate E{WSP(float, WS_X), WSP(float, WS_MODS) + (size_t)i * 5 * 6144}; pg8::gemm_phase<pg8::EpiResGate, pg8::StaticOrder, true, true>(F.lds, g, S, E); }
            } else if (p == 7) { if (PK_ON(14)) ph_mod2(F, i, (even ? WSP(bf16, WS_WOE) : WSP(bf16, WS_WOD)) + (size_t)j * DM * DM); }
            else if (p == 8) { if (PK_ON(15)) ph_topk(F, i); }
            else if (p == 9) {   }
            else if (p == 10) { if (PK_ON(17)) {
                pg8::Gemm g{WSP(bf16, WS_HA), WSP(bf16, WS_W13), NE * EROWS, NE * 2048, DM, WSP(int, WS_IDX)};     pg8::MoeOrder S{F.G, (int)blockIdx.x, 8, (need_ctx && F.G != 256) ? 9 : 8};
                pg8::EpiSwiGLU E{WSP(bf16, WS_HB)}; pg8::gemm_phase<pg8::EpiSwiGLU, pg8::MoeOrder, true, true, true>(F.lds, g, S, E); }
            } else if (p == 11) { if (PK_ON(18)) {
                if (need_ctx && F.G == 256) {
                    unsigned* mctr = (unsigned*)(F.ws + WS_CTL) + 3072 + 64 * i;
                    if (F.vcu < 128) {
                        pg8::Gemm g1{WSP(bf16, WS_HA), WSP(bf16, WS_W13), NE * EROWS, NE * 2048, DM, WSP(int, WS_IDX)}; pg8::OneUnit S1{(F.vcu >> 3) * 9 + 8, (F.vcu >> 3) * 8 + (F.vcu & 7)};
                        pg8::EpiSwiGLU E1{WSP(bf16, WS_HB)}; pg8::gemm_phase<pg8::EpiSwiGLU, pg8::OneUnit, true, true, true>(F.lds, g1, S1, E1);
                        subset_arrive(mctr);
                    }
                    pg8::Gemm g{WSP(bf16, WS_HB), WSP(bf16, WS_W2), NE * EROWS, NE * 1024, FF, nullptr}; pg8::Moe2Order S{F.vcu, mctr};
                    pg8::EpiGateBf16 E{WSP(bf16, WS_YB), WSP(float, WS_GATE)}; pg8::gemm_phase<pg8::EpiGateBf16, pg8::Moe2Order, true, true>(F.lds, g, S, E);
                } else {
                    pg8::Gemm g{WSP(bf16, WS_HB), WSP(bf16, WS_W2), NE * EROWS, NE * 1024, FF, nullptr}; pg8::MoeOrder S{F.G, (int)blockIdx.x, 4, need_ctx ? 9 : 8};
                    pg8::EpiGateBf16 E{WSP(bf16, WS_YB), WSP(float, WS_GATE)}; pg8::gemm_phase<pg8::EpiGateBf16, pg8::MoeOrder, true, true>(F.lds, g, S, E);
                } }
            } else { if (PK_ON(19)) ph_combine(F, i); }
        }
        if (PROBE_SUB) F0.tprobe = F.tprobe;
        if (ph + 1 < hi) xcd_barrier(bar); else { VM_WAIT(); }
        if (PROBE_MASK) { const unsigned long long t_now = __builtin_amdgcn_s_memrealtime(); if ((PROBE_MASK >> phase_kind(ph)) & 1u) t_acc += t_now - t_prev; t_prev = t_now; }
    }
    if (PROBE_MASK) { if (blockIdx.x == 0 && threadIdx.x == 0 && hi == N_PHASES) { const float us = (float)(PROBE_SUB ? F0.tprobe : t_acc) * 0.01f; F0.out[0] += 2.0f + us / PROBE_DIV; } }
}

extern "C" void kernel_launch(void* const* d_in, const int* in_sizes, int n_in, void* d_out, int out_size, void* d_ws, size_t ws_size, hipStream_t stream) {
    static int grid = 0;
    if (grid == 0) {
        if (n_in != N_IN || out_size != TLAT * DM || ws_size < WS_END) { fprintf(stderr, "kernel_launch: unexpected shapes: n_in %d out %d ws %zu (need %zu)\n", n_in, out_size, ws_size, (size_t)WS_END); grid = -1; return; }
        int dev = 0, cus = 0, per_cu = 0;
        if (hipGetDevice(&dev) != hipSuccess || hipDeviceGetAttribute(&cus, hipDeviceAttributeMultiprocessorCount, dev) != hipSuccess) { grid = -1; return; }
        if (hipFuncSetAttribute((const void*)mega_fwd, hipFuncAttributeMaxDynamicSharedMemorySize, LDS_BYTES) != hipSuccess) { fprintf(stderr, "kernel_launch: hipFuncSetAttribute failed\n"); grid = -1; return; }
        if (hipOccupancyMaxActiveBlocksPerMultiprocessor(&per_cu, (const void*)mega_fwd, NTHR, LDS_BYTES) != hipSuccess || per_cu < 1) fprintf(stderr, "kernel_launch: occupancy query reports %d\n", per_cu);
        (void)hipGetLastError();
        grid = cus;
    }
    if (grid < 0) return;
    if (hipMemsetAsync((char*)d_ws + WS_CTL, 0, CTL_ZERO_BYTES, stream) != hipSuccess) { fprintf(stderr, "kernel_launch: memset failed\n"); return; }
    Args a{};
    for (int i = 0; i < N_IN; ++i) a.in[i] = (const float*)d_in[i];
    a.out = (float*)d_out; a.ws = (unsigned char*)d_ws;
#if MK_PER_PHASE
    for (int ph = 0; ph < N_PHASES; ++ph) {
#ifdef DBG_MOE
        if (ph == 3 + 12) { a.ph_lo = 1000; a.ph_hi = 1001; hipLaunchKernelGGL(mega_fwd, dim3(grid), dim3(NTHR), LDS_BYTES, stream, a); a.ph_lo = 1001; a.ph_hi = 1002; hipLaunchKernelGGL(mega_fwd, dim3(grid), dim3(NTHR), LDS_BYTES, stream, a); break; }
#endif
        if ((ph >= 3) && ((((ph - 3) % PH_PER_LAYER) == 4) || (((ph - 3) % PH_PER_LAYER) == 9) || ((((ph - 3) / PH_PER_LAYER) & 1) && (((ph - 3) % PH_PER_LAYER) == 1 || ((ph - 3) % PH_PER_LAYER) == 3 || ((ph - 3) % PH_PER_LAYER) == 5)))) continue;
        a.ph_lo = ph; a.ph_hi = ph + 1;
        hipLaunchKernelGGL(mega_fwd, dim3(grid), dim3(NTHR), LDS_BYTES, stream, a);
    }
#else
    a.ph_lo = 0; a.ph_hi = N_PHASES;
    hipLaunchKernelGGL(mega_fwd, dim3(grid), dim3(NTHR), LDS_BYTES, stream, a);
#endif
    const hipError_t le = hipPeekAtLastError();
    if (le != hipSuccess) fprintf(stderr, "kernel_launch: launch failed: %s\n", hipGetErrorName(le));
}
```

```cpp
#define MK_PER_PHASE 0
#include <hip/hip_runtime.h>
#include <cstdio>
#include <cstdint>
#include <cmath>

#ifndef MK_PER_PHASE
#define MK_PER_PHASE 0
#endif

#define GAS __attribute__((address_space(1)))
#define LAS __attribute__((address_space(3)))
typedef unsigned short bf16;
typedef unsigned v4u __attribute__((ext_vector_type(4)));
typedef unsigned v2u __attribute__((ext_vector_type(2)));
typedef float f32x4 __attribute__((ext_vector_type(4)));
typedef float f32x2 __attribute__((ext_vector_type(2)));
typedef short bf16x8 __attribute__((ext_vector_type(8)));

constexpr int DM = 1024, NB = 4, SEQ = 4096, CTXL = 256, DEPTH = 4;
constexpr int TLAT = NB * SEQ, TCTX = NB * CTXL, TT = TLAT + TCTX;
constexpr int RWC = 1760, HYC = 1536, EVC = RWC + HYC, EVCP = 3328;
constexpr int RWW = 512, NH = 8, HD = 64;
constexpr int QKVC = 3072;
constexpr int NE = 16, FF = 1024, EROWS = 2304;
constexpr int NMOD = 6;
constexpr int KSEQ = CTXL + SEQ;

enum { I_X = 0, I_C, I_CTX, I_CCTX, I_ADAW, I_ADAB, I_NORMG, I_FINALG, I_EVWIN, I_EVWOUT, I_MU, I_W0, I_W2, I_A0, I_A2, I_G2, I_KK, I_KA, I_RK, I_GN,
       I_CONVW, I_CONVB, I_FW1, I_FB1, I_FW2, I_FB2, I_FW3, I_FREQ, I_HYB, I_WQKV, I_DAWOUT, I_LAM, I_SUBLN, I_ROUTER, I_MW1, I_MW3, I_MW2, N_IN };

struct Args { const float* in[N_IN]; float* out; unsigned char* ws; int ph_lo, ph_hi; };
static_assert(__builtin_offsetof(Args, in) == 0, "Args::in must be first");

constexpr size_t MiB = 1u << 20;
constexpr size_t WS_CTL = 0, CTL_ZERO_BYTES = 64 * 1024;
constexpr size_t WS_MODP = 384 * MiB;
constexpr size_t WS_MODS = 5 * MiB;
constexpr size_t WS_TW = 6 * MiB;
constexpr size_t WS_FRAGB = 7 * MiB;
constexpr size_t WS_AFF = 8 * MiB;
constexpr size_t WS_SLOT = 10 * MiB;
constexpr size_t WS_IDX = 12 * MiB;
constexpr size_t WS_GATE = 12 * MiB + 512 * 1024;
constexpr size_t WS_WIN = 16 * MiB;
constexpr size_t WS_WOE = 30 * MiB;
constexpr size_t WS_WQKV = 34 * MiB;
constexpr size_t WS_WOD = 46 * MiB;
constexpr size_t WS_W13 = 50 * MiB;
constexpr size_t WS_W2 = 114 * MiB;
constexpr size_t WS_UTL = 50 * MiB;
constexpr size_t WS_X = 146 * MiB;
constexpr size_t WS_HA = 214 * MiB;
constexpr size_t WS_CAT = 248 * MiB;
constexpr size_t WS_KSPL = 282 * MiB;
constexpr size_t WS_KSPC = 346 * MiB;
constexpr size_t WS_BIG = 384 * MiB;
constexpr size_t WS_P = WS_BIG;
constexpr size_t REC_BYTES = 12 * 1024;
constexpr size_t WS_REC = WS_BIG + 221 * MiB;
constexpr size_t WS_V = WS_BIG + 425 * MiB;
constexpr size_t WS_AOP = WS_BIG + 459 * MiB;
constexpr size_t WS_G = WS_BIG + 467 * MiB;
constexpr size_t WS_KCL = WS_BIG + 501 * MiB;
constexpr size_t WS_KCC = WS_BIG + 533 * MiB;
constexpr size_t WS_UTC = WS_BIG + 535 * MiB;
constexpr size_t WS_BON = WS_BIG + 541 * MiB;
constexpr size_t WS_Y = WS_BIG + 542 * MiB;
constexpr size_t WS_HYTL = WS_BIG;
constexpr size_t WS_HYTC = WS_BIG + 32 * MiB;
static_assert(WS_Y + 68 * MiB <= 1024 * MiB && 64 * 272 * REC_BYTES <= 204 * MiB, "ws map");
constexpr size_t WS_QB = WS_BIG + 204 * MiB;
constexpr size_t WS_KB = WS_QB + 34 * MiB;
constexpr size_t WS_VB = WS_KB + 34 * MiB;
constexpr size_t WS_OB = WS_VB + 34 * MiB;
static_assert(WS_OB + 136 * MiB <= 1024 * MiB, "ws map");
constexpr size_t WS_XG = WS_BIG;
constexpr size_t WS_HB = WS_BIG + 72 * MiB;
constexpr size_t WS_YB = WS_BIG + 144 * MiB;
constexpr size_t WS_END = 1024 * MiB;

constexpr int CW_BAR = 4096;

constexpr int RING_BYTES = 143360;
constexpr int LDSCTL_OFF = RING_BYTES;
constexpr int LDS_BYTES = 147456;
constexpr int NWAVES = 8, NTHR = 512;

__device__ __forceinline__ unsigned f2bf(float f) { unsigned u = __builtin_bit_cast(unsigned, f); return (u + 0x7fffu + ((u >> 16) & 1u)) >> 16; }
__device__ __forceinline__ unsigned pk2(float lo, float hi) { return f2bf(lo) | (f2bf(hi) << 16); }
__device__ __forceinline__ float bf2f(unsigned short h) { return __builtin_bit_cast(float, ((unsigned)h) << 16); }
template <int CTRL> __device__ __forceinline__ float dpp_f(float x) { return __builtin_bit_cast(float, __builtin_amdgcn_update_dpp(0, __builtin_bit_cast(int, x), CTRL, 0xF, 0xF, true)); }
template <int CTRL> __device__ __forceinline__ int dpp_i(int x) { return __builtin_amdgcn_update_dpp(0, x, CTRL, 0xF, 0xF, true); }
#define DPP_XOR1 0xB1
#define DPP_XOR2 0x4E
#define DPP_HMIRROR 0x141
#define DPP_MIRROR 0x140
__device__ __forceinline__ float xor1_f(float x) { return dpp_f<DPP_XOR1>(x); }
__device__ __forceinline__ float sum4_f(float x) { x += dpp_f<DPP_XOR1>(x); x += dpp_f<DPP_XOR2>(x); return x; }
__device__ __forceinline__ float sum8_f(float x) { x = sum4_f(x); x += dpp_f<DPP_HMIRROR>(x); return x; }
__device__ __forceinline__ float sum16_f(float x) { x = sum8_f(x); x += dpp_f<DPP_MIRROR>(x); return x; }
__device__ __forceinline__ float max16_f(float x) { x = fmaxf(x, dpp_f<DPP_XOR1>(x)); x = fmaxf(x, dpp_f<DPP_XOR2>(x)); x = fmaxf(x, dpp_f<DPP_HMIRROR>(x)); x = fmaxf(x, dpp_f<DPP_MIRROR>(x)); return x; }
__device__ __forceinline__ float wave_sum(float v) {
    v = sum16_f(v);
    v += __builtin_bit_cast(float, __builtin_amdgcn_ds_swizzle(__builtin_bit_cast(int, v), 0x401F));
    { auto rr = __builtin_amdgcn_permlane32_swap(__float_as_uint(v), __float_as_uint(v), false, false); const unsigned lo_ = rr[0], hi_ = rr[1];
      v = __uint_as_float(lo_) + __uint_as_float(hi_); }
    return v;
}
__device__ __forceinline__ int wave_sum_i(int v) {
    v += dpp_i<DPP_XOR1>(v); v += dpp_i<DPP_XOR2>(v); v += dpp_i<DPP_HMIRROR>(v); v += dpp_i<DPP_MIRROR>(v);
    v += __builtin_amdgcn_ds_swizzle(v, 0x401F);
    { auto rr = __builtin_amdgcn_permlane32_swap((unsigned)v, (unsigned)v, false, false); v = (int)rr[0] + (int)rr[1]; }
    return v;
}
__device__ __forceinline__ float sigmoidf_(float x) { return 1.0f / (1.0f + __expf(-x)); }
__device__ __forceinline__ float siluf_(float x) { return x / (1.0f + __expf(-x)); }
#define LDS_WAIT() asm volatile("s_waitcnt lgkmcnt(0)" ::: "memory")
#define VM_WAIT() asm volatile("s_waitcnt vmcnt(0)" ::: "memory")

namespace pg8 {
#define PG8_LAS __attribute__((address_space(3)))
typedef unsigned short bf16_t;
typedef short bf16x8 __attribute__((ext_vector_type(8)));
typedef float f32x4 __attribute__((ext_vector_type(4)));
typedef unsigned u32x4 __attribute__((ext_vector_type(4)));
constexpr int BM = 256, BK = 64, HALF = 128, HTB = HALF * BK * 2  , STAGE_BYTES = 8 * HTB, NXCD = 8, WGM = 8;

__host__ __device__ __forceinline__ int lds_byte(int r, int c) { const int st = (r >> 4) * 2 + (c >> 5), rr = r & 15, cc = c & 31, ob = rr * 64 + cc * 2; return st * 1024 + (ob ^ (((ob >> 9) & 1) << 5)); }
__host__ __device__ __forceinline__ void stage_rc(int b, int& R, int& C) { const int st = b / 1024, sb = b % 1024, swz = sb ^ (((sb >> 9) & 1) << 5); R = (st >> 1) * 16 + swz / 64; C = (st & 1) * 32 + (swz % 64) / 2; }
__host__ __device__ __forceinline__ int perm32(int rho) { const int n = rho >> 4, i = rho & 15; return 8 * (i >> 2) + 4 * n + (i & 3); }

struct Unit { int pm, pn; };
struct Gemm { const bf16_t* A; const bf16_t* Bt; int M, N, K; const int* gidx; };

struct StaticOrder {
    int nM, nN, nwg, G, c;
    __host__ __device__ void init(int M, int N, int G_, int c_) { nM = M / BM; nN = N / BM; nwg = nM * nN; G = G_; c = c_; }
    __host__ __device__ bool next(int i, Unit& u) const {
        const long L = (long)i * G + c; if (L >= nwg) return false;
        int wgid = (int)L; { const int q = nwg / NXCD, r = nwg % NXCD, xcd = wgid % NXCD, off = wgid / NXCD; wgid = (xcd < r ? xcd * (q + 1) : r * (q + 1) + (xcd - r) * q) + off; }
        const int nig = WGM * nN, gid = wgid / nig, fm = gid * WGM, gsz = (nM - fm) < WGM ? (nM - fm) : WGM;
        u.pm = fm + ((wgid % nig) % gsz); u.pn = (wgid % nig) / gsz; return true;
    }
    __device__ __forceinline__ void a_ready(const Unit&) const {}
    __device__ __forceinline__ void done(const Unit&) const {}
};

__device__ __forceinline__ unsigned cvt_pk_bf16(float lo, float hi) { unsigned r; asm volatile("v_cvt_pk_bf16_f32 %0, %1, %2" : "=v"(r) : "v"(lo), "v"(hi)); return r; }
typedef float f32x2 __attribute__((ext_vector_type(2)));
typedef unsigned u32x2v __attribute__((ext_vector_type(2)));

struct EpiF32 {
    static constexpr bool PERM = false, AFTER_DRAIN = false;
    float* O; int ldc;
    __device__ __forceinline__ void operator()(const f32x4 (&acc)[2][2][4][2], const Unit& u, int wr, int wc, int fr, int fq) const {
        const int col0 = u.pn * BM + wc * 32 + 4 * fq;
#pragma unroll
        for (int ai = 0; ai < 2; ++ai)
#pragma unroll
            for (int m = 0; m < 4; ++m) { float* rowp = O + (size_t)(u.pm * BM + ai * HALF + wr * 64 + m * 16 + fr) * ldc + col0;
#pragma unroll
                for (int bj = 0; bj < 2; ++bj)
#pragma unroll
                    for (int n = 0; n < 2; ++n) *(f32x4*)(rowp + bj * HALF + n * 16) = acc[ai][bj][m][n]; }
    }
};
struct EpiBf16S {
    static constexpr bool PERM = false, AFTER_DRAIN = false;
    bf16_t* O; int ldc;
    __device__ __forceinline__ void operator()(const f32x4 (&acc)[2][2][4][2], const Unit& u, int wr, int wc, int fr, int fq) const {
        const int col0 = u.pn * BM + wc * 32 + 4 * fq;
#pragma unroll
        for (int ai = 0; ai < 2; ++ai)
#pragma unroll
            for (int m = 0; m < 4; ++m) { bf16_t* rowp = O + (size_t)(u.pm * BM + ai * HALF + wr * 64 + m * 16 + fr) * ldc + col0;
#pragma unroll
                for (int bj = 0; bj < 2; ++bj)
#pragma unroll
                    for (int n = 0; n < 2; ++n) { const f32x4 v = acc[ai][bj][m][n]; u32x2v w; w.x = cvt_pk_bf16(v[0], v[1]); w.y = cvt_pk_bf16(v[2], v[3]); *(u32x2v*)(rowp + bj * HALF + n * 16) = w; } }
    }
};
struct EpiEven {
    static constexpr bool PERM = false, AFTER_DRAIN = false;
    float* P; int ldc; float* UTL; float* UTC;
    __device__ __forceinline__ void operator()(const f32x4 (&acc)[2][2][4][2], const Unit& u, int wr, int wc, int fr, int fq) const {
        const int col0 = u.pn * BM + wc * 32 + 4 * fq;
#pragma unroll
        for (int ai = 0; ai < 2; ++ai)
#pragma unroll
            for (int m = 0; m < 4; ++m) { const int row = u.pm * BM + ai * HALF + wr * 64 + m * 16 + fr; const bool lat = row < 16384;
                float* rowp = P + (size_t)row * ldc + col0;
                float* tp = lat ? UTL + ((size_t)(row >> 12) * 1536) * 4096 + (row & 4095) : UTC + ((size_t)((row - 16384) >> 8) * 1536) * 256 + ((row - 16384) & 255);
                const size_t ts = lat ? 4096 : 256;
#pragma unroll
                for (int bj = 0; bj < 2; ++bj)
#pragma unroll
                    for (int n = 0; n < 2; ++n) { const int c = col0 + bj * HALF + n * 16; const f32x4 v = acc[ai][bj][m][n];
                        if (c < 1760) *(f32x4*)(rowp + bj * HALF + n * 16) = v;
                        else if (c < 3296) { float* t0 = tp + (size_t)(c - 1760) * ts; t0[0] = v[0]; t0[ts] = v[1]; t0[2 * ts] = v[2]; t0[3 * ts] = v[3]; } } }
    }
};
struct EpiResGate {
    static constexpr bool PERM = false, AFTER_DRAIN = false;
    float* X; const float* mods;
    __device__ __forceinline__ void operator()(const f32x4 (&acc)[2][2][4][2], const Unit& u, int wr, int wc, int fr, int fq) const {
        const int col0 = u.pn * BM + wc * 32 + 4 * fq;
#pragma unroll
        for (int ai = 0; ai < 2; ++ai)
#pragma unroll
            for (int m = 0; m < 4; ++m) { const int row = u.pm * BM + ai * HALF + wr * 64 + m * 16 + fr; const int s = row < 16384 ? (row >> 12) : 4;
                float* rowp = X + (size_t)row * 1024 + col0; const float* gp = mods + s * 6144 + 2048 + col0;
#pragma unroll
                for (int bj = 0; bj < 2; ++bj)
#pragma unroll
                    for (int n = 0; n < 2; ++n) { const f32x4 g = *(const f32x4*)(gp + bj * HALF + n * 16); f32x4 x = *(f32x4*)(rowp + bj * HALF + n * 16);
                        x = x + g * acc[ai][bj][m][n]; *(f32x4*)(rowp + bj * HALF + n * 16) = x; } }
    }
};
struct EpiSwiGLU {
    static constexpr bool PERM = false, AFTER_DRAIN = false;
    bf16_t* H;
    __device__ __forceinline__ void operator()(const f32x4 (&acc)[2][2][4][2], const Unit& u, int wr, int wc, int fr, int fq) const {
        const int nt = u.pn & 7; const int col0 = nt * 128 + wc * 32 + 4 * fq;
#pragma unroll
        for (int ai = 0; ai < 2; ++ai)
#pragma unroll
            for (int m = 0; m < 4; ++m) { bf16_t* rowp = H + (size_t)(u.pm * BM + ai * HALF + wr * 64 + m * 16 + fr) * 1024 + col0;
#pragma unroll
                for (int n = 0; n < 2; ++n) { const f32x4 a = acc[ai][0][m][n], b = acc[ai][1][m][n]; f32x4 h;
#pragma unroll
                    for (int j = 0; j < 4; ++j) h[j] = a[j] / (1.0f + __expf(-a[j])) * b[j];
                    u32x2v w; w.x = cvt_pk_bf16(h[0], h[1]); w.y = cvt_pk_bf16(h[2], h[3]); *(u32x2v*)(rowp + n * 16) = w; } }
    }
};
struct EpiGateBf16 {
    static constexpr bool PERM = false, AFTER_DRAIN = false;
    bf16_t* Y; const float* gate;
    __device__ __forceinline__ void operator()(const f32x4 (&acc)[2][2][4][2], const Unit& u, int wr, int wc, int fr, int fq) const {
        const int nt = u.pn & 3; const int col0 = nt * 256 + wc * 32 + 4 * fq;
#pragma unroll
        for (int ai = 0; ai < 2; ++ai)
#pragma unroll
            for (int m = 0; m < 4; ++m) { const int row = u.pm * BM + ai * HALF + wr * 64 + m * 16 + fr; const float g = gate[row]; bf16_t* rowp = Y + (size_t)row * 1024 + col0;
#pragma unroll
                for (int bj = 0; bj < 2; ++bj)
#pragma unroll
                    for (int n = 0; n < 2; ++n) { const f32x4 v = acc[ai][bj][m][n] * g; u32x2v w; w.x = cvt_pk_bf16(v[0], v[1]); w.y = cvt_pk_bf16(v[2], v[3]); *(u32x2v*)(rowp + bj * HALF + n * 16) = w; } }
    }
};
struct EpiQKV {
    static constexpr bool PERM = false, AFTER_DRAIN = false;
    bf16_t* Q; bf16_t* Kb; bf16_t* Vb;
    __device__ __forceinline__ void operator()(const f32x4 (&acc)[2][2][4][2], const Unit& u, int wr, int wc, int fr, int fq) const {
        const int part = u.pn >> 2; const int col0 = (u.pn & 3) * BM + wc * 32 + 4 * fq; const bool lat = u.pm < 64;
        float invf[4];
#pragma unroll
        for (int j = 0; j < 4; ++j) invf[j] = exp2f(-(float)(4 * fq + j) * (13.287712379549449f / 16.0f)) * 0.15915494309189535f;
#pragma unroll
        for (int ai = 0; ai < 2; ++ai)
#pragma unroll
            for (int m = 0; m < 4; ++m) {
                const int row = u.pm * BM + ai * HALF + wr * 64 + m * 16 + fr;
                const int b = lat ? (row >> 12) : ((row - 16384) >> 8); const int l = lat ? (row & 4095) : ((row - 16384) & 255);
                float cs[4], sn[4];
                if (part < 2 && lat) { const float pos = (float)((wc & 1) ? (l & 63) : (l >> 6));
#pragma unroll
                    for (int j = 0; j < 4; ++j) { const float rev = pos * invf[j]; const float fr_ = rev - floorf(rev); cs[j] = __builtin_amdgcn_cosf(fr_); sn[j] = __builtin_amdgcn_sinf(fr_); } }
                bf16_t* rowp = (part == 0 ? Q + (size_t)row * 1024 : (part == 1 ? Kb : Vb) + ((size_t)b * 4352 + (lat ? 256 + l : l)) * 1024) + col0;
#pragma unroll
                for (int bj = 0; bj < 2; ++bj) {
                    f32x4 x1 = acc[ai][bj][m][0], x2 = acc[ai][bj][m][1];
                    if (part < 2 && lat) {
#pragma unroll
                        for (int j = 0; j < 4; ++j) { const float a = x1[j], bb = x2[j]; x1[j] = a * cs[j] - bb * sn[j]; x2[j] = bb * cs[j] + a * sn[j]; } }
                    u32x2v w; w.x = cvt_pk_bf16(x1[0], x1[1]); w.y = cvt_pk_bf16(x1[2], x1[3]); *(u32x2v*)(rowp + bj * HALF) = w;
                    w.x = cvt_pk_bf16(x2[0], x2[1]); w.y = cvt_pk_bf16(x2[2], x2[3]); *(u32x2v*)(rowp + bj * HALF + 16) = w;
                }
            }
    }
};
struct OneUnit { int pm, pn;
    __device__ __forceinline__ bool next(int i, Unit& u) const { if (i != 0) return false; u.pm = pm; u.pn = pn; return true; }
    __device__ __forceinline__ void a_ready(const Unit&) const {}
    __device__ __forceinline__ void done(const Unit&) const {}
};
struct Moe2Order {
    int w; unsigned* ctr;
    __device__ __forceinline__ bool next(int i, Unit& u) const {
        if (w < 128) {
            if (i == 0) { const int e = w >> 5, r = w & 31; u.pm = e * 9 + (r & 7); u.pn = e * 4 + (r >> 3); return true; }
            if (i == 1 && w < 64) { const int e = w >> 2; u.pm = e * 9 + 8; u.pn = e * 4 + (w & 3); return true; }
            return false;
        }
        if (i >= 3) return false;
        const int L = 128 + (w - 128) * 3 + i; const int e = L >> 5, r = L & 31; u.pm = e * 9 + (r & 7); u.pn = e * 4 + (r >> 3); return true;
    }
    __device__ __forceinline__ void a_ready(const Unit& u) const {
        if ((u.pm % 9) != 8) return;
        if ((threadIdx.x & 63) == 0) { unsigned sp = 0; while (__hip_atomic_load(ctr, __ATOMIC_RELAXED, __HIP_MEMORY_SCOPE_AGENT) < 128u) { __builtin_amdgcn_s_sleep(4); if (++sp > (1u << 24)) break; } }
        __builtin_amdgcn_fence(__ATOMIC_ACQUIRE, "agent");
    }
    __device__ __forceinline__ void done(const Unit&) const {}
};
struct MoeOrder {
    int G, c, ntn, nmt;
    __device__ __forceinline__ bool next(int i, Unit& u) const {
        const int L = i * G + c; const int per_e = nmt * ntn; if (L >= 16 * per_e) return false;
        const int e = L / per_e, r = L % per_e; u.pm = e * 9 + (r % nmt); u.pn = e * ntn + (r / nmt); return true;
    }
    __device__ __forceinline__ void a_ready(const Unit&) const {}
    __device__ __forceinline__ void done(const Unit&) const {}
};
template <class Epi, class Sched, bool ALIGN_EPI = false, bool SP2 = false, bool GATHER = false>
__device__ __forceinline__ void gemm_phase(PG8_LAS unsigned char* lds, const Gemm g, const Sched& S, const Epi& E) {
    int tid_ = threadIdx.x; asm volatile("" : "+v"(tid_));
    const int tid = tid_, wid = __builtin_amdgcn_readfirstlane(tid >> 6), lane = tid & 63, wr = wid >> 2, wc = wid & 3, fr = lane & 15, fq = lane >> 4;
    const int K = g.K, nt = K / BK;
    unsigned voffA[2], voffB[2];
#pragma unroll
    for (int i = 0; i < 2; ++i) { int R, C; stage_rc(tid * 16 + i * 8192, R, C); const int Rb = Epi::PERM ? ((R & ~31) + perm32(R & 31)) : R;
        voffA[i] = (unsigned)(R * K + C) * 2u; voffB[i] = (unsigned)(Rb * K + C) * 2u; }
    unsigned vA0[2] = {0u, 0u}, vA1[2] = {0u, 0u}, nvA0[2] = {0u, 0u}, nvA1[2] = {0u, 0u};
#define PG8_GOFF(dst0, dst1, unit) do { _Pragma("unroll") for (int i_ = 0; i_ < 2; ++i_) { int R_, C_; stage_rc(tid * 16 + i_ * 8192, R_, C_); \
        dst0[i_] = (unsigned)g.gidx[(unit).pm * BM + R_] * (unsigned)(K * 2) + (unsigned)(C_ * 2); dst1[i_] = (unsigned)g.gidx[(unit).pm * BM + HALF + R_] * (unsigned)(K * 2) + (unsigned)(C_ * 2); } } while (0)
    const size_t kstep = (size_t)(BK * 2);
    const size_t hstep = (size_t)HALF * K * 2;
    const size_t tstep = 2 * hstep;
    const unsigned ldsw = (unsigned)wid * 1024u;
    const int aoff = lds_byte(wr * 64 + fr, fq * 8), boff = lds_byte(wc * 32 + fr, fq * 8);
#define PG8_SA(b, h) (((b) * 2 + (h)) * HTB)
#define PG8_SB(b, h) ((4 + (b) * 2 + (h)) * HTB)
#define PG8_STAGE(bufoff, gbase, voff) do { _Pragma("unroll") for (int _i = 0; _i < 2; ++_i) \
        __builtin_amdgcn_global_load_lds((const unsigned*)((const char*)(gbase) + (voff)[_i]), (PG8_LAS unsigned*)(lds + (bufoff) + ldsw + _i * 8192), 16, 0, 0); } while (0)
#define PG8_STAGE_AC(bufoff, kptr, half) do { if constexpr (GATHER) { if (half) PG8_STAGE(bufoff, kptr, vA1); else PG8_STAGE(bufoff, kptr, vA0); } else PG8_STAGE(bufoff, (kptr) + (half) * hstep, voffA); } while (0)
#define PG8_STAGE_AX(bufoff, kptr, half) do { if constexpr (GATHER) { unsigned s_[2]; _Pragma("unroll") for (int i_ = 0; i_ < 2; ++i_) s_[i_] = last ? ((half) ? nvA1[i_] : nvA0[i_]) : ((half) ? vA1[i_] : vA0[i_]); PG8_STAGE(bufoff, kptr, s_); } \
        else PG8_STAGE(bufoff, (kptr) + (half) * hstep, voffA); } while (0)
#define PG8_LDA(dst, b, h) do { _Pragma("unroll") for (int m = 0; m < 4; ++m) _Pragma("unroll") for (int k = 0; k < 2; ++k) dst[m][k] = *(const PG8_LAS bf16x8*)(lds + PG8_SA(b, h) + aoff + m * 2048 + k * 1024); } while (0)
#define PG8_LDB(dst, b, h) do { _Pragma("unroll") for (int n = 0; n < 2; ++n) _Pragma("unroll") for (int k = 0; k < 2; ++k) dst[n][k] = *(const PG8_LAS bf16x8*)(lds + PG8_SB(b, h) + boff + n * 2048 + k * 1024); } while (0)
#define PG8_MMA(ai, bj, At, Bt) do { __builtin_amdgcn_s_setprio(1); _Pragma("unroll") for (int m = 0; m < 4; ++m) _Pragma("unroll") for (int n = 0; n < 2; ++n) _Pragma("unroll") for (int k = 0; k < 2; ++k) \
        acc[ai][bj][m][n] = __builtin_amdgcn_mfma_f32_16x16x32_bf16(Bt[n][k], At[m][k], acc[ai][bj][m][n], 0, 0, 0); __builtin_amdgcn_s_setprio(0); } while (0)
#define PG8_WAIT_V(n) asm volatile("s_waitcnt vmcnt(" #n ")" ::: "memory")
#define PG8_WAIT_L(n) asm volatile("s_waitcnt lgkmcnt(" #n ")" ::: "memory")
#define PG8_BAR __builtin_amdgcn_s_barrier()
#define PG8_SCHED __builtin_amdgcn_sched_barrier(0)
    Unit cur, nxt; int ui = 0;
    if (!S.next(0, cur)) return;
    f32x4 acc[2][2][4][2];
#pragma unroll
    for (int a = 0; a < 2; ++a)
#pragma unroll
        for (int b = 0; b < 2; ++b)
#pragma unroll
            for (int m = 0; m < 4; ++m)
#pragma unroll
                for (int n = 0; n < 2; ++n) acc[a][b][m][n] = (f32x4){0.f, 0.f, 0.f, 0.f};
    bf16x8 At[4][2], B0[2][2], B1[2][2];
    const char* cA = (const char*)g.A + (GATHER ? (size_t)0 : (size_t)cur.pm * tstep); const char* cB = (const char*)g.Bt + (size_t)cur.pn * tstep;
    if constexpr (GATHER) PG8_GOFF(vA0, vA1, cur);
    S.a_ready(cur);
    if constexpr (SP2) {
        PG8_STAGE(PG8_SB(0, 0), cB, voffB); PG8_STAGE(PG8_SB(0, 1), cB + hstep, voffB); PG8_STAGE_AC(PG8_SA(0, 0), cA, 0); PG8_STAGE_AC(PG8_SA(0, 1), cA, 1);
        if (wr == 1) PG8_BAR;
        PG8_WAIT_V(2); PG8_BAR;
        PG8_STAGE(PG8_SB(1, 0), cB + kstep, voffB); PG8_STAGE_AC(PG8_SA(1, 0), cA + kstep, 0); PG8_STAGE(PG8_SB(1, 1), cB + hstep + kstep, voffB);
        PG8_WAIT_V(6); PG8_BAR;
    } else {
        PG8_STAGE(PG8_SB(0, 0), cB, voffB); PG8_STAGE_AC(PG8_SA(0, 0), cA, 0); PG8_STAGE(PG8_SB(0, 1), cB + hstep, voffB); PG8_STAGE_AC(PG8_SA(0, 1), cA, 1);
        if (wr == 1) PG8_BAR;
        PG8_WAIT_V(4); PG8_BAR;
        PG8_STAGE(PG8_SB(1, 0), cB + kstep, voffB); PG8_STAGE_AC(PG8_SA(1, 0), cA + kstep, 0); PG8_STAGE(PG8_SB(1, 1), cB + hstep + kstep, voffB);
        PG8_WAIT_V(6); PG8_BAR;
    }
    for (;;) {
        const bool has_next = S.next(ui + 1, nxt);
        if constexpr (GATHER) { if (has_next) PG8_GOFF(nvA0, nvA1, nxt); else { nvA0[0] = vA0[0]; nvA0[1] = vA0[1]; nvA1[0] = vA1[0]; nvA1[1] = vA1[1]; } }
        const char* nA = (has_next && !GATHER) ? (const char*)g.A + (size_t)nxt.pm * tstep : cA; const char* nB = has_next ? (const char*)g.Bt + (size_t)nxt.pn * tstep : cB;
        for (int t = 0; t < nt; t += 2) {
            const bool last = (t == nt - 2);
            const char* a1 = cA + (size_t)(t + 1) * kstep;
            const char* a2 = last ? nA : cA + (size_t)(t + 2) * kstep; const char* b2 = last ? nB : cB + (size_t)(t + 2) * kstep;
            const char* a3 = a2 + kstep; const char* b3 = b2 + kstep;
            if (last && has_next) S.a_ready(nxt);
            if constexpr (SP2) {
            PG8_LDB(B0, 0, 0); PG8_LDB(B1, 0, 1); PG8_SCHED; PG8_LDA(At, 0, 0); PG8_STAGE_AC(PG8_SA(1, 1), a1, 1);
            PG8_WAIT_V(8); PG8_WAIT_L(0); PG8_BAR; PG8_MMA(0, 0, At, B0); PG8_MMA(0, 1, At, B1); PG8_BAR; PG8_SCHED;
            PG8_LDA(At, 0, 1); PG8_STAGE(PG8_SB(0, 0), b2, voffB); PG8_STAGE(PG8_SB(0, 1), b2 + hstep, voffB); PG8_STAGE_AX(PG8_SA(0, 0), a2, 0);
            PG8_WAIT_V(8); PG8_WAIT_L(0); PG8_BAR; PG8_MMA(1, 0, At, B0); PG8_MMA(1, 1, At, B1); PG8_BAR; PG8_SCHED;
            PG8_LDB(B0, 1, 0); PG8_LDB(B1, 1, 1); PG8_SCHED; PG8_LDA(At, 1, 0); PG8_STAGE_AX(PG8_SA(0, 1), a2, 1);
            PG8_WAIT_V(8); PG8_WAIT_L(0); PG8_BAR; PG8_MMA(0, 0, At, B0); PG8_MMA(0, 1, At, B1); PG8_BAR; PG8_SCHED;
            PG8_LDA(At, 1, 1); PG8_STAGE(PG8_SB(1, 0), b3, voffB); PG8_STAGE(PG8_SB(1, 1), b3 + hstep, voffB); PG8_STAGE_AX(PG8_SA(1, 0), a3, 0);
            PG8_WAIT_V(8); PG8_WAIT_L(0); PG8_BAR; PG8_MMA(1, 0, At, B0); PG8_MMA(1, 1, At, B1); PG8_BAR; PG8_SCHED;
            } else {
            PG8_LDB(B0, 0, 0); PG8_SCHED; PG8_LDA(At, 0, 0); PG8_STAGE_AC(PG8_SA(1, 1), a1, 1);
            PG8_WAIT_L(8); PG8_BAR; PG8_WAIT_L(0); PG8_MMA(0, 0, At, B0); PG8_BAR; PG8_SCHED;
            PG8_LDB(B1, 0, 1); PG8_STAGE(PG8_SB(0, 0), b2, voffB);
            PG8_BAR; PG8_WAIT_L(0); PG8_MMA(0, 1, At, B1); PG8_BAR;
            PG8_LDA(At, 0, 1); PG8_STAGE_AX(PG8_SA(0, 0), a2, 0);
            PG8_BAR; PG8_WAIT_L(0); PG8_MMA(1, 0, At, B0); PG8_BAR; PG8_SCHED;
            PG8_STAGE(PG8_SB(0, 1), b2 + hstep, voffB);
            PG8_WAIT_V(6); PG8_BAR; PG8_MMA(1, 1, At, B1); PG8_BAR;
            PG8_LDB(B0, 1, 0); PG8_SCHED; PG8_LDA(At, 1, 0); PG8_STAGE_AX(PG8_SA(0, 1), a2, 1);
            PG8_WAIT_L(8); PG8_BAR; PG8_WAIT_L(0); PG8_MMA(0, 0, At, B0); PG8_BAR; PG8_SCHED;
            PG8_LDB(B1, 1, 1); PG8_STAGE(PG8_SB(1, 0), b3, voffB);
            PG8_BAR; PG8_WAIT_L(0); PG8_MMA(0, 1, At, B1); PG8_BAR;
            PG8_LDA(At, 1, 1); PG8_STAGE_AX(PG8_SA(1, 0), a3, 0);
            PG8_BAR; PG8_WAIT_L(0); PG8_MMA(1, 0, At, B0); PG8_BAR; PG8_SCHED;
            PG8_STAGE(PG8_SB(1, 1), b3 + hstep, voffB);
            PG8_WAIT_V(6); PG8_BAR; PG8_MMA(1, 1, At, B1); PG8_BAR;
            }
        }
        if constexpr (ALIGN_EPI) { if (wr == 0) PG8_BAR; }
        if constexpr (!Epi::AFTER_DRAIN) { E(acc, cur, wr, wc, fr, fq); S.done(cur); }
        if (!has_next) break;
#pragma unroll
        for (int a = 0; a < 2; ++a)
#pragma unroll
            for (int b = 0; b < 2; ++b)
#pragma unroll
                for (int m = 0; m < 4; ++m)
#pragma unroll
                    for (int n = 0; n < 2; ++n) acc[a][b][m][n] = (f32x4){0.f, 0.f, 0.f, 0.f};
        cur = nxt; cA = nA; cB = nB; ++ui;
        if constexpr (GATHER) { vA0[0] = nvA0[0]; vA0[1] = nvA0[1]; vA1[0] = nvA1[0]; vA1[1] = nvA1[1]; }
        if constexpr (ALIGN_EPI) { if (wr == 1) PG8_BAR; }
    }
    PG8_WAIT_V(0);
    if constexpr (!ALIGN_EPI) { if (wr == 0) PG8_BAR; }
    PG8_BAR;
    if constexpr (Epi::AFTER_DRAIN) { E.fused(acc, cur, wr, wc, fr, fq, lds, wid, lane); S.done(cur); }
#undef PG8_SA
#undef PG8_SB
#undef PG8_STAGE
#undef PG8_LDA
#undef PG8_STAGE_AC
#undef PG8_STAGE_AX
#undef PG8_GOFF
#undef PG8_LDB
#undef PG8_MMA
#undef PG8_WAIT_V
#undef PG8_WAIT_L
#undef PG8_BAR
#undef PG8_SCHED
}
}
#define XB_TMO      128
#define XB_XCNT(j)  (256  + 64 * (j))
#define XB_XSUB(j)  (1280 + 64 * (j))
#define XB_XGEN(j)  (2304 + 64 * (j))
#define XB_TOP      3328
#define XB_TOPGEN   3392
#define XCD_BAR_WORDS 3456
#define XB_SPIN_CAP (1u << 18)

__device__ __forceinline__ unsigned xb_ld(unsigned* p)              { return __hip_atomic_load(p, __ATOMIC_RELAXED, __HIP_MEMORY_SCOPE_AGENT); }
__device__ __forceinline__ unsigned xb_add(unsigned* p, unsigned v) { return __hip_atomic_fetch_add(p, v, __ATOMIC_RELAXED, __HIP_MEMORY_SCOPE_AGENT); }
__device__ __forceinline__ unsigned xb_xcc_id() { return (unsigned)__builtin_amdgcn_s_getreg((3 << 11) | 20) & 0xFu; }
#define XB_SPIN(cond, bar) do { unsigned _sp = 0; while (cond) { __builtin_amdgcn_s_sleep(1); \
    if ((++_sp & 255u) == 0u) { if (xb_ld(&(bar)[XB_TMO])) break; if (_sp > XB_SPIN_CAP) { atomicAdd(&(bar)[XB_TMO], 1u); break; } } } } while (0)

struct XcdBarrier {
    unsigned* bar; unsigned x;
    volatile LAS unsigned* st;
};

__device__ __forceinline__ XcdBarrier xcd_barrier_post(unsigned* bar, volatile LAS unsigned* st) {
    XcdBarrier b; b.bar = bar; b.x = xb_xcc_id(); b.st = st;
    if (threadIdx.x == 0) (void)xb_add(&bar[XB_XCNT(b.x)], 1u);
    return b;
}
__device__ __forceinline__ void xcd_barrier_complete(unsigned* bar, unsigned x, unsigned& nloc, unsigned& nx) {
    const unsigned G = gridDim.x * gridDim.y * gridDim.z;
    unsigned sum, cnt, mine, sp = 0u;
    for (;;) {
        sum = 0u; cnt = 0u; mine = 0u;
#pragma unroll
        for (unsigned j = 0; j < 16; ++j) { const unsigned c = xb_ld(&bar[XB_XCNT(j)]); sum += c; cnt += (c > 0u) ? 1u : 0u; mine = (j == x) ? c : mine; }
        if (sum == G) break;
        __builtin_amdgcn_s_sleep(1);
        if ((++sp & 255u) == 0u) { if (xb_ld(&bar[XB_TMO])) break; if (sp > XB_SPIN_CAP) { atomicAdd(&bar[XB_TMO], 1u); break; } }
    }
    nloc = mine > 0u ? mine : 1u; nx = cnt > 0u ? cnt : 1u;
}

__device__ __forceinline__ void xcd_barrier(const XcdBarrier& b) {
    asm volatile("s_waitcnt vmcnt(0)" ::: "memory");
    __syncthreads();
    if (threadIdx.x == 0) {
        unsigned* bar = b.bar;
        __builtin_amdgcn_s_waitcnt(0);
        unsigned nloc = b.st[0], nx = b.st[1];
        if (nloc == 0u) { xcd_barrier_complete(bar, b.x, nloc, nx); b.st[0] = nloc; b.st[1] = nx; }
        const unsigned old = xb_add(&bar[XB_XSUB(b.x)], 1u);
        const unsigned gen = old / nloc;
        if (old + 1u == (gen + 1u) * nloc) {
            __builtin_amdgcn_fence(__ATOMIC_RELEASE, "agent");
            asm volatile("s_waitcnt vmcnt(0)" ::: "memory");
            const unsigned og = xb_add(&bar[XB_TOP], 1u);
            const unsigned tg = og / nx;
            if (og + 1u == (tg + 1u) * nx) xb_add(&bar[XB_TOPGEN], 1u);
            else XB_SPIN(xb_ld(&bar[XB_TOPGEN]) == tg, bar);
            __builtin_amdgcn_fence(__ATOMIC_ACQUIRE, "agent");
            xb_add(&bar[XB_XGEN(b.x)], 1u);
            asm volatile("s_waitcnt vmcnt(0)" ::: "memory");
        } else {
            XB_SPIN(xb_ld(&bar[XB_XGEN(b.x)]) == gen, bar);
            __builtin_amdgcn_fence(__ATOMIC_ACQUIRE, "agent");
            asm volatile("s_waitcnt vmcnt(0)" ::: "memory");
        }
    }
    __syncthreads();
}
struct Frame {
    LAS unsigned char* lds;
    unsigned char* ldsg;
    volatile LAS unsigned* MISC;
    int tid, lane, wave, vcu, G, gw, NGW;
    const GAS float* const __attribute__((address_space(4)))* in;
    GAS unsigned char* ws;
    GAS float* out;
    unsigned long long tprobe;
};
#ifndef PROBE_SUB
#define PROBE_SUB 0
#endif
#define TP_BEGIN() unsigned long long tp0_ = PROBE_SUB ? __builtin_amdgcn_s_memrealtime() : 0ull
#define TP_END(id) do { if (PROBE_SUB == (id)) { const unsigned long long t1_ = __builtin_amdgcn_s_memrealtime(); F0.tprobe += t1_ - tp0_; } if (PROBE_SUB) tp0_ = __builtin_amdgcn_s_memrealtime(); } while (0)
#define WSP(T, off) ((T*)(F.ws + (off)))
#define INP(k) ((const float*)F.in[k])
#define LAUNDER(F) asm volatile("" : "+s"(F.ws), "+s"(F.in), "+s"(F.out), "+v"(F.tid), "+v"(F.lane), "+s"(F.wave), "+s"(F.gw), "+s"(F.vcu), "+s"(F.G), "+s"(F.NGW))

__device__ __forceinline__ int row_s(int row) { return row < TLAT ? (row >> 12) : 4; }

__device__ __forceinline__ void mod_row_store(const f32x4 (&v)[4], const float* g, const float* shift, const float* scale, bf16* orow, int lane, f32x4 (&h)[4]) {
    float s = 0.f;
#pragma unroll
    for (int j = 0; j < 4; ++j) s += (v[j].x * v[j].x + v[j].y * v[j].y) + (v[j].z * v[j].z + v[j].w * v[j].w);
    const float rstd = 1.0f / sqrtf(wave_sum(s) * (1.0f / 1024.0f) + 1e-6f);
#pragma unroll
    for (int j = 0; j < 4; ++j) {
        const f32x4 g4 = ((const f32x4*)g)[64 * j + lane], sh = ((const f32x4*)shift)[64 * j + lane], sc = ((const f32x4*)scale)[64 * j + lane];
        h[j] = (v[j] * rstd) * g4 * (sc + 1.0f) + sh;
        v2u o; o.x = pk2(h[j].x, h[j].y); o.y = pk2(h[j].z, h[j].w);
        ((v2u*)orow)[64 * j + lane] = o;
    }
}

template <class RowMap>
__device__ __forceinline__ void transpose_item(const float* W, int K, int N, bf16* WT, const RowMap& rowmap, LAS float* scr, int item, int lane) {
    const int nblk = (N + 63) / 64, kb = item / nblk, nb = item % nblk, k0 = 64 * kb, n0 = 64 * nb;
    const int r = lane >> 4, c4 = (lane & 15) * 4;
    f32x4 t_[16];
#pragma unroll
    for (int i = 0; i < 16; ++i) t_[i] = (n0 + c4 < N) ? *(const f32x4*)(W + (size_t)(k0 + 4 * i + r) * N + n0 + c4) : (f32x4){0.f, 0.f, 0.f, 0.f};
#pragma unroll
    for (int i = 0; i < 16; ++i) { LAS float* d = scr + (4 * i + r) * 65 + c4; d[0] = t_[i].x; d[1] = t_[i].y; d[2] = t_[i].z; d[3] = t_[i].w; }
    LDS_WAIT(); asm volatile("" ::: "memory");
    const int c = lane & 7;
#pragma unroll
    for (int j = 0; j < 8; ++j) { const int n = (lane >> 3) + 8 * j; const LAS float* s = scr + (8 * c) * 65 + n;
        v4u o; o.x = pk2(s[0 * 65], s[1 * 65]); o.y = pk2(s[2 * 65], s[3 * 65]); o.z = pk2(s[4 * 65], s[5 * 65]); o.w = pk2(s[6 * 65], s[7 * 65]);
        *(v4u*)(WT + (size_t)rowmap(n0 + n) * K + k0 + 8 * c) = o; }
    LDS_WAIT(); asm volatile("" ::: "memory");
}
struct RowId { int off; __device__ __forceinline__ int operator()(int n) const { return off + n; } };
struct RowW13 { int e, w3; __device__ __forceinline__ int operator()(int n) const { return e * 2048 + (n >> 7) * 256 + w3 * 128 + (n & 127); } };

__device__ __forceinline__ void ph_filters(Frame& F, int j);
__device__ __forceinline__ void ph_prologue(Frame& F0) { Frame F = F0; LAUNDER(F);
    const bool filt_first = (F.vcu & 1) != 0;
    if (filt_first) { ph_filters(F, 0); __syncthreads(); }
    LAS float* scr = (LAS float*)(F.lds + F.wave * 16640);
    LAS float* sv = (LAS float*)F.lds;
    constexpr int I_IN = 16 * ((EVC + 63) / 64), I_O = 16 * 16, I_Q = 16 * (QKVC / 64);
    constexpr int PER_J = I_IN + I_O + I_Q + I_O, NT_ITEMS = 2 * PER_J;
    for (int it = F.gw; it < NT_ITEMS; it += F.NGW) {
        const int j = it / PER_J; int r = it % PER_J;
        if (r < I_IN) { transpose_item(INP(I_EVWIN) + (size_t)j * DM * EVC, DM, EVC, WSP(bf16, WS_WIN) + (size_t)j * EVCP * DM, RowId{0}, scr, r, F.lane); continue; } r -= I_IN;
        if (r < I_O) { transpose_item(INP(I_EVWOUT) + (size_t)j * DM * DM, DM, DM, WSP(bf16, WS_WOE) + (size_t)j * DM * DM, RowId{0}, scr, r, F.lane); continue; } r -= I_O;
        if (r < I_Q) { transpose_item(INP(I_WQKV) + (size_t)j * DM * QKVC, DM, QKVC, WSP(bf16, WS_WQKV) + (size_t)j * QKVC * DM, RowId{0}, scr, r, F.lane); continue; } r -= I_Q;
        transpose_item(INP(I_DAWOUT) + (size_t)j * DM * DM, DM, DM, WSP(bf16, WS_WOD) + (size_t)j * DM * DM, RowId{0}, scr, r, F.lane);
    }
    __syncthreads();
    for (int i = F.tid; i < 5 * 1024; i += NTHR) { const float x = i < 4096 ? INP(I_C)[i] : INP(I_CCTX)[i - 4096]; sv[i] = siluf_(x); }
    __syncthreads();
    for (int it = F.gw; it < 4 * 24 * 16; it += F.NGW) {
        const int kc = it & 15, cg = (it >> 4) % 24, i = it / (16 * 24); const int col = cg * 256 + F.lane * 4;
        const float* wp = INP(I_ADAW) + (size_t)i * DM * 6144 + (size_t)(kc * 64) * 6144 + col;
        f32x4 acc[5];
#pragma unroll
        for (int s = 0; s < 5; ++s) acc[s] = (f32x4){0.f, 0.f, 0.f, 0.f};
#pragma unroll 1
        for (int k0 = 0; k0 < 64; k0 += 16) {
            f32x4 w[16];
#pragma unroll
            for (int k = 0; k < 16; ++k) w[k] = *(const f32x4*)(wp + (size_t)(k0 + k) * 6144);
#pragma unroll
            for (int k = 0; k < 16; ++k)
#pragma unroll
                for (int s = 0; s < 5; ++s) acc[s] = acc[s] + w[k] * sv[s * 1024 + kc * 64 + k0 + k];
        }
#pragma unroll
        for (int s = 0; s < 5; ++s) *(f32x4*)(WSP(float, WS_MODP) + ((size_t)(kc * 4 + i) * 5 + s) * 6144 + col) = acc[s];
    }
    for (int k = F.gw * 64 + F.lane; k < 8192; k += F.NGW * 64) { float s, c; sincospif((float)k * (1.0f / 4096.0f), &s, &c); WSP(f32x2, WS_TW)[k] = (f32x2){c, -s}; }
    for (int idx = F.gw * 64 + F.lane; idx < 2 * 224 * 64; idx += F.NGW * 64) {
        const int l = idx & 63, f = (idx >> 6) % 224, j = idx / (224 * 64); const int kb = 8 * (l >> 4), n = l & 15;
        const float* src; int col;
        if (f < 64) { const int d = f >> 5, nt = f & 31; src = INP(I_W2) + ((size_t)(j * 2 + d) * 32 + kb) * RWW; col = nt * 16 + n; }
        else if (f < 128) { const int d = (f - 64) >> 5, nt = (f - 64) & 31; src = INP(I_A2) + ((size_t)(j * 2 + d) * 32 + kb) * RWW; col = nt * 16 + n; }
        else { const int nt = (f - 128) / 3, ks = (f - 128) % 3; src = INP(I_G2) + ((size_t)j * 96 + ks * 32 + kb) * RWW; col = nt * 16 + n; }
        v4u o; o.x = pk2(src[0 * RWW + col], src[1 * RWW + col]); o.y = pk2(src[2 * RWW + col], src[3 * RWW + col]); o.z = pk2(src[4 * RWW + col], src[5 * RWW + col]); o.w = pk2(src[6 * RWW + col], src[7 * RWW + col]);
        WSP(v4u, WS_FRAGB)[idx] = o;
    }
    if (!filt_first) { __syncthreads(); ph_filters(F, 0); }
}
__device__ __forceinline__ void ph_modred(Frame& F0) { Frame F = F0; LAUNDER(F);
    for (int idx = F.gw * 64 + F.lane; idx < 4 * 5 * 6144; idx += F.NGW * 64) {
        const int col = idx % 6144, i = idx / (5 * 6144); float a = INP(I_ADAB)[i * 6144 + col];
#pragma unroll
        for (int kc = 0; kc < 16; ++kc) a += WSP(float, WS_MODP)[(size_t)kc * 4 * 5 * 6144 + idx];
        WSP(float, WS_MODS)[idx] = a;
    }
}
__device__ __forceinline__ void ph_mod0(Frame& F0) { Frame F = F0; LAUNDER(F);
    const float* mods = WSP(float, WS_MODS);
    for (int row = F.gw; row < TT; row += F.NGW) {
        const float* src = row < TLAT ? INP(I_X) + (size_t)row * DM : INP(I_CTX) + (size_t)(row - TLAT) * DM;
        f32x4 v[4], h[4];
#pragma unroll
        for (int j = 0; j < 4; ++j) { v[j] = ((const f32x4*)src)[64 * j + F.lane]; ((f32x4*)(WSP(float, WS_X) + (size_t)row * DM))[64 * j + F.lane] = v[j]; }
        const int s = row_s(row);
        mod_row_store(v, INP(I_NORMG), mods + s * 6144, mods + s * 6144 + 1024, WSP(bf16, WS_HA) + (size_t)row * DM, F.lane, h);
    }
}
__device__ __forceinline__ float seq_pos(int row, int& L) { if (row < TLAT) { L = SEQ; return (float)(row & (SEQ - 1)); } L = CTXL; return (float)((row - TLAT) & (CTXL - 1)); }
__device__ __forceinline__ int seq_l(int row, int& L) { if (row < TLAT) { L = SEQ; return row & (SEQ - 1); } L = CTXL; return (row - TLAT) & (CTXL - 1); }

__device__ __forceinline__ f32x4 shift4(const float* P, size_t off, bool hp, bool hn, f32x4 m0, f32x4 m1) {
    const f32x4 u = *(const f32x4*)(P + off);
    const f32x4 up = hp ? *(const f32x4*)(P + off - EVCP) : (f32x4){0.f, 0.f, 0.f, 0.f};
    const f32x4 un = hn ? *(const f32x4*)(P + off + EVCP) : (f32x4){0.f, 0.f, 0.f, 0.f};
    return u + m0 * (up - u) + m1 * (un - u);
}

__device__ __forceinline__ void ph_evprep(Frame& F0, int j) { Frame F = F0; LAUNDER(F);
    const float* P = WSP(float, WS_P);
    const float* mu = INP(I_MU) + (size_t)j * 2 * RWC;
    TP_BEGIN();
    {
        float* Vv = WSP(float, WS_V); bf16* AOP = WSP(bf16, WS_AOP);
        for (int row = F.gw; row < TT; row += F.NGW) {
            int L; const int l = seq_l(row, L); const bool hp = l > 0, hn = l < L - 1;
#pragma unroll
            for (int q = 4; q < 7; ++q) {
                const int g = F.lane + 64 * q;
                if (q < 6 || g < 440) {
                    const int col = 4 * g;
                    const f32x4 m0 = *(const f32x4*)(mu + col), m1 = *(const f32x4*)(mu + RWC + col);
                    f32x4 sv = shift4(P, (size_t)row * EVCP + col, hp, hn, m0, m1);
                    if (q < 6) *(f32x4*)(Vv + (size_t)row * RWW + (col - 1024)) = sv;
                    else { const int c = col - 1536;
                        if (c < 64) { sv.x = tanhf(sv.x); sv.y = tanhf(sv.y); sv.z = tanhf(sv.z); sv.w = tanhf(sv.w); }
                        else if (c >= 128) { sv.x = sigmoidf_(sv.x); sv.y = sigmoidf_(sv.y); sv.z = sigmoidf_(sv.z); sv.w = sigmoidf_(sv.w); }
                        v2u w; w.x = pk2(sv.x, sv.y); w.y = pk2(sv.z, sv.w); *(v2u*)(AOP + (size_t)row * 224 + c) = w; }
                }
            }
        }
    }
    __syncthreads(); TP_END(1);
    __syncthreads(); TP_END(2);

}


__device__ __forceinline__ void ph_filters(Frame& F, int j) {
    __syncthreads();
    {
        LAS float* H1 = (LAS float*)F.lds; LAS float* H2 = (LAS float*)(F.lds + 16384);
        LAS float* W1s = (LAS float*)(F.lds + 32768); LAS float* B1s = (LAS float*)(F.lds + 41216); LAS float* B2s = (LAS float*)(F.lds + 41472); LAS float* FRs = (LAS float*)(F.lds + 41728);
        LAS float* W2s = (LAS float*)(F.lds + 42240); LAS float* W3s = (LAS float*)(F.lds + 58624);
        for (int i = F.tid; i < 33 * 64; i += NTHR) W1s[i] = INP(I_FW1)[(size_t)j * 33 * 64 + i];
        for (int i = F.tid; i < 64 * 64; i += NTHR) W2s[i] = INP(I_FW2)[(size_t)j * 64 * 64 + i];
        if (F.tid < 64) { B1s[F.tid] = INP(I_FB1)[j * 64 + F.tid]; B2s[F.tid] = INP(I_FB2)[j * 64 + F.tid]; }
        if (F.tid < 128) FRs[F.tid] = INP(I_FREQ)[j * 128 + F.tid];
        const float* w3 = INP(I_FW3) + (size_t)j * 64 * 2048;
        const int p = F.tid & 63, cg = F.wave;
        for (int it = F.vcu; it < 272; it += F.G) {
            const bool lat = it < 256; const int L = lat ? SEQ : CTXL; const int r = lat ? it : it - 256; const int pt = r >> 2, cq4 = r & 3; const int m = pt * 64 + p;
            float z[33];
            z[0] = (float)m / (float)(L - 1);
#pragma unroll
            for (int i = 0; i < 16; ++i) { const float band = 1e-4f + (float)i * ((15.0f - 1e-4f) / 15.0f); const float rev = (float)m * band / (float)L; const float fr_ = rev - floorf(rev);
                z[1 + i] = __builtin_amdgcn_cosf(fr_); z[17 + i] = -__builtin_amdgcn_sinf(fr_); }
            __syncthreads();
#pragma unroll 1
            for (int q = 0; q < 8; ++q) { const int n = cg * 8 + q; float a = B1s[n];
#pragma unroll
                for (int i = 0; i < 33; ++i) a += z[i] * W1s[i * 64 + n];
                H1[n * 64 + p] = __sinf(FRs[n] * a); }
            __syncthreads();
#pragma unroll 1
            for (int q = 0; q < 8; ++q) { const int n = cg * 8 + q; float a = B2s[n];
#pragma unroll 8
                for (int k = 0; k < 64; ++k) a += H1[k * 64 + p] * W2s[k * 64 + n];
                H2[n * 64 + p] = __sinf(FRs[64 + n] * a); }
            const float t = z[0];
            float* KC = lat ? WSP(float, WS_KCL) : WSP(float, WS_KCC); const int N2 = 2 * L;
#pragma unroll 1
            for (int c4 = 0; c4 < 4; ++c4) {
                const int ct = cq4 * 4 + c4;
                __syncthreads();
                for (int i = F.tid; i < 64 * 32; i += NTHR) { const int k = i >> 5, cc = i & 31; *(LAS f32x4*)(W3s + k * 128 + cc * 4) = *(const f32x4*)(w3 + (size_t)k * 2048 + ct * 128 + cc * 4); }
                __syncthreads();
                f32x4 acc[4];
#pragma unroll
                for (int q = 0; q < 4; ++q) acc[q] = (f32x4){0.f, 0.f, 0.f, 0.f};
#pragma unroll 2
                for (int k = 0; k < 64; ++k) { const float hv = H2[k * 64 + p]; const LAS f32x4* wr = (const LAS f32x4*)(W3s + k * 128 + cg * 16);
#pragma unroll
                    for (int q = 0; q < 4; ++q) acc[q] = acc[q] + wr[q] * hv; }
                const int colb = ct * 128 + cg * 16;
#pragma unroll
                for (int q = 0; q < 16; ++q) { const int col = colb + q; const int o = col >> 10, dirn = (col >> 9) & 1, c = col & 511;
                    const float d0 = -3.0701134573253945f, d1 = -15.350567286626973f; const float del = fabsf(d0 + (d1 - d0) * ((float)c / 511.0f));
                    const float val = acc[q >> 2][q & 3] * __expf(-t * del); float* kr = KC + (size_t)(o * 512 + c) * N2;
                    if (dirn == 0) kr[m] = val; else { if (m > 0) kr[N2 - m] = val; else kr[L] = 0.f; } }
            }
        }
        __syncthreads();
    }
}
#define ZI(i) ((i) + ((i) >> 5))
__device__ __forceinline__ f32x2 cmul(f32x2 a, f32x2 b) { return (f32x2){a.x * b.x - a.y * b.y, a.x * b.y + a.y * b.x}; }
__device__ __forceinline__ f32x2 cmulc(f32x2 a, f32x2 b) { return (f32x2){a.x * b.x + a.y * b.y, a.y * b.x - a.x * b.y}; }
template <int LOGN, int NF> __device__ __forceinline__ void fft_r2_dif(LAS f32x2* Z, const LAS f32x2* TWL, int lt, int lh) {
    constexpr int N = 1 << LOGN, TPG = NTHR / NF; const int half = 1 << lh;
    for (int bf = lt; bf < N / 2; bf += TPG) { const int jx = bf & (half - 1), i = ((bf - jx) << 1) + jx;
        const f32x2 a = Z[ZI(i)], b = Z[ZI(i + half)]; Z[ZI(i)] = a + b; Z[ZI(i + half)] = cmul(a - b, TWL[half + jx]); }
    __syncthreads();
}
template <int LOGN, int NF> __device__ __forceinline__ void fft_r8_dif(LAS f32x2* Z, const LAS f32x2* TWL, int lt, int lh) {
    constexpr int N = 1 << LOGN, TPG = NTHR / NF, NG = N / 8, PT = (NG + TPG - 1) / TPG; const int h = 1 << lh, qd = h >> 2, lq = lh - 2;
    f32x2 x[PT][8]; int i0[PT], j0[PT];
#pragma unroll
    for (int t = 0; t < PT; ++t) { const int g = lt + TPG * t; j0[t] = g & (qd - 1); i0[t] = ((g >> lq) << (lq + 3)) + j0[t];
        if (g < NG) {
#pragma unroll
            for (int m = 0; m < 8; ++m) x[t][m] = Z[ZI(i0[t] + m * qd)]; } }
#pragma unroll
    for (int t = 0; t < PT; ++t) { const int g = lt + TPG * t; if (g < NG) {
#pragma unroll
        for (int m = 0; m < 4; ++m) { const f32x2 a = x[t][m], b = x[t][m + 4]; x[t][m] = a + b; x[t][m + 4] = cmul(a - b, TWL[h + j0[t] + m * qd]); }
#pragma unroll
        for (int mm = 0; mm < 4; ++mm) { const int m = (mm & 1) + 4 * (mm >> 1); const f32x2 a = x[t][m], b = x[t][m + 2]; x[t][m] = a + b; x[t][m + 2] = cmul(a - b, TWL[(h >> 1) + j0[t] + (m & 1) * qd]); }
        const f32x2 wc = TWL[qd + j0[t]];
#pragma unroll
        for (int m = 0; m < 8; m += 2) { const f32x2 a = x[t][m], b = x[t][m + 1]; x[t][m] = a + b; x[t][m + 1] = cmul(a - b, wc); }
#pragma unroll
        for (int m = 0; m < 8; ++m) Z[ZI(i0[t] + m * qd)] = x[t][m]; } }
    __syncthreads();
}
template <int LOGN, int NF> __device__ __forceinline__ void fft_r16_dif(LAS f32x2* Z, const LAS f32x2* TWL, int lt, int lh) {
    constexpr int N = 1 << LOGN, TPG = NTHR / NF, NG = N / 16; const int h = 1 << lh, qd = h >> 3, lq = lh - 3;
    for (int g = lt; g < NG; g += TPG) {
        const int j0 = g & (qd - 1), i0 = ((g >> lq) << (lq + 4)) + j0;
        f32x2 x[16];
#pragma unroll
        for (int m = 0; m < 16; ++m) x[m] = Z[ZI(i0 + m * qd)];
#pragma unroll
        for (int m = 0; m < 8; ++m) { const f32x2 a = x[m], b = x[m + 8]; x[m] = a + b; x[m + 8] = cmul(a - b, TWL[h + j0 + m * qd]); }
#pragma unroll
        for (int mm = 0; mm < 8; ++mm) { const int m = (mm & 3) + 8 * (mm >> 2); const f32x2 a = x[m], b = x[m + 4]; x[m] = a + b; x[m + 4] = cmul(a - b, TWL[(h >> 1) + j0 + (m & 3) * qd]); }
#pragma unroll
        for (int mm = 0; mm < 8; ++mm) { const int m = (mm & 1) + 4 * (mm >> 1); const f32x2 a = x[m], b = x[m + 2]; x[m] = a + b; x[m + 2] = cmul(a - b, TWL[(h >> 2) + j0 + (m & 1) * qd]); }
        const f32x2 wc = TWL[qd + j0];
#pragma unroll
        for (int m = 0; m < 16; m += 2) { const f32x2 a = x[m], b = x[m + 1]; x[m] = a + b; x[m + 1] = cmul(a - b, wc); }
#pragma unroll
        for (int m = 0; m < 16; ++m) Z[ZI(i0 + m * qd)] = x[m];
    }
    __syncthreads();
}
template <int LOGN, int NF> __device__ __forceinline__ void fft_r16_dit(LAS f32x2* Z, const LAS f32x2* TWL, int lt, int lq) {
    constexpr int N = 1 << LOGN, TPG = NTHR / NF, NG = N / 16; const int qd = 1 << lq;
    for (int g = lt; g < NG; g += TPG) {
        const int j0 = g & (qd - 1), i0 = ((g >> lq) << (lq + 4)) + j0;
        f32x2 x[16];
#pragma unroll
        for (int m = 0; m < 16; ++m) x[m] = Z[ZI(i0 + m * qd)];
        const f32x2 wc = TWL[qd + j0];
#pragma unroll
        for (int m = 0; m < 16; m += 2) { const f32x2 a = x[m], b = cmulc(x[m + 1], wc); x[m] = a + b; x[m + 1] = a - b; }
#pragma unroll
        for (int mm = 0; mm < 8; ++mm) { const int m = (mm & 1) + 4 * (mm >> 1); const f32x2 a = x[m], b = cmulc(x[m + 2], TWL[2 * qd + j0 + (m & 1) * qd]); x[m] = a + b; x[m + 2] = a - b; }
#pragma unroll
        for (int mm = 0; mm < 8; ++mm) { const int m = (mm & 3) + 8 * (mm >> 2); const f32x2 a = x[m], b = cmulc(x[m + 4], TWL[4 * qd + j0 + (m & 3) * qd]); x[m] = a + b; x[m + 4] = a - b; }
#pragma unroll
        for (int m = 0; m < 8; ++m) { const f32x2 a = x[m], b = cmulc(x[m + 8], TWL[8 * qd + j0 + m * qd]); x[m] = a + b; x[m + 8] = a - b; }
#pragma unroll
        for (int m = 0; m < 16; ++m) Z[ZI(i0 + m * qd)] = x[m];
    }
    __syncthreads();
}
template <int LOGN, int NF, bool SKIP_R2 = false> __device__ __forceinline__ void fft_dif(LAS f32x2* Z, const LAS f32x2* TWL, int lt) {
    int lh = LOGN - 1;
    if (LOGN % 3 == 1) { if (!SKIP_R2) fft_r2_dif<LOGN, NF>(Z, TWL, lt, lh); lh -= 1; }
    if constexpr (LOGN % 3 == 1 && (LOGN - 1) % 4 == 0) {
#pragma unroll 1
        for (; lh >= 3; lh -= 4) fft_r16_dif<LOGN, NF>(Z, TWL, lt, lh);
    } else {
#pragma unroll 1
        for (; lh >= 2; lh -= 3) fft_r8_dif<LOGN, NF>(Z, TWL, lt, lh);
    }
}
template <int LOGN, int NF> __device__ __forceinline__ void fft_r8_dit(LAS f32x2* Z, const LAS f32x2* TWL, int lt, int lq) {
    constexpr int N = 1 << LOGN, TPG = NTHR / NF, NG = N / 8, PT = (NG + TPG - 1) / TPG; const int qd = 1 << lq;
    f32x2 x[PT][8]; int i0[PT], j0[PT];
#pragma unroll
    for (int t = 0; t < PT; ++t) { const int g = lt + TPG * t; j0[t] = g & (qd - 1); i0[t] = ((g >> lq) << (lq + 3)) + j0[t];
        if (g < NG) {
#pragma unroll
            for (int m = 0; m < 8; ++m) x[t][m] = Z[ZI(i0[t] + m * qd)]; } }
#pragma unroll
    for (int t = 0; t < PT; ++t) { const int g = lt + TPG * t; if (g < NG) {
        const f32x2 wc = TWL[qd + j0[t]];
#pragma unroll
        for (int m = 0; m < 8; m += 2) { const f32x2 a = x[t][m], b = cmulc(x[t][m + 1], wc); x[t][m] = a + b; x[t][m + 1] = a - b; }
#pragma unroll
        for (int mm = 0; mm < 4; ++mm) { const int m = (mm & 1) + 4 * (mm >> 1); const f32x2 a = x[t][m], b = cmulc(x[t][m + 2], TWL[2 * qd + j0[t] + (m & 1) * qd]); x[t][m] = a + b; x[t][m + 2] = a - b; }
#pragma unroll
        for (int m = 0; m < 4; ++m) { const f32x2 a = x[t][m], b = cmulc(x[t][m + 4], TWL[4 * qd + j0[t] + m * qd]); x[t][m] = a + b; x[t][m + 4] = a - b; }
#pragma unroll
        for (int m = 0; m < 8; ++m) Z[ZI(i0[t] + m * qd)] = x[t][m]; } }
    __syncthreads();
}
template <int LOGN, int NF, bool SKIP_R2 = false> __device__ __forceinline__ void fft_dit_inv(LAS f32x2* Z, const LAS f32x2* TWL, int lt) {
    constexpr int N = 1 << LOGN, TPG = NTHR / NF; constexpr int NTRI = LOGN / 3;
    if constexpr (LOGN % 3 == 1 && (LOGN - 1) % 4 == 0) {
#pragma unroll 1
        for (int k = 0; k < (LOGN - 1) / 4; ++k) fft_r16_dit<LOGN, NF>(Z, TWL, lt, 4 * k);
    } else {
#pragma unroll 1
        for (int k = 0; k < NTRI; ++k) fft_r8_dit<LOGN, NF>(Z, TWL, lt, 3 * k);
    }
    if (LOGN % 3 == 1 && !SKIP_R2) { const int half = N / 2;
        for (int bf = lt; bf < N / 2; bf += TPG) { const f32x2 a = Z[ZI(bf)], b = cmulc(Z[ZI(bf + half)], TWL[half + bf]); Z[ZI(bf)] = a + b; Z[ZI(bf + half)] = a - b; }
        __syncthreads(); }
}
template <int LOGN> __device__ __forceinline__ int brev_n(int x) { return (int)(__brev((unsigned)x) >> (32 - LOGN)); }
template <int LOGN> __device__ __forceinline__ void load_tw(Frame& F, LAS f32x2* TWL) {
    constexpr int N = 1 << LOGN; const f32x2* TW = WSP(f32x2, WS_TW);
    for (int k = F.tid; k < N; k += NTHR) { if (k == 0) { TWL[0] = (f32x2){1.f, 0.f}; continue; }
        const int lh = 31 - __builtin_clz((unsigned)k), jx = k - (1 << lh);
        TWL[k] = TW[(size_t)jx << (12 - lh)]; }
}
__device__ __forceinline__ float block_sum(Frame& F, float v, LAS float* red) {
    v = wave_sum(v); __syncthreads(); if (F.lane == 0) red[F.wave] = v; __syncthreads();
    float t = 0.f;
#pragma unroll
    for (int w = 0; w < NWAVES; ++w) t += red[w];
    return t;
}
template <int LOGN, int NF> struct FftGeo { static constexpr int N = 1 << LOGN, TPG = NTHR / NF, ZS = N + N / 32; };

template <int LOGN, int NF> __device__ __forceinline__ void fftk_item(Frame& F, const float* KC, f32x4* KSP, int item) {
    constexpr int N = 1 << LOGN, TPG = NTHR / NF, ZS = FftGeo<LOGN, NF>::ZS;
    const int fi = F.tid / TPG, lt = F.tid % TPG; const int p8 = item * NF + fi, o = p8 >> 8, pr = p8 & 255;
    LAS f32x2* Z = (LAS f32x2*)F.lds + fi * ZS; LAS f32x2* TWL = (LAS f32x2*)(F.lds + 67584); LAS float* red = (LAS float*)(F.lds + 133120);
    const float* ka = KC + (size_t)(o * 512 + 2 * pr) * N; const float* kb = ka + N;
    float sa = 0.f, sb = 0.f;
    for (int i = lt; i < N; i += TPG) { const float a = ka[i], b = kb[i]; sa += fabsf(a); sb += fabsf(b); Z[ZI(i)] = (f32x2){a, b}; }
    float na, nb;
    if (NF == 1) { na = block_sum(F, sa, red) + 1e-6f; nb = block_sum(F, sb, red + 8) + 1e-6f; } else { static_assert(NF == 1 || NTHR / NF == 64, "one wave per transform"); na = wave_sum(sa) + 1e-6f; nb = wave_sum(sb) + 1e-6f; }
    __syncthreads();
    fft_dif<LOGN, NF>(Z, TWL, lt);
    const float ia = 0.5f / (na * (float)N), ib = 0.5f / (nb * (float)N);
    f32x4* dst = KSP + (size_t)(o * 256 + pr) * N;
    for (int p = lt; p < N; p += TPG) {
        const int k = brev_n<LOGN>(p), p2 = brev_n<LOGN>((N - k) & (N - 1));
        const f32x2 z1 = Z[ZI(p)], z2 = Z[ZI(p2)];
        const f32x2 Ka = (f32x2){(z1.x + z2.x) * ia, (z1.y - z2.y) * ia}, Kb = (f32x2){(z1.y + z2.y) * ib, -(z1.x - z2.x) * ib};
        dst[p] = (f32x4){0.5f * (Ka.x + Kb.x), 0.5f * (Ka.y + Kb.y), 0.5f * (Ka.x - Kb.x), 0.5f * (Ka.y - Kb.y)};
    }
    __syncthreads();
}

template <int LOGN, int NF> __device__ __forceinline__ void spec_mul(LAS f32x2* Z, const f32x4* KS, int lt) {
    constexpr int N = 1 << LOGN, TPG = NTHR / NF, PT = (N + TPG - 1) / TPG;
    f32x4 kv[PT]; f32x2 yv[PT];
#pragma unroll
    for (int t = 0; t < PT; ++t) { const int p = lt + TPG * t; if (p < N) kv[t] = KS[p]; }
#pragma unroll
    for (int t = 0; t < PT; ++t) { const int p = lt + TPG * t; if (p < N) {
        const int k = brev_n<LOGN>(p), p2 = brev_n<LOGN>((N - k) & (N - 1));
        const f32x2 z1 = Z[ZI(p)], z2 = Z[ZI(p2)];
        yv[t] = cmul(z1, (f32x2){kv[t].x, kv[t].y}) + cmul((f32x2){z2.x, -z2.y}, (f32x2){kv[t].z, kv[t].w}); } }
    __syncthreads();
#pragma unroll
    for (int t = 0; t < PT; ++t) { const int p = lt + TPG * t; if (p < N) Z[ZI(p)] = yv[t]; }
    __syncthreads();
}
__device__ __forceinline__ float conv3_at(const float* p, int l, int L, float w0, float w1, float w2, float bb) {
    const float up = l > 0 ? p[l - 1] : 0.f, u = p[l], un = l < L - 1 ? p[l + 1] : 0.f; return up * w0 + u * w1 + un * w2 + bb; }
template <int LOGN, int NF> __device__ __forceinline__ void hyena_item(Frame& F, const float* UTall, const f32x4* KSP, float* HYTall, const float* hyb, const float* cw, const float* cb, int item) {
    constexpr int N = 1 << LOGN, L = N / 2, TPG = NTHR / NF, PT = (L + TPG - 1) / TPG, ZS = FftGeo<LOGN, NF>::ZS;
    const int fi = F.tid / TPG, lt = F.tid % TPG; const int p8 = item * NF + fi, b = p8 >> 8, pr = p8 & 255;
    const float* UT = UTall + (size_t)b * HYC * L; float* HYT = HYTall + (size_t)b * 512 * L;
    LAS f32x2* Z = (LAS f32x2*)F.lds + fi * ZS; LAS f32x2* TWL = (LAS f32x2*)(F.lds + 67584);
    const int c0 = 2 * pr; const float b0a = hyb[c0], b0b = hyb[c0 + 1], b1a = hyb[512 + c0], b1b = hyb[512 + c0 + 1];
#define CV(ptr, l_, s3, ch) conv3_at(ptr, l_, L, cw[(s3) * 512 + c0 + (ch)], cw[HYC + (s3) * 512 + c0 + (ch)], cw[2 * HYC + (s3) * 512 + c0 + (ch)], cb[(s3) * 512 + c0 + (ch)])
    const float* va = UT + (size_t)c0 * L; const float* vb = va + L;
    f32x2 keep[PT];
    f32x2 zpair = (f32x2){0.f, 0.f}; asm volatile("" : "+v"(zpair));
    const float* xa = UT + (size_t)(512 + c0) * L; const float* xb = xa + L;
    const float* x2a = UT + (size_t)(1024 + c0) * L; const float* x2b = x2a + L;
    float* oa = HYT + (size_t)c0 * L; float* ob = oa + L;
    if constexpr (LOGN % 3 == 1) {
#pragma unroll
        for (int q = 0; q < PT; ++q) { const int l = lt + TPG * q; keep[q] = (f32x2){CV(va, l, 0, 0), CV(vb, l, 0, 1)}; Z[ZI(l)] = keep[q]; Z[ZI(l + L)] = cmul(keep[q], TWL[L + l]); }
        __syncthreads();
        fft_dif<LOGN, NF, true>(Z, TWL, lt);
        spec_mul<LOGN, NF>(Z, KSP + (size_t)pr * N, lt);
        fft_dit_inv<LOGN, NF, true>(Z, TWL, lt);
        f32x2 x1v[PT];
#pragma unroll
        for (int q = 0; q < PT; ++q) { const int l = lt + TPG * q; x1v[q] = (f32x2){CV(xa, l, 1, 0), CV(xb, l, 1, 1)}; }
#pragma unroll
        for (int q = 0; q < PT; ++q) { const int l = lt + TPG * q; const f32x2 w = TWL[L + l]; const f32x2 y = Z[ZI(l)] + cmulc(Z[ZI(l + L)], w);
            keep[q] = (f32x2){x1v[q].x * (y.x + keep[q].x * b0a), x1v[q].y * (y.y + keep[q].y * b0b)};
            Z[ZI(l)] = keep[q]; Z[ZI(l + L)] = cmul(keep[q], w); }
        __syncthreads();
        fft_dif<LOGN, NF, true>(Z, TWL, lt);
        spec_mul<LOGN, NF>(Z, KSP + (size_t)(256 + pr) * N, lt);
        fft_dit_inv<LOGN, NF, true>(Z, TWL, lt);
#pragma unroll
        for (int q = 0; q < PT; ++q) { const int l = lt + TPG * q; x1v[q] = (f32x2){CV(x2a, l, 2, 0), CV(x2b, l, 2, 1)}; }
#pragma unroll
        for (int q = 0; q < PT; ++q) { const int l = lt + TPG * q; const f32x2 y = Z[ZI(l)] + cmulc(Z[ZI(l + L)], TWL[L + l]);
            oa[l] = x1v[q].x * (y.x + keep[q].x * b1a); ob[l] = x1v[q].y * (y.y + keep[q].y * b1b); }
        __syncthreads();
    } else {
#pragma unroll
        for (int q = 0; q < PT; ++q) { const int l = lt + TPG * q; if (l < L) { keep[q] = (f32x2){CV(va, l, 0, 0), CV(vb, l, 0, 1)}; Z[ZI(l)] = keep[q]; Z[ZI(l + L)] = zpair; } }
        __syncthreads();
        fft_dif<LOGN, NF>(Z, TWL, lt);
        spec_mul<LOGN, NF>(Z, KSP + (size_t)pr * N, lt);
        fft_dit_inv<LOGN, NF>(Z, TWL, lt);
#pragma unroll
        for (int q = 0; q < PT; ++q) { const int l = lt + TPG * q; if (l < L) { const f32x2 y = Z[ZI(l)]; keep[q] = (f32x2){CV(xa, l, 1, 0) * (y.x + keep[q].x * b0a), CV(xb, l, 1, 1) * (y.y + keep[q].y * b0b)}; } }
        __syncthreads();
#pragma unroll
        for (int q = 0; q < PT; ++q) { const int l = lt + TPG * q; if (l < L) { Z[ZI(l)] = keep[q]; Z[ZI(l + L)] = zpair; } }
        __syncthreads();
        fft_dif<LOGN, NF>(Z, TWL, lt);
        spec_mul<LOGN, NF>(Z, KSP + (size_t)(256 + pr) * N, lt);
        fft_dit_inv<LOGN, NF>(Z, TWL, lt);
#pragma unroll
        for (int q = 0; q < PT; ++q) { const int l = lt + TPG * q; if (l < L) { const f32x2 y = Z[ZI(l)]; oa[l] = CV(x2a, l, 2, 0) * (y.x + keep[q].x * b1a); ob[l] = CV(x2b, l, 2, 1) * (y.y + keep[q].y * b1b); } }
        __syncthreads();
    }
#undef CV
}
__device__ __forceinline__ void ph_hyena(Frame& F0, int j) { Frame F = F0; LAUNDER(F);
    LAS f32x2* TWL = (LAS f32x2*)(F.lds + 67584);
    const float* hyb = INP(I_HYB) + (size_t)j * 1024;
    load_tw<13>(F, TWL); __syncthreads();
    for (int it = F.vcu; it < 1024; it += F.G) hyena_item<13, 1>(F, WSP(float, WS_UTL), WSP(f32x4, WS_KSPL), WSP(float, WS_HYTL), hyb, INP(I_CONVW) + (size_t)j * 3 * HYC, INP(I_CONVB) + (size_t)j * HYC, it);
    __syncthreads(); load_tw<9>(F, TWL); __syncthreads();
    for (int it = F.vcu; it < 128; it += F.G) hyena_item<9, 8>(F, WSP(float, WS_UTC), WSP(f32x4, WS_KSPC), WSP(float, WS_HYTC), hyb, INP(I_CONVW) + (size_t)j * 3 * HYC, INP(I_CONVB) + (size_t)j * HYC, it);
    __syncthreads();
}

__device__ __forceinline__ void ph_readout(Frame& F0, int j) { Frame F = F0; LAUNDER(F);
    const float* Vv = WSP(float, WS_V); const float* Gg = WSP(float, WS_G); const float* BON = WSP(float, WS_BON);
    const float* Y0 = WSP(float, WS_Y); const float* Y1 = Y0 + (size_t)TT * RWW;
    const float* gn = INP(I_GN) + (size_t)j * 2 * RWW;
    bf16* CAT = WSP(bf16, WS_CAT);
    for (int row = F.gw; row < TT; row += F.NGW) {
#pragma unroll
        for (int q = 0; q < 2; ++q) {
            const int c = 4 * F.lane + 256 * q; const size_t o = (size_t)row * RWW + c;
            const f32x4 y = *(const f32x4*)(Y0 + o) + *(const f32x4*)(Y1 + o);
            float s = (y.x + y.y) + (y.z + y.w);
            s = sum16_f(s);
            const float mu = s * (1.0f / 64.0f); const f32x4 dy = y - mu;
            float v2 = (dy.x * dy.x + dy.y * dy.y) + (dy.z * dy.z + dy.w * dy.w);
            v2 = sum16_f(v2);
            const float rstd = 1.0f / sqrtf(v2 * (1.0f / 64.0f) + 64e-5f);
            const f32x4 yn = dy * rstd * *(const f32x4*)(gn + c) + *(const f32x4*)(gn + RWW + c);
            const f32x4 v = *(const f32x4*)(Vv + o), g = *(const f32x4*)(Gg + o);
            const float bs = BON[(size_t)row * 8 + (c >> 6)];
            f32x4 ov = (yn + v * bs) * g;
#ifdef ABL_RW
            ov = ov * 0.0f;
#endif
            v2u w; w.x = pk2(ov.x, ov.y); w.y = pk2(ov.z, ov.w);
            *(v2u*)(CAT + (size_t)row * DM + c) = w;
        }
    }
    LAS float* scr = (LAS float*)(F.lds + F.wave * 16640);
    for (int it = F.gw; it < (TT / 64) * 8; it += F.NGW) {
        const int rt = it >> 3, ct = it & 7; const int r0 = rt * 64; int L; const int l0 = seq_l(r0, L);
        const float* src; if (r0 < TLAT) src = WSP(float, WS_HYTL) + ((size_t)(r0 >> 12) * 512 + ct * 64) * SEQ + l0; else src = WSP(float, WS_HYTC) + ((size_t)((r0 - TLAT) >> 8) * 512 + ct * 64) * CTXL + l0;
        for (int cc = 0; cc < 64; ++cc) scr[cc * 65 + F.lane] = src[(size_t)cc * L + F.lane];
        LDS_WAIT(); asm volatile("" ::: "memory");
        const int c2 = 2 * (F.lane & 31);
        for (int i2 = 0; i2 < 32; ++i2) { const int rr = 2 * i2 + (F.lane >> 5);
            unsigned pkv = pk2(scr[c2 * 65 + rr], scr[(c2 + 1) * 65 + rr]);
#ifdef ABL_HY
            pkv = 0u;
#endif
            *(unsigned*)(CAT + (size_t)(r0 + rr) * DM + 512 + ct * 64 + c2) = pkv; }
        LDS_WAIT(); asm volatile("" ::: "memory");
    }
}

__device__ __forceinline__ int chunk_base_row(int b, int d, int n) {
    if (n < 16) return TLAT + b * CTXL + 16 * (d ? 15 - n : n);
    const int m = n - 16; return b * SEQ + 16 * (d ? 255 - m : m);
}

__device__ __forceinline__ void ph_chunkprep(Frame& F0, int j) { Frame F = F0; LAUNDER(F);
    const float* P = WSP(float, WS_P); const float* Vv = WSP(float, WS_V);
    const bf16* AOP = WSP(bf16, WS_AOP); float* Gg = WSP(float, WS_G); float* BON = WSP(float, WS_BON);
    LAS unsigned char* wl = F.lds + F.wave * 14336;
    LAS float* ST = (LAS float*)wl; LAS bf16* OPB = (LAS bf16*)(wl + 4096); LAS float* TM = (LAS float*)(wl + 12288); LAS float* M2s = (LAS float*)(wl + 13312);
    LAS v4u* FBL = (LAS v4u*)(F.lds + 8 * 14336);
    const int h = F.vcu & 7;
    {
        const v4u* FB = WSP(v4u, WS_FRAGB) + (size_t)j * 224 * 64;
        for (int i = F.tid; i < 28 * 64; i += NTHR) { const int f = i >> 6, l = i & 63; int src;
            if (f < 8) src = (f >> 2) * 32 + 4 * h + (f & 3); else if (f < 16) src = 64 + ((f - 8) >> 2) * 32 + 4 * h + (f & 3); else src = 128 + (4 * h + (f - 16) / 3) * 3 + (f - 16) % 3;
            FBL[i] = FB[src * 64 + l]; }
    }
    __syncthreads();
    const int lane = F.lane, n15 = lane & 15, q = lane >> 4;
    LAS float* BIAS = (LAS float*)(F.lds + LDSCTL_OFF + 1024);
    if (F.tid < 256) { const int which = F.tid >> 7, d = (F.tid >> 6) & 1, c = F.tid & 63; BIAS[F.tid] = (which ? INP(I_A0) : INP(I_W0))[(size_t)(j * 2 + d) * RWW + h * 64 + c]; }
    __syncthreads();
    const int col = h * 64 + lane;
    const float kav = INP(I_KA)[(size_t)j * RWW + col], rkv = INP(I_RK)[(size_t)j * RWW + col], kkw = INP(I_KK)[(size_t)j * RWW + col];
    const float* mu = INP(I_MU) + (size_t)j * 2 * RWC;
    const float mr0 = mu[col], mr1 = mu[RWC + col], mk0 = mu[512 + col], mk1 = mu[RWC + 512 + col];
    for (int c16 = (F.vcu >> 3) * 8 + F.wave; c16 < TT / 16; c16 += (F.G >> 3) * 8) {
        const int base = c16 * 16;
        const bool lat = base < TLAT; const int b = lat ? (base >> 12) : ((base - TLAT) >> 8); const int cidx = lat ? ((base & (SEQ - 1)) >> 4) : (((base - TLAT) & (CTXL - 1)) >> 4);
        bf16x8 af[7];
#pragma unroll
        for (int f7 = 4; f7 < 7; ++f7) af[f7] = *(const bf16x8*)(AOP + (size_t)(base + n15) * 224 + f7 * 32 + 8 * q);
        float kkv[16], kxv[16], rxv[16];
        {
            const int lpos = lat ? (base & (SEQ - 1)) : ((base - TLAT) & (CTXL - 1)); const int Lseq = lat ? SEQ : CTXL;
            float pr[18], pk[18];
#pragma unroll
            for (int s = 0; s < 18; ++s) { const bool ok = (s > 0 || lpos > 0) && (s < 17 || lpos + 16 < Lseq); const size_t o = (size_t)(base + s - 1) * EVCP + col;
                pr[s] = ok ? P[o] : 0.f; pk[s] = ok ? P[o + 512] : 0.f; }
#pragma unroll
            for (int s = 0; s < 16; ++s) {
                rxv[s] = pr[s + 1] + mr0 * (pr[s] - pr[s + 1]) + mr1 * (pr[s + 2] - pr[s + 1]);
                kxv[s] = pk[s + 1] + mk0 * (pk[s] - pk[s + 1]) + mk1 * (pk[s + 2] - pk[s + 1]);
                const float kq = kxv[s] * kkw; const float ss = wave_sum(kq * kq);
                kkv[s] = kq * (1.0f / fmaxf(sqrtf(ss), 1e-12f));
            }
        }
#pragma unroll
        for (int nt = 0; nt < 4; ++nt) {
            f32x4 cg = __builtin_amdgcn_mfma_f32_16x16x32_bf16(af[4], __builtin_bit_cast(bf16x8, FBL[(16 + nt * 3 + 0) * 64 + lane]), (f32x4){0.f, 0.f, 0.f, 0.f}, 0, 0, 0);
            cg = __builtin_amdgcn_mfma_f32_16x16x32_bf16(af[5], __builtin_bit_cast(bf16x8, FBL[(16 + nt * 3 + 1) * 64 + lane]), cg, 0, 0, 0);
            cg = __builtin_amdgcn_mfma_f32_16x16x32_bf16(af[6], __builtin_bit_cast(bf16x8, FBL[(16 + nt * 3 + 2) * 64 + lane]), cg, 0, 0, 0);
#pragma unroll
            for (int r = 0; r < 4; ++r) Gg[(size_t)(base + 4 * q + r) * RWW + h * 64 + nt * 16 + n15] = cg[r];
        }
        float bon_mine = 0.f;
#pragma unroll 1
        for (int d = 0; d < 2; ++d) {
            float wv[16], av[16];
            const bf16x8 afw = *(const bf16x8*)(AOP + (size_t)(base + n15) * 224 + d * 32 + 8 * q), afa = *(const bf16x8*)(AOP + (size_t)(base + n15) * 224 + 64 + d * 32 + 8 * q);
#pragma unroll
            for (int which = 0; which < 2; ++which) {
#pragma unroll
                for (int nt = 0; nt < 4; ++nt) {
                    const bf16x8 aop = which ? afa : afw;
                    const f32x4 c4 = __builtin_amdgcn_mfma_f32_16x16x32_bf16(aop, __builtin_bit_cast(bf16x8, FBL[(8 * which + 4 * d + nt) * 64 + lane]), (f32x4){0.f, 0.f, 0.f, 0.f}, 0, 0, 0);
                    const float bias = BIAS[(which * 2 + d) * 64 + nt * 16 + n15];
#pragma unroll
                    for (int r = 0; r < 4; ++r) { const int tok = 4 * q + r, st = d ? 15 - tok : tok; const float x = bias + c4[r];
                        ST[st * 64 + nt * 16 + n15] = which ? sigmoidf_(x) : __expf(-0.6065306597126334f * sigmoidf_(x)); }
                }
                LDS_WAIT(); asm volatile("" ::: "memory");
#pragma unroll
                for (int s = 0; s < 16; ++s) { if (which) av[s] = ST[s * 64 + lane]; else wv[s] = ST[s * 64 + lane]; }
                LDS_WAIT(); asm volatile("" ::: "memory");
            }
            float kt[16];
            float p = 1.0f;
#pragma unroll
            for (int s = 0; s < 16; ++s) {
                const float kk = d ? kkv[15 - s] : kkv[s], kx = d ? kxv[15 - s] : kxv[s], rx = d ? rxv[15 - s] : rxv[s];
                const float kd = kx * (1.0f + (av[s] - 1.0f) * kav);
                { const float bt_ = wave_sum(rx * kd * rkv); if (lane == (d ? 15 - s : s)) bon_mine += bt_; }
                kt[s] = kk * p; p *= wv[s]; const float ip = 1.0f / p;
                OPB[0 * 1024 + s * 64 + lane] = (bf16)f2bf(kt[s]);
                OPB[1 * 1024 + s * 64 + lane] = (bf16)f2bf(rx * p);
                OPB[2 * 1024 + s * 64 + lane] = (bf16)f2bf(kd * ip);
                OPB[3 * 1024 + s * 64 + lane] = (bf16)f2bf(kk * av[s] * ip);
            }
            const float pc = p;
            LDS_WAIT(); asm volatile("" ::: "memory");
            {
                bf16x8 fk[2], fr[2], fb[2], fkk[2];
#pragma unroll
                for (int ks = 0; ks < 2; ++ks) { const int off = n15 * 64 + ks * 32 + 8 * q;
                    fk[ks] = *(const LAS bf16x8*)(OPB + 0 * 1024 + off); fr[ks] = *(const LAS bf16x8*)(OPB + 1 * 1024 + off);
                    fkk[ks] = *(const LAS bf16x8*)(OPB + 2 * 1024 + off); fb[ks] = *(const LAS bf16x8*)(OPB + 3 * 1024 + off); }
                f32x4 mA = (f32x4){0.f, 0.f, 0.f, 0.f}, mB = mA, mE = mA, mG = mA;
#pragma unroll
                for (int ks = 0; ks < 2; ++ks) {
                    mA = __builtin_amdgcn_mfma_f32_16x16x32_bf16(fk[ks], fb[ks], mA, 0, 0, 0);
                    mB = __builtin_amdgcn_mfma_f32_16x16x32_bf16(fk[ks], fkk[ks], mB, 0, 0, 0);
                    mE = __builtin_amdgcn_mfma_f32_16x16x32_bf16(fr[ks], fkk[ks], mE, 0, 0, 0);
                    mG = __builtin_amdgcn_mfma_f32_16x16x32_bf16(fr[ks], fb[ks], mG, 0, 0, 0);
                }
#pragma unroll
                for (int r = 0; r < 4; ++r) { const int sr = 4 * q + r;
                    ST[0 * 256 + sr * 16 + n15] = n15 < sr ? mA[r] : 0.f; ST[1 * 256 + sr * 16 + n15] = n15 < sr ? mB[r] : 0.f;
                    ST[2 * 256 + sr * 16 + n15] = n15 <= sr ? mE[r] : 0.f; ST[3 * 256 + sr * 16 + n15] = n15 <= sr ? mG[r] : 0.f; }
            }
            LDS_WAIT(); asm volatile("" ::: "memory");
            float vfa[2][8], vfb[2][8];
#pragma unroll
            for (int ig = 0; ig < 2; ++ig)
#pragma unroll
                for (int jj = 0; jj < 8; ++jj) { const int sg = (8 * q + jj) & 15; vfa[ig][jj] = Vv[(size_t)(base + (d ? 15 - sg : sg)) * RWW + h * 64 + ig * 16 + n15]; }
            {
                float tc[16];
#pragma unroll
                for (int s = 0; s < 16; ++s) { float acc = (s == n15) ? 1.0f : 0.0f;
#pragma unroll
                    for (int sg = 0; sg < s; ++sg) acc -= ST[0 * 256 + s * 16 + sg] * tc[sg];
                    tc[s] = acc; }
                if (q == 0) {
#pragma unroll
                    for (int s = 0; s < 16; ++s) TM[s * 16 + n15] = tc[s]; }
            }
            LDS_WAIT(); asm volatile("" ::: "memory");
            {
                float m1[16];
#pragma unroll
                for (int s = 0; s < 16; ++s) { float acc = 0.f;
#pragma unroll
                    for (int sg = 0; sg <= s; ++sg) acc += TM[s * 16 + sg] * kt[sg];
                    m1[s] = acc; }
#pragma unroll
                for (int s = 0; s < 16; ++s) OPB[0 * 1024 + s * 64 + lane] = (bf16)f2bf(m1[s]);
#pragma unroll
                for (int r = 0; r < 4; ++r) { const int sr = 4 * q + r; float acc = 0.f;
#pragma unroll
                    for (int sg = 0; sg < 16; ++sg) acc += TM[sr * 16 + sg] * ST[1 * 256 + sg * 16 + n15];
                    M2s[sr * 16 + n15] = acc; }
            }
            LDS_WAIT(); asm volatile("" ::: "memory");
#pragma unroll
            for (int ig = 0; ig < 2; ++ig)
#pragma unroll
                for (int jj = 0; jj < 8; ++jj) { const int sg = (8 * q + jj) & 15; vfb[ig][jj] = Vv[(size_t)(base + (d ? 15 - sg : sg)) * RWW + h * 64 + (2 + ig) * 16 + n15]; }
            {
                const int scan = b * 16 + h * 2 + d; const int npos = lat ? 16 + (d ? 255 - cidx : cidx) : (d ? 15 - cidx : cidx);
                unsigned char* rec = (unsigned char*)F.ws + WS_REC + ((size_t)scan * 272 + npos) * REC_BYTES;
                unsigned short e8[8];
#define PK_LO() ((unsigned)e8[0] | ((unsigned)e8[1] << 16))
#define PK_HI() ((unsigned)e8[2] | ((unsigned)e8[3] << 16))
#define STORE_FULL(piece) do { v4u o_; o_.x = PK_LO(); o_.y = PK_HI(); o_.z = e8[4] | ((unsigned)e8[5] << 16); o_.w = e8[6] | ((unsigned)e8[7] << 16); *(v4u*)(rec + (piece) * 1024 + lane * 16) = o_; } while (0)
#define STORE_HALFLANES(piece, sel) do { if (q < 2) { v4u o_; o_.x = PK_LO(); o_.y = PK_HI(); o_.z = e8[4] | ((unsigned)e8[5] << 16); o_.w = e8[6] | ((unsigned)e8[7] << 16); *(v4u*)(rec + (piece) * 1024 + ((sel) * 32 + (lane & 31)) * 16) = o_; } } while (0)
#define STORE_HALFWIDTH(piece, sel) do { v2u o_; o_.x = PK_LO(); o_.y = PK_HI(); *(v2u*)(rec + (piece) * 1024 + lane * 16 + (sel) * 8) = o_; } while (0)
#pragma unroll
                for (int ks = 0; ks < 2; ++ks) {
#pragma unroll
                    for (int jj = 0; jj < 8; ++jj) e8[jj] = OPB[0 * 1024 + n15 * 64 + 32 * ks + 16 * (jj >> 2) + 4 * q + (jj & 3)];
                    STORE_FULL(ks);
#pragma unroll
                    for (int jj = 0; jj < 8; ++jj) e8[jj] = OPB[1 * 1024 + n15 * 64 + 32 * ks + 16 * (jj >> 2) + 4 * q + (jj & 3)];
                    STORE_FULL(2 + ks);
                }
#pragma unroll
                for (int jj = 0; jj < 8; ++jj) e8[jj] = (unsigned short)f2bf(M2s[n15 * 16 + ((8 * q + jj) & 15)]);
                STORE_HALFLANES(4, 0);
#pragma unroll
                for (int jj = 0; jj < 8; ++jj) e8[jj] = (unsigned short)f2bf(ST[2 * 256 + n15 * 16 + ((8 * q + jj) & 15)]);
                STORE_HALFLANES(4, 1);
#pragma unroll
                for (int jj = 0; jj < 4; ++jj) e8[jj] = (unsigned short)f2bf(-ST[3 * 256 + n15 * 16 + 4 * q + jj]);
                STORE_HALFWIDTH(9, 0);
#pragma unroll
                for (int tl = 0; tl < 4; ++tl) {
#pragma unroll
                    for (int jj = 0; jj < 8; ++jj) e8[jj] = (unsigned short)OPB[2 * 1024 + ((8 * q + jj) & 15) * 64 + 16 * tl + n15];
                    STORE_HALFLANES(5 + (tl >> 1), tl & 1);
#pragma unroll
                    for (int jj = 0; jj < 4; ++jj) e8[jj] = (unsigned short)(OPB[3 * 1024 + (4 * q + jj) * 64 + 16 * tl + n15] ^ 0x8000u);
                    if (tl == 0) STORE_HALFWIDTH(9, 1); else if (tl == 1) STORE_HALFWIDTH(10, 0); else if (tl == 2) STORE_HALFWIDTH(10, 1); else STORE_HALFWIDTH(11, 0);
                }
#pragma unroll
                for (int ig = 0; ig < 4; ++ig) {
#pragma unroll
                    for (int jj = 0; jj < 8; ++jj) e8[jj] = (unsigned short)f2bf(ig < 2 ? vfa[ig & 1][jj] : vfb[ig & 1][jj]);
                    STORE_HALFLANES(7 + (ig >> 1), ig & 1);
                }
#undef PK_LO
#undef PK_HI
#undef STORE_FULL
#undef STORE_HALFLANES
#undef STORE_HALFWIDTH
                *(float*)(rec + 11 * 1024 + (lane >> 1) * 16 + 8 + (lane & 1) * 4) = pc;
            }
            LDS_WAIT(); asm volatile("" ::: "memory");
        }
        if (lane < 16) BON[(size_t)(base + lane) * 8 + h] = bon_mine;
    }
}

__device__ __forceinline__ void scan_unit(Frame& F, int scan) {
    constexpr int R = 11, D = 10, NCH = 272;
    const int b = scan >> 4, h = (scan >> 1) & 7, d = scan & 1;
    const int lane = F.lane, n15 = lane & 15, q = lane >> 4, l31 = lane & 31;
    const unsigned char* rec0 = (const unsigned char*)F.ws + WS_REC + (size_t)scan * NCH * REC_BYTES;
    const bool loader = F.wave >= 4; const int lw = F.wave & 3, ig = F.wave & 3;
    float* Yd = WSP(float, WS_Y) + (size_t)d * TT * RWW;
    f32x4 S[4];
#pragma unroll
    for (int t = 0; t < 4; ++t) S[t] = (f32x4){0.f, 0.f, 0.f, 0.f};
#define ISSUE(n_) do { const unsigned char* g_ = rec0 + (size_t)(n_) * REC_BYTES + lw * 1024 + lane * 16; LAS unsigned char* l_ = F.lds + ((n_) % R) * (int)REC_BYTES + lw * 1024; \
        _Pragma("unroll") for (int p_ = 0; p_ < 3; ++p_) __builtin_amdgcn_global_load_lds((const unsigned*)(g_ + p_ * 4096), (LAS unsigned*)(l_ + p_ * 4096), 16, 0, 0); } while (0)
#define BF8(x) __builtin_bit_cast(bf16x8, x)
    if (loader) {
#pragma unroll 1
        for (int n = 0; n < D; ++n) ISSUE(n);
        asm volatile("s_waitcnt vmcnt(27)" ::: "memory");
    }
    __builtin_amdgcn_s_barrier();
    const v4u zf = (v4u){0u, 0u, 0u, 0u}; const bool vz = q >= 2;
#pragma unroll 1
    for (int n = 0; n < NCH; ++n) {
        if (loader) {
            if (n + D < NCH) { ISSUE(n + D); asm volatile("s_waitcnt vmcnt(27)" ::: "memory"); }
            else asm volatile("s_waitcnt vmcnt(0)" ::: "memory");
        } else {
            const LAS unsigned char* sl = F.lds + (n % R) * (int)REC_BYTES;
#define FULLP(p) (*(const LAS v4u*)(sl + (p) * 1024 + lane * 16))
#define HALFL(p, sel) (vz ? zf : *(const LAS v4u*)(sl + (p) * 1024 + ((sel) * 32 + l31) * 16))
#define HALFW(p, sel) ({ const v2u t_ = *(const LAS v2u*)(sl + (p) * 1024 + lane * 16 + (sel) * 8); (v4u){t_.x, t_.y, 0u, 0u}; })
            v4u sb0, sb1; sb0.x = pk2(S[0][0], S[0][1]); sb0.y = pk2(S[0][2], S[0][3]); sb0.z = pk2(S[1][0], S[1][1]); sb0.w = pk2(S[1][2], S[1][3]);
            sb1.x = pk2(S[2][0], S[2][1]); sb1.y = pk2(S[2][2], S[2][3]); sb1.z = pk2(S[3][0], S[3][1]); sb1.w = pk2(S[3][2], S[3][3]);
            const f32x4 z4 = (f32x4){0.f, 0.f, 0.f, 0.f};
            const v4u fv = HALFL(7 + (ig >> 1), ig & 1);
            f32x4 U = __builtin_amdgcn_mfma_f32_16x16x32_bf16(BF8(FULLP(0)), BF8(sb0), z4, 0, 0, 0);
            f32x4 Y = __builtin_amdgcn_mfma_f32_16x16x32_bf16(BF8(FULLP(2)), BF8(sb0), z4, 0, 0, 0);
            U = __builtin_amdgcn_mfma_f32_16x16x32_bf16(BF8(FULLP(1)), BF8(sb1), U, 0, 0, 0);
            Y = __builtin_amdgcn_mfma_f32_16x16x32_bf16(BF8(FULLP(3)), BF8(sb1), Y, 0, 0, 0);
            U = __builtin_amdgcn_mfma_f32_16x16x32_bf16(BF8(HALFL(4, 0)), BF8(fv), U, 0, 0, 0);
            Y = __builtin_amdgcn_mfma_f32_16x16x32_bf16(BF8(HALFL(4, 1)), BF8(fv), Y, 0, 0, 0);
#pragma unroll
            for (int t = 0; t < 4; ++t) S[t] = __builtin_amdgcn_mfma_f32_16x16x32_bf16(BF8(HALFL(5 + (t >> 1), t & 1)), BF8(fv), S[t], 0, 0, 0);
            v4u ub; ub.x = pk2(U[0], U[1]); ub.y = pk2(U[2], U[3]); ub.z = 0u; ub.w = 0u;
            Y = __builtin_amdgcn_mfma_f32_16x16x32_bf16(BF8(HALFW(9, 0)), BF8(ub), Y, 0, 0, 0);
            S[0] = __builtin_amdgcn_mfma_f32_16x16x32_bf16(BF8(HALFW(9, 1)), BF8(ub), S[0], 0, 0, 0);
            S[1] = __builtin_amdgcn_mfma_f32_16x16x32_bf16(BF8(HALFW(10, 0)), BF8(ub), S[1], 0, 0, 0);
            S[2] = __builtin_amdgcn_mfma_f32_16x16x32_bf16(BF8(HALFW(10, 1)), BF8(ub), S[2], 0, 0, 0);
            S[3] = __builtin_amdgcn_mfma_f32_16x16x32_bf16(BF8(HALFW(11, 0)), BF8(ub), S[3], 0, 0, 0);
#pragma unroll
            for (int t = 0; t < 4; ++t) { const LAS unsigned char* pp = sl + 11 * 1024 + (8 * t + 2 * q) * 16 + 8; const f32x2 p0 = *(const LAS f32x2*)pp, p1 = *(const LAS f32x2*)(pp + 16);
                S[t] = S[t] * (f32x4){p0.x, p0.y, p1.x, p1.y}; }
            const int base = chunk_base_row(b, d, n);
#pragma unroll
            for (int r = 0; r < 4; ++r) { const int st = 4 * q + r; Yd[(size_t)(base + (d ? 15 - st : st)) * RWW + h * 64 + ig * 16 + n15] = Y[r]; }
            asm volatile("s_waitcnt lgkmcnt(0)" ::: "memory");
#undef FULLP
#undef HALFL
#undef HALFW
        }
        __builtin_amdgcn_s_barrier();
    }
#undef ISSUE
#undef BF8
    asm volatile("s_waitcnt vmcnt(0)" ::: "memory");
    __syncthreads();
}

__device__ __forceinline__ void subset_arrive(unsigned* ctr) {
    asm volatile("s_waitcnt vmcnt(0)" ::: "memory"); __syncthreads();
    if (threadIdx.x == 0) { __builtin_amdgcn_fence(__ATOMIC_RELEASE, "agent"); asm volatile("s_waitcnt vmcnt(0)" ::: "memory"); __hip_atomic_fetch_add(ctr, 1u, __ATOMIC_RELAXED, __HIP_MEMORY_SCOPE_AGENT); }
}
__device__ __forceinline__ void subset_wait(unsigned* ctr, unsigned n) {
    if (threadIdx.x == 0) { unsigned sp = 0;
        while (__hip_atomic_load(ctr, __ATOMIC_RELAXED, __HIP_MEMORY_SCOPE_AGENT) < n) { __builtin_amdgcn_s_sleep(4); if (++sp > (1u << 24)) break; }
        __builtin_amdgcn_fence(__ATOMIC_ACQUIRE, "agent"); asm volatile("s_waitcnt vmcnt(0)" ::: "memory"); }
    __syncthreads();
}
__device__ __forceinline__ void ph_scan_hyena(Frame& F0, int j, int i) { Frame F = F0; LAUNDER(F);
    unsigned* ctl = (unsigned*)(F.ws + WS_CTL) + 512 + 256 * i;
    LAS f32x2* TWL = (LAS f32x2*)(F.lds + 67584); LAS int* tick = (LAS int*)(F.lds + 133120 + 256);
    const float* hyb = INP(I_HYB) + (size_t)j * 1024;
    const bool split = F.G >= 128; const int nf = split ? F.G - 64 : F.G;
    TP_BEGIN();
    if (split && F.vcu < 64) { scan_unit(F, F.vcu); TP_END(6); }
    else {
        if (!split) { for (int sc = F.vcu; sc < 64; sc += F.G) scan_unit(F, sc); }
        const int id = split ? F.vcu - 64 : F.vcu;
        load_tw<13>(F, TWL); __syncthreads();
        for (int it = id; it < 512; it += nf) fftk_item<13, 1>(F, WSP(float, WS_KCL), WSP(f32x4, WS_KSPL), it);
        __syncthreads(); load_tw<9>(F, TWL); __syncthreads();
        for (int it = id; it < 64; it += nf) fftk_item<9, 8>(F, WSP(float, WS_KCC), WSP(f32x4, WS_KSPC), it);
        subset_arrive(ctl);
    }
    subset_wait(ctl, (unsigned)nf);
    int cur_n = 0;
    for (;;) {
        __syncthreads();
        if (F.tid == 0) tick[0] = (int)__hip_atomic_fetch_add(ctl + 64, 1u, __ATOMIC_RELAXED, __HIP_MEMORY_SCOPE_AGENT);
        __syncthreads();
        const int it = tick[0];
        if (it >= 1024 + 128) break;
        const int want = it < 1024 ? 13 : 9;
        if (cur_n != want) { __syncthreads(); if (want == 13) load_tw<13>(F, TWL); else load_tw<9>(F, TWL); cur_n = want; __syncthreads(); }
        if (it < 1024) hyena_item<13, 1>(F, WSP(float, WS_UTL), WSP(f32x4, WS_KSPL), WSP(float, WS_HYTL), hyb, INP(I_CONVW) + (size_t)j * 3 * HYC, INP(I_CONVB) + (size_t)j * HYC, it);
        else hyena_item<9, 8>(F, WSP(float, WS_UTC), WSP(f32x4, WS_KSPC), WSP(float, WS_HYTC), hyb, INP(I_CONVW) + (size_t)j * 3 * HYC, INP(I_CONVB) + (size_t)j * HYC, it - 1024);
    }
}
__device__ __forceinline__ void ph_mod2(Frame& F0, int i, const bf16* wout_t) { Frame F = F0; LAUNDER(F);
    const bool need_ctx = i + 1 < DEPTH; const bool split = need_ctx && F.G >= 64;
    unsigned* cctr = (unsigned*)(F.ws + WS_CTL) + 2048 + 64 * i;
    if (need_ctx && (!split || F.vcu < 16)) {
        for (int uu = split ? F.vcu : F.vcu; uu < 16; uu += split ? 16 : F.G) {
            pg8::Gemm g{WSP(bf16, WS_CAT), wout_t, TT, DM, DM, nullptr}; pg8::OneUnit S{64 + (uu >> 2), uu & 3};
            pg8::EpiResGate E{WSP(float, WS_X), WSP(float, WS_MODS) + (size_t)i * 5 * 6144}; pg8::gemm_phase<pg8::EpiResGate, pg8::OneUnit, true, true>(F.lds, g, S, E);
        }
        __syncthreads();
        if (split) subset_arrive(cctr);
    }
    LAS float* RL = (LAS float*)F.lds;
    const float* router = INP(I_ROUTER) + (size_t)i * DM * NE;
    for (int idx = F.tid; idx < DM * NE; idx += NTHR) { const int c = idx >> 4, e = idx & 15; RL[e * 1024 + c] = router[idx]; }
    __syncthreads();
    const float* mods = WSP(float, WS_MODS) + (size_t)i * 5 * 6144; const float* g = INP(I_NORMG) + (size_t)(i * 2 + 1) * DM;
#pragma unroll 1
    for (int part = 0; part < 2; ++part) {
    int r0, r1, gwp, ngwp;
    if (part == 0) { r0 = 0; r1 = TLAT; if (split) { if (F.vcu < 16) continue; gwp = (F.vcu - 16) * NWAVES + F.wave; ngwp = (F.G - 16) * NWAVES; } else { gwp = F.gw; ngwp = F.NGW; } }
    else { if (!need_ctx) break; if (split) subset_wait(cctr, 16u); else __syncthreads(); r0 = TLAT; r1 = TT; gwp = F.gw; ngwp = F.NGW; }
    const int nrows = r1;
    f32x4 vn[4];
    if (r0 + gwp < nrows) {
#pragma unroll
        for (int jj = 0; jj < 4; ++jj) vn[jj] = ((const f32x4*)(WSP(float, WS_X) + (size_t)(r0 + gwp) * DM))[64 * jj + F.lane]; }
    for (int row = r0 + gwp; row < nrows; row += ngwp) {
        f32x4 v[4], h[4];
#pragma unroll
        for (int jj = 0; jj < 4; ++jj) v[jj] = vn[jj];
        if (row + ngwp < nrows) {
#pragma unroll
            for (int jj = 0; jj < 4; ++jj) vn[jj] = ((const f32x4*)(WSP(float, WS_X) + (size_t)(row + ngwp) * DM))[64 * jj + F.lane]; }
        const int s = row_s(row);
        mod_row_store(v, g, mods + s * 6144 + 3 * 1024, mods + s * 6144 + 4 * 1024, WSP(bf16, WS_HA) + (size_t)row * DM, F.lane, h);
        float mylg = 0.f;
#pragma unroll 1
        for (int g4 = 0; g4 < 4; ++g4) {
            float a4[4];
#pragma unroll
            for (int k = 0; k < 4; ++k) { float a = 0.f;
#pragma unroll
                for (int jj = 0; jj < 4; ++jj) { const f32x4 r4 = ((const LAS f32x4*)(RL + (4 * g4 + k) * 1024))[64 * jj + F.lane]; a += (h[jj].x * r4.x + h[jj].y * r4.y) + (h[jj].z * r4.z + h[jj].w * r4.w); }
                a4[k] = a; }
#pragma unroll
            for (int k = 0; k < 4; ++k) a4[k] += dpp_f<DPP_XOR1>(a4[k]);
#pragma unroll
            for (int k = 0; k < 4; ++k) a4[k] += dpp_f<DPP_XOR2>(a4[k]);
#pragma unroll
            for (int k = 0; k < 4; ++k) a4[k] += dpp_f<DPP_HMIRROR>(a4[k]);
#pragma unroll
            for (int k = 0; k < 4; ++k) a4[k] += dpp_f<DPP_MIRROR>(a4[k]);
#pragma unroll
            for (int k = 0; k < 4; ++k) if ((F.lane & 15) == 4 * g4 + k) mylg = a4[k];
        }
        mylg += __builtin_bit_cast(float, __builtin_amdgcn_ds_swizzle(__builtin_bit_cast(int, mylg), 0x401F));
        { auto rr = __builtin_amdgcn_permlane32_swap(__float_as_uint(mylg), __float_as_uint(mylg), false, false); const unsigned lo_ = rr[0], hi_ = rr[1]; mylg = __uint_as_float(lo_) + __uint_as_float(hi_); }
        if (F.lane >= 16) mylg = -1e30f;
        const float mx = max16_f(mylg);
        const float ex = expf(mylg - mx); const float den = sum16_f(ex);
        const float mine = ex / den;
        if (F.lane < 16) WSP(float, WS_AFF)[(size_t)row * 16 + F.lane] = mine;
    }
    }
}

__device__ __forceinline__ int block_excl_scan(Frame& F, int v, LAS int* sc, int& total) {
    LAS int* cnt = sc + 16;
    __syncthreads();
    cnt[F.tid] = v;
    const int ws = wave_sum_i(v);
    if (F.lane == 0) sc[F.wave] = ws;
    __syncthreads();
    int base = 0, tot = 0;
#pragma unroll
    for (int w = 0; w < NWAVES; ++w) { const int t = sc[w]; if (w < F.wave) base += t; tot += t; }
    int pre = 0;
    for (int k = 0; k < F.lane; ++k) pre += cnt[F.wave * 64 + k];
    total = tot; return base + pre;
}
__device__ __forceinline__ int block_sum_i(Frame& F, int v, LAS int* sc) {
    v = wave_sum_i(v);
    __syncthreads(); if (F.lane == 0) sc[F.wave] = v; __syncthreads();
    int t = 0;
#pragma unroll
    for (int w = 0; w < NWAVES; ++w) t += sc[w];
    return t;
}
__device__ __forceinline__ void topk_item(Frame& F, int set, int e) {
    LAS int* sc = (LAS int*)(F.lds + 133120);
    const bool lat = set < 4; const int L = lat ? SEQ : CTXL, cap = lat ? 512 : 32; const int rbase = lat ? set * SEQ : TLAT + (set - 4) * CTXL;
    const int sbase = e * EROWS + (lat ? set * 512 : 2048 + (set - 4) * 32);
    const float* aff = WSP(float, WS_AFF);
    unsigned key[8];
#pragma unroll
    for (int q = 0; q < 8; ++q) { const int l = F.tid * 8 + q; key[q] = l < L ? __builtin_bit_cast(unsigned, aff[(size_t)(rbase + l) * 16 + e]) : 0u; }
    unsigned thr = 0u;
    for (int bit = 30; bit >= 0; --bit) {
        const unsigned cand = thr | (1u << bit); int cnt = 0;
#pragma unroll
        for (int q = 0; q < 8; ++q) cnt += (key[q] >= cand) ? 1 : 0;
        if (block_sum_i(F, cnt, sc) >= cap) thr = cand;
    }
    int ngt = 0, neq = 0;
#pragma unroll
    for (int q = 0; q < 8; ++q) { ngt += key[q] > thr ? 1 : 0; neq += (key[q] == thr && (F.tid * 8 + q) < L) ? 1 : 0; }
    int tot_gt, tot_eq; const int bgt = block_excl_scan(F, ngt, sc, tot_gt); const int beq = block_excl_scan(F, neq, sc, tot_eq);
    const int need_eq = cap - tot_gt; int rg = bgt, re = beq;
    int* slotmap = WSP(int, WS_SLOT); int* idxo = WSP(int, WS_IDX); float* gate = WSP(float, WS_GATE);
#pragma unroll
    for (int q = 0; q < 8; ++q) { const int l = F.tid * 8 + q; if (l < L) {
        int slot = -1;
        if (key[q] > thr) { slot = rg; ++rg; } else if (key[q] == thr) { if (re < need_eq) slot = tot_gt + re; ++re; }
        slotmap[(size_t)(rbase + l) * 16 + e] = slot;
        if (slot >= 0) { idxo[sbase + slot] = rbase + l; gate[sbase + slot] = __builtin_bit_cast(float, key[q]); } } }
    if (set == 0) for (int p = F.tid; p < EROWS - 2176; p += NTHR) { idxo[e * EROWS + 2176 + p] = 0; gate[e * EROWS + 2176 + p] = 0.f; }
    __syncthreads();
}
__device__ __forceinline__ void ph_topk(Frame& F0, int i) { Frame F = F0; LAUNDER(F);
    const bool filt = (i == 1);
    const bool filt_first = filt && (F.vcu & 1) != 0;
    if (filt_first) { ph_filters(F, 1); __syncthreads(); }
    TP_BEGIN();
    for (int it = F.vcu; it < (i + 1 < DEPTH ? 128 : 64); it += F.G) topk_item(F, it >> 4, it & 15);
    TP_END(4);
    LAS float* scr = (LAS float*)(F.lds + F.wave * 16640);
    const float* w1 = INP(I_MW1) + (size_t)i * NE * DM * FF; const float* w3 = INP(I_MW3) + (size_t)i * NE * DM * FF; const float* w2 = INP(I_MW2) + (size_t)i * NE * FF * DM;
    for (int it = F.gw; it < 3 * NE * 256; it += F.NGW) {
        const int which = it / (NE * 256), r = it % (NE * 256), e = r >> 8, item = r & 255;
        if (which == 0) transpose_item(w1 + (size_t)e * DM * FF, DM, FF, WSP(bf16, WS_W13), RowW13{e, 0}, scr, item, F.lane);
        else if (which == 1) transpose_item(w3 + (size_t)e * DM * FF, DM, FF, WSP(bf16, WS_W13), RowW13{e, 1}, scr, item, F.lane);
        else transpose_item(w2 + (size_t)e * FF * DM, FF, DM, WSP(bf16, WS_W2), RowId{e * 1024}, scr, item, F.lane);
    }
    TP_END(5);
    if (filt && !filt_first) { __syncthreads(); ph_filters(F, 1); }
}
__device__ __forceinline__ void ph_gather(Frame& F0, bool need_ctx) { Frame F = F0; LAUNDER(F);
    const int* idx = WSP(int, WS_IDX); const bf16* HA = WSP(bf16, WS_HA); bf16* XG = WSP(bf16, WS_XG);
    for (int r = F.gw; r < NE * EROWS; r += F.NGW) {
        if (!need_ctx && (r % EROWS) >= 2048) continue;
        const int src = idx[r]; const v4u* s = (const v4u*)(HA + (size_t)src * DM); v4u* d = (v4u*)(XG + (size_t)r * DM);
        d[F.lane] = s[F.lane]; d[64 + F.lane] = s[64 + F.lane];
    }
}
__device__ __forceinline__ void ph_combine(Frame& F0, int i) { Frame F = F0; LAUNDER(F);
    const int* slotmap = WSP(int, WS_SLOT); const bf16* YB = WSP(bf16, WS_YB);
    const float* mods = WSP(float, WS_MODS) + (size_t)i * 5 * 6144;
    const int nrows_c = i + 1 < DEPTH ? TT : TLAT;
    int slotn = -1; f32x4 xn[4];
    if (F.gw < nrows_c) { slotn = F.lane < 16 ? slotmap[(size_t)F.gw * 16 + F.lane] : -1;
#pragma unroll
        for (int jj = 0; jj < 4; ++jj) xn[jj] = ((const f32x4*)(WSP(float, WS_X) + (size_t)F.gw * DM))[64 * jj + F.lane]; }
    for (int row = F.gw; row < nrows_c; row += F.NGW) {
        f32x4 acc[4], xc[4];
#pragma unroll
        for (int jj = 0; jj < 4; ++jj) { acc[jj] = (f32x4){0.f, 0.f, 0.f, 0.f}; xc[jj] = xn[jj]; }
        const int myslot = slotn;
        if (row + F.NGW < nrows_c) { slotn = F.lane < 16 ? slotmap[(size_t)(row + F.NGW) * 16 + F.lane] : -1;
#pragma unroll
            for (int jj = 0; jj < 4; ++jj) xn[jj] = ((const f32x4*)(WSP(float, WS_X) + (size_t)(row + F.NGW) * DM))[64 * jj + F.lane]; }
        unsigned long long sel = __ballot(myslot >= 0);
        const int sbase = row < TLAT ? (row >> 12) * 512 : 2048 + ((row - TLAT) >> 8) * 32;
        while (sel) {
            const int e = __builtin_ctzll(sel); sel &= sel - 1;
            const int sl = __builtin_amdgcn_readlane(myslot, e);
            const v2u* yr = (const v2u*)(YB + (size_t)(e * EROWS + sbase + sl) * DM);
#pragma unroll
            for (int jj = 0; jj < 4; ++jj) { const v2u w = yr[64 * jj + F.lane];
                acc[jj].x += __builtin_bit_cast(float, w.x << 16); acc[jj].y += __builtin_bit_cast(float, w.x & 0xffff0000u);
                acc[jj].z += __builtin_bit_cast(float, w.y << 16); acc[jj].w += __builtin_bit_cast(float, w.y & 0xffff0000u); }
        }
#ifdef ABL_MOE
#pragma unroll
        for (int jj = 0; jj < 4; ++jj) acc[jj] = acc[jj] * 0.0f;
#endif
        const int s = row_s(row); f32x4 v[4], h[4];
        float* xr = WSP(float, WS_X) + (size_t)row * DM;
#pragma unroll
        for (int jj = 0; jj < 4; ++jj) { const f32x4 gm = ((const f32x4*)(mods + s * 6144 + 5 * 1024))[64 * jj + F.lane]; v[jj] = xc[jj] + gm * acc[jj]; ((f32x4*)xr)[64 * jj + F.lane] = v[jj]; }
        if (i + 1 < DEPTH) {
            const float* m2 = WSP(float, WS_MODS) + (size_t)(i + 1) * 5 * 6144;
            mod_row_store(v, INP(I_NORMG) + (size_t)((i + 1) * 2) * DM, m2 + s * 6144, m2 + s * 6144 + 1024, WSP(bf16, WS_HA) + (size_t)row * DM, F.lane, h);
        } else if (row < TLAT) {
            float ss = 0.f;
#pragma unroll
            for (int jj = 0; jj < 4; ++jj) ss += (v[jj].x * v[jj].x + v[jj].y * v[jj].y) + (v[jj].z * v[jj].z + v[jj].w * v[jj].w);
            const float rstd = 1.0f / sqrtf(wave_sum(ss) * (1.0f / 1024.0f) + 1e-6f);
#pragma unroll
            for (int jj = 0; jj < 4; ++jj) ((f32x4*)(F.out + (size_t)row * DM))[64 * jj + F.lane] = v[jj] * rstd * ((const f32x4*)INP(I_FINALG))[64 * jj + F.lane];
        }
    }
}
__device__ __forceinline__ void ph_rope(Frame& F0) { Frame F = F0; LAUNDER(F);
    const float* P = WSP(float, WS_P); bf16* QB = WSP(bf16, WS_QB); bf16* KB = WSP(bf16, WS_KB); bf16* VB = WSP(bf16, WS_VB);
    const int axis = (F.lane >> 1) & 1, half = F.lane & 1;
    float inv[16];
#pragma unroll
    for (int f = 0; f < 16; ++f) inv[f] = exp2f(-(float)f * (13.287712379549449f / 16.0f));
    for (int row = F.gw; row < TT; row += F.NGW) {
        const bool lat = row < TLAT; const int b = lat ? (row >> 12) : ((row - TLAT) >> 8); const int l = lat ? (row & (SEQ - 1)) : ((row - TLAT) & (CTXL - 1));
        const size_t krow = (size_t)b * KSEQ + (lat ? CTXL + l : l);
        float cs[16], sn[16];
        if (lat) { const float pos = (float)(axis ? (l & 63) : (l >> 6));
#pragma unroll
            for (int f = 0; f < 16; ++f) sincosf(pos * inv[f], &sn[f], &cs[f]); }
#pragma unroll
        for (int part = 0; part < 3; ++part) {
            float x[16];
            const float* src = P + (size_t)row * QKVC + part * 1024 + 16 * F.lane;
#pragma unroll
            for (int q = 0; q < 4; ++q) { const f32x4 t = *(const f32x4*)(src + 4 * q); x[4 * q] = t.x; x[4 * q + 1] = t.y; x[4 * q + 2] = t.z; x[4 * q + 3] = t.w; }
            if (part < 2 && lat) {
#pragma unroll
                for (int f = 0; f < 16; ++f) { const float o = xor1_f(x[f]);
                    x[f] = half ? (x[f] * cs[f] + o * sn[f]) : (x[f] * cs[f] - o * sn[f]); }
            }
            v4u w0, w1; w0.x = pk2(x[0], x[1]); w0.y = pk2(x[2], x[3]); w0.z = pk2(x[4], x[5]); w0.w = pk2(x[6], x[7]); w1.x = pk2(x[8], x[9]); w1.y = pk2(x[10], x[11]); w1.z = pk2(x[12], x[13]); w1.w = pk2(x[14], x[15]);
            bf16* dst = part == 0 ? QB + (size_t)row * DM : (part == 1 ? KB + krow * DM : VB + krow * DM);
            *(v4u*)(dst + 16 * F.lane) = w0; *(v4u*)(dst + 16 * F.lane + 8) = w1;
        }
    }
}

namespace att {
using s16x4 = __attribute__((ext_vector_type(4))) short;
using f32x16 = __attribute__((ext_vector_type(16))) float;
using u32x4 = __attribute__((ext_vector_type(4))) unsigned;
constexpr int DQ = 64, DV = 128, NW = 8, QBLK = 32, KVBLK = 64, LD = 1024;
constexpr float SCALE = 0.125f, THR = 8.f;
#ifndef ATT_SDEPTH
#define ATT_SDEPTH 1
#endif
constexpr int SDEPTH = ATT_SDEPTH;
constexpr size_t SHM_V = KVBLK * DV * 2, SHM_K = KVBLK * DQ * 2, SHM_ATTN = 2 * SHM_V + 2 * SHM_K + NW * 64 * 4;
#define KSWZ(row, colB) ((row) * 128 + ((colB) ^ (((row) & 7) << 4)))
#define SBAR() __builtin_amdgcn_sched_barrier(0)
__device__ __forceinline__ int crow(int r, int hi) { return (r & 3) + 8 * (r >> 2) + 4 * hi; }
__device__ __forceinline__ unsigned cvtpk(float lo, float hi) { unsigned r; asm volatile("v_cvt_pk_bf16_f32 %0, %1, %2" : "=v"(r) : "v"(lo), "v"(hi)); return r; }
__device__ __forceinline__ void partialSM(f32x16& p0, f32x16& p1, float& m_reg, float& mn, float& alpha) {
  constexpr float C = SCALE * 1.4426950408889634f;
  float pmax = p0[0]; for (int r = 1; r < 16; ++r) pmax = fmaxf(pmax, p0[r]); for (int r = 0; r < 16; ++r) pmax = fmaxf(pmax, p1[r]);
  { auto rr = __builtin_amdgcn_permlane32_swap(__float_as_uint(pmax), __float_as_uint(pmax), false, false);
    pmax = fmaxf(__uint_as_float(rr[0]), __uint_as_float(rr[1])); }
  if (__builtin_expect(__all(pmax - m_reg <= THR / SCALE), 1)) { mn = m_reg; alpha = 1.f; }
  else { mn = fmaxf(m_reg, pmax); alpha = __builtin_amdgcn_exp2f((m_reg - mn) * C); m_reg = mn; }
  float mnC = -mn * C;
  for (int r = 0; r < 16; ++r) p0[r] = fmaf(p0[r], C, mnC); for (int r = 0; r < 16; ++r) p1[r] = fmaf(p1[r], C, mnC);
  for (int r = 0; r < 16; ++r) p0[r] = __builtin_amdgcn_exp2f(p0[r]);
}
__device__ __forceinline__ void finishSM(f32x16& p0, f32x16& p1, float alpha, float& l_reg, bf16x8& pa0, bf16x8& pa1, bf16x8& pa2, bf16x8& pa3) {
  for (int r = 0; r < 16; ++r) p1[r] = __builtin_amdgcn_exp2f(p1[r]);
  float ps = 0; for (int r = 0; r < 16; ++r) ps += p0[r]; for (int r = 0; r < 16; ++r) ps += p1[r];
  { auto rr = __builtin_amdgcn_permlane32_swap(__float_as_uint(ps), __float_as_uint(ps), false, false);
    ps = __uint_as_float(rr[0]) + __uint_as_float(rr[1]); }
  l_reg = l_reg * alpha + ps;
#define PK4(P, BASE, OUT) do { unsigned a0 = cvtpk(P[BASE + 0], P[BASE + 1]), a1 = cvtpk(P[BASE + 2], P[BASE + 3]);   \
    unsigned b0 = cvtpk(P[BASE + 4], P[BASE + 5]), b1 = cvtpk(P[BASE + 6], P[BASE + 7]);                              \
    auto r0 = __builtin_amdgcn_permlane32_swap(a0, b0, false, false); auto r1 = __builtin_amdgcn_permlane32_swap(a1, b1, false, false); \
    u32x4 w = {r0[0], r1[0], r0[1], r1[1]}; OUT = *reinterpret_cast<bf16x8*>(&w); } while (0)
  PK4(p0, 0, pa0); PK4(p0, 8, pa1); PK4(p1, 0, pa2); PK4(p1, 8, pa3);
#undef PK4
}
__device__ __forceinline__ void qkt(f32x16& p0, f32x16& p1, const bf16* Ks, const bf16x8* qr, int r32, int hi) {
  p0 = f32x16{}; p1 = f32x16{};
#pragma unroll
  for (int d0 = 0; d0 < 4; ++d0) { int cb = (d0 * 16 + hi * 8) * 2;
    bf16x8 b0 = *reinterpret_cast<const bf16x8*>((const char*)Ks + KSWZ(r32, cb));
    bf16x8 b1 = *reinterpret_cast<const bf16x8*>((const char*)Ks + KSWZ(32 + r32, cb));
    p0 = __builtin_amdgcn_mfma_f32_32x32x16_bf16(b0, qr[d0], p0, 0, 0, 0);
    p1 = __builtin_amdgcn_mfma_f32_32x32x16_bf16(b1, qr[d0], p1, 0, 0, 0); }
}
__device__ __forceinline__ int v_st(int k, int c) { const int kk = (k & ~0xC) | ((k & 4) << 1) | ((k & 8) >> 1); return ((kk >> 3) * 4 + (c >> 5)) * 512 + ((kk & 7) * 32 + (c & 31)) * 2; }
__device__ __forceinline__ int v_rd_base(int lane) { return ((lane & 3) << 3) | (((lane >> 2) & 3) << 6) | (((lane >> 4) & 1) << 5) | (((lane >> 5) & 1) << 8); }
constexpr int v_rd_off(int d0, int ks, int half) { return d0 * 512 + ks * 4096 + half * 2048; }
template <int OFF> __device__ __forceinline__ s16x4 tr_read(int vb) {
  s16x4 r; asm volatile("ds_read_b64_tr_b16 %0, %1 offset:%2" : "=&v"(r) : "v"(vb), "i"(OFF) : "memory"); return r;
}
template <int D0> __device__ __forceinline__ void pv_one(f32x16& od, int vb, bf16x8 pa0, bf16x8 pa1, bf16x8 pa2, bf16x8 pa3) {
  const s16x4 l0 = tr_read<v_rd_off(D0, 0, 0)>(vb), h0 = tr_read<v_rd_off(D0, 0, 1)>(vb), l1 = tr_read<v_rd_off(D0, 1, 0)>(vb), h1 = tr_read<v_rd_off(D0, 1, 1)>(vb);
  const s16x4 l2 = tr_read<v_rd_off(D0, 2, 0)>(vb), h2 = tr_read<v_rd_off(D0, 2, 1)>(vb), l3 = tr_read<v_rd_off(D0, 3, 0)>(vb), h3 = tr_read<v_rd_off(D0, 3, 1)>(vb);
  asm volatile("s_waitcnt lgkmcnt(0)" ::: "memory"); SBAR();
#define PK(L, H) (bf16x8){L[0], L[1], L[2], L[3], H[0], H[1], H[2], H[3]}
  od = __builtin_amdgcn_mfma_f32_32x32x16_bf16(pa0, PK(l0, h0), od, 0, 0, 0);
  od = __builtin_amdgcn_mfma_f32_32x32x16_bf16(pa1, PK(l1, h1), od, 0, 0, 0);
  od = __builtin_amdgcn_mfma_f32_32x32x16_bf16(pa2, PK(l2, h2), od, 0, 0, 0);
  od = __builtin_amdgcn_mfma_f32_32x32x16_bf16(pa3, PK(l3, h3), od, 0, 0, 0);
#undef PK
}
__device__ __forceinline__ void pv_d0(f32x16* o, int vb, bf16x8 pa0, bf16x8 pa1, bf16x8 pa2, bf16x8 pa3) {
  pv_one<0>(o[0], vb, pa0, pa1, pa2, pa3); pv_one<1>(o[1], vb, pa0, pa1, pa2, pa3); pv_one<2>(o[2], vb, pa0, pa1, pa2, pa3); pv_one<3>(o[3], vb, pa0, pa1, pa2, pa3);
}
struct Fin { float lam, scale; const float* sg; bf16* cat; };
template <int MODE>
__device__ __forceinline__ void attn_body(const bf16* __restrict__ Qb, const bf16* __restrict__ Kh, const bf16* __restrict__ Vh, float* Ob, int ldo, int seq, char* lds, const Fin fin) {
  int tid_ = threadIdx.x; asm volatile("" : "+v"(tid_));
  const int tid = tid_, wid = tid >> 6, lane = tid & 63, r32 = lane & 31, hi = lane >> 5;
  bf16* V_lds = (bf16*)lds; bf16* K_lds = (bf16*)(lds + 2 * SHM_V);
  float* ws = (float*)(lds + 2 * SHM_V + 2 * SHM_K) + wid * 64; float* li_l = ws; float* al_l = ws + 32;
  float m_reg = -1e30f, l_reg = 0; f32x16 o[4] = {}; bf16x8 qr[4];
  const bf16* Qw = Qb + (long)(wid * QBLK + r32) * LD + hi * 8;
#pragma unroll
  for (int d0 = 0; d0 < 4; ++d0) qr[d0] = *reinterpret_cast<const bf16x8*>(Qw + d0 * 16);
  const int sr = tid >> 4, sc = (tid & 15) * 8, vst0 = v_st(sr, sc), vst1 = v_st(32 + sr, sc);
  const int kr = tid >> 3, kc = (tid & 7) * 8;
  const int vb0 = (int)(uintptr_t)V_lds + v_rd_base(lane);
  struct { bf16x8 vs0, vs1, ks0; } sr_[SDEPTH];
#define SLOAD(i, k0) do { sr_[i].vs0 = *reinterpret_cast<const bf16x8*>(&Vh[(long)((k0) + sr) * LD + sc]); sr_[i].vs1 = *reinterpret_cast<const bf16x8*>(&Vh[(long)((k0) + 32 + sr) * LD + sc]); \
    sr_[i].ks0 = *reinterpret_cast<const bf16x8*>(&Kh[(long)((k0) + kr) * LD + kc]); } while (0)
#define SWRITE(b, i) do { *(bf16x8*)((char*)V_lds + (b) * SHM_V + vst0) = sr_[i].vs0;          \
    *(bf16x8*)((char*)V_lds + (b) * SHM_V + vst1) = sr_[i].vs1;               \
    *(bf16x8*)((char*)K_lds + (b) * SHM_K + KSWZ(kr, kc * 2)) = sr_[i].ks0; } while (0)
#define SWAIT() do { if constexpr (SDEPTH == 2) asm volatile("s_waitcnt vmcnt(3)" ::: "memory"); else asm volatile("s_waitcnt vmcnt(0)" ::: "memory"); } while (0)
#define RESC(a) do { if (__any((a) < 1.f)) { if (hi == 0) al_l[r32] = (a); asm volatile("s_waitcnt lgkmcnt(0)" ::: "memory"); \
    for (int d = 0; d < 4; ++d) for (int r = 0; r < 16; ++r) o[d][r] *= al_l[crow(r, hi)]; } } while (0)
  f32x16 pA0, pA1, pB0, pB1; float mnA, mnB, alA, alB; bf16x8 pa0, pa1, pa2, pa3; const int NT = seq / KVBLK;
  constexpr int SE = 0, SO = SDEPTH - 1;
  SLOAD(SE, 0); asm volatile("s_waitcnt vmcnt(0)" ::: "memory"); SWRITE(0, SE); __syncthreads();
  qkt(pA0, pA1, K_lds, qr, r32, hi); partialSM(pA0, pA1, m_reg, mnA, alA);
  SLOAD(SO, KVBLK); if constexpr (SDEPTH == 2) { if (2 < NT) SLOAD(SE, 2 * KVBLK); }
  SWAIT(); SWRITE(1, SO); __syncthreads();
  for (int j = 1; j + 1 < NT; j += 2) {
    SBAR(); qkt(pB0, pB1, (bf16*)((char*)K_lds + SHM_K), qr, r32, hi);
    finishSM(pA0, pA1, alA, l_reg, pa0, pa1, pa2, pa3); SBAR();
    SLOAD(SO, (j + SDEPTH) * KVBLK); SBAR();
    pv_d0(o, vb0, pa0, pa1, pa2, pa3); partialSM(pB0, pB1, m_reg, mnB, alB);
    __syncthreads(); SWAIT(); SWRITE(0, SE);
    RESC(alB); __syncthreads();
    SBAR(); qkt(pA0, pA1, K_lds, qr, r32, hi);
    finishSM(pB0, pB1, alB, l_reg, pa0, pa1, pa2, pa3); SBAR();
    if (SDEPTH == 1 || j + 3 < NT) SLOAD(SE, (j + 1 + SDEPTH) * KVBLK); SBAR();
    pv_d0(o, vb0 + (int)SHM_V, pa0, pa1, pa2, pa3); partialSM(pA0, pA1, m_reg, mnA, alA);
    __syncthreads(); SWAIT(); SWRITE(1, SO);
    RESC(alA); __syncthreads();
  }
  SBAR(); qkt(pB0, pB1, (bf16*)((char*)K_lds + SHM_K), qr, r32, hi);
  finishSM(pA0, pA1, alA, l_reg, pa0, pa1, pa2, pa3); SBAR();
  pv_d0(o, vb0, pa0, pa1, pa2, pa3); partialSM(pB0, pB1, m_reg, mnB, alB);
  __syncthreads(); RESC(alB);
  finishSM(pB0, pB1, alB, l_reg, pa0, pa1, pa2, pa3); SBAR();
  pv_d0(o, vb0 + (int)SHM_V, pa0, pa1, pa2, pa3);
  if (hi == 0) li_l[r32] = l_reg; asm volatile("s_waitcnt lgkmcnt(0)" ::: "memory");
  float rli[16];
#pragma unroll
  for (int r = 0; r < 16; ++r) rli[r] = __builtin_amdgcn_rcpf(li_l[crow(r, hi)]);
  float* Ow = Ob + (long)(wid * QBLK) * ldo;
  if constexpr (MODE == 0) {
#pragma unroll
    for (int r = 0; r < 16; ++r) { int orow = crow(r, hi);
      for (int d0 = 0; d0 < 4; ++d0) Ow[(long)orow * ldo + d0 * 32 + r32] = o[d0][r] * rli[r]; }
  } else {
    float sgv[4];
#pragma unroll
    for (int d0 = 0; d0 < 4; ++d0) sgv[d0] = fin.sg[d0 * 32 + r32] * fin.scale;
    bf16* Cw = fin.cat + (long)(wid * QBLK) * 1024;
#pragma unroll
    for (int r = 0; r < 16; ++r) { const int orow = crow(r, hi); float ss = 0.f;
#pragma unroll
      for (int d0 = 0; d0 < 4; ++d0) { const float dv = Ow[(long)orow * ldo + d0 * 32 + r32] - fin.lam * (o[d0][r] * rli[r]); o[d0][r] = dv; ss += dv * dv; }
      ss = sum16_f(ss); ss += __builtin_bit_cast(float, __builtin_amdgcn_ds_swizzle(__builtin_bit_cast(int, ss), 0x401F));
      const float sc = 1.0f / sqrtf(ss * (1.0f / 128.0f) + 1e-5f);
#pragma unroll
      for (int d0 = 0; d0 < 4; ++d0) Cw[(long)orow * 1024 + d0 * 32 + r32] = (bf16)f2bf(o[d0][r] * sc * sgv[d0]); }
  }
  __syncthreads();
#undef SLOAD
#undef SWRITE
#undef SWAIT
#undef RESC
}
#undef KSWZ
#undef SBAR
}

__device__ __forceinline__ void ph_attn(Frame& F0, int i, bool need_ctx) { Frame F = F0; LAUNDER(F);
    const bf16* QB = WSP(bf16, WS_QB); const bf16* KB = WSP(bf16, WS_KB); const bf16* VB = WSP(bf16, WS_VB); float* OB = WSP(float, WS_OB); bf16* CAT = WSP(bf16, WS_CAT);
    const int j = i >> 1; const float* lv = INP(I_LAM) + (size_t)j * 256;
    const float linit = (i == 1) ? 0.35550906759096934f : 0.5560582041556406f;
    const float d1 = wave_sum(lv[F.lane] * lv[64 + F.lane]), d2 = wave_sum(lv[128 + F.lane] * lv[192 + F.lane]);
    const float lam = expf(d1) - expf(d2) + linit;
    const int nun = 512 + (need_ctx ? 32 : 0);
    for (int u = F.vcu; u < nun; u += F.G) {
        const bool lat = u < 512; const int uu = lat ? u : u - 512;
        const int qb = lat ? (uu & 15) : 0, h = lat ? ((uu >> 4) & 7) : (uu & 7), b = lat ? (uu >> 7) : (uu >> 3);
        const size_t qrow = lat ? (size_t)b * SEQ + qb * 256 : (size_t)TLAT + b * CTXL; const int seq = lat ? KSEQ : CTXL;
        const bf16* kb = KB + (size_t)b * KSEQ * DM + h * 128; const bf16* vb = VB + (size_t)b * KSEQ * DM + h * 128;
        const att::Fin fin{lam, 1.0f - linit, INP(I_SUBLN) + (size_t)j * 128, CAT + qrow * DM + h * 128};
        att::attn_body<0>(QB + qrow * DM + h * 128, kb, vb, OB + qrow * DM + h * 128, DM, seq, (char*)F.ldsg, fin);
        att::attn_body<1>(QB + qrow * DM + h * 128 + 64, kb + 64, vb, OB + qrow * DM + h * 128, DM, seq, (char*)F.ldsg, fin);
    }
}
__device__ __forceinline__ void ph_attnfin(Frame& F0, int i, bool need_ctx) { Frame F = F0; LAUNDER(F);
    const int j = i >> 1; const float* lv = INP(I_LAM) + (size_t)j * 256; const float* sg = INP(I_SUBLN) + (size_t)j * 128;
    const float linit = (i == 1) ? 0.35550906759096934f : 0.5560582041556406f;
    const float d1 = wave_sum(lv[F.lane] * lv[64 + F.lane]), d2 = wave_sum(lv[128 + F.lane] * lv[192 + F.lane]);
    const float lam = expf(d1) - expf(d2) + linit;
    const float* OB = WSP(float, WS_OB); bf16* CAT = WSP(bf16, WS_CAT);
    const int nrows = need_ctx ? TT : TLAT;
    for (int row = F.gw; row < nrows; row += F.NGW) {
        const int h = F.lane >> 3, e0 = 16 * (F.lane & 7);
        const float* o0 = OB + (size_t)row * 2048 + (2 * h) * 128 + e0; const float* o1 = o0 + 128;
        float x[16]; float ss = 0.f;
#pragma unroll
        for (int q = 0; q < 4; ++q) { const f32x4 a = *(const f32x4*)(o0 + 4 * q), bb = *(const f32x4*)(o1 + 4 * q); const f32x4 d = a - bb * lam;
            x[4 * q] = d.x; x[4 * q + 1] = d.y; x[4 * q + 2] = d.z; x[4 * q + 3] = d.w; ss += (d.x * d.x + d.y * d.y) + (d.z * d.z + d.w * d.w); }
        ss = sum8_f(ss);
        const float sc = (1.0f - linit) / sqrtf(ss * (1.0f / 128.0f) + 1e-5f);
#pragma unroll
        for (int q = 0; q < 16; ++q) x[q] = x[q] * sc * sg[e0 + q];
#ifdef ABL_ATT
#pragma unroll
        for (int q = 0; q < 16; ++q) x[q] = 0.f;
#endif
        v4u w0, w1; w0.x = pk2(x[0], x[1]); w0.y = pk2(x[2], x[3]); w0.z = pk2(x[4], x[5]); w0.w = pk2(x[6], x[7]); w1.x = pk2(x[8], x[9]); w1.y = pk2(x[10], x[11]); w1.z = pk2(x[12], x[13]); w1.w = pk2(x[14], x[15]);
        bf16* dst = CAT + (size_t)row * DM + h * 128 + e0;
        *(v4u*)dst = w0; *(v4u*)(dst + 8) = w1;
    }
}
#ifdef DBG_MOE
__device__ __forceinline__ void ph_debug_moe(Frame& F0, int i) { Frame F = F0; LAUNDER(F);
    LAS float* xs = (LAS float*)F.lds; LAS float* hs = xs + 1024; LAS float* red = hs + 1024;
    unsigned* dbg = (unsigned*)(F.ws + WS_CTL) + 100;
    for (int s = F.vcu; s < 64; s += F.G) {
        const int e = s & 15, slot = (s * 37) % 2176; const int r = e * EROWS + slot;
        const int tok = WSP(int, WS_IDX)[r]; const float gate = WSP(float, WS_GATE)[r];
        const bf16* hrow = WSP(bf16, WS_HA) + (size_t)tok * DM;
        __syncthreads();
        for (int k = F.tid; k < 1024; k += NTHR) xs[k] = bf2f(hrow[k]);
        __syncthreads();
        const float* w1 = INP(I_MW1) + ((size_t)i * NE + e) * DM * FF; const float* w3 = INP(I_MW3) + ((size_t)i * NE + e) * DM * FF; const float* w2 = INP(I_MW2) + ((size_t)i * NE + e) * FF * DM;
        for (int f = F.tid; f < 1024; f += NTHR) { float a = 0.f, b = 0.f; for (int k = 0; k < 1024; ++k) { a += xs[k] * w1[(size_t)k * FF + f]; b += xs[k] * w3[(size_t)k * FF + f]; }
            hs[f] = a / (1.0f + __expf(-a)) * b; }
        __syncthreads();
        float num = 0.f, den = 0.f;
        for (int d = F.tid; d < 1024; d += NTHR) { float y = 0.f; for (int f = 0; f < 1024; ++f) y += hs[f] * w2[(size_t)f * DM + d]; y *= gate;
            const float yk = bf2f(WSP(bf16, WS_YB)[(size_t)r * DM + d]); num += (y - yk) * (y - yk); den += y * y; }
        num = block_sum(F, num, red); den = block_sum(F, den, red + 8);
        const float rel = sqrtf(num / fmaxf(den, 1e-30f));
        if (F.tid == 0) atomicMax(dbg, __builtin_bit_cast(unsigned, rel));
        if (s < 64) {
            const int set = s >> 4; const int rbase = set * SEQ; int cnt = 0; float mn_sel = 1e30f, mx_uns = -1e30f;
            for (int l = F.tid; l < SEQ; l += NTHR) { const int sl = WSP(int, WS_SLOT)[(size_t)(rbase + l) * 16 + e]; const float a = WSP(float, WS_AFF)[(size_t)(rbase + l) * 16 + e];
                if (sl >= 0) { ++cnt; mn_sel = fminf(mn_sel, a); if (sl >= 512 || WSP(int, WS_IDX)[e * EROWS + set * 512 + sl] != rbase + l) atomicAdd(dbg + 1, 1u); } else mx_uns = fmaxf(mx_uns, a); }
            const float tc = block_sum(F, (float)cnt, red);
            float a1 = -mn_sel, a2 = mx_uns;
#pragma unroll
            for (int o = 1; o < 64; o <<= 1) { a1 = fmaxf(a1, __shfl_xor(a1, o)); a2 = fmaxf(a2, __shfl_xor(a2, o)); }
            __syncthreads(); if (F.lane == 0) { red[F.wave] = a1; red[8 + F.wave] = a2; } __syncthreads();
            float m1 = red[0], m2 = red[8];
            for (int w = 1; w < 8; ++w) { m1 = fmaxf(m1, red[w]); m2 = fmaxf(m2, red[8 + w]); }
            if (F.tid == 0) { if ((int)tc != 512) atomicAdd(dbg + 2, 1u); if (-m1 < m2) atomicAdd(dbg + 3, 1u); atomicAdd(dbg + 4, (unsigned)(int)tc); }
        }
    }
}
#endif
__device__ __forceinline__ void ph_debug_out(Frame& F0) { Frame F = F0; LAUNDER(F);
    const unsigned* dbg = (const unsigned*)(F.ws + WS_CTL) + 100;
    const float e1 = __builtin_bit_cast(float, dbg[0]); const unsigned v2 = dbg[1];
#ifdef DBG_SEL2
    const float d1 = 1.0f + (float)dbg[2] + 100.0f * (float)dbg[3];
#elif defined(DBG_SEL3)
    const float d1 = (float)dbg[4] / 64.0f / 16.0f;
#else
    const float d1 = 1.0f + 10.0f * fminf(e1, 3.0f);
#endif
    float d2 = 10.0f + (float)v2 * 0.1f; d2 = fminf(d2, 900.f);
    for (size_t idx = (size_t)F.gw * 64 + F.lane; idx < (size_t)TLAT * DM; idx += (size_t)F.NGW * 64) F.out[idx] = idx == 0 ? d2 : d1;
}
constexpr int PH_PER_LAYER = 13, N_PHASES = 3 + DEPTH * PH_PER_LAYER;
#ifndef PH_MASK
#define PH_MASK 0xFFFFFFFFu
#endif
#define PK_ON(k) ((PH_MASK >> (k)) & 1u)

__device__ __forceinline__ bool phase_is_nop(int ph) {
    if (ph < 3) return false; const int i = (ph - 3) / PH_PER_LAYER, p = (ph - 3) % PH_PER_LAYER; return p == 4 || p == 9 || ((i & 1) && (p == 1 || p == 3 || p == 5));
}

__device__ __forceinline__ int phase_kind(int ph) {
    if (ph < 3) return ph;
    const int i = (ph - 3) / PH_PER_LAYER, p = (ph - 3) % PH_PER_LAYER; const bool even = !(i & 1);
    switch (p) { case 0: return even ? 3 : 4; case 1: return even ? 5 : 6; case 2: return even ? 7 : 8; case 3: return even ? 9 : 10; case 4: return 11; case 5: return 12; case 6: return 13;
                 case 7: return 14; case 8: return 15; case 9: return 16; case 10: return 17; case 11: return 18; default: return 19; }
}
#ifndef PROBE_MASK
#define PROBE_MASK 0u
#endif
#ifndef PROBE_DIV
#define PROBE_DIV 100.0f
#endif
__global__ void __launch_bounds__(NTHR, 2) mega_fwd(Args args) {
    extern __shared__ __attribute__((aligned(16))) unsigned char lds[];
    Frame F;
    F.lds = (LAS unsigned char*)lds; F.ldsg = lds;
    F.MISC = (volatile LAS unsigned*)(F.lds + LDSCTL_OFF + 320);
    F.tid = threadIdx.x; F.lane = F.tid & 63; F.wave = __builtin_amdgcn_readfirstlane(F.tid >> 6);
    F.G = gridDim.x; { const int bx = blockIdx.x; F.vcu = (F.G % 8 == 0) ? (bx % 8) * (F.G / 8) + bx / 8 : bx; }
    F.gw = F.vcu * NWAVES + F.wave; F.NGW = F.G * NWAVES;
    F.tprobe = 0ull;
    F.in = (const GAS float* const __attribute__((address_space(4)))*)__builtin_amdgcn_kernarg_segment_ptr();
    F.ws = (GAS unsigned char*)args.ws; F.out = (GAS float*)args.out;
    for (int u = F.tid; u < (LDS_BYTES - LDSCTL_OFF) / 4; u += NTHR) ((LAS unsigned*)(F.lds + LDSCTL_OFF))[u] = 0u;
    __syncthreads();
    XcdBarrier bar; bar.bar = (unsigned*)(F.ws + WS_CTL) + CW_BAR; bar.x = 0; bar.st = nullptr;
    const int lo = args.ph_lo, hi = args.ph_hi;
    if (hi - lo > 1) bar = xcd_barrier_post((unsigned*)(F.ws + WS_CTL) + CW_BAR, F.MISC + 8);

    Frame F0 = F;
    unsigned long long t_prev = 0ull, t_acc = 0ull;
    if (PROBE_MASK) t_prev = __builtin_amdgcn_s_memrealtime();
    for (int ph = lo; ph < hi; ++ph) {
        if (phase_is_nop(ph)) continue;
        Frame F = F0; LAUNDER(F);
#ifdef DBG_MOE
        if (ph == 1000) { ph_debug_moe(F, 0); VM_WAIT(); continue; }
        if (ph == 1001) { ph_debug_out(F); VM_WAIT(); continue; }
#endif
        if (ph == 0) { if (PK_ON(0)) ph_prologue(F); }
        else if (ph == 1) { if (PK_ON(1)) ph_modred(F); }
        else if (ph == 2) { if (PK_ON(2)) ph_mod0(F); }
        else {
            const int i = (ph - 3) / PH_PER_LAYER, p = (ph - 3) % PH_PER_LAYER, j = i >> 1; const bool even = !(i & 1), need_ctx = i < DEPTH - 1;
            if (p == 0) {
                if (even) { if (PK_ON(3)) { pg8::Gemm g{WSP(bf16, WS_HA), WSP(bf16, WS_WIN) + (size_t)j * EVCP * DM, TT, EVCP, DM, nullptr}; pg8::StaticOrder S; S.init(TT, EVCP, F.G, (int)blockIdx.x);
                    pg8::EpiEven E{WSP(float, WS_P), EVCP, WSP(float, WS_UTL), WSP(float, WS_UTC)}; pg8::gemm_phase<pg8::EpiEven, pg8::StaticOrder, true, true>(F.lds, g, S, E); } }
                else if (PK_ON(4)) { pg8::Gemm g{WSP(bf16, WS_HA), WSP(bf16, WS_WQKV) + (size_t)j * QKVC * DM, TT, QKVC, DM, nullptr}; pg8::StaticOrder S; S.init(TT, QKVC, F.G, (int)blockIdx.x);
                    pg8::EpiQKV E{WSP(bf16, WS_QB), WSP(bf16, WS_KB), WSP(bf16, WS_VB)}; pg8::gemm_phase<pg8::EpiQKV, pg8::StaticOrder, true, true>(F.lds, g, S, E); }
            } else if (p == 1) { if (even) { if (PK_ON(5)) ph_evprep(F, j); } else {   } }
            else if (p == 2) { if (even) { if (PK_ON(7)) ph_chunkprep(F, j); } else { if (PK_ON(8)) ph_attn(F, i, need_ctx); } }
            else if (p == 3) { if (even) { if (PK_ON(9)) ph_scan_hyena(F, j, i); } else {   } }
            else if (p == 4) {   }
            else if (p == 5) { if (PK_ON(12)) ph_readout(F, j); }
            else if (p == 6) { if (PK_ON(13)) {
                pg8::Gemm g{WSP(bf16, WS_CAT), (even ? WSP(bf16, WS_WOE) : WSP(bf16, WS_WOD)) + (size_t)j * DM * DM, TLAT, DM, DM, nullptr}; pg8::StaticOrder S; S.init(TLAT, DM, F.G, (int)blockIdx.x);
                pg8::EpiResGate E{WSP(float, WS_X), WSP(float, WS_MODS) + (size_t)i * 5 * 6144}; pg8::gemm_phase<pg8::EpiResGate, pg8::StaticOrder, true, true>(F.lds, g, S, E); }
            } else if (p == 7) { if (PK_ON(14)) ph_mod2(F, i, (even ? WSP(bf16, WS_WOE) : WSP(bf16, WS_WOD)) + (size_t)j * DM * DM); }
            else if (p == 8) { if (PK_ON(15)) ph_topk(F, i); }
            else if (p == 9) {   }
            else if (p == 10) { if (PK_ON(17)) {
                pg8::Gemm g{WSP(bf16, WS_HA), WSP(bf16, WS_W13), NE * EROWS, NE * 2048, DM, WSP(int, WS_IDX)};     pg8::MoeOrder S{F.G, (int)blockIdx.x, 8, (need_ctx && F.G != 256) ? 9 : 8};
                pg8::EpiSwiGLU E{WSP(bf16, WS_HB)}; pg8::gemm_phase<pg8::EpiSwiGLU, pg8::MoeOrder, true, true, true>(F.lds, g, S, E); }
            } else if (p == 11) { if (PK_ON(18)) {
                if (need_ctx && F.G == 256) {
                    unsigned* mctr = (unsigned*)(F.ws + WS_CTL) + 3072 + 64 * i;
                    if (F.vcu < 128) {
                        pg8::Gemm g1{WSP(bf16, WS_HA), WSP(bf16, WS_W13), NE * EROWS, NE * 2048, DM, WSP(int, WS_IDX)}; pg8::OneUnit S1{(F.vcu >> 3) * 9 + 8, (F.vcu >> 3) * 8 + (F.vcu & 7)};
                        pg8::EpiSwiGLU E1{WSP(bf16, WS_HB)}; pg8::gemm_phase<pg8::EpiSwiGLU, pg8::OneUnit, true, true, true>(F.lds, g1, S1, E1);
                        subset_arrive(mctr);
                    }
                    pg8::Gemm g{WSP(bf16, WS_HB), WSP(bf16, WS_W2), NE * EROWS, NE * 1024, FF, nullptr}; pg8::Moe2Order S{F.vcu, mctr};
                    pg8::EpiGateBf16 E{WSP(bf16, WS_YB), WSP(float, WS_GATE)}; pg8::gemm_phase<pg8::EpiGateBf16, pg8::Moe2Order, true, true>(F.lds, g, S, E);
                } else {
                    pg8::Gemm g{WSP(bf16, WS_HB), WSP(bf16, WS_W2), NE * EROWS, NE * 1024, FF, nullptr}; pg8::MoeOrder S{F.G, (int)blockIdx.x, 4, need_ctx ? 9 : 8};
                    pg8::EpiGateBf16 E{WSP(bf16, WS_YB), WSP(float, WS_GATE)}; pg8::gemm_phase<pg8::EpiGateBf16, pg8::MoeOrder, true, true>(F.lds, g, S, E);
                } }
            } else { if (PK_ON(19)) ph_combine(F, i); }
        }
        if (PROBE_SUB) F0.tprobe = F.tprobe;
        if (ph + 1 < hi) xcd_barrier(bar); else { VM_WAIT(); }
        if (PROBE_MASK) { const unsigned long long t_now = __builtin_amdgcn_s_memrealtime(); if ((PROBE_MASK >> phase_kind(ph)) & 1u) t_acc += t_now - t_prev; t_prev = t_now; }
    }
    if (PROBE_MASK) { if (blockIdx.x == 0 && threadIdx.x == 0 && hi == N_PHASES) { const float us = (float)(PROBE_SUB ? F0.tprobe : t_acc) * 0.01f; F0.out[0] += 2.0f + us / PROBE_DIV; } }
}

extern "C" void kernel_launch(void* const* d_in, const int* in_sizes, int n_in, void* d_out, int out_size, void* d_ws, size_t ws_size, hipStream_t stream) {
    static int grid = 0;
    if (grid == 0) {
        if (n_in != N_IN || out_size != TLAT * DM || ws_size < WS_END) { fprintf(stderr, "kernel_launch: unexpected shapes: n_in %d out %d ws %zu (need %zu)\n", n_in, out_size, ws_size, (size_t)WS_END); grid = -1; return; }
        int dev = 0, cus = 0, per_cu = 0;
        if (hipGetDevice(&dev) != hipSuccess || hipDeviceGetAttribute(&cus, hipDeviceAttributeMultiprocessorCount, dev) != hipSuccess) { grid = -1; return; }
        if (hipFuncSetAttribute((const void*)mega_fwd, hipFuncAttributeMaxDynamicSharedMemorySize, LDS_BYTES) != hipSuccess) { fprintf(stderr, "kernel_launch: hipFuncSetAttribute failed\n"); grid = -1; return; }
        if (hipOccupancyMaxActiveBlocksPerMultiprocessor(&per_cu, (const void*)mega_fwd, NTHR, LDS_BYTES) != hipSuccess || per_cu < 1) fprintf(stderr, "kernel_launch: occupancy query reports %d\n", per_cu);
        (void)hipGetLastError();
        grid = cus;
    }
    if (grid < 0) return;
    if (hipMemsetAsync((char*)d_ws + WS_CTL, 0, CTL_ZERO_BYTES, stream) != hipSuccess) { fprintf(stderr, "kernel_launch: memset failed\n"); return; }
    Args a{};
    for (int i = 0; i < N_IN; ++i) a.in[i] = (const float*)d_in[i];
    a.out = (float*)d_out; a.ws = (unsigned char*)d_ws;
#if MK_PER_PHASE
    for (int ph = 0; ph < N_PHASES; ++ph) {
#ifdef DBG_MOE
        if (ph == 3 + 12) { a.ph_lo = 1000; a.ph_hi = 1001; hipLaunchKernelGGL(mega_fwd, dim3(grid), dim3(NTHR), LDS_BYTES, stream, a); a.ph_lo = 1001; a.ph_hi = 1002; hipLaunchKernelGGL(mega_fwd, dim3(grid), dim3(NTHR), LDS_BYTES, stream, a); break; }
#endif
        if ((ph >= 3) && ((((ph - 3) % PH_PER_LAYER) == 4) || (((ph - 3) % PH_PER_LAYER) == 9) || ((((ph - 3) / PH_PER_LAYER) & 1) && (((ph - 3) % PH_PER_LAYER) == 1 || ((ph - 3) % PH_PER_LAYER) == 3 || ((ph - 3) % PH_PER_LAYER) == 5)))) continue;
        a.ph_lo = ph; a.ph_hi = ph + 1;
        hipLaunchKernelGGL(mega_fwd, dim3(grid), dim3(NTHR), LDS_BYTES, stream, a);
    }
#else
    a.ph_lo = 0; a.ph_hi = N_PHASES;
    hipLaunchKernelGGL(mega_fwd, dim3(grid), dim3(NTHR), LDS_BYTES, stream, a);
#endif
    const hipError_t le = hipPeekAtLastError();
    if (le != hipSuccess) fprintf(stderr, "kernel_launch: launch failed: %s\n", hipGetErrorName(le));
}
```

```cpp
#define MK_PER_PHASE 0
#include <hip/hip_runtime.h>
#include <cstdio>
#include <cstdint>
#include <cmath>

#ifndef MK_PER_PHASE
#define MK_PER_PHASE 0
#endif

#define GAS __attribute__((address_space(1)))
#define LAS __attribute__((address_space(3)))
typedef unsigned short bf16;
typedef unsigned v4u __attribute__((ext_vector_type(4)));
typedef unsigned v2u __attribute__((ext_vector_type(2)));
typedef float f32x4 __attribute__((ext_vector_type(4)));
typedef float f32x2 __attribute__((ext_vector_type(2)));
typedef short bf16x8 __attribute__((ext_vector_type(8)));

constexpr int DM = 1024, NB = 4, SEQ = 4096, CTXL = 256, DEPTH = 4;
constexpr int TLAT = NB * SEQ, TCTX = NB * CTXL, TT = TLAT + TCTX;
constexpr int RWC = 1760, HYC = 1536, EVC = RWC + HYC, EVCP = 3328;
constexpr int RWW = 512, NH = 8, HD = 64;
constexpr int QKVC = 3072;
constexpr int NE = 16, FF = 1024, EROWS = 2304;
constexpr int NMOD = 6;
constexpr int KSEQ = CTXL + SEQ;

enum { I_X = 0, I_C, I_CTX, I_CCTX, I_ADAW, I_ADAB, I_NORMG, I_FINALG, I_EVWIN, I_EVWOUT, I_MU, I_W0, I_W2, I_A0, I_A2, I_G2, I_KK, I_KA, I_RK, I_GN,
       I_CONVW, I_CONVB, I_FW1, I_FB1, I_FW2, I_FB2, I_FW3, I_FREQ, I_HYB, I_WQKV, I_DAWOUT, I_LAM, I_SUBLN, I_ROUTER, I_MW1, I_MW3, I_MW2, N_IN };

struct Args { const float* in[N_IN]; float* out; unsigned char* ws; int ph_lo, ph_hi; };
static_assert(__builtin_offsetof(Args, in) == 0, "Args::in must be first");

constexpr size_t MiB = 1u << 20;
constexpr size_t WS_CTL = 0, CTL_ZERO_BYTES = 64 * 1024;
constexpr size_t WS_MODP = 384 * MiB;
constexpr size_t WS_MODS = 5 * MiB;
constexpr size_t WS_TW = 6 * MiB;
constexpr size_t WS_FRAGB = 7 * MiB;
constexpr size_t WS_AFF = 8 * MiB;
constexpr size_t WS_SLOT = 10 * MiB;
constexpr size_t WS_IDX = 12 * MiB;
constexpr size_t WS_GATE = 12 * MiB + 512 * 1024;
constexpr size_t WS_WIN = 16 * MiB;
constexpr size_t WS_WOE = 30 * MiB;
constexpr size_t WS_WQKV = 34 * MiB;
constexpr size_t WS_WOD = 46 * MiB;
constexpr size_t WS_W13 = 50 * MiB;
constexpr size_t WS_W2 = 114 * MiB;
constexpr size_t WS_UTL = 50 * MiB;
constexpr size_t WS_X = 146 * MiB;
constexpr size_t WS_HA = 214 * MiB;
constexpr size_t WS_CAT = 248 * MiB;
constexpr size_t WS_KSPL = 282 * MiB;
constexpr size_t WS_KSPC = 346 * MiB;
constexpr size_t WS_BIG = 384 * MiB;
constexpr size_t WS_P = WS_BIG;
constexpr size_t REC_BYTES = 12 * 1024;
constexpr size_t WS_REC = WS_BIG + 221 * MiB;
constexpr size_t WS_V = WS_BIG + 425 * MiB;
constexpr size_t WS_AOP = WS_BIG + 459 * MiB;
constexpr size_t WS_G = WS_BIG + 467 * MiB;
constexpr size_t WS_KCL = WS_BIG + 501 * MiB;
constexpr size_t WS_KCC = WS_BIG + 533 * MiB;
constexpr size_t WS_UTC = WS_BIG + 535 * MiB;
constexpr size_t WS_BON = WS_BIG + 541 * MiB;
constexpr size_t WS_Y = WS_BIG + 542 * MiB;
constexpr size_t WS_HYTL = WS_BIG;
constexpr size_t WS_HYTC = WS_BIG + 32 * MiB;
static_assert(WS_Y + 68 * MiB <= 1024 * MiB && 64 * 272 * REC_BYTES <= 204 * MiB, "ws map");
constexpr size_t WS_QB = WS_BIG + 204 * MiB;
constexpr size_t WS_KB = WS_QB + 34 * MiB;
constexpr size_t WS_VB = WS_KB + 34 * MiB;
constexpr size_t WS_OB = WS_VB + 34 * MiB;
static_assert(WS_OB + 136 * MiB <= 1024 * MiB, "ws map");
constexpr size_t WS_XG = WS_BIG;
constexpr size_t WS_HB = WS_BIG + 72 * MiB;
constexpr size_t WS_YB = WS_BIG + 144 * MiB;
constexpr size_t WS_END = 1024 * MiB;

constexpr int CW_BAR = 4096;

constexpr int RING_BYTES = 143360;
constexpr int LDSCTL_OFF = RING_BYTES;
constexpr int LDS_BYTES = 147456;
constexpr int NWAVES = 8, NTHR = 512;

__device__ __forceinline__ unsigned f2bf(float f) { unsigned u = __builtin_bit_cast(unsigned, f); return (u + 0x7fffu + ((u >> 16) & 1u)) >> 16; }
__device__ __forceinline__ unsigned pk2(float lo, float hi) { return f2bf(lo) | (f2bf(hi) << 16); }
typedef __bf16 bf16x2_t __attribute__((ext_vector_type(2)));
__device__ __forceinline__ unsigned cvtpk_c(float lo, float hi) { const f32x2 v = {lo, hi}; const bf16x2_t b = __builtin_convertvector(v, bf16x2_t); return __builtin_bit_cast(unsigned, b); }
__device__ __forceinline__ float bf2f(unsigned short h) { return __builtin_bit_cast(float, ((unsigned)h) << 16); }
template <int CTRL> __device__ __forceinline__ float dpp_f(float x) { return __builtin_bit_cast(float, __builtin_amdgcn_update_dpp(0, __builtin_bit_cast(int, x), CTRL, 0xF, 0xF, true)); }
template <int CTRL> __device__ __forceinline__ int dpp_i(int x) { return __builtin_amdgcn_update_dpp(0, x, CTRL, 0xF, 0xF, true); }
#define DPP_XOR1 0xB1
#define DPP_XOR2 0x4E
#define DPP_HMIRROR 0x141
#define DPP_MIRROR 0x140
__device__ __forceinline__ float xor1_f(float x) { return dpp_f<DPP_XOR1>(x); }
__device__ __forceinline__ float sum4_f(float x) { x += dpp_f<DPP_XOR1>(x); x += dpp_f<DPP_XOR2>(x); return x; }
__device__ __forceinline__ float sum8_f(float x) { x = sum4_f(x); x += dpp_f<DPP_HMIRROR>(x); return x; }
__device__ __forceinline__ float sum16_f(float x) { x = sum8_f(x); x += dpp_f<DPP_MIRROR>(x); return x; }
__device__ __forceinline__ float max16_f(float x) { x = fmaxf(x, dpp_f<DPP_XOR1>(x)); x = fmaxf(x, dpp_f<DPP_XOR2>(x)); x = fmaxf(x, dpp_f<DPP_HMIRROR>(x)); x = fmaxf(x, dpp_f<DPP_MIRROR>(x)); return x; }
__device__ __forceinline__ float wave_sum(float v) {
    v = sum16_f(v);
    const int vi = __builtin_bit_cast(int, v);
    return (__builtin_bit_cast(float, __builtin_amdgcn_readlane(vi, 0)) + __builtin_bit_cast(float, __builtin_amdgcn_readlane(vi, 16)))
         + (__builtin_bit_cast(float, __builtin_amdgcn_readlane(vi, 32)) + __builtin_bit_cast(float, __builtin_amdgcn_readlane(vi, 48)));
}
__device__ __forceinline__ int wave_sum_i(int v) {
    v += dpp_i<DPP_XOR1>(v); v += dpp_i<DPP_XOR2>(v); v += dpp_i<DPP_HMIRROR>(v); v += dpp_i<DPP_MIRROR>(v);
    v += __builtin_amdgcn_ds_swizzle(v, 0x401F);
    { auto rr = __builtin_amdgcn_permlane32_swap((unsigned)v, (unsigned)v, false, false); v = (int)rr[0] + (int)rr[1]; }
    return v;
}
__device__ __forceinline__ float sigmoidf_(float x) { return 1.0f / (1.0f + __expf(-x)); }
__device__ __forceinline__ float siluf_(float x) { return x / (1.0f + __expf(-x)); }
#define LDS_WAIT() asm volatile("s_waitcnt lgkmcnt(0)" ::: "memory")
#define VM_WAIT() asm volatile("s_waitcnt vmcnt(0)" ::: "memory")

namespace pg8 {
#define PG8_LAS __attribute__((address_space(3)))
typedef unsigned short bf16_t;
typedef short bf16x8 __attribute__((ext_vector_type(8)));
typedef float f32x4 __attribute__((ext_vector_type(4)));
typedef unsigned u32x4 __attribute__((ext_vector_type(4)));
constexpr int BM = 256, BK = 64, HALF = 128, HTB = HALF * BK * 2  , STAGE_BYTES = 8 * HTB, NXCD = 8, WGM = 8;

__host__ __device__ __forceinline__ int lds_byte(int r, int c) { const int st = (r >> 4) * 2 + (c >> 5), rr = r & 15, cc = c & 31, ob = rr * 64 + cc * 2; return st * 1024 + (ob ^ (((ob >> 9) & 1) << 5)); }
__host__ __device__ __forceinline__ void stage_rc(int b, int& R, int& C) { const int st = b / 1024, sb = b % 1024, swz = sb ^ (((sb >> 9) & 1) << 5); R = (st >> 1) * 16 + swz / 64; C = (st & 1) * 32 + (swz % 64) / 2; }
__host__ __device__ __forceinline__ int perm32(int rho) { const int n = rho >> 4, i = rho & 15; return 8 * (i >> 2) + 4 * n + (i & 3); }

struct Unit { int pm, pn; };
struct Gemm { const bf16_t* A; const bf16_t* Bt; int M, N, K; const int* gidx; };

struct StaticOrder {
    int nM, nN, nwg, G, c;
    __host__ __device__ void init(int M, int N, int G_, int c_) { nM = M / BM; nN = N / BM; nwg = nM * nN; G = G_; c = c_; }
    __host__ __device__ bool next(int i, Unit& u) const {
        const long L = (long)i * G + c; if (L >= nwg) return false;
        int wgid = (int)L; { const int q = nwg / NXCD, r = nwg % NXCD, xcd = wgid % NXCD, off = wgid / NXCD; wgid = (xcd < r ? xcd * (q + 1) : r * (q + 1) + (xcd - r) * q) + off; }
        const int nig = WGM * nN, gid = wgid / nig, fm = gid * WGM, gsz = (nM - fm) < WGM ? (nM - fm) : WGM;
        u.pm = fm + ((wgid % nig) % gsz); u.pn = (wgid % nig) / gsz; return true;
    }
    __device__ __forceinline__ void a_ready(const Unit&) const {}
    __device__ __forceinline__ void done(const Unit&) const {}
};

__device__ __forceinline__ unsigned cvt_pk_bf16(float lo, float hi) { unsigned r; asm volatile("v_cvt_pk_bf16_f32 %0, %1, %2" : "=v"(r) : "v"(lo), "v"(hi)); return r; }
typedef float f32x2 __attribute__((ext_vector_type(2)));
typedef unsigned u32x2v __attribute__((ext_vector_type(2)));

struct EpiF32 {
    static constexpr bool PERM = false, AFTER_DRAIN = false;
    float* O; int ldc;
    __device__ __forceinline__ void operator()(const f32x4 (&acc)[2][2][4][2], const Unit& u, int wr, int wc, int fr, int fq) const {
        const int col0 = u.pn * BM + wc * 32 + 4 * fq;
#pragma unroll
        for (int ai = 0; ai < 2; ++ai)
#pragma unroll
            for (int m = 0; m < 4; ++m) { float* rowp = O + (size_t)(u.pm * BM + ai * HALF + wr * 64 + m * 16 + fr) * ldc + col0;
#pragma unroll
                for (int bj = 0; bj < 2; ++bj)
#pragma unroll
                    for (int n = 0; n < 2; ++n) *(f32x4*)(rowp + bj * HALF + n * 16) = acc[ai][bj][m][n]; }
    }
};
struct EpiBf16S {
    static constexpr bool PERM = false, AFTER_DRAIN = false;
    bf16_t* O; int ldc;
    __device__ __forceinline__ void operator()(const f32x4 (&acc)[2][2][4][2], const Unit& u, int wr, int wc, int fr, int fq) const {
        const int col0 = u.pn * BM + wc * 32 + 4 * fq;
#pragma unroll
        for (int ai = 0; ai < 2; ++ai)
#pragma unroll
            for (int m = 0; m < 4; ++m) { bf16_t* rowp = O + (size_t)(u.pm * BM + ai * HALF + wr * 64 + m * 16 + fr) * ldc + col0;
#pragma unroll
                for (int bj = 0; bj < 2; ++bj)
#pragma unroll
                    for (int n = 0; n < 2; ++n) { const f32x4 v = acc[ai][bj][m][n]; u32x2v w; w.x = cvt_pk_bf16(v[0], v[1]); w.y = cvt_pk_bf16(v[2], v[3]); *(u32x2v*)(rowp + bj * HALF + n * 16) = w; } }
    }
};
struct EpiEven {
    static constexpr bool PERM = false, AFTER_DRAIN = false;
    float* P; int ldc; float* UTL; float* UTC;
    __device__ __forceinline__ void operator()(const f32x4 (&acc)[2][2][4][2], const Unit& u, int wr, int wc, int fr, int fq) const {
        const int col0 = u.pn * BM + wc * 32 + 4 * fq;
#pragma unroll
        for (int ai = 0; ai < 2; ++ai)
#pragma unroll
            for (int m = 0; m < 4; ++m) { const int row = u.pm * BM + ai * HALF + wr * 64 + m * 16 + fr; const bool lat = row < 16384;
                float* rowp = P + (size_t)row * ldc + col0;
                float* tp = lat ? UTL + ((size_t)(row >> 12) * 1536) * 4096 + (row & 4095) : UTC + ((size_t)((row - 16384) >> 8) * 1536) * 256 + ((row - 16384) & 255);
                const size_t ts = lat ? 4096 : 256;
#pragma unroll
                for (int bj = 0; bj < 2; ++bj)
#pragma unroll
                    for (int n = 0; n < 2; ++n) { const int c = col0 + bj * HALF + n * 16; const f32x4 v = acc[ai][bj][m][n];
                        if (c < 1760) *(f32x4*)(rowp + bj * HALF + n * 16) = v;
                        else if (c < 3296) { float* t0 = tp + (size_t)(c - 1760) * ts; t0[0] = v[0]; t0[ts] = v[1]; t0[2 * ts] = v[2]; t0[3 * ts] = v[3]; } } }
    }
};
struct EpiResGate {
    static constexpr bool PERM = false, AFTER_DRAIN = false;
    float* X; const float* mods;
    __device__ __forceinline__ void operator()(const f32x4 (&acc)[2][2][4][2], const Unit& u, int wr, int wc, int fr, int fq) const {
        const int col0 = u.pn * BM + wc * 32 + 4 * fq;
        const int s = u.pm < 64 ? (u.pm >> 4) : 4;
        const float* gp = mods + s * 6144 + 2048 + col0;
        f32x4 g[2][2];
#pragma unroll
        for (int bj = 0; bj < 2; ++bj)
#pragma unroll
            for (int n = 0; n < 2; ++n) g[bj][n] = *(const f32x4*)(gp + bj * HALF + n * 16);
#pragma unroll
        for (int ai = 0; ai < 2; ++ai) {
            f32x4 x[4][2][2];
#pragma unroll
            for (int m = 0; m < 4; ++m) { const float* rowp = X + (size_t)(u.pm * BM + ai * HALF + wr * 64 + m * 16 + fr) * 1024 + col0;
#pragma unroll
                for (int bj = 0; bj < 2; ++bj)
#pragma unroll
                    for (int n = 0; n < 2; ++n) x[m][bj][n] = *(const f32x4*)(rowp + bj * HALF + n * 16); }
#pragma unroll
            for (int m = 0; m < 4; ++m) { float* rowp = X + (size_t)(u.pm * BM + ai * HALF + wr * 64 + m * 16 + fr) * 1024 + col0;
#pragma unroll
                for (int bj = 0; bj < 2; ++bj)
#pragma unroll
                    for (int n = 0; n < 2; ++n) *(f32x4*)(rowp + bj * HALF + n * 16) = x[m][bj][n] + g[bj][n] * acc[ai][bj][m][n]; }
        }
    }
};
struct EpiSwiGLU {
    static constexpr bool PERM = false, AFTER_DRAIN = false;
    bf16_t* H;
    __device__ __forceinline__ void operator()(const f32x4 (&acc)[2][2][4][2], const Unit& u, int wr, int wc, int fr, int fq) const {
        const int nt = u.pn & 7; const int col0 = nt * 128 + wc * 32 + 4 * fq;
#pragma unroll
        for (int ai = 0; ai < 2; ++ai)
#pragma unroll
            for (int m = 0; m < 4; ++m) { bf16_t* rowp = H + (size_t)(u.pm * BM + ai * HALF + wr * 64 + m * 16 + fr) * 1024 + col0;
#pragma unroll
                for (int n = 0; n < 2; ++n) { const f32x4 a = acc[ai][0][m][n], b = acc[ai][1][m][n]; f32x4 h;
#pragma unroll
                    for (int j = 0; j < 4; ++j) h[j] = a[j] / (1.0f + __expf(-a[j])) * b[j];
                    u32x2v w; w.x = cvt_pk_bf16(h[0], h[1]); w.y = cvt_pk_bf16(h[2], h[3]); *(u32x2v*)(rowp + n * 16) = w; } }
    }
};
struct EpiGateBf16 {
    static constexpr bool PERM = false, AFTER_DRAIN = false;
    bf16_t* Y; const float* gate;
    __device__ __forceinline__ void operator()(const f32x4 (&acc)[2][2][4][2], const Unit& u, int wr, int wc, int fr, int fq) const {
        const int nt = u.pn & 3; const int col0 = nt * 256 + wc * 32 + 4 * fq;
        float gv[2][4];
#pragma unroll
        for (int ai = 0; ai < 2; ++ai)
#pragma unroll
            for (int m = 0; m < 4; ++m) gv[ai][m] = gate[u.pm * BM + ai * HALF + wr * 64 + m * 16 + fr];
#pragma unroll
        for (int ai = 0; ai < 2; ++ai)
#pragma unroll
            for (int m = 0; m < 4; ++m) { const int row = u.pm * BM + ai * HALF + wr * 64 + m * 16 + fr; const float g = gv[ai][m]; bf16_t* rowp = Y + (size_t)row * 1024 + col0;
#pragma unroll
                for (int bj = 0; bj < 2; ++bj)
#pragma unroll
                    for (int n = 0; n < 2; ++n) { const f32x4 v = acc[ai][bj][m][n] * g; u32x2v w; w.x = cvt_pk_bf16(v[0], v[1]); w.y = cvt_pk_bf16(v[2], v[3]); *(u32x2v*)(rowp + bj * HALF + n * 16) = w; } }
    }
};
struct EpiQKV {
    static constexpr bool PERM = false, AFTER_DRAIN = false;
    bf16_t* Q; bf16_t* Kb; bf16_t* Vb;
    __device__ __forceinline__ void operator()(const f32x4 (&acc)[2][2][4][2], const Unit& u, int wr, int wc, int fr, int fq) const {
        const int part = u.pn >> 2; const int col0 = (u.pn & 3) * BM + wc * 32 + 4 * fq; const bool lat = u.pm < 64;
        float invf[4];
#pragma unroll
        for (int j = 0; j < 4; ++j) invf[j] = exp2f(-(float)(4 * fq + j) * (13.287712379549449f / 16.0f)) * 0.15915494309189535f;
#pragma unroll
        for (int ai = 0; ai < 2; ++ai)
#pragma unroll
            for (int m = 0; m < 4; ++m) {
                const int row = u.pm * BM + ai * HALF + wr * 64 + m * 16 + fr;
                const int b = lat ? (row >> 12) : ((row - 16384) >> 8); const int l = lat ? (row & 4095) : ((row - 16384) & 255);
                float cs[4], sn[4];
                if (part < 2 && lat) { const float pos = (float)((wc & 1) ? (l & 63) : (l >> 6));
#pragma unroll
                    for (int j = 0; j < 4; ++j) { const float rev = pos * invf[j]; const float fr_ = rev - floorf(rev); cs[j] = __builtin_amdgcn_cosf(fr_); sn[j] = __builtin_amdgcn_sinf(fr_); } }
                bf16_t* rowp = (part == 0 ? Q + (size_t)row * 1024 : (part == 1 ? Kb : Vb) + ((size_t)b * 4352 + (lat ? 256 + l : l)) * 1024) + col0;
#pragma unroll
                for (int bj = 0; bj < 2; ++bj) {
                    f32x4 x1 = acc[ai][bj][m][0], x2 = acc[ai][bj][m][1];
                    if (part < 2 && lat) {
#pragma unroll
                        for (int j = 0; j < 4; ++j) { const float a = x1[j], bb = x2[j]; x1[j] = a * cs[j] - bb * sn[j]; x2[j] = bb * cs[j] + a * sn[j]; } }
                    u32x2v w; w.x = cvt_pk_bf16(x1[0], x1[1]); w.y = cvt_pk_bf16(x1[2], x1[3]); *(u32x2v*)(rowp + bj * HALF) = w;
                    w.x = cvt_pk_bf16(x2[0], x2[1]); w.y = cvt_pk_bf16(x2[2], x2[3]); *(u32x2v*)(rowp + bj * HALF + 16) = w;
                }
            }
    }
};
struct OneUnit { int pm, pn;
    __device__ __forceinline__ bool next(int i, Unit& u) const { if (i != 0) return false; u.pm = pm; u.pn = pn; return true; }
    __device__ __forceinline__ void a_ready(const Unit&) const {}
    __device__ __forceinline__ void done(const Unit&) const {}
};
struct Moe2Order {
    int w; unsigned* ctr;
    __device__ __forceinline__ bool next(int i, Unit& u) const {
        if (w < 128) {
            if (i == 0) { const int e = w >> 5, r = w & 31; u.pm = e * 9 + (r & 7); u.pn = e * 4 + (r >> 3); return true; }
            if (i == 1 && w < 64) { const int e = w >> 2; u.pm = e * 9 + 8; u.pn = e * 4 + (w & 3); return true; }
            return false;
        }
        if (i >= 3) return false;
        const int L = 128 + (w - 128) * 3 + i; const int e = L >> 5, r = L & 31; u.pm = e * 9 + (r & 7); u.pn = e * 4 + (r >> 3); return true;
    }
    __device__ __forceinline__ void a_ready(const Unit& u) const {
        if ((u.pm % 9) != 8) return;
        if ((threadIdx.x & 63) == 0) { unsigned sp = 0; while (__hip_atomic_load(ctr, __ATOMIC_RELAXED, __HIP_MEMORY_SCOPE_AGENT) < 128u) { __builtin_amdgcn_s_sleep(4); if (++sp > (1u << 24)) break; } }
        __builtin_amdgcn_fence(__ATOMIC_ACQUIRE, "agent");
    }
    __device__ __forceinline__ void done(const Unit&) const {}
};
struct MoeOrder {
    int G, c, ntn, nmt;
    __device__ __forceinline__ bool next(int i, Unit& u) const {
        const int L = i * G + c; const int per_e = nmt * ntn; if (L >= 16 * per_e) return false;
        const int e = L / per_e, r = L % per_e; u.pm = e * 9 + (r % nmt); u.pn = e * ntn + (r / nmt); return true;
    }
    __device__ __forceinline__ void a_ready(const Unit&) const {}
    __device__ __forceinline__ void done(const Unit&) const {}
};
template <class Epi, class Sched, bool ALIGN_EPI = false, bool SP2 = false, bool GATHER = false>
__device__ __forceinline__ void gemm_phase(PG8_LAS unsigned char* lds, const Gemm g, const Sched& S, const Epi& E) {
    int tid_ = threadIdx.x; asm volatile("" : "+v"(tid_));
    const int tid = tid_, wid = __builtin_amdgcn_readfirstlane(tid >> 6), lane = tid & 63, wr = wid >> 2, wc = wid & 3, fr = lane & 15, fq = lane >> 4;
    const int K = g.K, nt = K / BK;
    unsigned voffA[2], voffB[2];
#pragma unroll
    for (int i = 0; i < 2; ++i) { int R, C; stage_rc(tid * 16 + i * 8192, R, C); const int Rb = Epi::PERM ? ((R & ~31) + perm32(R & 31)) : R;
        voffA[i] = (unsigned)(R * K + C) * 2u; voffB[i] = (unsigned)(Rb * K + C) * 2u; }
    unsigned vA0[2] = {0u, 0u}, vA1[2] = {0u, 0u}, nvA0[2] = {0u, 0u}, nvA1[2] = {0u, 0u};
#define PG8_GOFF(dst0, dst1, unit) do { _Pragma("unroll") for (int i_ = 0; i_ < 2; ++i_) { int R_, C_; stage_rc(tid * 16 + i_ * 8192, R_, C_); \
        dst0[i_] = (unsigned)g.gidx[(unit).pm * BM + R_] * (unsigned)(K * 2) + (unsigned)(C_ * 2); dst1[i_] = (unsigned)g.gidx[(unit).pm * BM + HALF + R_] * (unsigned)(K * 2) + (unsigned)(C_ * 2); } } while (0)
    const size_t kstep = (size_t)(BK * 2);
    const size_t hstep = (size_t)HALF * K * 2;
    const size_t tstep = 2 * hstep;
    const unsigned ldsw = (unsigned)wid * 1024u;
    const int aoff = lds_byte(wr * 64 + fr, fq * 8), boff = lds_byte(wc * 32 + fr, fq * 8);
#define PG8_SA(b, h) (((b) * 2 + (h)) * HTB)
#define PG8_SB(b, h) ((4 + (b) * 2 + (h)) * HTB)
#define PG8_STAGE(bufoff, gbase, voff) do { _Pragma("unroll") for (int _i = 0; _i < 2; ++_i) \
        __builtin_amdgcn_global_load_lds((const unsigned*)((const char*)(gbase) + (voff)[_i]), (PG8_LAS unsigned*)(lds + (bufoff) + ldsw + _i * 8192), 16, 0, 0); } while (0)
#define PG8_STAGE_AC(bufoff, kptr, half) do { if constexpr (GATHER) { if (half) PG8_STAGE(bufoff, kptr, vA1); else PG8_STAGE(bufoff, kptr, vA0); } else PG8_STAGE(bufoff, (kptr) + (half) * hstep, voffA); } while (0)
#define PG8_STAGE_AX(bufoff, kptr, half) do { if constexpr (GATHER) { unsigned s_[2]; _Pragma("unroll") for (int i_ = 0; i_ < 2; ++i_) s_[i_] = last ? ((half) ? nvA1[i_] : nvA0[i_]) : ((half) ? vA1[i_] : vA0[i_]); PG8_STAGE(bufoff, kptr, s_); } \
        else PG8_STAGE(bufoff, (kptr) + (half) * hstep, voffA); } while (0)
#define PG8_LDA(dst, b, h) do { _Pragma("unroll") for (int m = 0; m < 4; ++m) _Pragma("unroll") for (int k = 0; k < 2; ++k) dst[m][k] = *(const PG8_LAS bf16x8*)(lds + PG8_SA(b, h) + aoff + m * 2048 + k * 1024); } while (0)
#define PG8_LDB(dst, b, h) do { _Pragma("unroll") for (int n = 0; n < 2; ++n) _Pragma("unroll") for (int k = 0; k < 2; ++k) dst[n][k] = *(const PG8_LAS bf16x8*)(lds + PG8_SB(b, h) + boff + n * 2048 + k * 1024); } while (0)
#define PG8_MMA(ai, bj, At, Bt) do { __builtin_amdgcn_s_setprio(1); _Pragma("unroll") for (int m = 0; m < 4; ++m) _Pragma("unroll") for (int n = 0; n < 2; ++n) _Pragma("unroll") for (int k = 0; k < 2; ++k) \
        acc[ai][bj][m][n] = __builtin_amdgcn_mfma_f32_16x16x32_bf16(Bt[n][k], At[m][k], acc[ai][bj][m][n], 0, 0, 0); __builtin_amdgcn_s_setprio(0); } while (0)
#define PG8_WAIT_V(n) asm volatile("s_waitcnt vmcnt(" #n ")" ::: "memory")
#define PG8_WAIT_L(n) asm volatile("s_waitcnt lgkmcnt(" #n ")" ::: "memory")
#define PG8_BAR __builtin_amdgcn_s_barrier()
#define PG8_SCHED __builtin_amdgcn_sched_barrier(0)
    Unit cur, nxt; int ui = 0;
    if (!S.next(0, cur)) return;
    f32x4 acc[2][2][4][2];
#pragma unroll
    for (int a = 0; a < 2; ++a)
#pragma unroll
        for (int b = 0; b < 2; ++b)
#pragma unroll
            for (int m = 0; m < 4; ++m)
#pragma unroll
                for (int n = 0; n < 2; ++n) acc[a][b][m][n] = (f32x4){0.f, 0.f, 0.f, 0.f};
    bf16x8 At[4][2], B0[2][2], B1[2][2];
    const char* cA = (const char*)g.A + (GATHER ? (size_t)0 : (size_t)cur.pm * tstep); const char* cB = (const char*)g.Bt + (size_t)cur.pn * tstep;
    if constexpr (GATHER) PG8_GOFF(vA0, vA1, cur);
    S.a_ready(cur);
    if constexpr (SP2) {
        PG8_STAGE(PG8_SB(0, 0), cB, voffB); PG8_STAGE(PG8_SB(0, 1), cB + hstep, voffB); PG8_STAGE_AC(PG8_SA(0, 0), cA, 0); PG8_STAGE_AC(PG8_SA(0, 1), cA, 1);
        if (wr == 1) PG8_BAR;
        PG8_WAIT_V(2); PG8_BAR;
        PG8_STAGE(PG8_SB(1, 0), cB + kstep, voffB); PG8_STAGE_AC(PG8_SA(1, 0), cA + kstep, 0); PG8_STAGE(PG8_SB(1, 1), cB + hstep + kstep, voffB);
        PG8_WAIT_V(6); PG8_BAR;
    } else {
        PG8_STAGE(PG8_SB(0, 0), cB, voffB); PG8_STAGE_AC(PG8_SA(0, 0), cA, 0); PG8_STAGE(PG8_SB(0, 1), cB + hstep, voffB); PG8_STAGE_AC(PG8_SA(0, 1), cA, 1);
        if (wr == 1) PG8_BAR;
        PG8_WAIT_V(4); PG8_BAR;
        PG8_STAGE(PG8_SB(1, 0), cB + kstep, voffB); PG8_STAGE_AC(PG8_SA(1, 0), cA + kstep, 0); PG8_STAGE(PG8_SB(1, 1), cB + hstep + kstep, voffB);
        PG8_WAIT_V(6); PG8_BAR;
    }
    for (;;) {
        const bool has_next = S.next(ui + 1, nxt);
        if constexpr (GATHER) { if (has_next) PG8_GOFF(nvA0, nvA1, nxt); else { nvA0[0] = vA0[0]; nvA0[1] = vA0[1]; nvA1[0] = vA1[0]; nvA1[1] = vA1[1]; } }
        const char* nA = (has_next && !GATHER) ? (const char*)g.A + (size_t)nxt.pm * tstep : cA; const char* nB = has_next ? (const char*)g.Bt + (size_t)nxt.pn * tstep : cB;
        for (int t = 0; t < nt; t += 2) {
            const bool last = (t == nt - 2);
            const char* a1 = cA + (size_t)(t + 1) * kstep;
            const char* a2 = last ? nA : cA + (size_t)(t + 2) * kstep; const char* b2 = last ? nB : cB + (size_t)(t + 2) * kstep;
            const char* a3 = a2 + kstep; const char* b3 = b2 + kstep;
            if (last && has_next) S.a_ready(nxt);
            if constexpr (SP2) {
            PG8_LDB(B0, 0, 0); PG8_LDB(B1, 0, 1); PG8_SCHED; PG8_LDA(At, 0, 0); PG8_STAGE_AC(PG8_SA(1, 1), a1, 1);
            PG8_WAIT_V(8); PG8_WAIT_L(0); PG8_BAR; PG8_MMA(0, 0, At, B0); PG8_MMA(0, 1, At, B1); PG8_BAR; PG8_SCHED;
            PG8_LDA(At, 0, 1); PG8_STAGE(PG8_SB(0, 0), b2, voffB); PG8_STAGE(PG8_SB(0, 1), b2 + hstep, voffB); PG8_STAGE_AX(PG8_SA(0, 0), a2, 0);
            PG8_WAIT_V(8); PG8_WAIT_L(0); PG8_BAR; PG8_MMA(1, 0, At, B0); PG8_MMA(1, 1, At, B1); PG8_BAR; PG8_SCHED;
            PG8_LDB(B0, 1, 0); PG8_LDB(B1, 1, 1); PG8_SCHED; PG8_LDA(At, 1, 0); PG8_STAGE_AX(PG8_SA(0, 1), a2, 1);
            PG8_WAIT_V(8); PG8_WAIT_L(0); PG8_BAR; PG8_MMA(0, 0, At, B0); PG8_MMA(0, 1, At, B1); PG8_BAR; PG8_SCHED;
            PG8_LDA(At, 1, 1); PG8_STAGE(PG8_SB(1, 0), b3, voffB); PG8_STAGE(PG8_SB(1, 1), b3 + hstep, voffB); PG8_STAGE_AX(PG8_SA(1, 0), a3, 0);
            PG8_WAIT_V(8); PG8_WAIT_L(0); PG8_BAR; PG8_MMA(1, 0, At, B0); PG8_MMA(1, 1, At, B1); PG8_BAR; PG8_SCHED;
            } else {
            PG8_LDB(B0, 0, 0); PG8_SCHED; PG8_LDA(At, 0, 0); PG8_STAGE_AC(PG8_SA(1, 1), a1, 1);
            PG8_WAIT_L(8); PG8_BAR; PG8_WAIT_L(0); PG8_MMA(0, 0, At, B0); PG8_BAR; PG8_SCHED;
            PG8_LDB(B1, 0, 1); PG8_STAGE(PG8_SB(0, 0), b2, voffB);
            PG8_BAR; PG8_WAIT_L(0); PG8_MMA(0, 1, At, B1); PG8_BAR;
            PG8_LDA(At, 0, 1); PG8_STAGE_AX(PG8_SA(0, 0), a2, 0);
            PG8_BAR; PG8_WAIT_L(0); PG8_MMA(1, 0, At, B0); PG8_BAR; PG8_SCHED;
            PG8_STAGE(PG8_SB(0, 1), b2 + hstep, voffB);
            PG8_WAIT_V(6); PG8_BAR; PG8_MMA(1, 1, At, B1); PG8_BAR;
            PG8_LDB(B0, 1, 0); PG8_SCHED; PG8_LDA(At, 1, 0); PG8_STAGE_AX(PG8_SA(0, 1), a2, 1);
            PG8_WAIT_L(8); PG8_BAR; PG8_WAIT_L(0); PG8_MMA(0, 0, At, B0); PG8_BAR; PG8_SCHED;
            PG8_LDB(B1, 1, 1); PG8_STAGE(PG8_SB(1, 0), b3, voffB);
            PG8_BAR; PG8_WAIT_L(0); PG8_MMA(0, 1, At, B1); PG8_BAR;
            PG8_LDA(At, 1, 1); PG8_STAGE_AX(PG8_SA(1, 0), a3, 0);
            PG8_BAR; PG8_WAIT_L(0); PG8_MMA(1, 0, At, B0); PG8_BAR; PG8_SCHED;
            PG8_STAGE(PG8_SB(1, 1), b3 + hstep, voffB);
            PG8_WAIT_V(6); PG8_BAR; PG8_MMA(1, 1, At, B1); PG8_BAR;
            }
        }
        if constexpr (ALIGN_EPI) { if (wr == 0) PG8_BAR; }
        if constexpr (!Epi::AFTER_DRAIN) { E(acc, cur, wr, wc, fr, fq); S.done(cur); }
        if (!has_next) break;
#pragma unroll
        for (int a = 0; a < 2; ++a)
#pragma unroll
            for (int b = 0; b < 2; ++b)
#pragma unroll
                for (int m = 0; m < 4; ++m)
#pragma unroll
                    for (int n = 0; n < 2; ++n) acc[a][b][m][n] = (f32x4){0.f, 0.f, 0.f, 0.f};
        cur = nxt; cA = nA; cB = nB; ++ui;
        if constexpr (GATHER) { vA0[0] = nvA0[0]; vA0[1] = nvA0[1]; vA1[0] = nvA1[0]; vA1[1] = nvA1[1]; }
        if constexpr (ALIGN_EPI) { if (wr == 1) PG8_BAR; }
    }
    PG8_WAIT_V(0);
    if constexpr (!ALIGN_EPI) { if (wr == 0) PG8_BAR; }
    PG8_BAR;
    if constexpr (Epi::AFTER_DRAIN) { E.fused(acc, cur, wr, wc, fr, fq, lds, wid, lane); S.done(cur); }
#undef PG8_SA
#undef PG8_SB
#undef PG8_STAGE
#undef PG8_LDA
#undef PG8_STAGE_AC
#undef PG8_STAGE_AX
#undef PG8_GOFF
#undef PG8_LDB
#undef PG8_MMA
#undef PG8_WAIT_V
#undef PG8_WAIT_L
#undef PG8_BAR
#undef PG8_SCHED
}
}
#define XB_TMO      128
#define XB_XCNT(j)  (256  + 64 * (j))
#define XB_XSUB(j)  (1280 + 64 * (j))
#define XB_XGEN(j)  (2304 + 64 * (j))
#define XB_TOP      3328
#define XB_TOPGEN   3392
#define XCD_BAR_WORDS 3456
#define XB_SPIN_CAP (1u << 18)

__device__ __forceinline__ unsigned xb_ld(unsigned* p)              { return __hip_atomic_load(p, __ATOMIC_RELAXED, __HIP_MEMORY_SCOPE_AGENT); }
__device__ __forceinline__ unsigned xb_add(unsigned* p, unsigned v) { return __hip_atomic_fetch_add(p, v, __ATOMIC_RELAXED, __HIP_MEMORY_SCOPE_AGENT); }
__device__ __forceinline__ unsigned xb_xcc_id() { return (unsigned)__builtin_amdgcn_s_getreg((3 << 11) | 20) & 0xFu; }
#define XB_SPIN(cond, bar) do { unsigned _sp = 0; while (cond) { __builtin_amdgcn_s_sleep(1); \
    if ((++_sp & 255u) == 0u) { if (xb_ld(&(bar)[XB_TMO])) break; if (_sp > XB_SPIN_CAP) { atomicAdd(&(bar)[XB_TMO], 1u); break; } } } } while (0)

struct XcdBarrier {
    unsigned* bar; unsigned x;
    volatile LAS unsigned* st;
};

__device__ __forceinline__ XcdBarrier xcd_barrier_post(unsigned* bar, volatile LAS unsigned* st) {
    XcdBarrier b; b.bar = bar; b.x = xb_xcc_id(); b.st = st;
    if (threadIdx.x == 0) (void)xb_add(&bar[XB_XCNT(b.x)], 1u);
    return b;
}
__device__ __forceinline__ void xcd_barrier_complete(unsigned* bar, unsigned x, unsigned& nloc, unsigned& nx) {
    const unsigned G = gridDim.x * gridDim.y * gridDim.z;
    unsigned sum, cnt, mine, sp = 0u;
    for (;;) {
        sum = 0u; cnt = 0u; mine = 0u;
#pragma unroll
        for (unsigned j = 0; j < 16; ++j) { const unsigned c = xb_ld(&bar[XB_XCNT(j)]); sum += c; cnt += (c > 0u) ? 1u : 0u; mine = (j == x) ? c : mine; }
        if (sum == G) break;
        __builtin_amdgcn_s_sleep(1);
        if ((++sp & 255u) == 0u) { if (xb_ld(&bar[XB_TMO])) break; if (sp > XB_SPIN_CAP) { atomicAdd(&bar[XB_TMO], 1u); break; } }
    }
    nloc = mine > 0u ? mine : 1u; nx = cnt > 0u ? cnt : 1u;
}

__device__ __forceinline__ void xcd_barrier(const XcdBarrier& b) {
    asm volatile("s_waitcnt vmcnt(0)" ::: "memory");
    __syncthreads();
    if (threadIdx.x == 0) {
        unsigned* bar = b.bar;
        __builtin_amdgcn_s_waitcnt(0);
        unsigned nloc = b.st[0], nx = b.st[1];
        if (nloc == 0u) { xcd_barrier_complete(bar, b.x, nloc, nx); b.st[0] = nloc; b.st[1] = nx; }
        const unsigned old = xb_add(&bar[XB_XSUB(b.x)], 1u);
        const unsigned gen = old / nloc;
        if (old + 1u == (gen + 1u) * nloc) {
            __builtin_amdgcn_fence(__ATOMIC_RELEASE, "agent");
            asm volatile("s_waitcnt vmcnt(0)" ::: "memory");
            const unsigned og = xb_add(&bar[XB_TOP], 1u);
            const unsigned tg = og / nx;
            if (og + 1u == (tg + 1u) * nx) xb_add(&bar[XB_TOPGEN], 1u);
            else XB_SPIN(xb_ld(&bar[XB_TOPGEN]) == tg, bar);
            __builtin_amdgcn_fence(__ATOMIC_ACQUIRE, "agent");
            xb_add(&bar[XB_XGEN(b.x)], 1u);
            asm volatile("s_waitcnt vmcnt(0)" ::: "memory");
        } else {
            XB_SPIN(xb_ld(&bar[XB_XGEN(b.x)]) == gen, bar);
            __builtin_amdgcn_fence(__ATOMIC_ACQUIRE, "agent");
            asm volatile("s_waitcnt vmcnt(0)" ::: "memory");
        }
    }
    __syncthreads();
}
struct Frame {
    LAS unsigned char* lds;
    unsigned char* ldsg;
    volatile LAS unsigned* MISC;
    int tid, lane, wave, vcu, G, gw, NGW;
    const GAS float* const __attribute__((address_space(4)))* in;
    GAS unsigned char* ws;
    GAS float* out;
    unsigned long long tprobe;
};
#ifndef PROBE_SUB
#define PROBE_SUB 0
#endif
#define TP_BEGIN() unsigned long long tp0_ = PROBE_SUB ? __builtin_amdgcn_s_memrealtime() : 0ull
#define TP_END(id) do { if (PROBE_SUB == (id)) { const unsigned long long t1_ = __builtin_amdgcn_s_memrealtime(); F0.tprobe += t1_ - tp0_; } if (PROBE_SUB) tp0_ = __builtin_amdgcn_s_memrealtime(); } while (0)
#define WSP(T, off) ((T*)(F.ws + (off)))
#define INP(k) ((const float*)F.in[k])
#define LAUNDER(F) asm volatile("" : "+s"(F.ws), "+s"(F.in), "+s"(F.out), "+v"(F.tid), "+v"(F.lane), "+s"(F.wave), "+s"(F.gw), "+s"(F.vcu), "+s"(F.G), "+s"(F.NGW))

__device__ __forceinline__ int row_s(int row) { return row < TLAT ? (row >> 12) : 4; }

__device__ __forceinline__ void mod_row_apply(const f32x4 (&v)[4], const f32x4 (&g4)[4], const f32x4 (&sh)[4], const f32x4 (&sc)[4], bf16* orow, int lane, f32x4 (&h)[4]) {
    float s = 0.f;
#pragma unroll
    for (int j = 0; j < 4; ++j) s += (v[j].x * v[j].x + v[j].y * v[j].y) + (v[j].z * v[j].z + v[j].w * v[j].w);
    const float rstd = 1.0f / sqrtf(wave_sum(s) * (1.0f / 1024.0f) + 1e-6f);
#pragma unroll
    for (int j = 0; j < 4; ++j) {
        h[j] = (v[j] * rstd) * g4[j] * (sc[j] + 1.0f) + sh[j];
        v2u o; o.x = pk2(h[j].x, h[j].y); o.y = pk2(h[j].z, h[j].w);
        ((v2u*)orow)[64 * j + lane] = o;
    }
}
__device__ __forceinline__ void mod_row_store(const f32x4 (&v)[4], const float* g, const float* shift, const float* scale, bf16* orow, int lane, f32x4 (&h)[4]) {
    f32x4 g4[4], sh[4], sc[4];
#pragma unroll
    for (int j = 0; j < 4; ++j) { g4[j] = ((const f32x4*)g)[64 * j + lane]; sh[j] = ((const f32x4*)shift)[64 * j + lane]; sc[j] = ((const f32x4*)scale)[64 * j + lane]; }
    mod_row_apply(v, g4, sh, sc, orow, lane, h);
}

template <class RowMap>
__device__ __forceinline__ void transpose_item(const float* W, int K, int N, bf16* WT, const RowMap& rowmap, LAS float* scr, int item, int lane) {
    const int nblk = (N + 63) / 64, kb = item / nblk, nb = item % nblk, k0 = 64 * kb, n0 = 64 * nb;
    const int r = lane >> 4, c4 = (lane & 15) * 4;
    f32x4 t_[16];
#pragma unroll
    for (int i = 0; i < 16; ++i) t_[i] = (n0 + c4 < N) ? *(const f32x4*)(W + (size_t)(k0 + 4 * i + r) * N + n0 + c4) : (f32x4){0.f, 0.f, 0.f, 0.f};
#pragma unroll
    for (int i = 0; i < 16; ++i) { LAS float* d = scr + (4 * i + r) * 65 + c4; d[0] = t_[i].x; d[1] = t_[i].y; d[2] = t_[i].z; d[3] = t_[i].w; }
    LDS_WAIT(); asm volatile("" ::: "memory");
    const int c = lane & 7;
#pragma unroll
    for (int j = 0; j < 8; ++j) { const int n = (lane >> 3) + 8 * j; const LAS float* s = scr + (8 * c) * 65 + n;
        v4u o; o.x = pk2(s[0 * 65], s[1 * 65]); o.y = pk2(s[2 * 65], s[3 * 65]); o.z = pk2(s[4 * 65], s[5 * 65]); o.w = pk2(s[6 * 65], s[7 * 65]);
        *(v4u*)(WT + (size_t)rowmap(n0 + n) * K + k0 + 8 * c) = o; }
    LDS_WAIT(); asm volatile("" ::: "memory");
}
struct RowId { int off; __device__ __forceinline__ int operator()(int n) const { return off + n; } };
struct RowW13 { int e, w3; __device__ __forceinline__ int operator()(int n) const { return e * 2048 + (n >> 7) * 256 + w3 * 128 + (n & 127); } };

__device__ __forceinline__ void ph_filters(Frame& F, int j);
__device__ __forceinline__ void ph_prologue(Frame& F0) { Frame F = F0; LAUNDER(F);
    const bool filt_first = (F.vcu & 1) != 0;
    if (filt_first) { ph_filters(F, 0); __syncthreads(); }
    LAS float* scr = (LAS float*)(F.lds + F.wave * 16640);
    LAS float* sv = (LAS float*)F.lds;
    constexpr int I_IN = 16 * ((EVC + 63) / 64), I_O = 16 * 16, I_Q = 16 * (QKVC / 64);
    constexpr int PER_J = I_IN + I_O + I_Q + I_O, NT_ITEMS = 2 * PER_J;
    for (int it = F.gw; it < NT_ITEMS; it += F.NGW) {
        const int j = it / PER_J; int r = it % PER_J;
        if (r < I_IN) { transpose_item(INP(I_EVWIN) + (size_t)j * DM * EVC, DM, EVC, WSP(bf16, WS_WIN) + (size_t)j * EVCP * DM, RowId{0}, scr, r, F.lane); continue; } r -= I_IN;
        if (r < I_O) { transpose_item(INP(I_EVWOUT) + (size_t)j * DM * DM, DM, DM, WSP(bf16, WS_WOE) + (size_t)j * DM * DM, RowId{0}, scr, r, F.lane); continue; } r -= I_O;
        if (r < I_Q) { transpose_item(INP(I_WQKV) + (size_t)j * DM * QKVC, DM, QKVC, WSP(bf16, WS_WQKV) + (size_t)j * QKVC * DM, RowId{0}, scr, r, F.lane); continue; } r -= I_Q;
        transpose_item(INP(I_DAWOUT) + (size_t)j * DM * DM, DM, DM, WSP(bf16, WS_WOD) + (size_t)j * DM * DM, RowId{0}, scr, r, F.lane);
    }
    __syncthreads();
    for (int i = F.tid; i < 5 * 1024; i += NTHR) { const float x = i < 4096 ? INP(I_C)[i] : INP(I_CCTX)[i - 4096]; sv[i] = siluf_(x); }
    __syncthreads();
    for (int it = F.gw; it < 4 * 24 * 16; it += F.NGW) {
        const int kc = it & 15, cg = (it >> 4) % 24, i = it / (16 * 24); const int col = cg * 256 + F.lane * 4;
        const float* wp = INP(I_ADAW) + (size_t)i * DM * 6144 + (size_t)(kc * 64) * 6144 + col;
        f32x4 acc[5];
#pragma unroll
        for (int s = 0; s < 5; ++s) acc[s] = (f32x4){0.f, 0.f, 0.f, 0.f};
#pragma unroll 1
        for (int k0 = 0; k0 < 64; k0 += 16) {
            f32x4 w[16];
#pragma unroll
            for (int k = 0; k < 16; ++k) w[k] = *(const f32x4*)(wp + (size_t)(k0 + k) * 6144);
#pragma unroll
            for (int k = 0; k < 16; ++k)
#pragma unroll
                for (int s = 0; s < 5; ++s) acc[s] = acc[s] + w[k] * sv[s * 1024 + kc * 64 + k0 + k];
        }
#pragma unroll
        for (int s = 0; s < 5; ++s) *(f32x4*)(WSP(float, WS_MODP) + ((size_t)(kc * 4 + i) * 5 + s) * 6144 + col) = acc[s];
    }
    for (int k = F.gw * 64 + F.lane; k < 8192; k += F.NGW * 64) { float s, c; sincospif((float)k * (1.0f / 4096.0f), &s, &c); WSP(f32x2, WS_TW)[k] = (f32x2){c, -s}; }
    for (int idx = F.gw * 64 + F.lane; idx < 2 * 224 * 64; idx += F.NGW * 64) {
        const int l = idx & 63, f = (idx >> 6) % 224, j = idx / (224 * 64); const int kb = 8 * (l >> 4), n = l & 15;
        const float* src; int col;
        if (f < 64) { const int d = f >> 5, nt = f & 31; src = INP(I_W2) + ((size_t)(j * 2 + d) * 32 + kb) * RWW; col = nt * 16 + n; }
        else if (f < 128) { const int d = (f - 64) >> 5, nt = (f - 64) & 31; src = INP(I_A2) + ((size_t)(j * 2 + d) * 32 + kb) * RWW; col = nt * 16 + n; }
        else { const int nt = (f - 128) / 3, ks = (f - 128) % 3; src = INP(I_G2) + ((size_t)j * 96 + ks * 32 + kb) * RWW; col = nt * 16 + n; }
        v4u o; o.x = pk2(src[0 * RWW + col], src[1 * RWW + col]); o.y = pk2(src[2 * RWW + col], src[3 * RWW + col]); o.z = pk2(src[4 * RWW + col], src[5 * RWW + col]); o.w = pk2(src[6 * RWW + col], src[7 * RWW + col]);
        WSP(v4u, WS_FRAGB)[idx] = o;
    }
    if (!filt_first) { __syncthreads(); ph_filters(F, 0); }
}
__device__ __forceinline__ void ph_modred(Frame& F0) { Frame F = F0; LAUNDER(F);
    for (int idx = F.gw * 64 + F.lane; idx < 4 * 5 * 6144; idx += F.NGW * 64) {
        const int col = idx % 6144, i = idx / (5 * 6144); float a = INP(I_ADAB)[i * 6144 + col];
#pragma unroll
        for (int kc = 0; kc < 16; ++kc) a += WSP(float, WS_MODP)[(size_t)kc * 4 * 5 * 6144 + idx];
        WSP(float, WS_MODS)[idx] = a;
    }
}
__device__ __forceinline__ void ph_mod0(Frame& F0) { Frame F = F0; LAUNDER(F);
    const float* mods = WSP(float, WS_MODS);
    f32x4 g4[4], vn[4];
#pragma unroll
    for (int j = 0; j < 4; ++j) g4[j] = ((const f32x4*)INP(I_NORMG))[64 * j + F.lane];
    if (F.gw < TT) { const float* src = F.gw < TLAT ? INP(I_X) + (size_t)F.gw * DM : INP(I_CTX) + (size_t)(F.gw - TLAT) * DM;
#pragma unroll
        for (int j = 0; j < 4; ++j) vn[j] = ((const f32x4*)src)[64 * j + F.lane]; }
    for (int row = F.gw; row < TT; row += F.NGW) {
        f32x4 v[4], h[4], sh[4], sc[4];
        const int s = row_s(row);
#pragma unroll
        for (int j = 0; j < 4; ++j) { v[j] = vn[j]; sh[j] = ((const f32x4*)(mods + s * 6144))[64 * j + F.lane]; sc[j] = ((const f32x4*)(mods + s * 6144 + 1024))[64 * j + F.lane]; }
        const int rn = row + F.NGW;
        if (rn < TT) { const float* src = rn < TLAT ? INP(I_X) + (size_t)rn * DM : INP(I_CTX) + (size_t)(rn - TLAT) * DM;
#pragma unroll
            for (int j = 0; j < 4; ++j) vn[j] = ((const f32x4*)src)[64 * j + F.lane]; }
#pragma unroll
        for (int j = 0; j < 4; ++j) ((f32x4*)(WSP(float, WS_X) + (size_t)row * DM))[64 * j + F.lane] = v[j];
        mod_row_apply(v, g4, sh, sc, WSP(bf16, WS_HA) + (size_t)row * DM, F.lane, h);
    }
}
__device__ __forceinline__ float seq_pos(int row, int& L) { if (row < TLAT) { L = SEQ; return (float)(row & (SEQ - 1)); } L = CTXL; return (float)((row - TLAT) & (CTXL - 1)); }
__device__ __forceinline__ int seq_l(int row, int& L) { if (row < TLAT) { L = SEQ; return row & (SEQ - 1); } L = CTXL; return (row - TLAT) & (CTXL - 1); }

__device__ __forceinline__ f32x4 shift4(const float* P, size_t off, bool hp, bool hn, f32x4 m0, f32x4 m1) {
    const f32x4 u = *(const f32x4*)(P + off);
    const f32x4 up = hp ? *(const f32x4*)(P + off - EVCP) : (f32x4){0.f, 0.f, 0.f, 0.f};
    const f32x4 un = hn ? *(const f32x4*)(P + off + EVCP) : (f32x4){0.f, 0.f, 0.f, 0.f};
    return u + m0 * (up - u) + m1 * (un - u);
}

__device__ __forceinline__ void ph_evprep(Frame& F0, int j) { Frame F = F0; LAUNDER(F);
    const float* P = WSP(float, WS_P);
    const float* mu = INP(I_MU) + (size_t)j * 2 * RWC;
    TP_BEGIN();
    {
        float* Vv = WSP(float, WS_V); bf16* AOP = WSP(bf16, WS_AOP);
        for (int row = F.gw; row < TT; row += F.NGW) {
            int L; const int l = seq_l(row, L); const bool hp = l > 0, hn = l < L - 1;
#pragma unroll
            for (int q = 4; q < 7; ++q) {
                const int g = F.lane + 64 * q;
                if (q < 6 || g < 440) {
                    const int col = 4 * g;
                    const f32x4 m0 = *(const f32x4*)(mu + col), m1 = *(const f32x4*)(mu + RWC + col);
                    f32x4 sv = shift4(P, (size_t)row * EVCP + col, hp, hn, m0, m1);
                    if (q < 6) *(f32x4*)(Vv + (size_t)row * RWW + (col - 1024)) = sv;
                    else { const int c = col - 1536;
                        if (c < 64) { sv.x = tanhf(sv.x); sv.y = tanhf(sv.y); sv.z = tanhf(sv.z); sv.w = tanhf(sv.w); }
                        else if (c >= 128) { sv.x = sigmoidf_(sv.x); sv.y = sigmoidf_(sv.y); sv.z = sigmoidf_(sv.z); sv.w = sigmoidf_(sv.w); }
                        v2u w; w.x = pk2(sv.x, sv.y); w.y = pk2(sv.z, sv.w); *(v2u*)(AOP + (size_t)row * 224 + c) = w; }
                }
            }
        }
    }
    __syncthreads(); TP_END(1);
    __syncthreads(); TP_END(2);

}


__device__ __forceinline__ void ph_filters(Frame& F, int j) {
    __syncthreads();
    {
        LAS float* H1 = (LAS float*)F.lds; LAS float* H2 = (LAS float*)(F.lds + 16384);
        LAS float* W1s = (LAS float*)(F.lds + 32768); LAS float* B1s = (LAS float*)(F.lds + 41216); LAS float* B2s = (LAS float*)(F.lds + 41472); LAS float* FRs = (LAS float*)(F.lds + 41728);
        LAS float* W2s = (LAS float*)(F.lds + 42240); LAS float* W3s = (LAS float*)(F.lds + 58624);
        for (int i = F.tid; i < 33 * 64; i += NTHR) W1s[i] = INP(I_FW1)[(size_t)j * 33 * 64 + i];
        for (int i = F.tid; i < 64 * 64; i += NTHR) W2s[i] = INP(I_FW2)[(size_t)j * 64 * 64 + i];
        if (F.tid < 64) { B1s[F.tid] = INP(I_FB1)[j * 64 + F.tid]; B2s[F.tid] = INP(I_FB2)[j * 64 + F.tid]; }
        if (F.tid < 128) FRs[F.tid] = INP(I_FREQ)[j * 128 + F.tid];
        const float* w3 = INP(I_FW3) + (size_t)j * 64 * 2048;
        const int p = F.tid & 63, cg = F.wave;
        for (int it = F.vcu; it < 320; it += F.G) {
            const bool lat = it < 256; const int L = lat ? SEQ : CTXL; const int r = lat ? it : it - 256; const int pt = lat ? (r >> 2) : (r >> 4); const int nct = lat ? 4 : 1, ct0 = lat ? (r & 3) * 4 : (r & 15); const int m = pt * 64 + p;
            float z[33];
            z[0] = (float)m / (float)(L - 1);
#pragma unroll
            for (int i = 0; i < 16; ++i) { const float band = 1e-4f + (float)i * ((15.0f - 1e-4f) / 15.0f); const float rev = (float)m * band / (float)L; const float fr_ = rev - floorf(rev);
                z[1 + i] = __builtin_amdgcn_cosf(fr_); z[17 + i] = -__builtin_amdgcn_sinf(fr_); }
            __syncthreads();
            {
                float a1[8];
#pragma unroll
                for (int q = 0; q < 8; ++q) a1[q] = B1s[cg * 8 + q];
#pragma unroll
                for (int i0 = 0; i0 < 33; i0 += 4) {
                    f32x4 wa[4], wb[4];
#pragma unroll
                    for (int u = 0; u < 4; ++u) if (i0 + u < 33) { wa[u] = *(const LAS f32x4*)(W1s + (i0 + u) * 64 + cg * 8); wb[u] = *(const LAS f32x4*)(W1s + (i0 + u) * 64 + cg * 8 + 4); }
                    asm volatile("s_waitcnt lgkmcnt(0)" ::: "memory"); __builtin_amdgcn_sched_barrier(0);
#pragma unroll
                    for (int u = 0; u < 4; ++u) if (i0 + u < 33) { const float zz = z[i0 + u];
                        a1[0] += zz * wa[u].x; a1[1] += zz * wa[u].y; a1[2] += zz * wa[u].z; a1[3] += zz * wa[u].w; a1[4] += zz * wb[u].x; a1[5] += zz * wb[u].y; a1[6] += zz * wb[u].z; a1[7] += zz * wb[u].w; }
                }
#pragma unroll
                for (int q = 0; q < 8; ++q) H1[(cg * 8 + q) * 64 + p] = __sinf(FRs[cg * 8 + q] * a1[q]);
            }
            __syncthreads();
            {
                float a2[8];
#pragma unroll
                for (int q = 0; q < 8; ++q) a2[q] = B2s[cg * 8 + q];
#pragma unroll 2
                for (int k0 = 0; k0 < 64; k0 += 4) {
                    f32x4 wa[4], wb[4]; float hh[4];
#pragma unroll
                    for (int u = 0; u < 4; ++u) { hh[u] = H1[(k0 + u) * 64 + p]; wa[u] = *(const LAS f32x4*)(W2s + (k0 + u) * 64 + cg * 8); wb[u] = *(const LAS f32x4*)(W2s + (k0 + u) * 64 + cg * 8 + 4); }
                    asm volatile("s_waitcnt lgkmcnt(0)" ::: "memory"); __builtin_amdgcn_sched_barrier(0);
#pragma unroll
                    for (int u = 0; u < 4; ++u) { const float zz = hh[u];
                        a2[0] += zz * wa[u].x; a2[1] += zz * wa[u].y; a2[2] += zz * wa[u].z; a2[3] += zz * wa[u].w; a2[4] += zz * wb[u].x; a2[5] += zz * wb[u].y; a2[6] += zz * wb[u].z; a2[7] += zz * wb[u].w; }
                }
#pragma unroll
                for (int q = 0; q < 8; ++q) H2[(cg * 8 + q) * 64 + p] = __sinf(FRs[64 + cg * 8 + q] * a2[q]);
            }
            const float t = z[0];
            float* KC = lat ? WSP(float, WS_KCL) : WSP(float, WS_KCC); const int N2 = 2 * L;
#pragma unroll 1
            for (int c4 = 0; c4 < nct; ++c4) {
                const int ct = ct0 + c4;
                __syncthreads();
                for (int i = F.tid; i < 64 * 32; i += NTHR) { const int k = i >> 5, cc = i & 31; *(LAS f32x4*)(W3s + k * 128 + cc * 4) = *(const f32x4*)(w3 + (size_t)k * 2048 + ct * 128 + cc * 4); }
                __syncthreads();
                f32x4 acc[4];
#pragma unroll
                for (int q = 0; q < 4; ++q) acc[q] = (f32x4){0.f, 0.f, 0.f, 0.f};
#pragma unroll 2
                for (int k = 0; k < 64; ++k) { const float hv = H2[k * 64 + p]; const LAS f32x4* wr = (const LAS f32x4*)(W3s + k * 128 + cg * 16);
#pragma unroll
                    for (int q = 0; q < 4; ++q) acc[q] = acc[q] + wr[q] * hv; }
                const int colb = ct * 128 + cg * 16;
#pragma unroll
                for (int q = 0; q < 16; ++q) { const int col = colb + q; const int o = col >> 10, dirn = (col >> 9) & 1, c = col & 511;
                    const float d0 = -3.0701134573253945f, d1 = -15.350567286626973f; const float del = fabsf(d0 + (d1 - d0) * ((float)c / 511.0f));
                    const float val = acc[q >> 2][q & 3] * __expf(-t * del); float* kr = KC + (size_t)(o * 512 + c) * N2;
                    if (dirn == 0) kr[m] = val; else { if (m > 0) kr[N2 - m] = val; else kr[L] = 0.f; } }
            }
        }
        __syncthreads();
    }
}
#define ZI(i) ((i) + ((i) >> 5))
__device__ __forceinline__ f32x2 cmul(f32x2 a, f32x2 b) { return (f32x2){a.x * b.x - a.y * b.y, a.x * b.y + a.y * b.x}; }
__device__ __forceinline__ f32x2 cmulc(f32x2 a, f32x2 b) { return (f32x2){a.x * b.x + a.y * b.y, a.y * b.x - a.x * b.y}; }
template <int LOGN, int NF> __device__ __forceinline__ void fft_r2_dif(LAS f32x2* Z, const LAS f32x2* TWL, int lt, int lh) {
    constexpr int N = 1 << LOGN, TPG = NTHR / NF; const int half = 1 << lh;
    for (int bf = lt; bf < N / 2; bf += TPG) { const int jx = bf & (half - 1), i = ((bf - jx) << 1) + jx;
        const f32x2 a = Z[ZI(i)], b = Z[ZI(i + half)]; Z[ZI(i)] = a + b; Z[ZI(i + half)] = cmul(a - b, TWL[half + jx]); }
    __syncthreads();
}
template <int LOGN, int NF> __device__ __forceinline__ void fft_r8_dif(LAS f32x2* Z, const LAS f32x2* TWL, int lt, int lh) {
    constexpr int N = 1 << LOGN, TPG = NTHR / NF, NG = N / 8, PT = (NG + TPG - 1) / TPG; const int h = 1 << lh, qd = h >> 2, lq = lh - 2;
    f32x2 x[PT][8]; int i0[PT], j0[PT];
#pragma unroll
    for (int t = 0; t < PT; ++t) { const int g = lt + TPG * t; j0[t] = g & (qd - 1); i0[t] = ((g >> lq) << (lq + 3)) + j0[t];
        if (g < NG) {
#pragma unroll
            for (int m = 0; m < 8; ++m) x[t][m] = Z[ZI(i0[t] + m * qd)]; } }
#pragma unroll
    for (int t = 0; t < PT; ++t) { const int g = lt + TPG * t; if (g < NG) {
#pragma unroll
        for (int m = 0; m < 4; ++m) { const f32x2 a = x[t][m], b = x[t][m + 4]; x[t][m] = a + b; x[t][m + 4] = cmul(a - b, TWL[h + j0[t] + m * qd]); }
#pragma unroll
        for (int mm = 0; mm < 4; ++mm) { const int m = (mm & 1) + 4 * (mm >> 1); const f32x2 a = x[t][m], b = x[t][m + 2]; x[t][m] = a + b; x[t][m + 2] = cmul(a - b, TWL[(h >> 1) + j0[t] + (m & 1) * qd]); }
        const f32x2 wc = TWL[qd + j0[t]];
#pragma unroll
        for (int m = 0; m < 8; m += 2) { const f32x2 a = x[t][m], b = x[t][m + 1]; x[t][m] = a + b; x[t][m + 1] = cmul(a - b, wc); }
#pragma unroll
        for (int m = 0; m < 8; ++m) Z[ZI(i0[t] + m * qd)] = x[t][m]; } }
    __syncthreads();
}
template <int LOGN, int NF> __device__ __forceinline__ void fft_r16_dif(LAS f32x2* Z, const LAS f32x2* TWL, int lt, int lh) {
    constexpr int N = 1 << LOGN, TPG = NTHR / NF, NG = N / 16; const int h = 1 << lh, qd = h >> 3, lq = lh - 3;
    for (int g = lt; g < NG; g += TPG) {
        const int j0 = g & (qd - 1), i0 = ((g >> lq) << (lq + 4)) + j0;
        f32x2 x[16], t1[8], t2[4], t3[2];
#pragma unroll
        for (int m = 0; m < 16; ++m) x[m] = Z[ZI(i0 + m * qd)];
#pragma unroll
        for (int m = 0; m < 8; ++m) t1[m] = TWL[h + j0 + m * qd];
        asm volatile("s_waitcnt lgkmcnt(0)" ::: "memory"); __builtin_amdgcn_sched_barrier(0);
#pragma unroll
        for (int m = 0; m < 8; ++m) { const f32x2 a = x[m], b = x[m + 8]; x[m] = a + b; x[m + 8] = cmul(a - b, t1[m]); }
        __builtin_amdgcn_sched_barrier(0);
#pragma unroll
        for (int m = 0; m < 4; ++m) t2[m] = TWL[(h >> 1) + j0 + m * qd];
#pragma unroll
        for (int m = 0; m < 2; ++m) t3[m] = TWL[(h >> 2) + j0 + m * qd];
        const f32x2 wc = TWL[qd + j0];
        asm volatile("s_waitcnt lgkmcnt(0)" ::: "memory"); __builtin_amdgcn_sched_barrier(0);
#pragma unroll
        for (int mm = 0; mm < 8; ++mm) { const int m = (mm & 3) + 8 * (mm >> 2); const f32x2 a = x[m], b = x[m + 4]; x[m] = a + b; x[m + 4] = cmul(a - b, t2[m & 3]); }
#pragma unroll
        for (int mm = 0; mm < 8; ++mm) { const int m = (mm & 1) + 4 * (mm >> 1); const f32x2 a = x[m], b = x[m + 2]; x[m] = a + b; x[m + 2] = cmul(a - b, t3[m & 1]); }
#pragma unroll
        for (int m = 0; m < 16; m += 2) { const f32x2 a = x[m], b = x[m + 1]; x[m] = a + b; x[m + 1] = cmul(a - b, wc); }
#pragma unroll
        for (int m = 0; m < 16; ++m) Z[ZI(i0 + m * qd)] = x[m];
    }
    __syncthreads();
}
template <int LOGN, int NF> __device__ __forceinline__ void fft_r16_dit(LAS f32x2* Z, const LAS f32x2* TWL, int lt, int lq) {
    constexpr int N = 1 << LOGN, TPG = NTHR / NF, NG = N / 16; const int qd = 1 << lq;
    for (int g = lt; g < NG; g += TPG) {
        const int j0 = g & (qd - 1), i0 = ((g >> lq) << (lq + 4)) + j0;
        f32x2 x[16], t2[2], t4[4], t8[8];
#pragma unroll
        for (int m = 0; m < 16; ++m) x[m] = Z[ZI(i0 + m * qd)];
        const f32x2 wc = TWL[qd + j0];
#pragma unroll
        for (int m = 0; m < 2; ++m) t2[m] = TWL[2 * qd + j0 + m * qd];
#pragma unroll
        for (int m = 0; m < 4; ++m) t4[m] = TWL[4 * qd + j0 + m * qd];
        asm volatile("s_waitcnt lgkmcnt(0)" ::: "memory"); __builtin_amdgcn_sched_barrier(0);
#pragma unroll
        for (int m = 0; m < 16; m += 2) { const f32x2 a = x[m], b = cmulc(x[m + 1], wc); x[m] = a + b; x[m + 1] = a - b; }
#pragma unroll
        for (int mm = 0; mm < 8; ++mm) { const int m = (mm & 1) + 4 * (mm >> 1); const f32x2 a = x[m], b = cmulc(x[m + 2], t2[m & 1]); x[m] = a + b; x[m + 2] = a - b; }
#pragma unroll
        for (int mm = 0; mm < 8; ++mm) { const int m = (mm & 3) + 8 * (mm >> 2); const f32x2 a = x[m], b = cmulc(x[m + 4], t4[m & 3]); x[m] = a + b; x[m + 4] = a - b; }
        __builtin_amdgcn_sched_barrier(0);
#pragma unroll
        for (int m = 0; m < 8; ++m) t8[m] = TWL[8 * qd + j0 + m * qd];
        asm volatile("s_waitcnt lgkmcnt(0)" ::: "memory"); __builtin_amdgcn_sched_barrier(0);
#pragma unroll
        for (int m = 0; m < 8; ++m) { const f32x2 a = x[m], b = cmulc(x[m + 8], t8[m]); x[m] = a + b; x[m + 8] = a - b; }
#pragma unroll
        for (int m = 0; m < 16; ++m) Z[ZI(i0 + m * qd)] = x[m];
    }
    __syncthreads();
}
template <int LOGN, int NF, bool SKIP_R2 = false> __device__ __forceinline__ void fft_dif(LAS f32x2* Z, const LAS f32x2* TWL, int lt) {
    int lh = LOGN - 1;
    if (LOGN % 3 == 1) { if (!SKIP_R2) fft_r2_dif<LOGN, NF>(Z, TWL, lt, lh); lh -= 1; }
    if constexpr (LOGN % 3 == 1 && (LOGN - 1) % 4 == 0) {
#pragma unroll 1
        for (; lh >= 3; lh -= 4) fft_r16_dif<LOGN, NF>(Z, TWL, lt, lh);
    } else {
#pragma unroll 1
        for (; lh >= 2; lh -= 3) fft_r8_dif<LOGN, NF>(Z, TWL, lt, lh);
    }
}
template <int LOGN, int NF> __device__ __forceinline__ void fft_r8_dit(LAS f32x2* Z, const LAS f32x2* TWL, int lt, int lq) {
    constexpr int N = 1 << LOGN, TPG = NTHR / NF, NG = N / 8, PT = (NG + TPG - 1) / TPG; const int qd = 1 << lq;
    f32x2 x[PT][8]; int i0[PT], j0[PT];
#pragma unroll
    for (int t = 0; t < PT; ++t) { const int g = lt + TPG * t; j0[t] = g & (qd - 1); i0[t] = ((g >> lq) << (lq + 3)) + j0[t];
        if (g < NG) {
#pragma unroll
            for (int m = 0; m < 8; ++m) x[t][m] = Z[ZI(i0[t] + m * qd)]; } }
#pragma unroll
    for (int t = 0; t < PT; ++t) { const int g = lt + TPG * t; if (g < NG) {
        const f32x2 wc = TWL[qd + j0[t]];
#pragma unroll
        for (int m = 0; m < 8; m += 2) { const f32x2 a = x[t][m], b = cmulc(x[t][m + 1], wc); x[t][m] = a + b; x[t][m + 1] = a - b; }
#pragma unroll
        for (int mm = 0; mm < 4; ++mm) { const int m = (mm & 1) + 4 * (mm >> 1); const f32x2 a = x[t][m], b = cmulc(x[t][m + 2], TWL[2 * qd + j0[t] + (m & 1) * qd]); x[t][m] = a + b; x[t][m + 2] = a - b; }
#pragma unroll
        for (int m = 0; m < 4; ++m) { const f32x2 a = x[t][m], b = cmulc(x[t][m + 4], TWL[4 * qd + j0[t] + m * qd]); x[t][m] = a + b; x[t][m + 4] = a - b; }
#pragma unroll
        for (int m = 0; m < 8; ++m) Z[ZI(i0[t] + m * qd)] = x[t][m]; } }
    __syncthreads();
}
template <int LOGN, int NF, bool SKIP_R2 = false> __device__ __forceinline__ void fft_dit_inv(LAS f32x2* Z, const LAS f32x2* TWL, int lt) {
    constexpr int N = 1 << LOGN, TPG = NTHR / NF; constexpr int NTRI = LOGN / 3;
    if constexpr (LOGN % 3 == 1 && (LOGN - 1) % 4 == 0) {
#pragma unroll 1
        for (int k = 0; k < (LOGN - 1) / 4; ++k) fft_r16_dit<LOGN, NF>(Z, TWL, lt, 4 * k);
    } else {
#pragma unroll 1
        for (int k = 0; k < NTRI; ++k) fft_r8_dit<LOGN, NF>(Z, TWL, lt, 3 * k);
    }
    if (LOGN % 3 == 1 && !SKIP_R2) { const int half = N / 2;
        for (int bf = lt; bf < N / 2; bf += TPG) { const f32x2 a = Z[ZI(bf)], b = cmulc(Z[ZI(bf + half)], TWL[half + bf]); Z[ZI(bf)] = a + b; Z[ZI(bf + half)] = a - b; }
        __syncthreads(); }
}
template <int LOGN> __device__ __forceinline__ int brev_n(int x) { return (int)(__brev((unsigned)x) >> (32 - LOGN)); }
template <int LOGN> __device__ __forceinline__ void load_tw(Frame& F, LAS f32x2* TWL) {
    constexpr int N = 1 << LOGN; const f32x2* TW = WSP(f32x2, WS_TW);
    for (int k = F.tid; k < N; k += NTHR) { if (k == 0) { TWL[0] = (f32x2){1.f, 0.f}; continue; }
        const int lh = 31 - __builtin_clz((unsigned)k), jx = k - (1 << lh);
        TWL[k] = TW[(size_t)jx << (12 - lh)]; }
}
__device__ __forceinline__ float block_sum(Frame& F, float v, LAS float* red) {
    v = wave_sum(v); __syncthreads(); if (F.lane == 0) red[F.wave] = v; __syncthreads();
    float t = 0.f;
#pragma unroll
    for (int w = 0; w < NWAVES; ++w) t += red[w];
    return t;
}
template <int LOGN, int NF> struct FftGeo { static constexpr int N = 1 << LOGN, TPG = NTHR / NF, ZS = N + N / 32; };

template <int LOGN, int NF> __device__ __forceinline__ void fftk_item(Frame& F, const float* KC, f32x4* KSP, int item) {
    constexpr int N = 1 << LOGN, TPG = NTHR / NF, ZS = FftGeo<LOGN, NF>::ZS;
    const int fi = F.tid / TPG, lt = F.tid % TPG; const int p8 = item * NF + fi, o = p8 >> 8, pr = p8 & 255;
    LAS f32x2* Z = (LAS f32x2*)F.lds + fi * ZS; LAS f32x2* TWL = (LAS f32x2*)(F.lds + 67584); LAS float* red = (LAS float*)(F.lds + 133120);
    const float* ka = KC + (size_t)(o * 512 + 2 * pr) * N; const float* kb = ka + N;
    float sa = 0.f, sb = 0.f;
    {
        constexpr int PTK = N / TPG; float av[PTK], bv[PTK];
#pragma unroll
        for (int t = 0; t < PTK; ++t) { av[t] = ka[lt + TPG * t]; bv[t] = kb[lt + TPG * t]; }
#pragma unroll
        for (int t = 0; t < PTK; ++t) { sa += fabsf(av[t]); sb += fabsf(bv[t]); Z[ZI(lt + TPG * t)] = (f32x2){av[t], bv[t]}; }
    }
    float na, nb;
    if (NF == 1) { na = block_sum(F, sa, red) + 1e-6f; nb = block_sum(F, sb, red + 8) + 1e-6f; } else { static_assert(NF == 1 || NTHR / NF == 64, "one wave per transform"); na = wave_sum(sa) + 1e-6f; nb = wave_sum(sb) + 1e-6f; }
    __syncthreads();
    fft_dif<LOGN, NF>(Z, TWL, lt);
    const float ia = 0.5f / (na * (float)N), ib = 0.5f / (nb * (float)N);
    f32x4* dst = KSP + (size_t)(o * 256 + pr) * N;
#pragma unroll 4
    for (int p = lt; p < N; p += TPG) {
        const int k = brev_n<LOGN>(p), p2 = brev_n<LOGN>((N - k) & (N - 1));
        const f32x2 z1 = Z[ZI(p)], z2 = Z[ZI(p2)];
        const f32x2 Ka = (f32x2){(z1.x + z2.x) * ia, (z1.y - z2.y) * ia}, Kb = (f32x2){(z1.y + z2.y) * ib, -(z1.x - z2.x) * ib};
        dst[p] = (f32x4){0.5f * (Ka.x + Kb.x), 0.5f * (Ka.y + Kb.y), 0.5f * (Ka.x - Kb.x), 0.5f * (Ka.y - Kb.y)};
    }
    __syncthreads();
}

template <int LOGN, int NF> __device__ __forceinline__ void spec_mul(LAS f32x2* Z, const f32x4* KS, int lt) {
    constexpr int N = 1 << LOGN, TPG = NTHR / NF, PT = (N + TPG - 1) / TPG;
    f32x4 kv[PT]; f32x2 yv[PT];
#pragma unroll
    for (int t = 0; t < PT; ++t) { const int p = lt + TPG * t; if (p < N) kv[t] = KS[p]; }
#pragma unroll
    for (int t = 0; t < PT; ++t) { const int p = lt + TPG * t; if (p < N) {
        const int k = brev_n<LOGN>(p), p2 = brev_n<LOGN>((N - k) & (N - 1));
        const f32x2 z1 = Z[ZI(p)], z2 = Z[ZI(p2)];
        yv[t] = cmul(z1, (f32x2){kv[t].x, kv[t].y}) + cmul((f32x2){z2.x, -z2.y}, (f32x2){kv[t].z, kv[t].w}); } }
    __syncthreads();
#pragma unroll
    for (int t = 0; t < PT; ++t) { const int p = lt + TPG * t; if (p < N) Z[ZI(p)] = yv[t]; }
    __syncthreads();
}
__device__ __forceinline__ float conv3_at(const float* p, int l, int L, float w0, float w1, float w2, float bb) {
    const float up = l > 0 ? p[l - 1] : 0.f, u = p[l], un = l < L - 1 ? p[l + 1] : 0.f; return up * w0 + u * w1 + un * w2 + bb; }
template <int LOGN, int NF> __device__ __forceinline__ void hyena_item(Frame& F, const float* UTall, const f32x4* KSP, float* HYTall, const float* hyb, const float* cw, const float* cb, int item) {
    constexpr int N = 1 << LOGN, L = N / 2, TPG = NTHR / NF, PT = (L + TPG - 1) / TPG, ZS = FftGeo<LOGN, NF>::ZS;
    const int fi = F.tid / TPG, lt = F.tid % TPG; const int p8 = item * NF + fi, b = p8 >> 8, pr = p8 & 255;
    const float* UT = UTall + (size_t)b * HYC * L; float* HYT = HYTall + (size_t)b * 512 * L;
    LAS f32x2* Z = (LAS f32x2*)F.lds + fi * ZS; LAS f32x2* TWL = (LAS f32x2*)(F.lds + 67584);
    const int c0 = 2 * pr; const float b0a = hyb[c0], b0b = hyb[c0 + 1], b1a = hyb[512 + c0], b1b = hyb[512 + c0 + 1];
#define CV(ptr, l_, s3, ch) conv3_at(ptr, l_, L, cw[(s3) * 512 + c0 + (ch)], cw[HYC + (s3) * 512 + c0 + (ch)], cw[2 * HYC + (s3) * 512 + c0 + (ch)], cb[(s3) * 512 + c0 + (ch)])
    const float* va = UT + (size_t)c0 * L; const float* vb = va + L;
    f32x2 keep[PT];
    f32x2 zpair = (f32x2){0.f, 0.f}; asm volatile("" : "+v"(zpair));
    const float* xa = UT + (size_t)(512 + c0) * L; const float* xb = xa + L;
    const float* x2a = UT + (size_t)(1024 + c0) * L; const float* x2b = x2a + L;
    float* oa = HYT + (size_t)c0 * L; float* ob = oa + L;
    if constexpr (LOGN % 3 == 1) {
#pragma unroll
        for (int q = 0; q < PT; ++q) { const int l = lt + TPG * q; keep[q] = (f32x2){CV(va, l, 0, 0), CV(vb, l, 0, 1)}; Z[ZI(l)] = keep[q]; Z[ZI(l + L)] = cmul(keep[q], TWL[L + l]); }
        __syncthreads();
        fft_dif<LOGN, NF, true>(Z, TWL, lt);
        spec_mul<LOGN, NF>(Z, KSP + (size_t)pr * N, lt);
        fft_dit_inv<LOGN, NF, true>(Z, TWL, lt);
        f32x2 x1v[PT];
#pragma unroll
        for (int q = 0; q < PT; ++q) { const int l = lt + TPG * q; x1v[q] = (f32x2){CV(xa, l, 1, 0), CV(xb, l, 1, 1)}; }
#pragma unroll
        for (int q = 0; q < PT; ++q) { const int l = lt + TPG * q; const f32x2 w = TWL[L + l]; const f32x2 y = Z[ZI(l)] + cmulc(Z[ZI(l + L)], w);
            keep[q] = (f32x2){x1v[q].x * (y.x + keep[q].x * b0a), x1v[q].y * (y.y + keep[q].y * b0b)};
            Z[ZI(l)] = keep[q]; Z[ZI(l + L)] = cmul(keep[q], w); }
        __syncthreads();
        fft_dif<LOGN, NF, true>(Z, TWL, lt);
        spec_mul<LOGN, NF>(Z, KSP + (size_t)(256 + pr) * N, lt);
        fft_dit_inv<LOGN, NF, true>(Z, TWL, lt);
#pragma unroll
        for (int q = 0; q < PT; ++q) { const int l = lt + TPG * q; x1v[q] = (f32x2){CV(x2a, l, 2, 0), CV(x2b, l, 2, 1)}; }
#pragma unroll
        for (int q = 0; q < PT; ++q) { const int l = lt + TPG * q; const f32x2 y = Z[ZI(l)] + cmulc(Z[ZI(l + L)], TWL[L + l]);
            oa[l] = x1v[q].x * (y.x + keep[q].x * b1a); ob[l] = x1v[q].y * (y.y + keep[q].y * b1b); }
        __syncthreads();
    } else {
#pragma unroll
        for (int q = 0; q < PT; ++q) { const int l = lt + TPG * q; if (l < L) { keep[q] = (f32x2){CV(va, l, 0, 0), CV(vb, l, 0, 1)}; Z[ZI(l)] = keep[q]; Z[ZI(l + L)] = zpair; } }
        __syncthreads();
        fft_dif<LOGN, NF>(Z, TWL, lt);
        spec_mul<LOGN, NF>(Z, KSP + (size_t)pr * N, lt);
        fft_dit_inv<LOGN, NF>(Z, TWL, lt);
#pragma unroll
        for (int q = 0; q < PT; ++q) { const int l = lt + TPG * q; if (l < L) { const f32x2 y = Z[ZI(l)]; keep[q] = (f32x2){CV(xa, l, 1, 0) * (y.x + keep[q].x * b0a), CV(xb, l, 1, 1) * (y.y + keep[q].y * b0b)}; } }
        __syncthreads();
#pragma unroll
        for (int q = 0; q < PT; ++q) { const int l = lt + TPG * q; if (l < L) { Z[ZI(l)] = keep[q]; Z[ZI(l + L)] = zpair; } }
        __syncthreads();
        fft_dif<LOGN, NF>(Z, TWL, lt);
        spec_mul<LOGN, NF>(Z, KSP + (size_t)(256 + pr) * N, lt);
        fft_dit_inv<LOGN, NF>(Z, TWL, lt);
#pragma unroll
        for (int q = 0; q < PT; ++q) { const int l = lt + TPG * q; if (l < L) { const f32x2 y = Z[ZI(l)]; oa[l] = CV(x2a, l, 2, 0) * (y.x + keep[q].x * b1a); ob[l] = CV(x2b, l, 2, 1) * (y.y + keep[q].y * b1b); } }
        __syncthreads();
    }
#undef CV
}
__device__ __forceinline__ void ph_hyena(Frame& F0, int j) { Frame F = F0; LAUNDER(F);
    LAS f32x2* TWL = (LAS f32x2*)(F.lds + 67584);
    const float* hyb = INP(I_HYB) + (size_t)j * 1024;
    load_tw<13>(F, TWL); __syncthreads();
    for (int it = F.vcu; it < 1024; it += F.G) hyena_item<13, 1>(F, WSP(float, WS_UTL), WSP(f32x4, WS_KSPL), WSP(float, WS_HYTL), hyb, INP(I_CONVW) + (size_t)j * 3 * HYC, INP(I_CONVB) + (size_t)j * HYC, it);
    __syncthreads(); load_tw<9>(F, TWL); __syncthreads();
    for (int it = F.vcu; it < 128; it += F.G) hyena_item<9, 8>(F, WSP(float, WS_UTC), WSP(f32x4, WS_KSPC), WSP(float, WS_HYTC), hyb, INP(I_CONVW) + (size_t)j * 3 * HYC, INP(I_CONVB) + (size_t)j * HYC, it);
    __syncthreads();
}

__device__ __forceinline__ void ph_readout(Frame& F0, int j) { Frame F = F0; LAUNDER(F);
    const float* Vv = WSP(float, WS_V); const float* Gg = WSP(float, WS_G); const float* BON = WSP(float, WS_BON);
    const float* Y0 = WSP(float, WS_Y); const float* Y1 = Y0 + (size_t)TT * RWW;
    const float* gn = INP(I_GN) + (size_t)j * 2 * RWW;
    bf16* CAT = WSP(bf16, WS_CAT);
    f32x4 gwt[2], gbs[2], ny0[2], ny1[2], nv[2], ng[2]; float nb[2];
#pragma unroll
    for (int q = 0; q < 2; ++q) { const int c = 4 * F.lane + 256 * q; gwt[q] = *(const f32x4*)(gn + c); gbs[q] = *(const f32x4*)(gn + RWW + c); }
#define RD_LOAD(r_) do { _Pragma("unroll") for (int q = 0; q < 2; ++q) { const int c = 4 * F.lane + 256 * q; const size_t o = (size_t)(r_) * RWW + c; \
        ny0[q] = *(const f32x4*)(Y0 + o); ny1[q] = *(const f32x4*)(Y1 + o); nv[q] = *(const f32x4*)(Vv + o); ng[q] = *(const f32x4*)(Gg + o); nb[q] = BON[(size_t)(r_) * 8 + (c >> 6)]; } } while (0)
    if (F.gw < TT) RD_LOAD(F.gw);
    for (int row = F.gw; row < TT; row += F.NGW) {
        f32x4 y[2], v[2], g[2]; float bs[2];
#pragma unroll
        for (int q = 0; q < 2; ++q) { y[q] = ny0[q] + ny1[q]; v[q] = nv[q]; g[q] = ng[q]; bs[q] = nb[q]; }
        if (row + F.NGW < TT) RD_LOAD(row + F.NGW);
#pragma unroll
        for (int q = 0; q < 2; ++q) {
            const int c = 4 * F.lane + 256 * q;
            float s = (y[q].x + y[q].y) + (y[q].z + y[q].w);
            s = sum16_f(s);
            const float mu = s * (1.0f / 64.0f); const f32x4 dy = y[q] - mu;
            float v2 = (dy.x * dy.x + dy.y * dy.y) + (dy.z * dy.z + dy.w * dy.w);
            v2 = sum16_f(v2);
            const float rstd = 1.0f / sqrtf(v2 * (1.0f / 64.0f) + 64e-5f);
            const f32x4 yn = dy * rstd * gwt[q] + gbs[q];
            f32x4 ov = (yn + v[q] * bs[q]) * g[q];
#ifdef ABL_RW
            ov = ov * 0.0f;
#endif
            v2u w; w.x = pk2(ov.x, ov.y); w.y = pk2(ov.z, ov.w);
            *(v2u*)(CAT + (size_t)row * DM + c) = w;
        }
    }
#undef RD_LOAD
    LAS float* scr = (LAS float*)(F.lds + F.wave * 16640);
    for (int it = (F.gw + F.NGW / 2) % F.NGW; it < (TT / 64) * 8; it += F.NGW) {
        const int rt = it >> 3, ct = it & 7; const int r0 = rt * 64; int L; const int l0 = seq_l(r0, L);
        const float* src; if (r0 < TLAT) src = WSP(float, WS_HYTL) + ((size_t)(r0 >> 12) * 512 + ct * 64) * SEQ + l0; else src = WSP(float, WS_HYTC) + ((size_t)((r0 - TLAT) >> 8) * 512 + ct * 64) * CTXL + l0;
#pragma unroll 16
        for (int cc = 0; cc < 64; ++cc) scr[cc * 65 + F.lane] = src[(size_t)cc * L + F.lane];
        LDS_WAIT(); asm volatile("" ::: "memory");
        const int c2 = 2 * (F.lane & 31);
        for (int i2 = 0; i2 < 32; ++i2) { const int rr = 2 * i2 + (F.lane >> 5);
            unsigned pkv = pk2(scr[c2 * 65 + rr], scr[(c2 + 1) * 65 + rr]);
#ifdef ABL_HY
            pkv = 0u;
#endif
            *(unsigned*)(CAT + (size_t)(r0 + rr) * DM + 512 + ct * 64 + c2) = pkv; }
        LDS_WAIT(); asm volatile("" ::: "memory");
    }
}

__device__ __forceinline__ int chunk_base_row(int b, int d, int n) {
    if (n < 16) return TLAT + b * CTXL + 16 * (d ? 15 - n : n);
    const int m = n - 16; return b * SEQ + 16 * (d ? 255 - m : m);
}

__device__ __forceinline__ void ph_chunkprep(Frame& F0, int j) { Frame F = F0; LAUNDER(F);
    const float* P = WSP(float, WS_P); const float* Vv = WSP(float, WS_V);
    const bf16* AOP = WSP(bf16, WS_AOP); float* Gg = WSP(float, WS_G); float* BON = WSP(float, WS_BON);
    LAS unsigned char* wl = F.lds + F.wave * 14336;
    LAS float* ST = (LAS float*)wl; LAS bf16* OPB = (LAS bf16*)(wl + 4096); LAS float* TM = (LAS float*)(wl + 12288); LAS float* M2s = (LAS float*)(wl + 13312);
    LAS v4u* FBL = (LAS v4u*)(F.lds + 8 * 14336);
    const int h = F.vcu & 7;
    {
        const v4u* FB = WSP(v4u, WS_FRAGB) + (size_t)j * 224 * 64;
        for (int i = F.tid; i < 28 * 64; i += NTHR) { const int f = i >> 6, l = i & 63; int src;
            if (f < 8) src = (f >> 2) * 32 + 4 * h + (f & 3); else if (f < 16) src = 64 + ((f - 8) >> 2) * 32 + 4 * h + (f & 3); else src = 128 + (4 * h + (f - 16) / 3) * 3 + (f - 16) % 3;
            FBL[i] = FB[src * 64 + l]; }
    }
    __syncthreads();
    const int lane = F.lane, n15 = lane & 15, q = lane >> 4;
    LAS float* BIAS = (LAS float*)(F.lds + LDSCTL_OFF + 1024);
    if (F.tid < 256) { const int which = F.tid >> 7, d = (F.tid >> 6) & 1, c = F.tid & 63; BIAS[F.tid] = (which ? INP(I_A0) : INP(I_W0))[(size_t)(j * 2 + d) * RWW + h * 64 + c]; }
    __syncthreads();
    const int col = h * 64 + lane;
    const float kav = INP(I_KA)[(size_t)j * RWW + col], rkv = INP(I_RK)[(size_t)j * RWW + col], kkw = INP(I_KK)[(size_t)j * RWW + col];
    const float* mu = INP(I_MU) + (size_t)j * 2 * RWC;
    const float mr0 = mu[col], mr1 = mu[RWC + col], mk0 = mu[512 + col], mk1 = mu[RWC + 512 + col];
    for (int c16 = (F.vcu >> 3) * 8 + F.wave; c16 < TT / 16; c16 += (F.G >> 3) * 8) {
        unsigned long long tq_ = PROBE_SUB ? __builtin_amdgcn_s_memrealtime() : 0ull;
#define TQ(id) do { if (PROBE_SUB) { asm volatile("s_waitcnt vmcnt(0) lgkmcnt(0)" ::: "memory"); const unsigned long long t1_ = __builtin_amdgcn_s_memrealtime(); if (PROBE_SUB == (id)) F.tprobe += t1_ - tq_; tq_ = t1_; } } while (0)
        const int base = c16 * 16;
        const bool lat = base < TLAT; const int b = lat ? (base >> 12) : ((base - TLAT) >> 8); const int cidx = lat ? ((base & (SEQ - 1)) >> 4) : (((base - TLAT) & (CTXL - 1)) >> 4);
        bf16x8 af[7];
#pragma unroll
        for (int f7 = 4; f7 < 7; ++f7) af[f7] = *(const bf16x8*)(AOP + (size_t)(base + n15) * 224 + f7 * 32 + 8 * q);
        float kkv[16], kxv[16], rxv[16];
        {
            const int lpos = lat ? (base & (SEQ - 1)) : ((base - TLAT) & (CTXL - 1)); const int Lseq = lat ? SEQ : CTXL;
            float pr[18], pk[18];
#pragma unroll
            for (int s = 0; s < 18; ++s) { const bool ok = (s > 0 || lpos > 0) && (s < 17 || lpos + 16 < Lseq); const size_t o = (size_t)(base + s - 1) * EVCP + col;
                pr[s] = ok ? P[o] : 0.f; pk[s] = ok ? P[o + 512] : 0.f; }
#pragma unroll
            for (int s = 0; s < 16; ++s) {
                rxv[s] = pr[s + 1] + mr0 * (pr[s] - pr[s + 1]) + mr1 * (pr[s + 2] - pr[s + 1]);
                kxv[s] = pk[s + 1] + mk0 * (pk[s] - pk[s + 1]) + mk1 * (pk[s + 2] - pk[s + 1]);
                const float kq = kxv[s] * kkw; const float ss = wave_sum(kq * kq);
                kkv[s] = kq * (1.0f / fmaxf(sqrtf(ss), 1e-12f));
            }
        }
#pragma unroll
        for (int nt = 0; nt < 4; ++nt) {
            f32x4 cg = __builtin_amdgcn_mfma_f32_16x16x32_bf16(af[4], __builtin_bit_cast(bf16x8, FBL[(16 + nt * 3 + 0) * 64 + lane]), (f32x4){0.f, 0.f, 0.f, 0.f}, 0, 0, 0);
            cg = __builtin_amdgcn_mfma_f32_16x16x32_bf16(af[5], __builtin_bit_cast(bf16x8, FBL[(16 + nt * 3 + 1) * 64 + lane]), cg, 0, 0, 0);
            cg = __builtin_amdgcn_mfma_f32_16x16x32_bf16(af[6], __builtin_bit_cast(bf16x8, FBL[(16 + nt * 3 + 2) * 64 + lane]), cg, 0, 0, 0);
#pragma unroll
            for (int r = 0; r < 4; ++r) Gg[(size_t)(base + 4 * q + r) * RWW + h * 64 + nt * 16 + n15] = cg[r];
        }
        float bon_mine = 0.f;
#pragma unroll 1
        for (int d = 0; d < 2; ++d) {
            if (d == 0) TQ(10); else TQ(13);
            float wv[16], av[16];
            const bf16x8 afw = *(const bf16x8*)(AOP + (size_t)(base + n15) * 224 + d * 32 + 8 * q), afa = *(const bf16x8*)(AOP + (size_t)(base + n15) * 224 + 64 + d * 32 + 8 * q);
#pragma unroll
            for (int which = 0; which < 2; ++which) {
#pragma unroll
                for (int nt = 0; nt < 4; ++nt) {
                    const bf16x8 aop = which ? afa : afw;
                    const f32x4 c4 = __builtin_amdgcn_mfma_f32_16x16x32_bf16(aop, __builtin_bit_cast(bf16x8, FBL[(8 * which + 4 * d + nt) * 64 + lane]), (f32x4){0.f, 0.f, 0.f, 0.f}, 0, 0, 0);
                    const float bias = BIAS[(which * 2 + d) * 64 + nt * 16 + n15];
#pragma unroll
                    for (int r = 0; r < 4; ++r) { const int tok = 4 * q + r, st = d ? 15 - tok : tok; const float x = bias + c4[r];
                        ST[st * 64 + nt * 16 + n15] = which ? sigmoidf_(x) : __expf(-0.6065306597126334f * sigmoidf_(x)); }
                }
                LDS_WAIT(); asm volatile("" ::: "memory");
#pragma unroll
                for (int s = 0; s < 16; ++s) { if (which) av[s] = ST[s * 64 + lane]; else wv[s] = ST[s * 64 + lane]; }
                LDS_WAIT(); asm volatile("" ::: "memory");
            }
            float kt[16];
            float p = 1.0f;
#pragma unroll
            for (int s = 0; s < 16; ++s) {
                const float kk = d ? kkv[15 - s] : kkv[s], kx = d ? kxv[15 - s] : kxv[s], rx = d ? rxv[15 - s] : rxv[s];
                const float kd = kx * (1.0f + (av[s] - 1.0f) * kav);
                { const float bt_ = wave_sum(rx * kd * rkv); if (lane == (d ? 15 - s : s)) bon_mine += bt_; }
                kt[s] = kk * p; p *= wv[s]; const float ip = 1.0f / p;
                OPB[0 * 1024 + s * 64 + lane] = (bf16)f2bf(kt[s]);
                OPB[1 * 1024 + s * 64 + lane] = (bf16)f2bf(rx * p);
                OPB[2 * 1024 + s * 64 + lane] = (bf16)f2bf(kd * ip);
                OPB[3 * 1024 + s * 64 + lane] = (bf16)f2bf(kk * av[s] * ip);
            }
            const float pc = p;
            LDS_WAIT(); asm volatile("" ::: "memory");
            TQ(11);
            {
                bf16x8 fk[2], fr[2], fb[2], fkk[2];
#pragma unroll
                for (int ks = 0; ks < 2; ++ks) { const int off = n15 * 64 + ks * 32 + 8 * q;
                    fk[ks] = *(const LAS bf16x8*)(OPB + 0 * 1024 + off); fr[ks] = *(const LAS bf16x8*)(OPB + 1 * 1024 + off);
                    fkk[ks] = *(const LAS bf16x8*)(OPB + 2 * 1024 + off); fb[ks] = *(const LAS bf16x8*)(OPB + 3 * 1024 + off); }
                f32x4 mA = (f32x4){0.f, 0.f, 0.f, 0.f}, mB = mA, mE = mA, mG = mA;
#pragma unroll
                for (int ks = 0; ks < 2; ++ks) {
                    mA = __builtin_amdgcn_mfma_f32_16x16x32_bf16(fk[ks], fb[ks], mA, 0, 0, 0);
                    mB = __builtin_amdgcn_mfma_f32_16x16x32_bf16(fk[ks], fkk[ks], mB, 0, 0, 0);
                    mE = __builtin_amdgcn_mfma_f32_16x16x32_bf16(fr[ks], fkk[ks], mE, 0, 0, 0);
                    mG = __builtin_amdgcn_mfma_f32_16x16x32_bf16(fr[ks], fb[ks], mG, 0, 0, 0);
                }
#pragma unroll
                for (int r = 0; r < 4; ++r) { const int sr = 4 * q + r;
                    ST[0 * 256 + sr * 16 + n15] = n15 < sr ? mA[r] : 0.f; ST[1 * 256 + sr * 16 + n15] = n15 < sr ? mB[r] : 0.f;
                    ST[2 * 256 + sr * 16 + n15] = n15 <= sr ? mE[r] : 0.f; ST[3 * 256 + sr * 16 + n15] = n15 <= sr ? mG[r] : 0.f; }
            }
            LDS_WAIT(); asm volatile("" ::: "memory");
            float vfa[2][8], vfb[2][8];
#pragma unroll
            for (int ig = 0; ig < 2; ++ig)
#pragma unroll
                for (int jj = 0; jj < 8; ++jj) { const int sg = (8 * q + jj) & 15; vfa[ig][jj] = Vv[(size_t)(base + (d ? 15 - sg : sg)) * RWW + h * 64 + ig * 16 + n15]; }
            {
                float tc[16];
                const LAS f32x4* A4 = (const LAS f32x4*)ST;
                f32x4 ar[4];
#pragma unroll
                for (int v = 0; v < 4; ++v) ar[v] = A4[1 * 4 + v];
                tc[0] = (n15 == 0) ? 1.0f : 0.0f;
#pragma unroll
                for (int s = 1; s < 16; ++s) {
                    f32x4 nx[4];
                    if (s + 1 < 16) {
#pragma unroll
                        for (int v = 0; v < 4; ++v) nx[v] = A4[(s + 1) * 4 + v]; }
                    float acc = (s == n15) ? 1.0f : 0.0f;
#pragma unroll
                    for (int sg = 0; sg < s; ++sg) acc -= ar[sg >> 2][sg & 3] * tc[sg];
                    tc[s] = acc;
#pragma unroll
                    for (int v = 0; v < 4; ++v) ar[v] = nx[v];
                }
                if (q == 0) {
#pragma unroll
                    for (int s = 0; s < 16; ++s) TM[s * 16 + n15] = tc[s]; }
            }
            LDS_WAIT(); asm volatile("" ::: "memory");
            {
                const LAS f32x4* T4 = (const LAS f32x4*)TM;
                float m1[16];
#pragma unroll
                for (int s = 0; s < 16; ++s) { f32x4 tr[4];
#pragma unroll
                    for (int v = 0; v < 4; ++v) if (4 * v <= s) tr[v] = T4[s * 4 + v];
                    float acc = 0.f;
#pragma unroll
                    for (int sg = 0; sg <= s; ++sg) acc += tr[sg >> 2][sg & 3] * kt[sg];
                    m1[s] = acc; }
#pragma unroll
                for (int s = 0; s < 16; ++s) OPB[0 * 1024 + s * 64 + lane] = (bf16)f2bf(m1[s]);
                float bc[16];
#pragma unroll
                for (int sg = 0; sg < 16; ++sg) bc[sg] = ST[1 * 256 + sg * 16 + n15];
#pragma unroll
                for (int r = 0; r < 4; ++r) { const int sr = 4 * q + r; f32x4 tr[4];
#pragma unroll
                    for (int v = 0; v < 4; ++v) tr[v] = T4[sr * 4 + v];
                    float acc = 0.f;
#pragma unroll
                    for (int sg = 0; sg < 16; ++sg) acc += tr[sg >> 2][sg & 3] * bc[sg];
                    M2s[sr * 16 + n15] = acc; }
            }
            LDS_WAIT(); asm volatile("" ::: "memory");
            TQ(12);
#pragma unroll
            for (int ig = 0; ig < 2; ++ig)
#pragma unroll
                for (int jj = 0; jj < 8; ++jj) { const int sg = (8 * q + jj) & 15; vfb[ig][jj] = Vv[(size_t)(base + (d ? 15 - sg : sg)) * RWW + h * 64 + (2 + ig) * 16 + n15]; }
            {
                const int scan = b * 16 + h * 2 + d; const int npos = lat ? 16 + (d ? 255 - cidx : cidx) : (d ? 15 - cidx : cidx);
                unsigned char* rec = (unsigned char*)F.ws + WS_REC + ((size_t)scan * 272 + npos) * REC_BYTES;
                unsigned short e8[8];
#define PK_LO() ((unsigned)e8[0] | ((unsigned)e8[1] << 16))
#define PK_HI() ((unsigned)e8[2] | ((unsigned)e8[3] << 16))
#define STORE_FULL(piece) do { v4u o_; o_.x = PK_LO(); o_.y = PK_HI(); o_.z = e8[4] | ((unsigned)e8[5] << 16); o_.w = e8[6] | ((unsigned)e8[7] << 16); *(v4u*)(rec + (piece) * 1024 + lane * 16) = o_; } while (0)
#define STORE_HALFLANES(piece, sel) do { if (q < 2) { v4u o_; o_.x = PK_LO(); o_.y = PK_HI(); o_.z = e8[4] | ((unsigned)e8[5] << 16); o_.w = e8[6] | ((unsigned)e8[7] << 16); *(v4u*)(rec + (piece) * 1024 + ((sel) * 32 + (lane & 31)) * 16) = o_; } } while (0)
#define STORE_HALFWIDTH(piece, sel) do { v2u o_; o_.x = PK_LO(); o_.y = PK_HI(); *(v2u*)(rec + (piece) * 1024 + lane * 16 + (sel) * 8) = o_; } while (0)
#pragma unroll
                for (int ks = 0; ks < 2; ++ks) {
#pragma unroll
                    for (int jj = 0; jj < 8; ++jj) e8[jj] = OPB[0 * 1024 + n15 * 64 + 32 * ks + 16 * (jj >> 2) + 4 * q + (jj & 3)];
                    STORE_FULL(ks);
#pragma unroll
                    for (int jj = 0; jj < 8; ++jj) e8[jj] = OPB[1 * 1024 + n15 * 64 + 32 * ks + 16 * (jj >> 2) + 4 * q + (jj & 3)];
                    STORE_FULL(2 + ks);
                }
#pragma unroll
                for (int jj = 0; jj < 8; ++jj) e8[jj] = (unsigned short)f2bf(M2s[n15 * 16 + ((8 * q + jj) & 15)]);
                STORE_HALFLANES(4, 0);
#pragma unroll
                for (int jj = 0; jj < 8; ++jj) e8[jj] = (unsigned short)f2bf(ST[2 * 256 + n15 * 16 + ((8 * q + jj) & 15)]);
                STORE_HALFLANES(4, 1);
#pragma unroll
                for (int jj = 0; jj < 4; ++jj) e8[jj] = (unsigned short)f2bf(-ST[3 * 256 + n15 * 16 + 4 * q + jj]);
                STORE_HALFWIDTH(9, 0);
#pragma unroll
                for (int tl = 0; tl < 4; ++tl) {
#pragma unroll
                    for (int jj = 0; jj < 8; ++jj) e8[jj] = (unsigned short)OPB[2 * 1024 + ((8 * q + jj) & 15) * 64 + 16 * tl + n15];
                    STORE_HALFLANES(5 + (tl >> 1), tl & 1);
#pragma unroll
                    for (int jj = 0; jj < 4; ++jj) e8[jj] = (unsigned short)(OPB[3 * 1024 + (4 * q + jj) * 64 + 16 * tl + n15] ^ 0x8000u);
                    if (tl == 0) STORE_HALFWIDTH(9, 1); else if (tl == 1) STORE_HALFWIDTH(10, 0); else if (tl == 2) STORE_HALFWIDTH(10, 1); else STORE_HALFWIDTH(11, 0);
                }
#pragma unroll
                for (int ig = 0; ig < 4; ++ig) {
#pragma unroll
                    for (int jj = 0; jj < 8; ++jj) e8[jj] = (unsigned short)f2bf(ig < 2 ? vfa[ig & 1][jj] : vfb[ig & 1][jj]);
                    STORE_HALFLANES(7 + (ig >> 1), ig & 1);
                }
#undef PK_LO
#undef PK_HI
#undef STORE_FULL
#undef STORE_HALFLANES
#undef STORE_HALFWIDTH
                *(float*)(rec + 11 * 1024 + (lane >> 1) * 16 + 8 + (lane & 1) * 4) = pc;
            }
            LDS_WAIT(); asm volatile("" ::: "memory");
        }
        TQ(13);
        if (lane < 16) BON[(size_t)(base + lane) * 8 + h] = bon_mine;
#undef TQ
    }
    if (PROBE_SUB) F0.tprobe = F.tprobe;
}

__device__ __forceinline__ void scan_unit(Frame& F, int scan) {
    constexpr int R = 11, D = 10, NCH = 272;
    const int b = scan >> 4, h = (scan >> 1) & 7, d = scan & 1;
    const int lane = F.lane, n15 = lane & 15, q = lane >> 4, l31 = lane & 31;
    const unsigned char* rec0 = (const unsigned char*)F.ws + WS_REC + (size_t)scan * NCH * REC_BYTES;
    const bool loader = F.wave >= 4; const int lw = F.wave & 3, ig = F.wave & 3;
    float* Yd = WSP(float, WS_Y) + (size_t)d * TT * RWW;
    f32x4 S[4];
#pragma unroll
    for (int t = 0; t < 4; ++t) S[t] = (f32x4){0.f, 0.f, 0.f, 0.f};
#define ISSUE(n_) do { const unsigned char* g_ = rec0 + (size_t)(n_) * REC_BYTES + lw * 1024 + lane * 16; LAS unsigned char* l_ = F.lds + ((n_) % R) * (int)REC_BYTES + lw * 1024; \
        _Pragma("unroll") for (int p_ = 0; p_ < 3; ++p_) __builtin_amdgcn_global_load_lds((const unsigned*)(g_ + p_ * 4096), (LAS unsigned*)(l_ + p_ * 4096), 16, 0, 0); } while (0)
#define BF8(x) __builtin_bit_cast(bf16x8, x)
#define SC_DECL(X) v4u X##m10, X##m11, X##r0, X##r1, X##m2, X##e, X##k0, X##k1, X##k2, X##k3, X##v; v2u X##g, X##b0, X##b1, X##b2, X##b3; f32x2 X##pc[4][2];
#define SC_LOAD(X, n_) do { const LAS unsigned char* sl_ = F.lds + ((n_) % R) * (int)REC_BYTES; const LAS v4u* fp_ = (const LAS v4u*)sl_ + lane; const LAS v4u* hp_ = (const LAS v4u*)sl_ + l31; \
        X##m10 = fp_[0]; X##m11 = fp_[64]; X##r0 = fp_[128]; X##r1 = fp_[192]; X##m2 = hp_[4 * 64]; X##e = hp_[4 * 64 + 32]; \
        X##k0 = hp_[5 * 64]; X##k1 = hp_[5 * 64 + 32]; X##k2 = hp_[6 * 64]; X##k3 = hp_[6 * 64 + 32]; X##v = hp_[(7 + (ig >> 1)) * 64 + (ig & 1) * 32]; \
        const LAS v2u* wp_ = (const LAS v2u*)(sl_ + 9 * 1024 + lane * 16); X##g = wp_[0]; X##b0 = wp_[1]; X##b1 = wp_[128]; X##b2 = wp_[129]; X##b3 = wp_[256]; \
        const LAS f32x2* pcp_ = (const LAS f32x2*)(sl_ + 11 * 1024 + 2 * q * 16 + 8); \
        _Pragma("unroll") for (int t = 0; t < 4; ++t) { X##pc[t][0] = pcp_[(8 * t) * 2]; X##pc[t][1] = pcp_[(8 * t + 1) * 2]; } } while (0)
#define W4(w_) ((v4u){(w_).x, (w_).y, 0u, 0u})
#define SC_COMPUTE(X, n_) do { \
        if (vz) { X##m2 = zf; X##e = zf; X##k0 = zf; X##k1 = zf; X##k2 = zf; X##k3 = zf; X##v = zf; }     \
        v4u sb0, sb1; sb0.x = cvtpk_c(S[0][0], S[0][1]); sb0.y = cvtpk_c(S[0][2], S[0][3]); sb0.z = cvtpk_c(S[1][0], S[1][1]); sb0.w = cvtpk_c(S[1][2], S[1][3]); \
        sb1.x = cvtpk_c(S[2][0], S[2][1]); sb1.y = cvtpk_c(S[2][2], S[2][3]); sb1.z = cvtpk_c(S[3][0], S[3][1]); sb1.w = cvtpk_c(S[3][2], S[3][3]); \
        const f32x4 z4 = (f32x4){0.f, 0.f, 0.f, 0.f}; \
        f32x4 U = __builtin_amdgcn_mfma_f32_16x16x32_bf16(BF8(X##m10), BF8(sb0), z4, 0, 0, 0); \
        f32x4 Y = __builtin_amdgcn_mfma_f32_16x16x32_bf16(BF8(X##r0), BF8(sb0), z4, 0, 0, 0); \
        U = __builtin_amdgcn_mfma_f32_16x16x32_bf16(BF8(X##m11), BF8(sb1), U, 0, 0, 0); \
        Y = __builtin_amdgcn_mfma_f32_16x16x32_bf16(BF8(X##r1), BF8(sb1), Y, 0, 0, 0); \
        U = __builtin_amdgcn_mfma_f32_16x16x32_bf16(BF8(X##m2), BF8(X##v), U, 0, 0, 0); \
        Y = __builtin_amdgcn_mfma_f32_16x16x32_bf16(BF8(X##e), BF8(X##v), Y, 0, 0, 0); \
        S[0] = __builtin_amdgcn_mfma_f32_16x16x32_bf16(BF8(X##k0), BF8(X##v), S[0], 0, 0, 0); \
        S[1] = __builtin_amdgcn_mfma_f32_16x16x32_bf16(BF8(X##k1), BF8(X##v), S[1], 0, 0, 0); \
        S[2] = __builtin_amdgcn_mfma_f32_16x16x32_bf16(BF8(X##k2), BF8(X##v), S[2], 0, 0, 0); \
        S[3] = __builtin_amdgcn_mfma_f32_16x16x32_bf16(BF8(X##k3), BF8(X##v), S[3], 0, 0, 0); \
        v4u ub; ub.x = cvtpk_c(U[0], U[1]); ub.y = cvtpk_c(U[2], U[3]); ub.z = 0u; ub.w = 0u; \
        Y = __builtin_amdgcn_mfma_f32_16x16x32_bf16(BF8(W4(X##g)), BF8(ub), Y, 0, 0, 0); \
        S[0] = __builtin_amdgcn_mfma_f32_16x16x32_bf16(BF8(W4(X##b0)), BF8(ub), S[0], 0, 0, 0); \
        S[1] = __builtin_amdgcn_mfma_f32_16x16x32_bf16(BF8(W4(X##b1)), BF8(ub), S[1], 0, 0, 0); \
        S[2] = __builtin_amdgcn_mfma_f32_16x16x32_bf16(BF8(W4(X##b2)), BF8(ub), S[2], 0, 0, 0); \
        S[3] = __builtin_amdgcn_mfma_f32_16x16x32_bf16(BF8(W4(X##b3)), BF8(ub), S[3], 0, 0, 0); \
        _Pragma("unroll") for (int t = 0; t < 4; ++t) S[t] = S[t] * (f32x4){X##pc[t][0].x, X##pc[t][0].y, X##pc[t][1].x, X##pc[t][1].y}; \
        const int base_ = chunk_base_row(b, d, (n_)); \
        _Pragma("unroll") for (int r = 0; r < 4; ++r) { const int st = 4 * q + r; Yd[(size_t)(base_ + (d ? 15 - st : st)) * RWW + h * 64 + ig * 16 + n15] = Y[r]; } } while (0)
#define LD_STEP(n_) do { if ((n_) + D < NCH) { ISSUE((n_) + D); asm volatile("s_waitcnt vmcnt(24)" ::: "memory"); } else asm volatile("s_waitcnt vmcnt(0)" ::: "memory"); } while (0)
    if (loader) {
#pragma unroll 1
        for (int n = 0; n < D; ++n) ISSUE(n);
        asm volatile("s_waitcnt vmcnt(24)" ::: "memory");
    }
    __builtin_amdgcn_s_barrier();
    const v4u zf = (v4u){0u, 0u, 0u, 0u}; const bool vz = q >= 2;
    if (loader) {
#pragma unroll 1
        for (int n = 0; n < NCH; ++n) { LD_STEP(n); __builtin_amdgcn_s_barrier(); }
    } else {
        SC_DECL(A) SC_DECL(B)
        SC_LOAD(A, 0);
#pragma unroll 1
        for (int n = 0; n < NCH; n += 2) {
            asm volatile("s_waitcnt lgkmcnt(0)" ::: "memory"); __builtin_amdgcn_sched_barrier(0); SC_LOAD(B, n + 1); __builtin_amdgcn_sched_barrier(0); SC_COMPUTE(A, n);
            __builtin_amdgcn_s_barrier();
            asm volatile("s_waitcnt lgkmcnt(0)" ::: "memory"); __builtin_amdgcn_sched_barrier(0); SC_LOAD(A, (n + 2 < NCH ? n + 2 : NCH - 1)); __builtin_amdgcn_sched_barrier(0); SC_COMPUTE(B, n + 1);
            __builtin_amdgcn_s_barrier();
        }
    }
#undef SC_DECL
#undef SC_LOAD
#undef SC_COMPUTE
#undef LD_STEP
#undef W4
#undef ISSUE
#undef BF8
    asm volatile("s_waitcnt vmcnt(0)" ::: "memory");
    __syncthreads();
}

__device__ __forceinline__ void subset_arrive(unsigned* ctr) {
    asm volatile("s_waitcnt vmcnt(0)" ::: "memory"); __syncthreads();
    if (threadIdx.x == 0) { __builtin_amdgcn_fence(__ATOMIC_RELEASE, "agent"); asm volatile("s_waitcnt vmcnt(0)" ::: "memory"); __hip_atomic_fetch_add(ctr, 1u, __ATOMIC_RELAXED, __HIP_MEMORY_SCOPE_AGENT); }
}
__device__ __forceinline__ void subset_wait(unsigned* ctr, unsigned n) {
    if (threadIdx.x == 0) { unsigned sp = 0;
        while (__hip_atomic_load(ctr, __ATOMIC_RELAXED, __HIP_MEMORY_SCOPE_AGENT) < n) { __builtin_amdgcn_s_sleep(4); if (++sp > (1u << 24)) break; }
        __builtin_amdgcn_fence(__ATOMIC_ACQUIRE, "agent"); asm volatile("s_waitcnt vmcnt(0)" ::: "memory"); }
    __syncthreads();
}
__device__ __forceinline__ void ph_scan_hyena(Frame& F0, int j, int i) { Frame F = F0; LAUNDER(F);
    unsigned* ctl = (unsigned*)(F.ws + WS_CTL) + 512 + 256 * i;
    LAS f32x2* TWL = (LAS f32x2*)(F.lds + 67584); LAS int* tick = (LAS int*)(F.lds + 133120 + 256);
    const float* hyb = INP(I_HYB) + (size_t)j * 1024;
    const bool split = F.G >= 128; const int nf = split ? F.G - 64 : F.G;
    TP_BEGIN();
    if (split && F.vcu < 64) { scan_unit(F, F.vcu); TP_END(6); }
    else {
        if (!split) { for (int sc = F.vcu; sc < 64; sc += F.G) scan_unit(F, sc); }
        const int id = split ? F.vcu - 64 : F.vcu;
        load_tw<13>(F, TWL); __syncthreads();
        for (int it = id; it < 512; it += nf) fftk_item<13, 1>(F, WSP(float, WS_KCL), WSP(f32x4, WS_KSPL), it);
        __syncthreads(); load_tw<9>(F, TWL); __syncthreads();
        for (int it = id; it < 64; it += nf) fftk_item<9, 8>(F, WSP(float, WS_KCC), WSP(f32x4, WS_KSPC), it);
        subset_arrive(ctl);
    }
    subset_wait(ctl, (unsigned)nf);
    int cur_n = 0, nxt = 0;
    if (F.tid == 0) nxt = (int)__hip_atomic_fetch_add(ctl + 64, 1u, __ATOMIC_RELAXED, __HIP_MEMORY_SCOPE_AGENT);
    for (;;) {
        __syncthreads();
        if (F.tid == 0) tick[0] = nxt;
        __syncthreads();
        const int it = tick[0];
        if (it >= 1024 + 128) break;
        if (F.tid == 0) nxt = (int)__hip_atomic_fetch_add(ctl + 64, 1u, __ATOMIC_RELAXED, __HIP_MEMORY_SCOPE_AGENT);
        const int want = it < 1024 ? 13 : 9;
        if (cur_n != want) { __syncthreads(); if (want == 13) load_tw<13>(F, TWL); else load_tw<9>(F, TWL); cur_n = want; __syncthreads(); }
        if (it < 1024) hyena_item<13, 1>(F, WSP(float, WS_UTL), WSP(f32x4, WS_KSPL), WSP(float, WS_HYTL), hyb, INP(I_CONVW) + (size_t)j * 3 * HYC, INP(I_CONVB) + (size_t)j * HYC, it);
        else hyena_item<9, 8>(F, WSP(float, WS_UTC), WSP(f32x4, WS_KSPC), WSP(float, WS_HYTC), hyb, INP(I_CONVW) + (size_t)j * 3 * HYC, INP(I_CONVB) + (size_t)j * HYC, it - 1024);
    }
}
__device__ __forceinline__ void ph_mod2(Frame& F0, int i, const bf16* wout_t) { Frame F = F0; LAUNDER(F);
    const bool need_ctx = i + 1 < DEPTH; const bool split = need_ctx && F.G >= 64;
    unsigned* cctr = (unsigned*)(F.ws + WS_CTL) + 2048 + 64 * i;
    if (need_ctx && (!split || F.vcu < 16)) {
        for (int uu = split ? F.vcu : F.vcu; uu < 16; uu += split ? 16 : F.G) {
            pg8::Gemm g{WSP(bf16, WS_CAT), wout_t, TT, DM, DM, nullptr}; pg8::OneUnit S{64 + (uu >> 2), uu & 3};
            pg8::EpiResGate E{WSP(float, WS_X), WSP(float, WS_MODS) + (size_t)i * 5 * 6144}; pg8::gemm_phase<pg8::EpiResGate, pg8::OneUnit, true, true>(F.lds, g, S, E);
        }
        __syncthreads();
        if (split) subset_arrive(cctr);
    }
    LAS float* RL = (LAS float*)F.lds;
    const float* router = INP(I_ROUTER) + (size_t)i * DM * NE;
#pragma unroll 8
    for (int idx = F.tid; idx < DM * NE; idx += NTHR) { const int c = idx >> 4, e = idx & 15; RL[e * 1024 + c] = router[idx]; }
    __syncthreads();
    const float* mods = WSP(float, WS_MODS) + (size_t)i * 5 * 6144;
    f32x4 gq[4];
#pragma unroll
    for (int jj = 0; jj < 4; ++jj) gq[jj] = ((const f32x4*)(INP(I_NORMG) + (size_t)(i * 2 + 1) * DM))[64 * jj + F.lane];
#pragma unroll 1
    for (int part = 0; part < 2; ++part) {
    int r0, r1, gwp, ngwp;
    if (part == 0) { r0 = 0; r1 = TLAT; if (split) { if (F.vcu < 16) continue; gwp = (F.vcu - 16) * NWAVES + F.wave; ngwp = (F.G - 16) * NWAVES; } else { gwp = F.gw; ngwp = F.NGW; } }
    else { if (!need_ctx) break; if (split) subset_wait(cctr, 16u); else __syncthreads(); r0 = TLAT; r1 = TT; gwp = F.gw; ngwp = F.NGW; }
    const int nrows = r1;
    f32x4 vn[4], shn[4], scn[4];
    if (r0 + gwp < nrows) { const int s = row_s(r0 + gwp);
#pragma unroll
        for (int jj = 0; jj < 4; ++jj) { vn[jj] = ((const f32x4*)(WSP(float, WS_X) + (size_t)(r0 + gwp) * DM))[64 * jj + F.lane];
            shn[jj] = ((const f32x4*)(mods + s * 6144 + 3 * 1024))[64 * jj + F.lane]; scn[jj] = ((const f32x4*)(mods + s * 6144 + 4 * 1024))[64 * jj + F.lane]; } }
    for (int row = r0 + gwp; row < nrows; row += ngwp) {
        f32x4 v[4], h[4], sh[4], sc[4];
#pragma unroll
        for (int jj = 0; jj < 4; ++jj) { v[jj] = vn[jj]; sh[jj] = shn[jj]; sc[jj] = scn[jj]; }
        if (row + ngwp < nrows) {
            const int s = row_s(row + ngwp);
#pragma unroll
            for (int jj = 0; jj < 4; ++jj) { vn[jj] = ((const f32x4*)(WSP(float, WS_X) + (size_t)(row + ngwp) * DM))[64 * jj + F.lane];
                shn[jj] = ((const f32x4*)(mods + s * 6144 + 3 * 1024))[64 * jj + F.lane]; scn[jj] = ((const f32x4*)(mods + s * 6144 + 4 * 1024))[64 * jj + F.lane]; } }
        mod_row_apply(v, gq, sh, sc, WSP(bf16, WS_HA) + (size_t)row * DM, F.lane, h);
        float mylg = 0.f;
#pragma unroll 1
        for (int g4 = 0; g4 < 4; ++g4) {
            float a4[4];
#pragma unroll
            for (int k = 0; k < 4; ++k) { float a = 0.f;
#pragma unroll
                for (int jj = 0; jj < 4; ++jj) { const f32x4 r4 = ((const LAS f32x4*)(RL + (4 * g4 + k) * 1024))[64 * jj + F.lane]; a += (h[jj].x * r4.x + h[jj].y * r4.y) + (h[jj].z * r4.z + h[jj].w * r4.w); }
                a4[k] = a; }
#pragma unroll
            for (int k = 0; k < 4; ++k) a4[k] += dpp_f<DPP_XOR1>(a4[k]);
#pragma unroll
            for (int k = 0; k < 4; ++k) a4[k] += dpp_f<DPP_XOR2>(a4[k]);
#pragma unroll
            for (int k = 0; k < 4; ++k) a4[k] += dpp_f<DPP_HMIRROR>(a4[k]);
#pragma unroll
            for (int k = 0; k < 4; ++k) a4[k] += dpp_f<DPP_MIRROR>(a4[k]);
#pragma unroll
            for (int k = 0; k < 4; ++k) if ((F.lane & 15) == 4 * g4 + k) mylg = a4[k];
        }
        mylg += __builtin_bit_cast(float, __builtin_amdgcn_ds_swizzle(__builtin_bit_cast(int, mylg), 0x401F));
        { auto rr = __builtin_amdgcn_permlane32_swap(__float_as_uint(mylg), __float_as_uint(mylg), false, false); const unsigned lo_ = rr[0], hi_ = rr[1]; mylg = __uint_as_float(lo_) + __uint_as_float(hi_); }
        if (F.lane >= 16) mylg = -1e30f;
        const float mx = max16_f(mylg);
        const float ex = expf(mylg - mx); const float den = sum16_f(ex);
        const float mine = ex / den;
        if (F.lane < 16) WSP(float, WS_AFF)[(size_t)row * 16 + F.lane] = mine;
    }
    }
}

__device__ __forceinline__ int block_excl_scan(Frame& F, int v, LAS int* sc, int& total) {
    LAS int* cnt = sc + 16;
    __syncthreads();
    cnt[F.tid] = v;
    const int ws = wave_sum_i(v);
    if (F.lane == 0) sc[F.wave] = ws;
    __syncthreads();
    int base = 0, tot = 0;
#pragma unroll
    for (int w = 0; w < NWAVES; ++w) { const int t = sc[w]; if (w < F.wave) base += t; tot += t; }
    int pre = 0;
    for (int k = 0; k < F.lane; ++k) pre += cnt[F.wave * 64 + k];
    total = tot; return base + pre;
}
__device__ __forceinline__ int block_sum_i(Frame& F, int v, LAS int* sc) {
    v = wave_sum_i(v);
    __syncthreads(); if (F.lane == 0) sc[F.wave] = v; __syncthreads();
    int t = 0;
#pragma unroll
    for (int w = 0; w < NWAVES; ++w) t += sc[w];
    return t;
}
__device__ __forceinline__ void topk_item(Frame& F, int set, int e) {
    LAS int* sc = (LAS int*)(F.lds + 133120);
    const bool lat = set < 4; const int L = lat ? SEQ : CTXL, cap = lat ? 512 : 32; const int rbase = lat ? set * SEQ : TLAT + (set - 4) * CTXL;
    const int sbase = e * EROWS + (lat ? set * 512 : 2048 + (set - 4) * 32);
    const float* aff = WSP(float, WS_AFF);
    unsigned key[8];
#pragma unroll
    for (int q = 0; q < 8; ++q) { const int l = F.tid * 8 + q; key[q] = l < L ? __builtin_bit_cast(unsigned, aff[(size_t)(rbase + l) * 16 + e]) : 0u; }
    unsigned thr = 0u;
    for (int bit = 30; bit >= 0; --bit) {
        const unsigned cand = thr | (1u << bit); int cnt = 0;
#pragma unroll
        for (int q = 0; q < 8; ++q) cnt += (key[q] >= cand) ? 1 : 0;
        if (block_sum_i(F, cnt, sc) >= cap) thr = cand;
    }
    int ngt = 0, neq = 0;
#pragma unroll
    for (int q = 0; q < 8; ++q) { ngt += key[q] > thr ? 1 : 0; neq += (key[q] == thr && (F.tid * 8 + q) < L) ? 1 : 0; }
    int tot_gt, tot_eq; const int bgt = block_excl_scan(F, ngt, sc, tot_gt); const int beq = block_excl_scan(F, neq, sc, tot_eq);
    const int need_eq = cap - tot_gt; int rg = bgt, re = beq;
    int* slotmap = WSP(int, WS_SLOT); int* idxo = WSP(int, WS_IDX); float* gate = WSP(float, WS_GATE);
#pragma unroll
    for (int q = 0; q < 8; ++q) { const int l = F.tid * 8 + q; if (l < L) {
        int slot = -1;
        if (key[q] > thr) { slot = rg; ++rg; } else if (key[q] == thr) { if (re < need_eq) slot = tot_gt + re; ++re; }
        slotmap[(size_t)(rbase + l) * 16 + e] = slot;
        if (slot >= 0) { idxo[sbase + slot] = rbase + l; gate[sbase + slot] = __builtin_bit_cast(float, key[q]); } } }
    if (set == 0) for (int p = F.tid; p < EROWS - 2176; p += NTHR) { idxo[e * EROWS + 2176 + p] = 0; gate[e * EROWS + 2176 + p] = 0.f; }
    __syncthreads();
}
__device__ __forceinline__ void moe_convert_item(Frame& F, int i, int it) {
    LAS float* scr = (LAS float*)(F.lds + F.wave * 16640);
    const float* w1 = INP(I_MW1) + (size_t)i * NE * DM * FF; const float* w3 = INP(I_MW3) + (size_t)i * NE * DM * FF; const float* w2 = INP(I_MW2) + (size_t)i * NE * FF * DM;
    const int which = it / (NE * 256), r = it % (NE * 256), e = r >> 8, item = r & 255;
    if (which == 0) transpose_item(w1 + (size_t)e * DM * FF, DM, FF, WSP(bf16, WS_W13), RowW13{e, 0}, scr, item, F.lane);
    else if (which == 1) transpose_item(w3 + (size_t)e * DM * FF, DM, FF, WSP(bf16, WS_W13), RowW13{e, 1}, scr, item, F.lane);
    else transpose_item(w2 + (size_t)e * FF * DM, FF, DM, WSP(bf16, WS_W2), RowId{e * 1024}, scr, item, F.lane);
}
constexpr int MOE_HOSTED = 208 * NWAVES * 2;
__device__ __forceinline__ bool moe_hosting(const Frame& F, int i) { return (i & 1) && F.G == 256; }
__device__ __forceinline__ void moe_convert_hosted(Frame& F0, int i, int c) { Frame F = F0; LAUNDER(F);
    __syncthreads();
    const int w = (c - 48) * NWAVES + F.wave;
    moe_convert_item(F, i, w); moe_convert_item(F, i, w + 208 * NWAVES);
}
__device__ __forceinline__ void ph_topk(Frame& F0, int i) { Frame F = F0; LAUNDER(F);
    const bool filt = (i == 1);
    const bool filt_first = filt && (F.vcu & 1) != 0;
    if (filt_first) { ph_filters(F, 1); __syncthreads(); }
    TP_BEGIN();
    for (int it = F.vcu; it < (i + 1 < DEPTH ? 128 : 64); it += F.G) topk_item(F, it >> 4, it & 15);
    TP_END(4);
    const int first = moe_hosting(F, i) ? MOE_HOSTED : 0, full = moe_hosting(F, i) ? 3 : 5;
    const int ntk = (i + 1 < DEPTH ? 128 : 64); const bool bal = F.G > ntk && first + F.NGW * full <= 3 * NE * 256;
    const int nA = bal ? first + F.NGW * full : 3 * NE * 256;
    for (int k = 0;; ++k) {
        int it;
        if (k < full || !bal) { it = first + F.gw + k * F.NGW; if (it >= nA) { if (!bal || F.vcu < ntk) break; it = -1; } }
        else { if (F.vcu < ntk) break; it = -1; }
        if (it < 0) { it = nA + (F.vcu - ntk) * NWAVES + F.wave + (k - full) * (F.G - ntk) * NWAVES; if (it >= 3 * NE * 256) break; }
        moe_convert_item(F, i, it);
    }
    TP_END(5);
    if (filt && !filt_first) { __syncthreads(); ph_filters(F, 1); }
}
__device__ __forceinline__ void ph_gather(Frame& F0, bool need_ctx) { Frame F = F0; LAUNDER(F);
    const int* idx = WSP(int, WS_IDX); const bf16* HA = WSP(bf16, WS_HA); bf16* XG = WSP(bf16, WS_XG);
    for (int r = F.gw; r < NE * EROWS; r += F.NGW) {
        if (!need_ctx && (r % EROWS) >= 2048) continue;
        const int src = idx[r]; const v4u* s = (const v4u*)(HA + (size_t)src * DM); v4u* d = (v4u*)(XG + (size_t)r * DM);
        d[F.lane] = s[F.lane]; d[64 + F.lane] = s[64 + F.lane];
    }
}
__device__ __forceinline__ void ph_combine(Frame& F0, int i) { Frame F = F0; LAUNDER(F);
    const int* slotmap = WSP(int, WS_SLOT); const bf16* YB = WSP(bf16, WS_YB);
    const float* mods = WSP(float, WS_MODS) + (size_t)i * 5 * 6144;
    const float* m2 = WSP(float, WS_MODS) + (size_t)(i + 1 < DEPTH ? i + 1 : i) * 5 * 6144;
    const int nrows_c = i + 1 < DEPTH ? TT : TLAT;
    int slotn = -1; f32x4 xn[4], gn[4];
#pragma unroll
    for (int jj = 0; jj < 4; ++jj) gn[jj] = ((const f32x4*)(i + 1 < DEPTH ? INP(I_NORMG) + (size_t)((i + 1) * 2) * DM : INP(I_FINALG)))[64 * jj + F.lane];
    if (F.gw < nrows_c) { slotn = F.lane < 16 ? slotmap[(size_t)F.gw * 16 + F.lane] : -1;
#pragma unroll
        for (int jj = 0; jj < 4; ++jj) xn[jj] = ((const f32x4*)(WSP(float, WS_X) + (size_t)F.gw * DM))[64 * jj + F.lane]; }
    for (int row = F.gw; row < nrows_c; row += F.NGW) {
        f32x4 acc[4], xc[4];
#pragma unroll
        for (int jj = 0; jj < 4; ++jj) { acc[jj] = (f32x4){0.f, 0.f, 0.f, 0.f}; xc[jj] = xn[jj]; }
        const int myslot = slotn;
        if (row + F.NGW < nrows_c) { slotn = F.lane < 16 ? slotmap[(size_t)(row + F.NGW) * 16 + F.lane] : -1;
#pragma unroll
            for (int jj = 0; jj < 4; ++jj) xn[jj] = ((const f32x4*)(WSP(float, WS_X) + (size_t)(row + F.NGW) * DM))[64 * jj + F.lane]; }
        const int s = row_s(row); f32x4 gm[4], sh[4], sc[4];
#pragma unroll
        for (int jj = 0; jj < 4; ++jj) { gm[jj] = ((const f32x4*)(mods + s * 6144 + 5 * 1024))[64 * jj + F.lane];
            if (i + 1 < DEPTH) { sh[jj] = ((const f32x4*)(m2 + s * 6144))[64 * jj + F.lane]; sc[jj] = ((const f32x4*)(m2 + s * 6144 + 1024))[64 * jj + F.lane]; } }
        unsigned long long sel = __ballot(myslot >= 0);
        const int sbase = row < TLAT ? (row >> 12) * 512 : 2048 + ((row - TLAT) >> 8) * 32;
        while (sel) {
            const int e0 = __builtin_ctzll(sel); sel &= sel - 1;
            const bool two = sel != 0ull; const int e1 = two ? __builtin_ctzll(sel) : e0; if (two) sel &= sel - 1;
            const int sl0 = __builtin_amdgcn_readlane(myslot, e0), sl1 = __builtin_amdgcn_readlane(myslot, e1);
            const v2u* yr0 = (const v2u*)(YB + (size_t)(e0 * EROWS + sbase + sl0) * DM); const v2u* yr1 = (const v2u*)(YB + (size_t)(e1 * EROWS + sbase + sl1) * DM);
            v2u w0[4], w1[4];
#pragma unroll
            for (int jj = 0; jj < 4; ++jj) { w0[jj] = yr0[64 * jj + F.lane]; w1[jj] = yr1[64 * jj + F.lane]; }
#pragma unroll
            for (int jj = 0; jj < 4; ++jj) { const v2u w = w0[jj];
                acc[jj].x += __builtin_bit_cast(float, w.x << 16); acc[jj].y += __builtin_bit_cast(float, w.x & 0xffff0000u);
                acc[jj].z += __builtin_bit_cast(float, w.y << 16); acc[jj].w += __builtin_bit_cast(float, w.y & 0xffff0000u); }
            if (two) {
#pragma unroll
                for (int jj = 0; jj < 4; ++jj) { const v2u w = w1[jj];
                    acc[jj].x += __builtin_bit_cast(float, w.x << 16); acc[jj].y += __builtin_bit_cast(float, w.x & 0xffff0000u);
                    acc[jj].z += __builtin_bit_cast(float, w.y << 16); acc[jj].w += __builtin_bit_cast(float, w.y & 0xffff0000u); } }
        }
#ifdef ABL_MOE
#pragma unroll
        for (int jj = 0; jj < 4; ++jj) acc[jj] = acc[jj] * 0.0f;
#endif
        f32x4 v[4];
        float* xr = WSP(float, WS_X) + (size_t)row * DM;
        float ss = 0.f;
#pragma unroll
        for (int jj = 0; jj < 4; ++jj) { v[jj] = xc[jj] + gm[jj] * acc[jj]; ss += (v[jj].x * v[jj].x + v[jj].y * v[jj].y) + (v[jj].z * v[jj].z + v[jj].w * v[jj].w); }
        const float rstd = 1.0f / sqrtf(wave_sum(ss) * (1.0f / 1024.0f) + 1e-6f);
        if (i + 1 < DEPTH) {
            bf16* orow = WSP(bf16, WS_HA) + (size_t)row * DM;
#pragma unroll
            for (int jj = 0; jj < 4; ++jj) { ((f32x4*)xr)[64 * jj + F.lane] = v[jj];
                const f32x4 h = (v[jj] * rstd) * gn[jj] * (sc[jj] + 1.0f) + sh[jj];
                v2u o; o.x = pk2(h.x, h.y); o.y = pk2(h.z, h.w); ((v2u*)orow)[64 * jj + F.lane] = o; }
        } else {
#pragma unroll
            for (int jj = 0; jj < 4; ++jj) ((f32x4*)(F.out + (size_t)row * DM))[64 * jj + F.lane] = v[jj] * rstd * gn[jj];
        }
    }
}
__device__ __forceinline__ void ph_rope(Frame& F0) { Frame F = F0; LAUNDER(F);
    const float* P = WSP(float, WS_P); bf16* QB = WSP(bf16, WS_QB); bf16* KB = WSP(bf16, WS_KB); bf16* VB = WSP(bf16, WS_VB);
    const int axis = (F.lane >> 1) & 1, half = F.lane & 1;
    float inv[16];
#pragma unroll
    for (int f = 0; f < 16; ++f) inv[f] = exp2f(-(float)f * (13.287712379549449f / 16.0f));
    for (int row = F.gw; row < TT; row += F.NGW) {
        const bool lat = row < TLAT; const int b = lat ? (row >> 12) : ((row - TLAT) >> 8); const int l = lat ? (row & (SEQ - 1)) : ((row - TLAT) & (CTXL - 1));
        const size_t krow = (size_t)b * KSEQ + (lat ? CTXL + l : l);
        float cs[16], sn[16];
        if (lat) { const float pos = (float)(axis ? (l & 63) : (l >> 6));
#pragma unroll
            for (int f = 0; f < 16; ++f) sincosf(pos * inv[f], &sn[f], &cs[f]); }
#pragma unroll
        for (int part = 0; part < 3; ++part) {
            float x[16];
            const float* src = P + (size_t)row * QKVC + part * 1024 + 16 * F.lane;
#pragma unroll
            for (int q = 0; q < 4; ++q) { const f32x4 t = *(const f32x4*)(src + 4 * q); x[4 * q] = t.x; x[4 * q + 1] = t.y; x[4 * q + 2] = t.z; x[4 * q + 3] = t.w; }
            if (part < 2 && lat) {
#pragma unroll
                for (int f = 0; f < 16; ++f) { const float o = xor1_f(x[f]);
                    x[f] = half ? (x[f] * cs[f] + o * sn[f]) : (x[f] * cs[f] - o * sn[f]); }
            }
            v4u w0, w1; w0.x = pk2(x[0], x[1]); w0.y = pk2(x[2], x[3]); w0.z = pk2(x[4], x[5]); w0.w = pk2(x[6], x[7]); w1.x = pk2(x[8], x[9]); w1.y = pk2(x[10], x[11]); w1.z = pk2(x[12], x[13]); w1.w = pk2(x[14], x[15]);
            bf16* dst = part == 0 ? QB + (size_t)row * DM : (part == 1 ? KB + krow * DM : VB + krow * DM);
            *(v4u*)(dst + 16 * F.lane) = w0; *(v4u*)(dst + 16 * F.lane + 8) = w1;
        }
    }
}

namespace att {
using s16x4 = __attribute__((ext_vector_type(4))) short;
using f32x16 = __attribute__((ext_vector_type(16))) float;
using u32x4 = __attribute__((ext_vector_type(4))) unsigned;
constexpr int DQ = 64, DV = 128, NW = 8, QBLK = 32, KVBLK = 64, LD = 1024;
constexpr float SCALE = 0.125f, THR = 8.f;
#ifndef ATT_SDEPTH
#define ATT_SDEPTH 1
#endif
constexpr int SDEPTH = ATT_SDEPTH;
constexpr size_t SHM_V = KVBLK * DV * 2, SHM_K = KVBLK * DQ * 2, SHM_ATTN = 2 * SHM_V + 2 * SHM_K + NW * 64 * 4;
#define KSWZ(row, colB) ((row) * 128 + ((colB) ^ (((row) & 7) << 4)))
#define SBAR() __builtin_amdgcn_sched_barrier(0)
__device__ __forceinline__ int crow(int r, int hi) { return (r & 3) + 8 * (r >> 2) + 4 * hi; }
__device__ __forceinline__ unsigned cvtpk(float lo, float hi) { unsigned r; asm volatile("v_cvt_pk_bf16_f32 %0, %1, %2" : "=v"(r) : "v"(lo), "v"(hi)); return r; }
__device__ __forceinline__ void partialSM(f32x16& p0, f32x16& p1, float& m_reg, float& mn, float& alpha) {
  constexpr float C = SCALE * 1.4426950408889634f;
  float pmax = p0[0]; for (int r = 1; r < 16; ++r) pmax = fmaxf(pmax, p0[r]); for (int r = 0; r < 16; ++r) pmax = fmaxf(pmax, p1[r]);
  { auto rr = __builtin_amdgcn_permlane32_swap(__float_as_uint(pmax), __float_as_uint(pmax), false, false);
    pmax = fmaxf(__uint_as_float(rr[0]), __uint_as_float(rr[1])); }
  if (__builtin_expect(__all(pmax - m_reg <= THR / SCALE), 1)) { mn = m_reg; alpha = 1.f; }
  else { mn = fmaxf(m_reg, pmax); alpha = __builtin_amdgcn_exp2f((m_reg - mn) * C); m_reg = mn; }
  float mnC = -mn * C;
  for (int r = 0; r < 16; ++r) p0[r] = fmaf(p0[r], C, mnC); for (int r = 0; r < 16; ++r) p1[r] = fmaf(p1[r], C, mnC);
  for (int r = 0; r < 16; ++r) p0[r] = __builtin_amdgcn_exp2f(p0[r]);
}
__device__ __forceinline__ void finishSM(f32x16& p0, f32x16& p1, float alpha, float& l_reg, bf16x8& pa0, bf16x8& pa1, bf16x8& pa2, bf16x8& pa3) {
  for (int r = 0; r < 16; ++r) p1[r] = __builtin_amdgcn_exp2f(p1[r]);
  float ps = 0; for (int r = 0; r < 16; ++r) ps += p0[r]; for (int r = 0; r < 16; ++r) ps += p1[r];
  { auto rr = __builtin_amdgcn_permlane32_swap(__float_as_uint(ps), __float_as_uint(ps), false, false);
    ps = __uint_as_float(rr[0]) + __uint_as_float(rr[1]); }
  l_reg = l_reg * alpha + ps;
#define PK4(P, BASE, OUT) do { unsigned a0 = cvtpk(P[BASE + 0], P[BASE + 1]), a1 = cvtpk(P[BASE + 2], P[BASE + 3]);   \
    unsigned b0 = cvtpk(P[BASE + 4], P[BASE + 5]), b1 = cvtpk(P[BASE + 6], P[BASE + 7]);                              \
    auto r0 = __builtin_amdgcn_permlane32_swap(a0, b0, false, false); auto r1 = __builtin_amdgcn_permlane32_swap(a1, b1, false, false); \
    u32x4 w = {r0[0], r1[0], r0[1], r1[1]}; OUT = *reinterpret_cast<bf16x8*>(&w); } while (0)
  PK4(p0, 0, pa0); PK4(p0, 8, pa1); PK4(p1, 0, pa2); PK4(p1, 8, pa3);
#undef PK4
}
__device__ __forceinline__ void qkt(f32x16& p0, f32x16& p1, const bf16* Ks, const bf16x8* qr, int r32, int hi) {
  p0 = f32x16{}; p1 = f32x16{};
#pragma unroll
  for (int d0 = 0; d0 < 4; ++d0) { int cb = (d0 * 16 + hi * 8) * 2;
    bf16x8 b0 = *reinterpret_cast<const bf16x8*>((const char*)Ks + KSWZ(r32, cb));
    bf16x8 b1 = *reinterpret_cast<const bf16x8*>((const char*)Ks + KSWZ(32 + r32, cb));
    p0 = __builtin_amdgcn_mfma_f32_32x32x16_bf16(b0, qr[d0], p0, 0, 0, 0);
    p1 = __builtin_amdgcn_mfma_f32_32x32x16_bf16(b1, qr[d0], p1, 0, 0, 0); }
}
__device__ __forceinline__ int v_st(int k, int c) { const int kk = (k & ~0xC) | ((k & 4) << 1) | ((k & 8) >> 1); return ((kk >> 3) * 4 + (c >> 5)) * 512 + ((kk & 7) * 32 + (c & 31)) * 2; }
__device__ __forceinline__ int v_rd_base(int lane) { return ((lane & 3) << 3) | (((lane >> 2) & 3) << 6) | (((lane >> 4) & 1) << 5) | (((lane >> 5) & 1) << 8); }
constexpr int v_rd_off(int d0, int ks, int half) { return d0 * 512 + ks * 4096 + half * 2048; }
template <int OFF> __device__ __forceinline__ s16x4 tr_read(int vb) {
  s16x4 r; asm volatile("ds_read_b64_tr_b16 %0, %1 offset:%2" : "=&v"(r) : "v"(vb), "i"(OFF) : "memory"); return r;
}
template <int D0> __device__ __forceinline__ void pv_one(f32x16& od, int vb, bf16x8 pa0, bf16x8 pa1, bf16x8 pa2, bf16x8 pa3) {
  const s16x4 l0 = tr_read<v_rd_off(D0, 0, 0)>(vb), h0 = tr_read<v_rd_off(D0, 0, 1)>(vb), l1 = tr_read<v_rd_off(D0, 1, 0)>(vb), h1 = tr_read<v_rd_off(D0, 1, 1)>(vb);
  const s16x4 l2 = tr_read<v_rd_off(D0, 2, 0)>(vb), h2 = tr_read<v_rd_off(D0, 2, 1)>(vb), l3 = tr_read<v_rd_off(D0, 3, 0)>(vb), h3 = tr_read<v_rd_off(D0, 3, 1)>(vb);
  asm volatile("s_waitcnt lgkmcnt(0)" ::: "memory"); SBAR();
#define PK(L, H) (bf16x8){L[0], L[1], L[2], L[3], H[0], H[1], H[2], H[3]}
  od = __builtin_amdgcn_mfma_f32_32x32x16_bf16(pa0, PK(l0, h0), od, 0, 0, 0);
  od = __builtin_amdgcn_mfma_f32_32x32x16_bf16(pa1, PK(l1, h1), od, 0, 0, 0);
  od = __builtin_amdgcn_mfma_f32_32x32x16_bf16(pa2, PK(l2, h2), od, 0, 0, 0);
  od = __builtin_amdgcn_mfma_f32_32x32x16_bf16(pa3, PK(l3, h3), od, 0, 0, 0);
#undef PK
}
__device__ __forceinline__ void pv_d0(f32x16* o, int vb, bf16x8 pa0, bf16x8 pa1, bf16x8 pa2, bf16x8 pa3) {
  pv_one<0>(o[0], vb, pa0, pa1, pa2, pa3); pv_one<1>(o[1], vb, pa0, pa1, pa2, pa3); pv_one<2>(o[2], vb, pa0, pa1, pa2, pa3); pv_one<3>(o[3], vb, pa0, pa1, pa2, pa3);
}
struct Fin { float lam, scale; const float* sg; bf16* cat; };
template <int MODE>
__device__ __forceinline__ void attn_body(const bf16* __restrict__ Qb, const bf16* __restrict__ Kh, const bf16* __restrict__ Vh, float* Ob, int ldo, int seq, char* lds, const Fin fin) {
  int tid_ = threadIdx.x; asm volatile("" : "+v"(tid_));
  const int tid = tid_, wid = tid >> 6, lane = tid & 63, r32 = lane & 31, hi = lane >> 5;
  bf16* V_lds = (bf16*)lds; bf16* K_lds = (bf16*)(lds + 2 * SHM_V);
  float* ws = (float*)(lds + 2 * SHM_V + 2 * SHM_K) + wid * 64; float* li_l = ws; float* al_l = ws + 32;
  float m_reg = -1e30f, l_reg = 0; f32x16 o[4] = {}; bf16x8 qr[4];
  const bf16* Qw = Qb + (long)(wid * QBLK + r32) * LD + hi * 8;
#pragma unroll
  for (int d0 = 0; d0 < 4; ++d0) qr[d0] = *reinterpret_cast<const bf16x8*>(Qw + d0 * 16);
  const int sr = tid >> 4, sc = (tid & 15) * 8, vst0 = v_st(sr, sc), vst1 = v_st(32 + sr, sc);
  const int kr = tid >> 3, kc = (tid & 7) * 8;
  const int vb0 = (int)(uintptr_t)V_lds + v_rd_base(lane);
  struct { bf16x8 vs0, vs1, ks0; } sr_[SDEPTH];
#define SLOAD(i, k0) do { sr_[i].vs0 = *reinterpret_cast<const bf16x8*>(&Vh[(long)((k0) + sr) * LD + sc]); sr_[i].vs1 = *reinterpret_cast<const bf16x8*>(&Vh[(long)((k0) + 32 + sr) * LD + sc]); \
    sr_[i].ks0 = *reinterpret_cast<const bf16x8*>(&Kh[(long)((k0) + kr) * LD + kc]); } while (0)
#define SWRITE(b, i) do { *(bf16x8*)((char*)V_lds + (b) * SHM_V + vst0) = sr_[i].vs0;          \
    *(bf16x8*)((char*)V_lds + (b) * SHM_V + vst1) = sr_[i].vs1;               \
    *(bf16x8*)((char*)K_lds + (b) * SHM_K + KSWZ(kr, kc * 2)) = sr_[i].ks0; } while (0)
#define SWAIT() do { if constexpr (SDEPTH == 2) asm volatile("s_waitcnt vmcnt(3)" ::: "memory"); else asm volatile("s_waitcnt vmcnt(0)" ::: "memory"); } while (0)
#define RESC(a) do { if (__any((a) < 1.f)) { if (hi == 0) al_l[r32] = (a); asm volatile("s_waitcnt lgkmcnt(0)" ::: "memory"); \
    for (int d = 0; d < 4; ++d) for (int r = 0; r < 16; ++r) o[d][r] *= al_l[crow(r, hi)]; } } while (0)
  f32x16 pA0, pA1, pB0, pB1; float mnA, mnB, alA, alB; bf16x8 pa0, pa1, pa2, pa3; const int NT = seq / KVBLK;
  constexpr int SE = 0, SO = SDEPTH - 1;
  SLOAD(SE, 0); asm volatile("s_waitcnt vmcnt(0)" ::: "memory"); SWRITE(0, SE); __syncthreads();
  qkt(pA0, pA1, K_lds, qr, r32, hi); partialSM(pA0, pA1, m_reg, mnA, alA);
  SLOAD(SO, KVBLK); if constexpr (SDEPTH == 2) { if (2 < NT) SLOAD(SE, 2 * KVBLK); }
  SWAIT(); SWRITE(1, SO); __syncthreads();
  for (int j = 1; j + 1 < NT; j += 2) {
    SBAR(); qkt(pB0, pB1, (bf16*)((char*)K_lds + SHM_K), qr, r32, hi);
    finishSM(pA0, pA1, alA, l_reg, pa0, pa1, pa2, pa3); SBAR();
    SLOAD(SO, (j + SDEPTH) * KVBLK); SBAR();
    pv_d0(o, vb0, pa0, pa1, pa2, pa3); partialSM(pB0, pB1, m_reg, mnB, alB);
    __syncthreads(); SWAIT(); SWRITE(0, SE);
    RESC(alB); __syncthreads();
    SBAR(); qkt(pA0, pA1, K_lds, qr, r32, hi);
    finishSM(pB0, pB1, alB, l_reg, pa0, pa1, pa2, pa3); SBAR();
    if (SDEPTH == 1 || j + 3 < NT) SLOAD(SE, (j + 1 + SDEPTH) * KVBLK); SBAR();
    pv_d0(o, vb0 + (int)SHM_V, pa0, pa1, pa2, pa3); partialSM(pA0, pA1, m_reg, mnA, alA);
    __syncthreads(); SWAIT(); SWRITE(1, SO);
    RESC(alA); __syncthreads();
  }
  SBAR(); qkt(pB0, pB1, (bf16*)((char*)K_lds + SHM_K), qr, r32, hi);
  finishSM(pA0, pA1, alA, l_reg, pa0, pa1, pa2, pa3); SBAR();
  pv_d0(o, vb0, pa0, pa1, pa2, pa3); partialSM(pB0, pB1, m_reg, mnB, alB);
  __syncthreads(); RESC(alB);
  finishSM(pB0, pB1, alB, l_reg, pa0, pa1, pa2, pa3); SBAR();
  pv_d0(o, vb0 + (int)SHM_V, pa0, pa1, pa2, pa3);
  if (hi == 0) li_l[r32] = l_reg; asm volatile("s_waitcnt lgkmcnt(0)" ::: "memory");
  float rli[16];
#pragma unroll
  for (int r = 0; r < 16; ++r) rli[r] = __builtin_amdgcn_rcpf(li_l[crow(r, hi)]);
  float* Ow = Ob + (long)(wid * QBLK) * ldo;
  if constexpr (MODE == 0) {
#pragma unroll
    for (int r = 0; r < 16; ++r) { int orow = crow(r, hi);
      for (int d0 = 0; d0 < 4; ++d0) Ow[(long)orow * ldo + d0 * 32 + r32] = o[d0][r] * rli[r]; }
  } else {
    float sgv[4];
#pragma unroll
    for (int d0 = 0; d0 < 4; ++d0) sgv[d0] = fin.sg[d0 * 32 + r32] * fin.scale;
    bf16* Cw = fin.cat + (long)(wid * QBLK) * 1024;
#pragma unroll
    for (int r = 0; r < 16; ++r) { const int orow = crow(r, hi); float ss = 0.f;
#pragma unroll
      for (int d0 = 0; d0 < 4; ++d0) { const float dv = Ow[(long)orow * ldo + d0 * 32 + r32] - fin.lam * (o[d0][r] * rli[r]); o[d0][r] = dv; ss += dv * dv; }
      ss = sum16_f(ss); ss += __builtin_bit_cast(float, __builtin_amdgcn_ds_swizzle(__builtin_bit_cast(int, ss), 0x401F));
      const float sc = 1.0f / sqrtf(ss * (1.0f / 128.0f) + 1e-5f);
#pragma unroll
      for (int d0 = 0; d0 < 4; ++d0) Cw[(long)orow * 1024 + d0 * 32 + r32] = (bf16)f2bf(o[d0][r] * sc * sgv[d0]); }
  }
  __syncthreads();
#undef SLOAD
#undef SWRITE
#undef SWAIT
#undef RESC
}
#undef KSWZ
#undef SBAR
}

__device__ __forceinline__ void ph_attn(Frame& F0, int i, bool need_ctx) { Frame F = F0; LAUNDER(F);
    const bf16* QB = WSP(bf16, WS_QB); const bf16* KB = WSP(bf16, WS_KB); const bf16* VB = WSP(bf16, WS_VB); float* OB = WSP(float, WS_OB); bf16* CAT = WSP(bf16, WS_CAT);
    const int j = i >> 1; const float* lv = INP(I_LAM) + (size_t)j * 256;
    const float linit = (i == 1) ? 0.35550906759096934f : 0.5560582041556406f;
    const float d1 = wave_sum(lv[F.lane] * lv[64 + F.lane]), d2 = wave_sum(lv[128 + F.lane] * lv[192 + F.lane]);
    const float lam = expf(d1) - expf(d2) + linit;
    const int nun = 512 + (need_ctx ? 32 : 0);
    for (int u = F.vcu; u < nun; u += F.G) {
        const bool lat = u < 512; const int uu = lat ? u : u - 512;
        const int qb = lat ? (uu & 15) : 0, h = lat ? ((uu >> 4) & 7) : (uu & 7), b = lat ? (uu >> 7) : (uu >> 3);
        const size_t qrow = lat ? (size_t)b * SEQ + qb * 256 : (size_t)TLAT + b * CTXL; const int seq = lat ? KSEQ : CTXL;
        const bf16* kb = KB + (size_t)b * KSEQ * DM + h * 128; const bf16* vb = VB + (size_t)b * KSEQ * DM + h * 128;
        const att::Fin fin{lam, 1.0f - linit, INP(I_SUBLN) + (size_t)j * 128, CAT + qrow * DM + h * 128};
        att::attn_body<0>(QB + qrow * DM + h * 128, kb, vb, OB + qrow * DM + h * 128, DM, seq, (char*)F.ldsg, fin);
        att::attn_body<1>(QB + qrow * DM + h * 128 + 64, kb + 64, vb, OB + qrow * DM + h * 128, DM, seq, (char*)F.ldsg, fin);
    }
}
__device__ __forceinline__ void ph_attnfin(Frame& F0, int i, bool need_ctx) { Frame F = F0; LAUNDER(F);
    const int j = i >> 1; const float* lv = INP(I_LAM) + (size_t)j * 256; const float* sg = INP(I_SUBLN) + (size_t)j * 128;
    const float linit = (i == 1) ? 0.35550906759096934f : 0.5560582041556406f;
    const float d1 = wave_sum(lv[F.lane] * lv[64 + F.lane]), d2 = wave_sum(lv[128 + F.lane] * lv[192 + F.lane]);
    const float lam = expf(d1) - expf(d2) + linit;
    const float* OB = WSP(float, WS_OB); bf16* CAT = WSP(bf16, WS_CAT);
    const int nrows = need_ctx ? TT : TLAT;
    for (int row = F.gw; row < nrows; row += F.NGW) {
        const int h = F.lane >> 3, e0 = 16 * (F.lane & 7);
        const float* o0 = OB + (size_t)row * 2048 + (2 * h) * 128 + e0; const float* o1 = o0 + 128;
        float x[16]; float ss = 0.f;
#pragma unroll
        for (int q = 0; q < 4; ++q) { const f32x4 a = *(const f32x4*)(o0 + 4 * q), bb = *(const f32x4*)(o1 + 4 * q); const f32x4 d = a - bb * lam;
            x[4 * q] = d.x; x[4 * q + 1] = d.y; x[4 * q + 2] = d.z; x[4 * q + 3] = d.w; ss += (d.x * d.x + d.y * d.y) + (d.z * d.z + d.w * d.w); }
        ss = sum8_f(ss);
        const float sc = (1.0f - linit) / sqrtf(ss * (1.0f / 128.0f) + 1e-5f);
#pragma unroll
        for (int q = 0; q < 16; ++q) x[q] = x[q] * sc * sg[e0 + q];
#ifdef ABL_ATT
#pragma unroll
        for (int q = 0; q < 16; ++q) x[q] = 0.f;
#endif
        v4u w0, w1; w0.x = pk2(x[0], x[1]); w0.y = pk2(x[2], x[3]); w0.z = pk2(x[4], x[5]); w0.w = pk2(x[6], x[7]); w1.x = pk2(x[8], x[9]); w1.y = pk2(x[10], x[11]); w1.z = pk2(x[12], x[13]); w1.w = pk2(x[14], x[15]);
        bf16* dst = CAT + (size_t)row * DM + h * 128 + e0;
        *(v4u*)dst = w0; *(v4u*)(dst + 8) = w1;
    }
}
#ifdef DBG_MOE
__device__ __forceinline__ void ph_debug_moe(Frame& F0, int i) { Frame F = F0; LAUNDER(F);
    LAS float* xs = (LAS float*)F.lds; LAS float* hs = xs + 1024; LAS float* red = hs + 1024;
    unsigned* dbg = (unsigned*)(F.ws + WS_CTL) + 100;
    for (int s = F.vcu; s < 64; s += F.G) {
        const int e = s & 15, slot = (s * 37) % 2176; const int r = e * EROWS + slot;
        const int tok = WSP(int, WS_IDX)[r]; const float gate = WSP(float, WS_GATE)[r];
        const bf16* hrow = WSP(bf16, WS_HA) + (size_t)tok * DM;
        __syncthreads();
        for (int k = F.tid; k < 1024; k += NTHR) xs[k] = bf2f(hrow[k]);
        __syncthreads();
        const float* w1 = INP(I_MW1) + ((size_t)i * NE + e) * DM * FF; const float* w3 = INP(I_MW3) + ((size_t)i * NE + e) * DM * FF; const float* w2 = INP(I_MW2) + ((size_t)i * NE + e) * FF * DM;
        for (int f = F.tid; f < 1024; f += NTHR) { float a = 0.f, b = 0.f; for (int k = 0; k < 1024; ++k) { a += xs[k] * w1[(size_t)k * FF + f]; b += xs[k] * w3[(size_t)k * FF + f]; }
            hs[f] = a / (1.0f + __expf(-a)) * b; }
        __syncthreads();
        float num = 0.f, den = 0.f;
        for (int d = F.tid; d < 1024; d += NTHR) { float y = 0.f; for (int f = 0; f < 1024; ++f) y += hs[f] * w2[(size_t)f * DM + d]; y *= gate;
            const float yk = bf2f(WSP(bf16, WS_YB)[(size_t)r * DM + d]); num += (y - yk) * (y - yk); den += y * y; }
        num = block_sum(F, num, red); den = block_sum(F, den, red + 8);
        const float rel = sqrtf(num / fmaxf(den, 1e-30f));
        if (F.tid == 0) atomicMax(dbg, __builtin_bit_cast(unsigned, rel));
        if (s < 64) {
            const int set = s >> 4; const int rbase = set * SEQ; int cnt = 0; float mn_sel = 1e30f, mx_uns = -1e30f;
            for (int l = F.tid; l < SEQ; l += NTHR) { const int sl = WSP(int, WS_SLOT)[(size_t)(rbase + l) * 16 + e]; const float a = WSP(float, WS_AFF)[(size_t)(rbase + l) * 16 + e];
                if (sl >= 0) { ++cnt; mn_sel = fminf(mn_sel, a); if (sl >= 512 || WSP(int, WS_IDX)[e * EROWS + set * 512 + sl] != rbase + l) atomicAdd(dbg + 1, 1u); } else mx_uns = fmaxf(mx_uns, a); }
            const float tc = block_sum(F, (float)cnt, red);
            float a1 = -mn_sel, a2 = mx_uns;
#pragma unroll
            for (int o = 1; o < 64; o <<= 1) { a1 = fmaxf(a1, __shfl_xor(a1, o)); a2 = fmaxf(a2, __shfl_xor(a2, o)); }
            __syncthreads(); if (F.lane == 0) { red[F.wave] = a1; red[8 + F.wave] = a2; } __syncthreads();
            float m1 = red[0], m2 = red[8];
            for (int w = 1; w < 8; ++w) { m1 = fmaxf(m1, red[w]); m2 = fmaxf(m2, red[8 + w]); }
            if (F.tid == 0) { if ((int)tc != 512) atomicAdd(dbg + 2, 1u); if (-m1 < m2) atomicAdd(dbg + 3, 1u); atomicAdd(dbg + 4, (unsigned)(int)tc); }
        }
    }
}
#endif
__device__ __forceinline__ void ph_debug_out(Frame& F0) { Frame F = F0; LAUNDER(F);
    const unsigned* dbg = (const unsigned*)(F.ws + WS_CTL) + 100;
    const float e1 = __builtin_bit_cast(float, dbg[0]); const unsigned v2 = dbg[1];
#ifdef DBG_SEL2
    const float d1 = 1.0f + (float)dbg[2] + 100.0f * (float)dbg[3];
#elif defined(DBG_SEL3)
    const float d1 = (float)dbg[4] / 64.0f / 16.0f;
#else
    const float d1 = 1.0f + 10.0f * fminf(e1, 3.0f);
#endif
    float d2 = 10.0f + (float)v2 * 0.1f; d2 = fminf(d2, 900.f);
    for (size_t idx = (size_t)F.gw * 64 + F.lane; idx < (size_t)TLAT * DM; idx += (size_t)F.NGW * 64) F.out[idx] = idx == 0 ? d2 : d1;
}
constexpr int PH_PER_LAYER = 13, N_PHASES = 3 + DEPTH * PH_PER_LAYER;
#ifndef PH_MASK
#define PH_MASK 0xFFFFFFFFu
#endif
#define PK_ON(k) ((PH_MASK >> (k)) & 1u)

__device__ __forceinline__ bool phase_is_nop(int ph) {
    if (ph < 3) return false; const int i = (ph - 3) / PH_PER_LAYER, p = (ph - 3) % PH_PER_LAYER; return p == 4 || p == 9 || ((i & 1) && (p == 1 || p == 3 || p == 5));
}

__device__ __forceinline__ int phase_kind(int ph) {
    if (ph < 3) return ph;
    const int i = (ph - 3) / PH_PER_LAYER, p = (ph - 3) % PH_PER_LAYER; const bool even = !(i & 1);
    switch (p) { case 0: return even ? 3 : 4; case 1: return even ? 5 : 6; case 2: return even ? 7 : 8; case 3: return even ? 9 : 10; case 4: return 11; case 5: return 12; case 6: return 13;
                 case 7: return 14; case 8: return 15; case 9: return 16; case 10: return 17; case 11: return 18; default: return 19; }
}
#ifndef PROBE_MASK
#define PROBE_MASK 0u
#endif
#ifndef PROBE_DIV
#define PROBE_DIV 100.0f
#endif
__global__ void __launch_bounds__(NTHR, 2) mega_fwd(Args args) {
    extern __shared__ __attribute__((aligned(16))) unsigned char lds[];
    Frame F;
    F.lds = (LAS unsigned char*)lds; F.ldsg = lds;
    F.MISC = (volatile LAS unsigned*)(F.lds + LDSCTL_OFF + 320);
    F.tid = threadIdx.x; F.lane = F.tid & 63; F.wave = __builtin_amdgcn_readfirstlane(F.tid >> 6);
    F.G = gridDim.x; { const int bx = blockIdx.x; F.vcu = (F.G % 8 == 0) ? (bx % 8) * (F.G / 8) + bx / 8 : bx; }
    F.gw = F.vcu * NWAVES + F.wave; F.NGW = F.G * NWAVES;
    F.tprobe = 0ull;
    F.in = (const GAS float* const __attribute__((address_space(4)))*)__builtin_amdgcn_kernarg_segment_ptr();
    F.ws = (GAS unsigned char*)args.ws; F.out = (GAS float*)args.out;
    for (int u = F.tid; u < (LDS_BYTES - LDSCTL_OFF) / 4; u += NTHR) ((LAS unsigned*)(F.lds + LDSCTL_OFF))[u] = 0u;
    __syncthreads();
    XcdBarrier bar; bar.bar = (unsigned*)(F.ws + WS_CTL) + CW_BAR; bar.x = 0; bar.st = nullptr;
    const int lo = args.ph_lo, hi = args.ph_hi;
    if (hi - lo > 1) bar = xcd_barrier_post((unsigned*)(F.ws + WS_CTL) + CW_BAR, F.MISC + 8);

    Frame F0 = F;
    unsigned long long t_prev = 0ull, t_acc = 0ull;
    if (PROBE_MASK) t_prev = __builtin_amdgcn_s_memrealtime();
    for (int ph = lo; ph < hi; ++ph) {
        if (phase_is_nop(ph)) continue;
        Frame F = F0; LAUNDER(F);
#ifdef DBG_MOE
        if (ph == 1000) { ph_debug_moe(F, 0); VM_WAIT(); continue; }
        if (ph == 1001) { ph_debug_out(F); VM_WAIT(); continue; }
#endif
        if (ph == 0) { if (PK_ON(0)) ph_prologue(F); }
        else if (ph == 1) { if (PK_ON(1)) ph_modred(F); }
        else if (ph == 2) { if (PK_ON(2)) ph_mod0(F); }
        else {
            const int i = (ph - 3) / PH_PER_LAYER, p = (ph - 3) % PH_PER_LAYER, j = i >> 1; const bool even = !(i & 1), need_ctx = i < DEPTH - 1;
            if (p == 0) {
                if (even) { if (PK_ON(3)) { pg8::Gemm g{WSP(bf16, WS_HA), WSP(bf16, WS_WIN) + (size_t)j * EVCP * DM, TT, EVCP, DM, nullptr}; pg8::StaticOrder S; S.init(TT, EVCP, F.G, (int)blockIdx.x);
                    pg8::EpiEven E{WSP(float, WS_P), EVCP, WSP(float, WS_UTL), WSP(float, WS_UTC)}; pg8::gemm_phase<pg8::EpiEven, pg8::StaticOrder, true, true>(F.lds, g, S, E); } }
                else if (PK_ON(4)) { pg8::Gemm g{WSP(bf16, WS_HA), WSP(bf16, WS_WQKV) + (size_t)j * QKVC * DM, TT, QKVC, DM, nullptr}; pg8::StaticOrder S; S.init(TT, QKVC, F.G, (int)blockIdx.x);
                    pg8::EpiQKV E{WSP(bf16, WS_QB), WSP(bf16, WS_KB), WSP(bf16, WS_VB)}; pg8::gemm_phase<pg8::EpiQKV, pg8::StaticOrder, true, true>(F.lds, g, S, E);
                    if (moe_hosting(F, i) && (int)blockIdx.x >= 48) moe_convert_hosted(F, i, (int)blockIdx.x); }
            } else if (p == 1) { if (even) { if (PK_ON(5)) ph_evprep(F, j); } else {   } }
            else if (p == 2) { if (even) { if (PK_ON(7)) ph_chunkprep(F, j); } else { if (PK_ON(8)) ph_attn(F, i, need_ctx); } }
            else if (p == 3) { if (even) { if (PK_ON(9)) ph_scan_hyena(F, j, i); } else {   } }
            else if (p == 4) {   }
            else if (p == 5) { if (PK_ON(12)) ph_readout(F, j); }
            else if (p == 6) { if (PK_ON(13)) {
                pg8::Gemm g{WSP(bf16, WS_CAT), (even ? WSP(bf16, WS_WOE) : WSP(bf16, WS_WOD)) + (size_t)j * DM * DM, TLAT, DM, DM, nullptr}; pg8::StaticOrder S; S.init(TLAT, DM, F.G, (int)blockIdx.x);
                pg8::EpiResGate E{WSP(float, WS_X), WSP(float, WS_MODS) + (size_t)i * 5 * 6144}; pg8::gemm_phase<pg8::EpiResGate, pg8::StaticOrder, true, true>(F.lds, g, S, E); }
            } else if (p == 7) { if (PK_ON(14)) ph_mod2(F, i, (even ? WSP(bf16, WS_WOE) : WSP(bf16, WS_WOD)) + (size_t)j * DM * DM); }
            else if (p == 8) { if (PK_ON(15)) ph_topk(F, i); }
            else if (p == 9) {   }
            else if (p == 10) { if (PK_ON(17)) {
                pg8::Gemm g{WSP(bf16, WS_HA), WSP(bf16, WS_W13), NE * EROWS, NE * 2048, DM, WSP(int, WS_IDX)};     pg8::MoeOrder S{F.G, F.vcu, 8, (need_ctx && F.G != 256) ? 9 : 8};
                pg8::EpiSwiGLU E{WSP(bf16, WS_HB)}; pg8::gemm_phase<pg8::EpiSwiGLU, pg8::MoeOrder, true, true, true>(F.lds, g, S, E); }
            } else if (p == 11) { if (PK_ON(18)) {
                if (need_ctx && F.G == 256) {
                    unsigned* mctr = (unsigned*)(F.ws + WS_CTL) + 3072 + 64 * i;
                    if (F.vcu < 128) {
                        pg8::Gemm g1{WSP(bf16, WS_HA), WSP(bf16, WS_W13), NE * EROWS, NE * 2048, DM, WSP(int, WS_IDX)}; pg8::OneUnit S1{(F.vcu >> 3) * 9 + 8, (F.vcu >> 3) * 8 + (F.vcu & 7)};
                        pg8::EpiSwiGLU E1{WSP(bf16, WS_HB)}; pg8::gemm_phase<pg8::EpiSwiGLU, pg8::OneUnit, true, true, true>(F.lds, g1, S1, E1);
                        subset_arrive(mctr);
                    }
                    pg8::Gemm g{WSP(bf16, WS_HB), WSP(bf16, WS_W2), NE * EROWS, NE * 1024, FF, nullptr}; pg8::Moe2Order S{F.vcu, mctr};
                    pg8::EpiGateBf16 E{WSP(bf16, WS_YB), WSP(float, WS_GATE)}; pg8::gemm_phase<pg8::EpiGateBf16, pg8::Moe2Order, true, true>(F.lds, g, S, E);
                } else {
                    pg8::Gemm g{WSP(bf16, WS_HB), WSP(bf16, WS_W2), NE * EROWS, NE * 1024, FF, nullptr}; pg8::MoeOrder S{F.G, F.vcu, 4, need_ctx ? 9 : 8};
                    pg8::EpiGateBf16 E{WSP(bf16, WS_YB), WSP(float, WS_GATE)}; pg8::gemm_phase<pg8::EpiGateBf16, pg8::MoeOrder, true, true>(F.lds, g, S, E);
                } }
            } else { if (PK_ON(19)) ph_combine(F, i); }
        }
        if (PROBE_SUB) F0.tprobe = F.tprobe;
        if (ph + 1 < hi) xcd_barrier(bar); else { VM_WAIT(); }
        if (PROBE_MASK) { const unsigned long long t_now = __builtin_amdgcn_s_memrealtime(); if ((PROBE_MASK >> phase_kind(ph)) & 1u) t_acc += t_now - t_prev; t_prev = t_now; }
    }
    if (PROBE_MASK) { if (blockIdx.x == 0 && threadIdx.x == 0 && hi == N_PHASES) { const float us = (float)(PROBE_SUB ? F0.tprobe : t_acc) * 0.01f; F0.out[0] += 2.0f + us / PROBE_DIV; } }
}

extern "C" void kernel_launch(void* const* d_in, const int* in_sizes, int n_in, void* d_out, int out_size, void* d_ws, size_t ws_size, hipStream_t stream) {
    static int grid = 0;
    if (grid == 0) {
        if (n_in != N_IN || out_size != TLAT * DM || ws_size < WS_END) { fprintf(stderr, "kernel_launch: unexpected shapes: n_in %d out %d ws %zu (need %zu)\n", n_in, out_size, ws_size, (size_t)WS_END); grid = -1; return; }
        int dev = 0, cus = 0, per_cu = 0;
        if (hipGetDevice(&dev) != hipSuccess || hipDeviceGetAttribute(&cus, hipDeviceAttributeMultiprocessorCount, dev) != hipSuccess) { grid = -1; return; }
        if (hipFuncSetAttribute((const void*)mega_fwd, hipFuncAttributeMaxDynamicSharedMemorySize, LDS_BYTES) != hipSuccess) { fprintf(stderr, "kernel_launch: hipFuncSetAttribute failed\n"); grid = -1; return; }
        if (hipOccupancyMaxActiveBlocksPerMultiprocessor(&per_cu, (const void*)mega_fwd, NTHR, LDS_BYTES) != hipSuccess || per_cu < 1) fprintf(stderr, "kernel_launch: occupancy query reports %d\n", per_cu);
        (void)hipGetLastError();
        grid = cus;
    }
    if (grid < 0) return;
    if (hipMemsetAsync((char*)d_ws + WS_CTL, 0, CTL_ZERO_BYTES, stream) != hipSuccess) { fprintf(stderr, "kernel_launch: memset failed\n"); return; }
    Args a{};
    for (int i = 0; i < N_IN; ++i) a.in[i] = (const float*)d_in[i];
    a.out = (float*)d_out; a.ws = (unsigned char*)d_ws;
#if MK_PER_PHASE
    for (int ph = 0; ph < N_PHASES; ++ph) {
#ifdef DBG_MOE
        if (ph == 3 + 12) { a.ph_lo = 1000; a.ph_hi = 1001; hipLaunchKernelGGL(mega_fwd, dim3(grid), dim3(NTHR), LDS_BYTES, stream, a); a.ph_lo = 1001; a.ph_hi = 1002; hipLaunchKernelGGL(mega_fwd, dim3(grid), dim3(NTHR), LDS_BYTES, stream, a); break; }
#endif
        if ((ph >= 3) && ((((ph - 3) % PH_PER_LAYER) == 4) || (((ph - 3) % PH_PER_LAYER) == 9) || ((((ph - 3) / PH_PER_LAYER) & 1) && (((ph - 3) % PH_PER_LAYER) == 1 || ((ph - 3) % PH_PER_LAYER) == 3 || ((ph - 3) % PH_PER_LAYER) == 5)))) continue;
        a.ph_lo = ph; a.ph_hi = ph + 1;
        hipLaunchKernelGGL(mega_fwd, dim3(grid), dim3(NTHR), LDS_BYTES, stream, a);
    }
#else
    a.ph_lo = 0; a.ph_hi = N_PHASES;
    hipLaunchKernelGGL(mega_fwd, dim3(grid), dim3(NTHR), LDS_BYTES, stream, a);
#endif
    const hipError_t le = hipPeekAtLastError();
    if (le != hipSuccess) fprintf(stderr, "kernel_launch: launch failed: %s\n", hipGetErrorName(le));
}
```
